# Optimizing an MI355X kernel written in HIP

```python
import jax
import jax.numpy as jnp
from jax import lax
import numpy as np

D_MODEL = 1024
BATCH = 8
SEQ = 2048
DEPTH = 1
DEC_BATCH = 128
DEC_SEQ = 4
PAST_LEN = 8192
PAGE_SIZE = 128

A_GROUPS = 8
A_GROUP_DIM = 64
A_WIDTH = A_GROUPS * A_GROUP_DIM
CHUNK = 128
MLA_HEADS = 8
Q_LORA = 256
KV_LORA = 256
QK_NOPE = 64
QK_ROPE = 32
QK_HEAD = QK_NOPE + QK_ROPE
V_HEAD = 64
B_WIDTH = MLA_HEADS * V_HEAD
MIX_WIDTH = A_WIDTH + B_WIDTH
ROPE_THETA = 10000.0
Q_BLOCK = 128
OFF_CQ = 2 * A_WIDTH
OFF_CKV = OFF_CQ + Q_LORA
OFF_KPE = OFF_CKV + KV_LORA
N_IN = OFF_KPE + QK_ROPE
MEM_LEN = 256
MEM_HEADS = 4
MEM_HEAD_DIM = 128
MEM_WIDTH = MEM_HEADS * MEM_HEAD_DIM
D_FF = 2816
CONV_W = 3
EPS = 1e-6
NEG_INF = -1e30

kernel_name = 'hymba_gmlp_mla_memxattn_convffn_step'


def rms_norm(x, g):
    xf = x.astype(jnp.float32)
    y = xf * lax.rsqrt(jnp.mean(xf * xf, axis=-1, keepdims=True) + EPS)
    return (y * g.astype(jnp.float32)).astype(x.dtype)


def layer_norm(x, g, b):
    xf = x.astype(jnp.float32)
    xc = xf - jnp.mean(xf, axis=-1, keepdims=True)
    y = xc * lax.rsqrt(jnp.mean(xc * xc, axis=-1, keepdims=True) + EPS)
    return (y * g.astype(jnp.float32) + b.astype(jnp.float32)).astype(x.dtype)


def split_in(z):
    return (z[..., :A_WIDTH], z[..., A_WIDTH:OFF_CQ], z[..., OFF_CQ:OFF_CKV],
            z[..., OFF_CKV:OFF_KPE], z[..., OFF_KPE:N_IN])


def qk_rope(x, pos):
    half = QK_ROPE // 2
    inv_freq = ROPE_THETA ** (-jnp.arange(half, dtype=jnp.float32) / half)
    ang = pos.astype(jnp.float32)[:, None] * inv_freq[None, :]
    cos = jnp.cos(ang)[:, None, :]
    sin = jnp.sin(ang)[:, None, :]
    x1 = x[..., QK_NOPE:QK_NOPE + half].astype(jnp.float32)
    x2 = x[..., QK_NOPE + half:].astype(jnp.float32)
    rot = jnp.concatenate([x1 * cos - x2 * sin, x2 * cos + x1 * sin], axis=-1).astype(x.dtype)
    return jnp.concatenate([x[..., :QK_NOPE], rot], axis=-1)


def chunk_gmlp(u, v, w_s, b_s, ln_g, ln_b):
    n, t, _ = u.shape
    c = min(t, CHUNK)
    vg = layer_norm(jax.nn.gelu(v).reshape(n, t // c, c, A_GROUPS, A_GROUP_DIM), ln_g, ln_b)
    w = jnp.where(jnp.tril(jnp.ones((c, c), dtype=bool)), w_s[:, :c, :c], 0.0).astype(vg.dtype)
    mixed = jnp.einsum('gts,nmsgd->nmtgd', w, vg) + b_s[:, :c].T[:, :, None].astype(vg.dtype)
    out = jax.nn.gelu(u) * mixed.reshape(n, t, A_WIDTH)
    return out, vg.reshape(n, t, A_GROUPS, A_GROUP_DIM)


def mla_queries(cq, pos, g_q_a, w_uq, g_qk_q):
    n, t, _ = cq.shape
    q = (rms_norm(cq, g_q_a) @ w_uq).reshape(n, t, MLA_HEADS, QK_HEAD)
    return qk_rope(rms_norm(q, g_qk_q), pos)


def mla_keys_values(ckv_n, kpe, pos, w_uk, w_uv, g_qk_k):
    lead = ckv_n.shape[:-1]
    k_nope = (ckv_n @ w_uk).reshape(*lead, MLA_HEADS, QK_NOPE)
    v = (ckv_n @ w_uv).reshape(*lead, MLA_HEADS, V_HEAD)
    k_pe = jnp.broadcast_to(kpe[..., None, :], (*lead, MLA_HEADS, QK_ROPE))
    k = qk_rope(rms_norm(jnp.concatenate([k_nope, k_pe], axis=-1), g_qk_k), pos)
    return k, v


def masked_attend(q, k, v, q_pos, k_pos):
    s = jnp.einsum('...qhd,...khd->...hqk', q, k).astype(jnp.float32) * (QK_HEAD ** -0.5)
    s = jnp.where(k_pos[None, :] <= q_pos[:, None], s, NEG_INF)
    p = jax.nn.softmax(s, axis=-1).astype(v.dtype)
    return jnp.einsum('...hqk,...khd->...qhd', p, v)


def mla_prompt_attend(q, k, v):
    n, s = q.shape[:2]
    nb = s // Q_BLOCK
    pos = jnp.arange(s)
    qb = q.reshape(n, nb, Q_BLOCK, MLA_HEADS, QK_HEAD).swapaxes(0, 1)

    def block(args):
        q_blk, start = args
        return masked_attend(q_blk, k, v, start + jnp.arange(Q_BLOCK), pos)

    o = lax.map(block, (qb, jnp.arange(nb) * Q_BLOCK))
    return o.swapaxes(0, 1).reshape(n, s, B_WIDTH)


def mla_sample_attend(q, ckv_n, kpe, pool_ckv, pool_kpe, page_table, w_uk, w_uv, g_qk_k):
    n, t = q.shape[:2]
    q_pos = PAST_LEN + jnp.arange(t)
    k_pos = jnp.arange(PAST_LEN + t)

    def one(args):
        pages, q1, c1, pe1 = args
        c_all = jnp.concatenate([pool_ckv[pages].reshape(PAST_LEN, KV_LORA), c1.astype(pool_ckv.dtype)], axis=0)
        pe_all = jnp.concatenate([pool_kpe[pages].reshape(PAST_LEN, QK_ROPE), pe1.astype(pool_kpe.dtype)], axis=0)
        k, v = mla_keys_values(c_all, pe_all, k_pos, w_uk, w_uv, g_qk_k)
        return masked_attend(q1, k, v, q_pos, k_pos)

    o = lax.map(one, (page_table, q, ckv_n, kpe))
    return o.reshape(n, t, B_WIDTH)


def merge_out(a_out, b_out, g_out_a, g_out_b, w_o):
    return jnp.concatenate([rms_norm(a_out, g_out_a), rms_norm(b_out, g_out_b)], axis=-1) @ w_o


def mem_kv(mem, g_mem_in, w_mk, w_mv, g_mk):
    n, m, _ = mem.shape
    hm = rms_norm(mem, g_mem_in)
    k = rms_norm((hm @ w_mk).reshape(n, m, MEM_HEADS, MEM_HEAD_DIM), g_mk)
    v = (hm @ w_mv).reshape(n, m, MEM_HEADS, MEM_HEAD_DIM)
    return k, v


def mem_attend(h, mk, mv, w_mq, g_mq, w_mo):
    n, t, _ = h.shape
    q = rms_norm((h @ w_mq).reshape(n, t, MEM_HEADS, MEM_HEAD_DIM), g_mq)
    s = jnp.einsum('nthd,nmhd->nhtm', q, mk.astype(q.dtype)).astype(jnp.float32) * (MEM_HEAD_DIM ** -0.5)
    p = jax.nn.softmax(s, axis=-1).astype(q.dtype)
    o = jnp.einsum('nhtm,nmhd->nthd', p, mv.astype(q.dtype)).reshape(n, t, MEM_WIDTH)
    return o @ w_mo


def conv_ffn(h, buf, w_up, w_conv, b_conv, w_down):
    t = h.shape[1]
    gate, val = jnp.split(h @ w_up, 2, axis=-1)
    gpad = jnp.concatenate([buf.astype(gate.dtype), gate], axis=1)
    conv = b_conv + sum(gpad[:, j:j + t] * w_conv[j] for j in range(CONV_W))
    return (jax.nn.silu(conv) * val) @ w_down, gpad[:, t:]


def setup_inputs(seed: int = 0) -> dict:
    key = jax.random.key(seed)
    ks = iter(jax.random.split(key, 48))

    def nrm(shape, scale=1.0):
        return jax.random.normal(next(ks), shape, jnp.float32) * scale

    def gain(shape):
        return 1.0 + 0.02 * jax.random.normal(next(ks), shape, jnp.float32)

    n_pages = PAST_LEN // PAGE_SIZE
    n_phys = (DEC_BATCH * n_pages * 5) // 4
    L = DEPTH
    inputs = {
        'x_prompt': nrm((BATCH, SEQ, D_MODEL)),
        'x_sample': nrm((DEC_BATCH, DEC_SEQ, D_MODEL)),
        'cache_ckv': nrm((L, n_phys, PAGE_SIZE, KV_LORA)),
        'cache_kpe': nrm((L, n_phys, PAGE_SIZE, QK_ROPE)),
        'cache_mem_k': nrm((L, DEC_BATCH, MEM_LEN, MEM_HEADS, MEM_HEAD_DIM)),
        'cache_mem_v': nrm((L, DEC_BATCH, MEM_LEN, MEM_HEADS, MEM_HEAD_DIM)),
        'state_ffn_conv': nrm((L, DEC_BATCH, CONV_W - 1, D_FF)),
        'page_table': jax.random.permutation(next(ks), n_phys)[:DEC_BATCH * n_pages]
                      .reshape(DEC_BATCH, n_pages).astype(jnp.int32),
        'mem_prompt': nrm((BATCH, MEM_LEN, D_MODEL)),
        'g_mix': gain((L, D_MODEL)),
        'w_in': nrm((L, D_MODEL, N_IN), D_MODEL ** -0.5),
        'ln_v_g': gain((L, A_GROUPS, A_GROUP_DIM)),
        'ln_v_b': nrm((L, A_GROUPS, A_GROUP_DIM), 0.02),
        'w_s': nrm((L, A_GROUPS, CHUNK, CHUNK), CHUNK ** -0.5),
        'b_s': gain((L, A_GROUPS, CHUNK)),
        'g_q_a': gain((L, Q_LORA)),
        'w_uq': nrm((L, Q_LORA, MLA_HEADS * QK_HEAD), Q_LORA ** -0.5),
        'g_kv_a': gain((L, KV_LORA)),
        'w_uk': nrm((L, KV_LORA, MLA_HEADS * QK_NOPE), KV_LORA ** -0.5),
        'w_uv': nrm((L, KV_LORA, MLA_HEADS * V_HEAD), KV_LORA ** -0.5),
        'g_qk_q': gain((L, QK_HEAD)),
        'g_qk_k': gain((L, QK_HEAD)),
        'g_out_a': gain((L, A_WIDTH)),
        'g_out_b': gain((L, B_WIDTH)),
        'w_o': nrm((L, MIX_WIDTH, D_MODEL), MIX_WIDTH ** -0.5),
        'g_mem_x': gain((L, D_MODEL)),
        'g_mem_in': gain((L, D_MODEL)),
        'w_mq': nrm((L, D_MODEL, MEM_WIDTH), D_MODEL ** -0.5),
        'w_mk': nrm((L, D_MODEL, MEM_WIDTH), D_MODEL ** -0.5),
        'w_mv': nrm((L, D_MODEL, MEM_WIDTH), D_MODEL ** -0.5),
        'g_mq': gain((L, MEM_HEAD_DIM)),
        'g_mk': gain((L, MEM_HEAD_DIM)),
        'w_mo': nrm((L, MEM_WIDTH, D_MODEL), MEM_WIDTH ** -0.5),
        'g_ffn': gain((L, D_MODEL)),
        'w_up': nrm((L, D_MODEL, 2 * D_FF), D_MODEL ** -0.5),
        'w_conv': nrm((L, CONV_W, D_FF), CONV_W ** -0.5),
        'b_conv': nrm((L, D_FF), 0.02),
        'w_down': nrm((L, D_FF, D_MODEL), D_FF ** -0.5),
    }
    return inputs


def reference(x_prompt, x_sample, cache_ckv, cache_kpe, cache_mem_k, cache_mem_v, state_ffn_conv,
              page_table, mem_prompt,
              g_mix, w_in, ln_v_g, ln_v_b, w_s, b_s, g_q_a, w_uq, g_kv_a, w_uk, w_uv, g_qk_q, g_qk_k,
              g_out_a, g_out_b, w_o, g_mem_x, g_mem_in, w_mq, w_mk, w_mv, g_mq, g_mk, w_mo,
              g_ffn, w_up, w_conv, b_conv, w_down):
    n_p, s = x_prompt.shape[:2]
    t = x_sample.shape[1]
    pos_p = jnp.arange(s)
    pos_s = PAST_LEN + jnp.arange(t)
    xp, xs = x_prompt, x_sample
    p_ckv, p_kpe, p_mk, p_mv, p_conv = [], [], [], [], []
    s_ckv, s_kpe, s_chunk_v, s_conv = [], [], [], []
    for l in range(DEPTH):
        u, v, cq, ckv, kpe = split_in(rms_norm(xp, g_mix[l]) @ w_in[l])
        a_out, _ = chunk_gmlp(u, v, w_s[l], b_s[l], ln_v_g[l], ln_v_b[l])
        ckv_n = rms_norm(ckv, g_kv_a[l])
        q = mla_queries(cq, pos_p, g_q_a[l], w_uq[l], g_qk_q[l])
        k, vv = mla_keys_values(ckv_n, kpe, pos_p, w_uk[l], w_uv[l], g_qk_k[l])
        b_out = mla_prompt_attend(q, k, vv)
        xp = xp + merge_out(a_out, b_out, g_out_a[l], g_out_b[l], w_o[l])
        p_ckv.append(ckv_n)
        p_kpe.append(kpe)
        mk, mv = mem_kv(mem_prompt, g_mem_in[l], w_mk[l], w_mv[l], g_mk[l])
        xp = xp + mem_attend(rms_norm(xp, g_mem_x[l]), mk, mv, w_mq[l], g_mq[l], w_mo[l])
        p_mk.append(mk)
        p_mv.append(mv)
        y, buf = conv_ffn(rms_norm(xp, g_ffn[l]), jnp.zeros((n_p, CONV_W - 1, D_FF), xp.dtype),
                          w_up[l], w_conv[l], b_conv[l], w_down[l])
        xp = xp + y
        p_conv.append(buf)

        u, v, cq, ckv, kpe = split_in(rms_norm(xs, g_mix[l]) @ w_in[l])
        a_out, v_rows = chunk_gmlp(u, v, w_s[l], b_s[l], ln_v_g[l], ln_v_b[l])
        ckv_n = rms_norm(ckv, g_kv_a[l])
        q = mla_queries(cq, pos_s, g_q_a[l], w_uq[l], g_qk_q[l])
        b_out = mla_sample_attend(q, ckv_n, kpe, cache_ckv[l], cache_kpe[l], page_table,
                                  w_uk[l], w_uv[l], g_qk_k[l])
        xs = xs + merge_out(a_out, b_out, g_out_a[l], g_out_b[l], w_o[l])
        s_ckv.append(ckv_n)
        s_kpe.append(kpe)
        s_chunk_v.append(v_rows)
        xs = xs + mem_attend(rms_norm(xs, g_mem_x[l]), cache_mem_k[l], cache_mem_v[l], w_mq[l], g_mq[l], w_mo[l])
        y, buf = conv_ffn(rms_norm(xs, g_ffn[l]), state_ffn_conv[l], w_up[l], w_conv[l], b_conv[l], w_down[l])
        xs = xs + y
        s_conv.append(buf)
    return (xp, xs, jnp.stack(p_ckv), jnp.stack(p_kpe), jnp.stack(p_mk), jnp.stack(p_mv), jnp.stack(p_conv),
            jnp.stack(s_ckv), jnp.stack(s_kpe), jnp.stack(s_chunk_v), jnp.stack(s_conv))
```

```cpp
#include <hip/hip_runtime.h>
#include <cstdio>
#include <cstdint>
#include <cmath>
namespace nv {
constexpr int D = 1024, NIN = 1568, AW = 512, NP_TOK = 16384, NS_TOK = 512, SEQ = 2048, TS = 4, PAST = 8192;
constexpr int DFF = 2816, MEMLEN = 256;
constexpr float EPS = 1e-6f;

__device__ __forceinline__ float gelu_tanh(float x) {
    const float k0 = 0.7978845608028654f, k1 = 0.044715f;
    float u = k0 * (x + k1 * x * x * x);
    return 0.5f * x * (1.f + tanhf(u));
}
__device__ __forceinline__ float wsum(float v) {
#pragma unroll
    for (int o = 32; o > 0; o >>= 1) v += __shfl_xor(v, o);
    return v;
}
__device__ __forceinline__ float wmax(float v) {
#pragma unroll
    for (int o = 32; o > 0; o >>= 1) v = fmaxf(v, __shfl_xor(v, o));
    return v;
}

template <bool RES>
__global__ __launch_bounds__(256) void gemm(const float* __restrict__ A, int lda, const float* __restrict__ B, int ldb,
                                            float* C, int ldc, const float* R, int ldr, int M, int N, int K) {
    __shared__ float As[16][68];
    __shared__ float Bs[16][68];
    const int tx = threadIdx.x % 16, ty = threadIdx.x / 16;
    const int m0 = blockIdx.y * 64, n0 = blockIdx.x * 64;
    float acc[4][4];
#pragma unroll
    for (int i = 0; i < 4; ++i)
#pragma unroll
        for (int j = 0; j < 4; ++j) acc[i][j] = 0.f;
    for (int k0 = 0; k0 < K; k0 += 16) {
#pragma unroll
        for (int i = 0; i < 4; ++i) {
            int idx = threadIdx.x + i * 256;
            int m = idx / 16, k = idx % 16;
            As[k][m] = (m0 + m < M) ? A[(size_t)(m0 + m) * lda + k0 + k] : 0.f;
        }
#pragma unroll
        for (int i = 0; i < 4; ++i) {
            int idx = threadIdx.x + i * 256;
            int k = idx / 64, n = idx % 64;
            Bs[k][n] = (n0 + n < N) ? B[(size_t)(k0 + k) * ldb + n0 + n] : 0.f;
        }
        __syncthreads();
#pragma unroll
        for (int k = 0; k < 16; ++k) {
            float a[4], b[4];
#pragma unroll
            for (int i = 0; i < 4; ++i) { a[i] = As[k][ty * 4 + i]; b[i] = Bs[k][tx * 4 + i]; }
#pragma unroll
            for (int i = 0; i < 4; ++i)
#pragma unroll
                for (int j = 0; j < 4; ++j) acc[i][j] += a[i] * b[j];
        }
        __syncthreads();
    }
#pragma unroll
    for (int i = 0; i < 4; ++i) {
        int m = m0 + ty * 4 + i;
        if (m >= M) continue;
#pragma unroll
        for (int j = 0; j < 4; ++j) {
            int n = n0 + tx * 4 + j;
            if (n >= N) continue;
            float v = acc[i][j];
            if (RES) v += R[(size_t)m * ldr + n];
            C[(size_t)m * ldc + n] = v;
        }
    }
}

__global__ __launch_bounds__(256) void rmsnorm_rows(const float* x, long ldx, const float* g, float* out, long ldo, int nrows, int dim) {
    int row = blockIdx.x * 4 + (threadIdx.x >> 6), lane = threadIdx.x & 63;
    if (row >= nrows) return;
    const float* xr = x + (size_t)row * ldx;
    float s = 0.f;
    for (int i = lane; i < dim; i += 64) { float v = xr[i]; s += v * v; }
    s = wsum(s);
    float r = rsqrtf(s / (float)dim + EPS);
    float* o = out + (size_t)row * ldo;
    for (int i = lane; i < dim; i += 64) o[i] = xr[i] * r * g[i];
}

__global__ __launch_bounds__(256) void rmsnorm_heads(const float* x, long ldx, const float* g, float* out, long ldo, int nrows, int heads, int hd) {
    int id = blockIdx.x * 4 + (threadIdx.x >> 6), lane = threadIdx.x & 63;
    if (id >= nrows * heads) return;
    int row = id / heads, h = id % heads;
    const float* xr = x + (size_t)row * ldx + h * hd;
    float s = 0.f;
    for (int i = lane; i < hd; i += 64) { float v = xr[i]; s += v * v; }
    s = wsum(s);
    float r = rsqrtf(s / (float)hd + EPS);
    float* o = out + (size_t)row * ldo + h * hd;
    for (int i = lane; i < hd; i += 64) o[i] = xr[i] * r * g[i];
}

__global__ void rope_table(float* cs, float* sn, int npos) {
    int i = blockIdx.x * blockDim.x + threadIdx.x;
    if (i >= npos * 16) return;
    int pos = i / 16, f = i % 16;
    double inv = pow(10000.0, -(double)f / 16.0);
    double ang = (double)pos * inv;
    cs[i] = (float)cos(ang); sn[i] = (float)sin(ang);
}

__global__ __launch_bounds__(256) void qk_norm_rope(const float* nope, long nope_ld, int nope_hs, const float* pe, long pe_ld, int pe_hs,
                                                    const float* g, const float* cs, const float* sn, float* dst, int nrows, int heads,
                                                    int rows_per_seq, int pos0) {
    int id = blockIdx.x * 4 + (threadIdx.x >> 6), lane = threadIdx.x & 63;
    if (id >= nrows * heads) return;
    int row = id / heads, h = id % heads;
    const float* np_ = nope + (size_t)row * nope_ld + (size_t)h * nope_hs;
    const float* pp = pe + (size_t)row * pe_ld + (size_t)h * pe_hs;
    float a = np_[lane];
    float b = (lane < 32) ? pp[lane] : 0.f;
    float s = wsum(a * a + b * b);
    float r = rsqrtf(s / 96.f + EPS);
    a = a * r * g[lane];
    if (lane < 32) b = b * r * g[64 + lane];
    int pos = pos0 + (row % rows_per_seq);
    float other = __shfl_xor(b, 16);
    float outb = 0.f;
    if (lane < 32) {
        int f = lane & 15;
        float c = cs[pos * 16 + f], sv = sn[pos * 16 + f];
        if (lane < 16) outb = b * c - other * sv;
        else outb = b * c + other * sv;
    }
    float* d = dst + ((size_t)row * heads + h) * 96;
    d[lane] = a;
    if (lane < 32) d[64 + lane] = outb;
}

__global__ __launch_bounds__(256) void gelu_ln_groups(const float* z, long ldz, int voff, const float* lg, const float* lb, float* vg, int nrows) {
    int id = blockIdx.x * 4 + (threadIdx.x >> 6), lane = threadIdx.x & 63;
    if (id >= nrows * 8) return;
    int row = id / 8, g = id % 8;
    float x = gelu_tanh(z[(size_t)row * ldz + voff + g * 64 + lane]);
    float mean = wsum(x) / 64.f;
    float xc = x - mean;
    float var = wsum(xc * xc) / 64.f;
    float y = xc * rsqrtf(var + EPS) * lg[g * 64 + lane] + lb[g * 64 + lane];
    vg[(size_t)row * 512 + g * 64 + lane] = y;
}

__global__ __launch_bounds__(256) void gmlp_mix(const float* z, long ldz, const float* vg, const float* w_s, const float* b_s, float* a_out, int nrows, int c) {
    size_t i = (size_t)blockIdx.x * 256 + threadIdx.x;
    if (i >= (size_t)nrows * 512) return;
    int row = (int)(i / 512), col = (int)(i % 512), g = col / 64;
    int tl = row % c, chunk0 = row - tl;
    float acc = 0.f;
    const float* wr = w_s + ((size_t)g * 128 + tl) * 128;
    for (int s = 0; s <= tl; ++s) acc += wr[s] * vg[(size_t)(chunk0 + s) * 512 + col];
    acc += b_s[g * 128 + tl];
    a_out[i] = gelu_tanh(z[(size_t)row * ldz + col]) * acc;
}

template <int DQK, int DV>
__global__ __launch_bounds__(256) void attn(const float* q, const float* k, const float* v, float* o, int H, int TQ, int KPS, int nvis0, int causal, float scale) {
    extern __shared__ float sc[];
    __shared__ float red[8];
    __shared__ float part[4][DV];
    const int Q = blockIdx.x, h = blockIdx.y, tid = threadIdx.x, lane = tid & 63, wv = tid >> 6;
    const int seq = Q / TQ, i = Q % TQ;
    const int nvis = nvis0 + (causal ? i : 0);
    const float* qp = q + ((size_t)Q * H + h) * DQK;
    const size_t kbase = (size_t)seq * KPS;
    float mx = -3.0e38f;
    for (int j = tid; j < nvis; j += 256) {
        const float* kp = k + ((kbase + j) * H + h) * DQK;
        float s = 0.f;
        for (int d = 0; d < DQK; ++d) s += qp[d] * kp[d];
        s *= scale;
        sc[j] = s;
        mx = fmaxf(mx, s);
    }
    mx = wmax(mx);
    if (lane == 0) red[wv] = mx;
    __syncthreads();
    mx = fmaxf(fmaxf(red[0], red[1]), fmaxf(red[2], red[3]));
    float sum = 0.f;
    for (int j = tid; j < nvis; j += 256) { float p = __expf(sc[j] - mx); sc[j] = p; sum += p; }
    sum = wsum(sum);
    if (lane == 0) red[4 + wv] = sum;
    __syncthreads();
    sum = red[4] + red[5] + red[6] + red[7];
    constexpr int NP = 256 / DV;
    const int d = tid % DV, pt = tid / DV;
    float acc = 0.f;
    for (int j = pt; j < nvis; j += NP) acc += sc[j] * v[(kbase + j) * (size_t)(H * DV) + h * DV + d];
    part[pt][d] = acc;
    __syncthreads();
    if (tid < DV) {
        float r = 0.f;
        for (int p2 = 0; p2 < NP; ++p2) r += part[p2][tid];
        o[(size_t)Q * (H * DV) + h * DV + tid] = r / sum;
    }
}

__global__ __launch_bounds__(256) void gather_cache(const float* pool_ckv, const float* pool_kpe, const int* page_table, const float* new_ckv, const float* new_kpe,
                                                    float* call, float* peall, int s0, int ns) {
    size_t i = (size_t)blockIdx.x * 256 + threadIdx.x;
    size_t total = (size_t)ns * 8196 * 72;
    if (i >= total) return;
    int c4 = (int)(i % 72); size_t r = i / 72; int j = (int)(r % 8196); int sl = (int)(r / 8196); int s = s0 + sl;
    const float4* src; float4* dst;
    if (j < 8192) {
        int page = page_table[s * 64 + (j >> 7)]; int off = j & 127;
        if (c4 < 64) src = (const float4*)(pool_ckv + ((size_t)page * 128 + off) * 256) + c4;
        else src = (const float4*)(pool_kpe + ((size_t)page * 128 + off) * 32) + (c4 - 64);
    } else {
        int t = j - 8192;
        if (c4 < 64) src = (const float4*)(new_ckv + ((size_t)s * 4 + t) * 256) + c4;
        else src = (const float4*)(new_kpe + ((size_t)s * 4 + t) * 32) + (c4 - 64);
    }
    if (c4 < 64) dst = (float4*)(call + r * 256) + c4; else dst = (float4*)(peall + r * 32) + (c4 - 64);
    *dst = *src;
}

__global__ void copy_cols(const float* src, long ld, int off, float* dst, int w, int nrows) {
    size_t i = (size_t)blockIdx.x * 256 + threadIdx.x;
    if (i >= (size_t)nrows * w) return;
    int row = (int)(i / w), c = (int)(i % w);
    dst[i] = src[(size_t)row * ld + off + c];
}

__global__ __launch_bounds__(256) void conv_gate(const float* up, const float* buf, const float* w_conv, const float* b_conv, float* hid, int nrows, int T) {
    size_t i = (size_t)blockIdx.x * 256 + threadIdx.x;
    if (i >= (size_t)nrows * DFF) return;
    int row = (int)(i / DFF), f = (int)(i % DFF);
    int n = row / T, t = row % T;
    float conv = b_conv[f];
#pragma unroll
    for (int j = 0; j < 3; ++j) {
        int tp = t + j;
        float gv;
        if (tp < 2) gv = buf ? buf[((size_t)n * 2 + tp) * DFF + f] : 0.f;
        else gv = up[(size_t)(n * T + tp - 2) * (2 * DFF) + f];
        conv += gv * w_conv[j * DFF + f];
    }
    float sl = conv / (1.f + __expf(-conv));
    hid[i] = sl * up[(size_t)row * (2 * DFF) + DFF + f];
}
__global__ void conv_state(const float* up, float* out, int nseq, int T) {
    size_t i = (size_t)blockIdx.x * 256 + threadIdx.x;
    if (i >= (size_t)nseq * 2 * DFF) return;
    int f = (int)(i % DFF); int r = (int)((i / DFF) % 2); int n = (int)(i / (2 * DFF));
    out[i] = up[(size_t)(n * T + T + r - 2) * (2 * DFF) + f];
}

struct Ptrs {
    const float *x_prompt, *x_sample, *cache_ckv, *cache_kpe, *cache_mem_k, *cache_mem_v, *state_ffn_conv; const int* page_table; const float* mem_prompt;
    const float *g_mix, *w_in, *ln_v_g, *ln_v_b, *w_s, *b_s, *g_q_a, *w_uq, *g_kv_a, *w_uk, *w_uv, *g_qk_q, *g_qk_k, *g_out_a, *g_out_b, *w_o, *g_mem_x, *g_mem_in,
        *w_mq, *w_mk, *w_mv, *g_mq, *g_mk, *w_mo, *g_ffn, *w_up, *w_conv, *b_conv, *w_down;
};
struct Outs { float *y_prompt, *y_sample, *p_ckv, *p_kpe, *p_mem_k, *p_mem_v, *p_ffn_conv, *s_ckv, *s_kpe, *s_chunk_v, *s_ffn_conv; };

inline void G(hipStream_t st, const float* A, int lda, const float* B, int ldb, float* C, int ldc, int M, int N, int K) {
    dim3 grid((N + 63) / 64, (M + 63) / 64);
    gemm<false><<<grid, 256, 0, st>>>(A, lda, B, ldb, C, ldc, nullptr, 0, M, N, K);
}
inline void GR(hipStream_t st, const float* A, int lda, const float* B, int ldb, float* C, int ldc, const float* R, int ldr, int M, int N, int K) {
    dim3 grid((N + 63) / 64, (M + 63) / 64);
    gemm<true><<<grid, 256, 0, st>>>(A, lda, B, ldb, C, ldc, R, ldr, M, N, K);
}
inline int cdiv(size_t a, size_t b) { return (int)((a + b - 1) / b); }

inline void run_group(hipStream_t st, const Ptrs& P, bool is_sample, const float* x, float* y, float* o_ckv, float* o_kpe, float* o_chunk_v, float* o_conv,
                      const float* mem_k, const float* mem_v, float* ws, const float* cs, const float* sn) {
    const int T = is_sample ? TS : SEQ, nseq = is_sample ? 128 : 8, NT = nseq * T;
    float* p = ws;
    auto take = [&](size_t n) { float* r = p; p += (n + 63) / 64 * 64; return r; };
    float* h = take((size_t)NT * D);
    float* z = take((size_t)NT * NIN);
    float* vg = take((size_t)NT * 512);
    float* a_out = take((size_t)NT * 512);
    float* cqn = take((size_t)NT * 256);
    float* qraw = take((size_t)NT * 768);
    float* qf = take((size_t)NT * 768);
    float* b_out = take((size_t)NT * 512);
    float* merged = take((size_t)NT * 1024);
    float* x1 = take((size_t)NT * 1024);
    float* mq = take((size_t)NT * 512);
    float* mqn = take((size_t)NT * 512);
    float* mo = take((size_t)NT * 512);
    float* x2 = take((size_t)NT * 1024);
    float* up = take((size_t)NT * 2 * DFF);
    float* hid = take((size_t)NT * DFF);
    rmsnorm_rows<<<cdiv(NT, 4), 256, 0, st>>>(x, D, P.g_mix, h, D, NT, D);
    G(st, h, D, P.w_in, NIN, z, NIN, NT, NIN, D);
    float* vgdst = is_sample ? o_chunk_v : vg;
    gelu_ln_groups<<<cdiv((size_t)NT * 8, 4), 256, 0, st>>>(z, NIN, 512, P.ln_v_g, P.ln_v_b, vgdst, NT);
    gmlp_mix<<<cdiv((size_t)NT * 512, 256), 256, 0, st>>>(z, NIN, vgdst, P.w_s, P.b_s, a_out, NT, is_sample ? 4 : 128);
    rmsnorm_rows<<<cdiv(NT, 4), 256, 0, st>>>(z + 1280, NIN, P.g_kv_a, o_ckv, 256, NT, 256);
    copy_cols<<<cdiv((size_t)NT * 32, 256), 256, 0, st>>>(z, NIN, 1536, o_kpe, 32, NT);
    rmsnorm_rows<<<cdiv(NT, 4), 256, 0, st>>>(z + 1024, NIN, P.g_q_a, cqn, 256, NT, 256);
    G(st, cqn, 256, P.w_uq, 768, qraw, 768, NT, 768, 256);
    qk_norm_rope<<<cdiv((size_t)NT * 8, 4), 256, 0, st>>>(qraw, 768, 96, qraw + 64, 768, 96, P.g_qk_q, cs, sn, qf, NT, 8, T, is_sample ? PAST : 0);
    const float scale = 1.0f / sqrtf(96.f);
    if (!is_sample) {
        float* kn = take((size_t)NT * 512);
        float* vv = take((size_t)NT * 512);
        float* kf = take((size_t)NT * 768);
        G(st, o_ckv, 256, P.w_uk, 512, kn, 512, NT, 512, 256);
        G(st, o_ckv, 256, P.w_uv, 512, vv, 512, NT, 512, 256);
        qk_norm_rope<<<cdiv((size_t)NT * 8, 4), 256, 0, st>>>(kn, 512, 64, o_kpe, 32, 0, P.g_qk_k, cs, sn, kf, NT, 8, T, 0);
        attn<96, 64><<<dim3(NT, 8), 256, SEQ * 4, st>>>(qf, kf, vv, b_out, 8, T, SEQ, 1, 1, scale);
    } else {
        constexpr int SB = 16;
        const size_t rows = (size_t)SB * 8196;
        float* call = take(rows * 256);
        float* peall = take(rows * 32);
        float* kn = take(rows * 512);
        float* vv = take(rows * 512);
        float* kf = take(rows * 768);
        for (int s0 = 0; s0 < 128; s0 += SB) {
            gather_cache<<<cdiv(rows * 72, 256), 256, 0, st>>>(P.cache_ckv, P.cache_kpe, P.page_table, o_ckv, o_kpe, call, peall, s0, SB);
            G(st, call, 256, P.w_uk, 512, kn, 512, (int)rows, 512, 256);
            G(st, call, 256, P.w_uv, 512, vv, 512, (int)rows, 512, 256);
            qk_norm_rope<<<cdiv(rows * 8, 4), 256, 0, st>>>(kn, 512, 64, peall, 32, 0, P.g_qk_k, cs, sn, kf, (int)rows, 8, 8196, 0);
            attn<96, 64><<<dim3(SB * TS, 8), 256, 8196 * 4, st>>>(qf + (size_t)s0 * TS * 768, kf, vv, b_out + (size_t)s0 * TS * 512, 8, TS, 8196, PAST + 1, 1, scale);
        }
    }
    rmsnorm_rows<<<cdiv(NT, 4), 256, 0, st>>>(a_out, 512, P.g_out_a, merged, 1024, NT, 512);
    rmsnorm_rows<<<cdiv(NT, 4), 256, 0, st>>>(b_out, 512, P.g_out_b, merged + 512, 1024, NT, 512);
    GR(st, merged, 1024, P.w_o, 1024, x1, 1024, x, 1024, NT, 1024, 1024);
    rmsnorm_rows<<<cdiv(NT, 4), 256, 0, st>>>(x1, D, P.g_mem_x, h, D, NT, D);
    G(st, h, D, P.w_mq, 512, mq, 512, NT, 512, D);
    rmsnorm_heads<<<cdiv((size_t)NT * 4, 4), 256, 0, st>>>(mq, 512, P.g_mq, mqn, 512, NT, 4, 128);
    attn<128, 128><<<dim3(NT, 4), 256, MEMLEN * 4, st>>>(mqn, mem_k, mem_v, mo, 4, T, MEMLEN, MEMLEN, 0, 1.0f / sqrtf(128.f));
    GR(st, mo, 512, P.w_mo, 1024, x2, 1024, x1, 1024, NT, 1024, 512);
    rmsnorm_rows<<<cdiv(NT, 4), 256, 0, st>>>(x2, D, P.g_ffn, h, D, NT, D);
    G(st, h, D, P.w_up, 2 * DFF, up, 2 * DFF, NT, 2 * DFF, D);
    conv_gate<<<cdiv((size_t)NT * DFF, 256), 256, 0, st>>>(up, is_sample ? P.state_ffn_conv : nullptr, P.w_conv, P.b_conv, hid, NT, T);
    conv_state<<<cdiv((size_t)nseq * 2 * DFF, 256), 256, 0, st>>>(up, o_conv, nseq, T);
    GR(st, hid, DFF, P.w_down, 1024, y, 1024, x2, 1024, NT, 1024, DFF);
}

inline void forward(hipStream_t st, const Ptrs& P, const Outs& O, float* ws) {
    float* p = ws;
    auto take = [&](size_t n) { float* r = p; p += (n + 63) / 64 * 64; return r; };
    float* cs = take(8200 * 16); float* sn = take(8200 * 16);
    float* hm = take((size_t)2048 * D);
    float* mkraw = take((size_t)2048 * 512);
    rope_table<<<cdiv(8200 * 16, 256), 256, 0, st>>>(cs, sn, 8200);
    rmsnorm_rows<<<cdiv(2048, 4), 256, 0, st>>>(P.mem_prompt, D, P.g_mem_in, hm, D, 2048, D);
    G(st, hm, D, P.w_mk, 512, mkraw, 512, 2048, 512, D);
    rmsnorm_heads<<<cdiv(2048 * 4, 4), 256, 0, st>>>(mkraw, 512, P.g_mk, O.p_mem_k, 512, 2048, 4, 128);
    G(st, hm, D, P.w_mv, 512, O.p_mem_v, 512, 2048, 512, D);
    run_group(st, P, false, P.x_prompt, O.y_prompt, O.p_ckv, O.p_kpe, nullptr, O.p_ffn_conv, O.p_mem_k, O.p_mem_v, p, cs, sn);
    run_group(st, P, true, P.x_sample, O.y_sample, O.s_ckv, O.s_kpe, O.s_chunk_v, O.s_ffn_conv, P.cache_mem_k, P.cache_mem_v, p, cs, sn);
}
}
static void fill_ptrs(void* const* d_in, nv::Ptrs& P) {
    P.x_prompt = (const float*)d_in[0]; P.x_sample = (const float*)d_in[1]; P.cache_ckv = (const float*)d_in[2]; P.cache_kpe = (const float*)d_in[3];
    P.cache_mem_k = (const float*)d_in[4]; P.cache_mem_v = (const float*)d_in[5]; P.state_ffn_conv = (const float*)d_in[6]; P.page_table = (const int*)d_in[7];
    P.mem_prompt = (const float*)d_in[8]; P.g_mix = (const float*)d_in[9]; P.w_in = (const float*)d_in[10]; P.ln_v_g = (const float*)d_in[11]; P.ln_v_b = (const float*)d_in[12];
    P.w_s = (const float*)d_in[13]; P.b_s = (const float*)d_in[14]; P.g_q_a = (const float*)d_in[15]; P.w_uq = (const float*)d_in[16]; P.g_kv_a = (const float*)d_in[17];
    P.w_uk = (const float*)d_in[18]; P.w_uv = (const float*)d_in[19]; P.g_qk_q = (const float*)d_in[20]; P.g_qk_k = (const float*)d_in[21]; P.g_out_a = (const float*)d_in[22];
    P.g_out_b = (const float*)d_in[23]; P.w_o = (const float*)d_in[24]; P.g_mem_x = (const float*)d_in[25]; P.g_mem_in = (const float*)d_in[26]; P.w_mq = (const float*)d_in[27];
    P.w_mk = (const float*)d_in[28]; P.w_mv = (const float*)d_in[29]; P.g_mq = (const float*)d_in[30]; P.g_mk = (const float*)d_in[31]; P.w_mo = (const float*)d_in[32];
    P.g_ffn = (const float*)d_in[33]; P.w_up = (const float*)d_in[34]; P.w_conv = (const float*)d_in[35]; P.b_conv = (const float*)d_in[36]; P.w_down = (const float*)d_in[37];
}
static void fill_outs(float* o, nv::Outs& O) {
    O.y_prompt = o; o += 16777216; O.y_sample = o; o += 524288; O.p_ckv = o; o += 4194304; O.p_kpe = o; o += 524288; O.p_mem_k = o; o += 1048576; O.p_mem_v = o; o += 1048576;
    O.p_ffn_conv = o; o += 45056; O.s_ckv = o; o += 131072; O.s_kpe = o; o += 16384; O.s_chunk_v = o; o += 262144; O.s_ffn_conv = o; o += 720896;
}
extern "C" void kernel_launch(void* const* d_in, const int* in_sizes, int n_in, void* d_out, int out_size, void* d_ws, size_t ws_size, hipStream_t stream) {
    if (n_in != 38 || out_size != 25292800) { fprintf(stderr, "kernel_launch: unexpected n_in %d / out_size %d\n", n_in, out_size); return; }
    nv::Ptrs P; fill_ptrs(d_in, P);
    nv::Outs O; fill_outs((float*)d_out, O);
    nv::forward(stream, P, O, (float*)d_ws);
}
```

```cpp
#include <hip/hip_runtime.h>
#include <cstdio>
#include <cstdint>
#include <cmath>
#define GAS __attribute__((address_space(1)))
#define LAS __attribute__((address_space(3)))
typedef unsigned short bf16;
typedef unsigned v4u __attribute__((ext_vector_type(4)));
typedef unsigned v2u __attribute__((ext_vector_type(2)));
typedef float f32x4 __attribute__((ext_vector_type(4)));
typedef float f32x16 __attribute__((ext_vector_type(16)));
typedef short bf16x8 __attribute__((ext_vector_type(8)));
typedef short s16x4 __attribute__((ext_vector_type(4)));
#define LDS_WAIT() asm volatile("s_waitcnt lgkmcnt(0)" ::: "memory")
#define VM_WAIT() asm volatile("s_waitcnt vmcnt(0)" ::: "memory")
__device__ __forceinline__ unsigned f2bf(float f) { unsigned u = __builtin_bit_cast(unsigned, f); return (u + 0x7fffu + ((u >> 16) & 1u)) >> 16; }
__device__ __forceinline__ unsigned pk2(float lo, float hi) { return f2bf(lo) | (f2bf(hi) << 16); }
__device__ __forceinline__ float bf2f(unsigned short b) { return __builtin_bit_cast(float, (unsigned)b << 16); }
__device__ __forceinline__ float bflo(unsigned w) { return __builtin_bit_cast(float, w << 16); }
__device__ __forceinline__ float bfhi(unsigned w) { return __builtin_bit_cast(float, w & 0xffff0000u); }
__device__ __forceinline__ float wave_sum(float v) {
#pragma unroll
    for (int o = 1; o < 64; o <<= 1) v += __shfl_xor(v, o);
    return v;
}
__device__ __forceinline__ float gelu_tanh_f(float x) {
    const float u = 0.7978845608028654f * (x + 0.044715f * x * x * x);
    const float e = __expf(2.f * u);
    const float th = 1.f - 2.f / (e + 1.f);
    return 0.5f * x * (1.f + th);
}
namespace pg8 {
#define PG8_LAS __attribute__((address_space(3)))
typedef unsigned short bf16_t;
typedef short bf16x8 __attribute__((ext_vector_type(8)));
typedef float f32x4 __attribute__((ext_vector_type(4)));
typedef unsigned u32x4 __attribute__((ext_vector_type(4)));
constexpr int BM = 256, BK = 64, HALF = 128, HTB = HALF * BK * 2  , STAGE_BYTES = 8 * HTB, NXCD = 8, WGM = 8;

__host__ __device__ __forceinline__ int lds_byte(int r, int c) { const int st = (r >> 4) * 2 + (c >> 5), rr = r & 15, cc = c & 31, ob = rr * 64 + cc * 2; return st * 1024 + (ob ^ (((ob >> 9) & 1) << 5)); }
__host__ __device__ __forceinline__ void stage_rc(int b, int& R, int& C) { const int st = b / 1024, sb = b % 1024, swz = sb ^ (((sb >> 9) & 1) << 5); R = (st >> 1) * 16 + swz / 64; C = (st & 1) * 32 + (swz % 64) / 2; }
__host__ __device__ __forceinline__ int perm32(int rho) { const int n = rho >> 4, i = rho & 15; return 8 * (i >> 2) + 4 * n + (i & 3); }

struct Unit { int pm, pn; };
struct Gemm { const bf16_t* A; const bf16_t* Bt; int M, N, K; };

struct StaticOrder {
    int nM, nN, nwg, G, c;
    __host__ __device__ void init(int M, int N, int G_, int c_) { nM = M / BM; nN = N / BM; nwg = nM * nN; G = G_; c = c_; }
    __host__ __device__ bool next(int i, Unit& u) const {
        const long L = (long)i * G + c; if (L >= nwg) return false;
        int wgid = (int)L; { const int q = nwg / NXCD, r = nwg % NXCD, xcd = wgid % NXCD, off = wgid / NXCD; wgid = (xcd < r ? xcd * (q + 1) : r * (q + 1) + (xcd - r) * q) + off; }
        const int nig = WGM * nN, gid = wgid / nig, fm = gid * WGM, gsz = (nM - fm) < WGM ? (nM - fm) : WGM;
        u.pm = fm + ((wgid % nig) % gsz); u.pn = (wgid % nig) / gsz; return true;
    }
    __device__ __forceinline__ void a_ready(const Unit&) const {}
    __device__ __forceinline__ void done(const Unit&) const {}
};

__device__ __forceinline__ unsigned cvt_pk_bf16(float lo, float hi) { unsigned r; asm volatile("v_cvt_pk_bf16_f32 %0, %1, %2" : "=v"(r) : "v"(lo), "v"(hi)); return r; }
typedef float f32x2 __attribute__((ext_vector_type(2)));
struct EpiBf16 {
    static constexpr bool PERM = true, AFTER_DRAIN = false;
    bf16_t* O; int ldc; float scale;
    __device__ __forceinline__ void operator()(const f32x4 (&acc)[2][2][4][2], const Unit& u, int wr, int wc, int fr, int fq) const {
        const int row0 = u.pm * BM + wr * 64 + fr; const int col0 = u.pn * BM + wc * 32 + 8 * fq;
#pragma unroll
        for (int ai = 0; ai < 2; ++ai)
#pragma unroll
            for (int m = 0; m < 4; ++m) { bf16_t* rowp = O + (size_t)(row0 + ai * HALF + m * 16) * ldc + col0;
#pragma unroll
                for (int bj = 0; bj < 2; ++bj) { const f32x4 v0 = acc[ai][bj][m][0] * scale, v1 = acc[ai][bj][m][1] * scale;
                    u32x4 w; w.x = cvt_pk_bf16(v0[0], v0[1]); w.y = cvt_pk_bf16(v0[2], v0[3]); w.z = cvt_pk_bf16(v1[0], v1[1]); w.w = cvt_pk_bf16(v1[2], v1[3]);
                    *(u32x4*)(rowp + bj * HALF) = w; } }
    }
};
struct EpiResF32 {
    static constexpr bool PERM = false, AFTER_DRAIN = false;
    const float* res0; const float* res1; int split_pm; float* out; int ldc;
    __device__ __forceinline__ void operator()(const f32x4 (&acc)[2][2][4][2], const Unit& u, int wr, int wc, int fr, int fq) const {
        const int row0 = u.pm * BM + wr * 64 + fr; const int col0 = u.pn * BM + wc * 32 + 4 * fq;
        const float* rb = (u.pm < split_pm) ? res0 : res1 - (size_t)split_pm * BM * ldc;
#pragma unroll
        for (int ai = 0; ai < 2; ++ai)
#pragma unroll
            for (int m = 0; m < 4; ++m) { const size_t off = (size_t)(row0 + ai * HALF + m * 16) * ldc + col0;
#pragma unroll
                for (int bj = 0; bj < 2; ++bj)
#pragma unroll
                    for (int n = 0; n < 2; ++n) { const f32x4 r = *(const f32x4*)(rb + off + bj * HALF + n * 16); *(f32x4*)(out + off + bj * HALF + n * 16) = acc[ai][bj][m][n] + r; }
                if (m & 1) asm volatile("" ::: "memory"); }
    }
};
template <class Epi, class Sched, bool ALIGN_EPI = false, bool SP2 = false>
__device__ __forceinline__ void gemm_phase(PG8_LAS unsigned char* lds, const Gemm g, const Sched& S, const Epi& E) {
    const int tid = threadIdx.x, wid = __builtin_amdgcn_readfirstlane(tid >> 6), lane = tid & 63, wr = wid >> 2, wc = wid & 3, fr = lane & 15, fq = lane >> 4;
    const int K = g.K, nt = K / BK;
    unsigned voffA[2], voffB[2];
#pragma unroll
    for (int i = 0; i < 2; ++i) { int R, C; stage_rc(tid * 16 + i * 8192, R, C); const int Rb = Epi::PERM ? ((R & ~31) + perm32(R & 31)) : R;
        voffA[i] = (unsigned)(R * K + C) * 2u; voffB[i] = (unsigned)(Rb * K + C) * 2u; }
    const size_t kstep = (size_t)(BK * 2);
    const size_t hstep = (size_t)HALF * K * 2;
    const size_t tstep = 2 * hstep;
    const unsigned ldsw = (unsigned)wid * 1024u;
    const int aoff = lds_byte(wr * 64 + fr, fq * 8), boff = lds_byte(wc * 32 + fr, fq * 8);
#define PG8_SA(b, h) (((b) * 2 + (h)) * HTB)
#define PG8_SB(b, h) ((4 + (b) * 2 + (h)) * HTB)
#define PG8_STAGE(bufoff, gbase, voff) do { _Pragma("unroll") for (int _i = 0; _i < 2; ++_i) \
        __builtin_amdgcn_global_load_lds((const unsigned*)((const char*)(gbase) + (voff)[_i]), (PG8_LAS unsigned*)(lds + (bufoff) + ldsw + _i * 8192), 16, 0, 0); } while (0)
#define PG8_LDA(dst, b, h) do { _Pragma("unroll") for (int m = 0; m < 4; ++m) _Pragma("unroll") for (int k = 0; k < 2; ++k) dst[m][k] = *(const PG8_LAS bf16x8*)(lds + PG8_SA(b, h) + aoff + m * 2048 + k * 1024); } while (0)
#define PG8_LDB(dst, b, h) do { _Pragma("unroll") for (int n = 0; n < 2; ++n) _Pragma("unroll") for (int k = 0; k < 2; ++k) dst[n][k] = *(const PG8_LAS bf16x8*)(lds + PG8_SB(b, h) + boff + n * 2048 + k * 1024); } while (0)
#define PG8_MMA(ai, bj, At, Bt) do { __builtin_amdgcn_s_setprio(1); _Pragma("unroll") for (int m = 0; m < 4; ++m) _Pragma("unroll") for (int n = 0; n < 2; ++n) _Pragma("unroll") for (int k = 0; k < 2; ++k) \
        acc[ai][bj][m][n] = __builtin_amdgcn_mfma_f32_16x16x32_bf16(Bt[n][k], At[m][k], acc[ai][bj][m][n], 0, 0, 0); __builtin_amdgcn_s_setprio(0); } while (0)
#define PG8_WAIT_V(n) asm volatile("s_waitcnt vmcnt(" #n ")" ::: "memory")
#define PG8_WAIT_L(n) asm volatile("s_waitcnt lgkmcnt(" #n ")" ::: "memory")
#define PG8_BAR __builtin_amdgcn_s_barrier()
#define PG8_SCHED __builtin_amdgcn_sched_barrier(0)
    Unit cur, nxt; int ui = 0;
    if (!S.next(0, cur)) return;
    f32x4 acc[2][2][4][2];
#pragma unroll
    for (int a = 0; a < 2; ++a)
#pragma unroll
        for (int b = 0; b < 2; ++b)
#pragma unroll
            for (int m = 0; m < 4; ++m)
#pragma unroll
                for (int n = 0; n < 2; ++n) acc[a][b][m][n] = (f32x4){0.f, 0.f, 0.f, 0.f};
    bf16x8 At[4][2], B0[2][2], B1[2][2];
    const char* cA = (const char*)g.A + (size_t)cur.pm * tstep; const char* cB = (const char*)g.Bt + (size_t)cur.pn * tstep;
    S.a_ready(cur);
    if constexpr (SP2) {
        PG8_STAGE(PG8_SB(0, 0), cB, voffB); PG8_STAGE(PG8_SB(0, 1), cB + hstep, voffB); PG8_STAGE(PG8_SA(0, 0), cA, voffA); PG8_STAGE(PG8_SA(0, 1), cA + hstep, voffA);
        if (wr == 1) PG8_BAR;
        PG8_WAIT_V(2); PG8_BAR;
        PG8_STAGE(PG8_SB(1, 0), cB + kstep, voffB); PG8_STAGE(PG8_SA(1, 0), cA + kstep, voffA); PG8_STAGE(PG8_SB(1, 1), cB + hstep + kstep, voffB);
        PG8_WAIT_V(6); PG8_BAR;
    } else {
        PG8_STAGE(PG8_SB(0, 0), cB, voffB); PG8_STAGE(PG8_SA(0, 0), cA, voffA); PG8_STAGE(PG8_SB(0, 1), cB + hstep, voffB); PG8_STAGE(PG8_SA(0, 1), cA + hstep, voffA);
        if (wr == 1) PG8_BAR;
        PG8_WAIT_V(4); PG8_BAR;
        PG8_STAGE(PG8_SB(1, 0), cB + kstep, voffB); PG8_STAGE(PG8_SA(1, 0), cA + kstep, voffA); PG8_STAGE(PG8_SB(1, 1), cB + hstep + kstep, voffB);
        PG8_WAIT_V(6); PG8_BAR;
    }
    for (;;) {
        const bool has_next = S.next(ui + 1, nxt);
        const char* nA = has_next ? (const char*)g.A + (size_t)nxt.pm * tstep : cA; const char* nB = has_next ? (const char*)g.Bt + (size_t)nxt.pn * tstep : cB;
        for (int t = 0; t < nt; t += 2) {
            const bool last = (t == nt - 2);
            const char* a1 = cA + (size_t)(t + 1) * kstep;
            const char* a2 = last ? nA : cA + (size_t)(t + 2) * kstep; const char* b2 = last ? nB : cB + (size_t)(t + 2) * kstep;
            const char* a3 = a2 + kstep; const char* b3 = b2 + kstep;
            if (last && has_next) S.a_ready(nxt);
            if constexpr (SP2) {
            PG8_LDB(B0, 0, 0); PG8_LDB(B1, 0, 1); PG8_SCHED; PG8_LDA(At, 0, 0); PG8_STAGE(PG8_SA(1, 1), a1 + hstep, voffA);
            PG8_WAIT_V(8); PG8_WAIT_L(0); PG8_BAR; PG8_MMA(0, 0, At, B0); PG8_MMA(0, 1, At, B1); PG8_BAR; PG8_SCHED;
            PG8_LDA(At, 0, 1); PG8_STAGE(PG8_SB(0, 0), b2, voffB); PG8_STAGE(PG8_SB(0, 1), b2 + hstep, voffB); PG8_STAGE(PG8_SA(0, 0), a2, voffA);
            PG8_WAIT_V(8); PG8_WAIT_L(0); PG8_BAR; PG8_MMA(1, 0, At, B0); PG8_MMA(1, 1, At, B1); PG8_BAR; PG8_SCHED;
            PG8_LDB(B0, 1, 0); PG8_LDB(B1, 1, 1); PG8_SCHED; PG8_LDA(At, 1, 0); PG8_STAGE(PG8_SA(0, 1), a2 + hstep, voffA);
            PG8_WAIT_V(8); PG8_WAIT_L(0); PG8_BAR; PG8_MMA(0, 0, At, B0); PG8_MMA(0, 1, At, B1); PG8_BAR; PG8_SCHED;
            PG8_LDA(At, 1, 1); PG8_STAGE(PG8_SB(1, 0), b3, voffB); PG8_STAGE(PG8_SB(1, 1), b3 + hstep, voffB); PG8_STAGE(PG8_SA(1, 0), a3, voffA);
            PG8_WAIT_V(8); PG8_WAIT_L(0); PG8_BAR; PG8_MMA(1, 0, At, B0); PG8_MMA(1, 1, At, B1); PG8_BAR; PG8_SCHED;
            } else {
            PG8_LDB(B0, 0, 0); PG8_SCHED; PG8_LDA(At, 0, 0); PG8_STAGE(PG8_SA(1, 1), a1 + hstep, voffA);
            PG8_WAIT_L(8); PG8_BAR; PG8_WAIT_L(0); PG8_MMA(0, 0, At, B0); PG8_BAR; PG8_SCHED;
            PG8_LDB(B1, 0, 1); PG8_STAGE(PG8_SB(0, 0), b2, voffB);
            PG8_BAR; PG8_WAIT_L(0); PG8_MMA(0, 1, At, B1); PG8_BAR;
            PG8_LDA(At, 0, 1); PG8_STAGE(PG8_SA(0, 0), a2, voffA);
            PG8_BAR; PG8_WAIT_L(0); PG8_MMA(1, 0, At, B0); PG8_BAR; PG8_SCHED;
            PG8_STAGE(PG8_SB(0, 1), b2 + hstep, voffB);
            PG8_WAIT_V(6); PG8_BAR; PG8_MMA(1, 1, At, B1); PG8_BAR;
            PG8_LDB(B0, 1, 0); PG8_SCHED; PG8_LDA(At, 1, 0); PG8_STAGE(PG8_SA(0, 1), a2 + hstep, voffA);
            PG8_WAIT_L(8); PG8_BAR; PG8_WAIT_L(0); PG8_MMA(0, 0, At, B0); PG8_BAR; PG8_SCHED;
            PG8_LDB(B1, 1, 1); PG8_STAGE(PG8_SB(1, 0), b3, voffB);
            PG8_BAR; PG8_WAIT_L(0); PG8_MMA(0, 1, At, B1); PG8_BAR;
            PG8_LDA(At, 1, 1); PG8_STAGE(PG8_SA(1, 0), a3, voffA);
            PG8_BAR; PG8_WAIT_L(0); PG8_MMA(1, 0, At, B0); PG8_BAR; PG8_SCHED;
            PG8_STAGE(PG8_SB(1, 1), b3 + hstep, voffB);
            PG8_WAIT_V(6); PG8_BAR; PG8_MMA(1, 1, At, B1); PG8_BAR;
            }
        }
        if constexpr (ALIGN_EPI) { if (wr == 0) PG8_BAR; }
        if constexpr (!Epi::AFTER_DRAIN) { E(acc, cur, wr, wc, fr, fq); S.done(cur); }
        if (!has_next) break;
#pragma unroll
        for (int a = 0; a < 2; ++a)
#pragma unroll
            for (int b = 0; b < 2; ++b)
#pragma unroll
                for (int m = 0; m < 4; ++m)
#pragma unroll
                    for (int n = 0; n < 2; ++n) acc[a][b][m][n] = (f32x4){0.f, 0.f, 0.f, 0.f};
        cur = nxt; cA = nA; cB = nB; ++ui;
        if constexpr (ALIGN_EPI) { if (wr == 1) PG8_BAR; }
    }
    PG8_WAIT_V(0);
    if constexpr (!ALIGN_EPI) { if (wr == 0) PG8_BAR; }
    PG8_BAR;
    if constexpr (Epi::AFTER_DRAIN) { E.fused(acc, cur, wr, wc, fr, fq, lds, wid, lane); S.done(cur); }
#undef PG8_SA
#undef PG8_SB
#undef PG8_STAGE
#undef PG8_LDA
#undef PG8_LDB
#undef PG8_MMA
#undef PG8_WAIT_V
#undef PG8_WAIT_L
#undef PG8_BAR
#undef PG8_SCHED
}
}
#define XB_TMO      128
#define XB_XCNT(j)  (256  + 64 * (j))
#define XB_XSUB(j)  (1280 + 64 * (j))
#define XB_XGEN(j)  (2304 + 64 * (j))
#define XB_TOP      3328
#define XB_TOPGEN   3392
#define XCD_BAR_WORDS 3456
#define XB_SPIN_CAP (1u << 18)

__device__ __forceinline__ unsigned xb_ld(unsigned* p)              { return __hip_atomic_load(p, __ATOMIC_RELAXED, __HIP_MEMORY_SCOPE_AGENT); }
__device__ __forceinline__ unsigned xb_add(unsigned* p, unsigned v) { return __hip_atomic_fetch_add(p, v, __ATOMIC_RELAXED, __HIP_MEMORY_SCOPE_AGENT); }
__device__ __forceinline__ unsigned xb_xcc_id() { return (unsigned)__builtin_amdgcn_s_getreg((3 << 11) | 20) & 0xFu; }
#define XB_SPIN(cond, bar) do { unsigned _sp = 0; while (cond) { __builtin_amdgcn_s_sleep(1); \
    if ((++_sp & 255u) == 0u) { if (xb_ld(&(bar)[XB_TMO])) break; if (_sp > XB_SPIN_CAP) { atomicAdd(&(bar)[XB_TMO], 1u); break; } } } } while (0)

struct XcdBarrier {
    unsigned* bar; unsigned x;
    volatile LAS unsigned* st;
};

__device__ __forceinline__ XcdBarrier xcd_barrier_post(unsigned* bar, volatile LAS unsigned* st) {
    XcdBarrier b; b.bar = bar; b.x = xb_xcc_id(); b.st = st;
    if (threadIdx.x == 0) (void)xb_add(&bar[XB_XCNT(b.x)], 1u);
    return b;
}
__device__ __forceinline__ void xcd_barrier_complete(unsigned* bar, unsigned x, unsigned& nloc, unsigned& nx) {
    const unsigned G = gridDim.x * gridDim.y * gridDim.z;
    unsigned sum, cnt, mine, sp = 0u;
    for (;;) {
        sum = 0u; cnt = 0u; mine = 0u;
#pragma unroll
        for (unsigned j = 0; j < 16; ++j) { const unsigned c = xb_ld(&bar[XB_XCNT(j)]); sum += c; cnt += (c > 0u) ? 1u : 0u; mine = (j == x) ? c : mine; }
        if (sum == G) break;
        __builtin_amdgcn_s_sleep(1);
        if ((++sp & 255u) == 0u) { if (xb_ld(&bar[XB_TMO])) break; if (sp > XB_SPIN_CAP) { atomicAdd(&bar[XB_TMO], 1u); break; } }
    }
    nloc = mine > 0u ? mine : 1u; nx = cnt > 0u ? cnt : 1u;
}

__device__ __forceinline__ void xcd_barrier(const XcdBarrier& b) {
    asm volatile("s_waitcnt vmcnt(0)" ::: "memory");
    __syncthreads();
    if (threadIdx.x == 0) {
        unsigned* bar = b.bar;
        __builtin_amdgcn_s_waitcnt(0);
        unsigned nloc = b.st[0], nx = b.st[1];
        if (nloc == 0u) { xcd_barrier_complete(bar, b.x, nloc, nx); b.st[0] = nloc; b.st[1] = nx; }
        const unsigned old = xb_add(&bar[XB_XSUB(b.x)], 1u);
        const unsigned gen = old / nloc;
        if (old + 1u == (gen + 1u) * nloc) {
            __builtin_amdgcn_fence(__ATOMIC_RELEASE, "agent");
            asm volatile("s_waitcnt vmcnt(0)" ::: "memory");
            const unsigned og = xb_add(&bar[XB_TOP], 1u);
            const unsigned tg = og / nx;
            if (og + 1u == (tg + 1u) * nx) xb_add(&bar[XB_TOPGEN], 1u);
            else XB_SPIN(xb_ld(&bar[XB_TOPGEN]) == tg, bar);
            __builtin_amdgcn_fence(__ATOMIC_ACQUIRE, "agent");
            xb_add(&bar[XB_XGEN(b.x)], 1u);
            asm volatile("s_waitcnt vmcnt(0)" ::: "memory");
        } else {
            XB_SPIN(xb_ld(&bar[XB_XGEN(b.x)]) == gen, bar);
            __builtin_amdgcn_fence(__ATOMIC_ACQUIRE, "agent");
            asm volatile("s_waitcnt vmcnt(0)" ::: "memory");
        }
    }
    __syncthreads();
}
namespace mk {
constexpr int NWAVES = 8;
constexpr int D = 1024, TP = 16384, TSMP = 512, T = TP + TSMP, SEQ = 2048, NSEQ = 128, PAST = 8192;
constexpr int NIN = 1568, NINP = 1792, DFF = 2816;
constexpr float EPS = 1e-6f;
constexpr float LOG2E = 1.4426950408889634f;
constexpr float QSCALE = 0.10206207261596577f * LOG2E;
constexpr float MQSCALE = 0.08838834764831845f * LOG2E;

constexpr size_t O_YP = 0, O_YS = 16777216, O_PCKV = O_YS + 524288, O_PKPE = O_PCKV + 4194304, O_PMK = O_PKPE + 524288, O_PMV = O_PMK + 1048576,
                 O_PCONV = O_PMV + 1048576, O_SCKV = O_PCONV + 45056, O_SKPE = O_SCKV + 131072, O_SCV = O_SKPE + 16384, O_SCONV = O_SCV + 262144, O_END = O_SCONV + 720896;
static_assert(O_END == 25292800, "output size");

constexpr size_t al(size_t x) { return (x + 4095) & ~(size_t)4095; }
constexpr size_t WS_CTL = 0, CTL_ZERO_BYTES = 1u << 20;
constexpr size_t WS_W_IN = 1u << 20;
constexpr size_t WS_W_UQ = al(WS_W_IN + (size_t)NINP * D * 2);
constexpr size_t WS_W_UK = al(WS_W_UQ + (size_t)768 * 256 * 2);
constexpr size_t WS_W_UV = al(WS_W_UK + (size_t)512 * 256 * 2);
constexpr size_t WS_W_O = al(WS_W_UV + (size_t)512 * 256 * 2);
constexpr size_t WS_W_MQ = al(WS_W_O + (size_t)1024 * 1024 * 2);
constexpr size_t WS_W_MKV = al(WS_W_MQ + (size_t)512 * 1024 * 2);
constexpr size_t WS_W_MO = al(WS_W_MKV + (size_t)1024 * 1024 * 2);
constexpr size_t WS_W_UP = al(WS_W_MO + (size_t)1024 * 512 * 2);
constexpr size_t WS_W_DN = al(WS_W_UP + (size_t)2 * DFF * D * 2);
constexpr size_t WS_ROPE = al(WS_W_DN + (size_t)D * DFF * 2);
constexpr size_t ROPE_N = 8200;
constexpr size_t WS_XN = al(WS_ROPE + 2 * ROPE_N * 16 * 4);
constexpr size_t WS_MN = al(WS_XN + (size_t)T * D * 2);
constexpr size_t WS_Z = al(WS_MN + (size_t)2048 * D * 2);
constexpr size_t WS_MKV = al(WS_Z + (size_t)T * NINP * 2);
constexpr size_t WS_CQN = al(WS_MKV + (size_t)2048 * 1024 * 2);
constexpr size_t WS_CKVN = al(WS_CQN + (size_t)T * 256 * 2);
constexpr size_t WS_VG = al(WS_CKVN + (size_t)T * 256 * 2);
constexpr size_t WS_MK = al(WS_VG + (size_t)T * 512 * 2);
constexpr size_t WS_MVT = al(WS_MK + (size_t)2048 * 512 * 2);
constexpr size_t WS_QR = al(WS_MVT + (size_t)2048 * 512 * 2);
constexpr size_t WS_KNR = al(WS_QR + (size_t)T * 768 * 2);
constexpr size_t WS_VT = al(WS_KNR + (size_t)TP * 512 * 2);
constexpr size_t WS_QF = al(WS_VT + (size_t)512 * TP * 2);
constexpr size_t WS_KF = al(WS_QF + (size_t)T * 768 * 2);
constexpr size_t WS_BO = al(WS_KF + (size_t)TP * 768 * 2);
constexpr size_t WS_MRG = al(WS_BO + (size_t)T * 512 * 2);
constexpr size_t WS_X1 = al(WS_MRG + (size_t)T * 1024 * 2);
constexpr size_t WS_H2 = al(WS_X1 + (size_t)T * 1024 * 4);
constexpr size_t WS_MQ = al(WS_H2 + (size_t)T * 1024 * 2);
constexpr size_t WS_MO = al(WS_MQ + (size_t)T * 512 * 2);
constexpr size_t WS_X2 = al(WS_MO + (size_t)T * 512 * 2);
constexpr size_t WS_H3 = al(WS_X2 + (size_t)T * 1024 * 4);
constexpr size_t WS_UP = al(WS_H3 + (size_t)T * 1024 * 2);
constexpr size_t WS_HID = al(WS_UP + (size_t)T * 2 * DFF * 2);
constexpr size_t WS_SPART = al(WS_HID + (size_t)T * DFF * 2);
constexpr size_t SPART_STRIDE = (32 + 32 * 256) * 4;
constexpr size_t WS_MK_END = al(WS_SPART + (size_t)NSEQ * 2 * SPART_STRIDE);
static_assert(WS_MK_END < (1000u << 20), "mk workspace under 1000 MiB");
constexpr int CW_BAR = 4096;

constexpr int RING_BYTES = 139264, MISC_OFF = RING_BYTES + 320, LDS_BYTES = 143360;

struct Args { const void* in[38]; float* out; unsigned char* ws; int ph_lo, ph_hi; };
static_assert(sizeof(Args) == 38 * 8 + 8 + 8 + 8, "Args has no padding");

struct Frame {
    LAS unsigned char* lds; unsigned char* lds_g;
    int tid, lane, wave, G, bid;
    unsigned char* ws; float* out;
    const float* const* in;
    template <class P> __device__ __forceinline__ P* w(size_t off) const { return (P*)(ws + off); }
    __device__ __forceinline__ const float* inf(int i) const { return (const float*)in[i]; }
};

enum { I_XP = 0, I_XS, I_CKV, I_KPE, I_CMK, I_CMV, I_CONVST, I_PT, I_MEMP, I_GMIX, I_WIN, I_LNG, I_LNB, I_WS, I_BS, I_GQA, I_WUQ, I_GKVA, I_WUK, I_WUV, I_GQKQ, I_GQKK,
       I_GOA, I_GOB, I_WO, I_GMEMX, I_GMEMIN, I_WMQ, I_WMK, I_WMV, I_GMQ, I_GMK, I_WMO, I_GFFN, I_WUP, I_WCONV, I_BCONV, I_WDOWN };

__device__ __forceinline__ void p0_transpose_item(const float* W, int K, int N, bf16* WT, int row_off, LAS float* scr, int item, int lane) {
    const int nblk = N / 32, kb = item / nblk, nb = item % nblk, k0 = 64 * kb, n0 = 32 * nb;
#pragma unroll 8
    for (int i = 0; i < 32; ++i) { const int kk = 2 * i + (lane >> 5); scr[kk * 33 + (lane & 31)] = W[(size_t)(k0 + kk) * N + n0 + (lane & 31)]; }
    LDS_WAIT(); asm volatile("" ::: "memory");
    const int c = lane & 7;
#pragma unroll
    for (int j = 0; j < 4; ++j) { const int n = (lane >> 3) + 8 * j; const LAS float* s = scr + (8 * c) * 33 + n;
        v4u o; o.x = pk2(s[0 * 33], s[1 * 33]); o.y = pk2(s[2 * 33], s[3 * 33]); o.z = pk2(s[4 * 33], s[5 * 33]); o.w = pk2(s[6 * 33], s[7 * 33]);
        *(v4u*)(WT + (size_t)(row_off + n0 + n) * K + k0 + 8 * c) = o; }
    LDS_WAIT(); asm volatile("" ::: "memory");
}
__device__ __forceinline__ void rms_row_to_bf16(const float* xrow, const float* g, bf16* orow, int lane) {
    const f32x4* xr = (const f32x4*)xrow + lane; const f32x4* gr = (const f32x4*)g + lane;
    f32x4 v[4]; float s = 0.f;
#pragma unroll
    for (int j = 0; j < 4; ++j) { v[j] = xr[64 * j]; s += (v[j].x * v[j].x + v[j].y * v[j].y) + (v[j].z * v[j].z + v[j].w * v[j].w); }
    const float rstd = rsqrtf(wave_sum(s) * (1.f / 1024.f) + EPS);
    unsigned long long* o8 = (unsigned long long*)orow + lane;
#pragma unroll
    for (int j = 0; j < 4; ++j) { const f32x4 gg = gr[64 * j];
        o8[64 * j] = (unsigned long long)pk2(v[j].x * rstd * gg.x, v[j].y * rstd * gg.y) | ((unsigned long long)pk2(v[j].z * rstd * gg.z, v[j].w * rstd * gg.w) << 32); }
}
__device__ __forceinline__ const float* xrow_ptr(const Frame& F, int r) { return r < TP ? F.inf(I_XP) + (size_t)r * D : F.inf(I_XS) + (size_t)(r - TP) * D; }

__device__ __forceinline__ void p0_prologue(Frame& F) {
    LAS float* scr = (LAS float*)(F.lds + F.wave * 16384);
    const int gw = F.bid * NWAVES + F.wave, NGW = F.G * NWAVES;
    constexpr int NI = 11;
    const int srcs[NI] = {I_WIN, I_WUQ, I_WUK, I_WUV, I_WO, I_WMQ, I_WMK, I_WMV, I_WMO, I_WUP, I_WDOWN};
    const int Ks[NI] = {1024, 256, 256, 256, 1024, 1024, 1024, 1024, 512, 1024, 2816};
    const int Ns[NI] = {1568, 768, 512, 512, 1024, 512, 512, 512, 1024, 5632, 1024};
    const size_t dsts[NI] = {WS_W_IN, WS_W_UQ, WS_W_UK, WS_W_UV, WS_W_O, WS_W_MQ, WS_W_MKV, WS_W_MKV, WS_W_MO, WS_W_UP, WS_W_DN};
    const int roffs[NI] = {0, 0, 0, 0, 0, 0, 0, 512, 0, 0, 0};
    int base = 0;
#pragma unroll
    for (int m = 0; m < NI; ++m) {
        const int cnt = (Ks[m] / 64) * (Ns[m] / 32);
        int first = gw - (base % NGW); if (first < 0) first += NGW;
        for (int it = first; it < cnt; it += NGW) p0_transpose_item(F.inf(srcs[m]), Ks[m], Ns[m], F.w<bf16>(dsts[m]), roffs[m], scr, it, F.lane);
        base += cnt;
    }
    for (int r = gw; r < NINP - NIN; r += NGW) { v4u* p = (v4u*)(F.w<bf16>(WS_W_IN) + (size_t)(NIN + r) * D) + F.lane; p[0] = (v4u){0, 0, 0, 0}; p[64] = (v4u){0, 0, 0, 0}; }
    for (int r = gw; r < T; r += NGW) rms_row_to_bf16(xrow_ptr(F, r), F.inf(I_GMIX), F.w<bf16>(WS_XN) + (size_t)r * D, F.lane);
    for (int r = gw; r < 2048; r += NGW) rms_row_to_bf16(F.inf(I_MEMP) + (size_t)r * D, F.inf(I_GMEMIN), F.w<bf16>(WS_MN) + (size_t)r * D, F.lane);
    { float* cs = F.w<float>(WS_ROPE); float* sn = cs + ROPE_N * 16;
      for (int i = F.bid * 512 + F.tid; i < (int)ROPE_N * 16; i += F.G * 512) { const int pos = i >> 4, f = i & 15;
          const double ang = (double)pos * pow(10000.0, -(double)f / 16.0); cs[i] = (float)cos(ang); sn[i] = (float)sin(ang); } }
}

__device__ __forceinline__ void p2_post_inproj(Frame& F) {
    const int gw = F.bid * NWAVES + F.wave, NGW = F.G * NWAVES, lane = F.lane;
    const bf16* Z = F.w<bf16>(WS_Z);
    const float* lg = F.inf(I_LNG); const float* lb = F.inf(I_LNB);
    for (int r = gw; r < T; r += NGW) {
        const bf16* zr = Z + (size_t)r * NINP;
        {
            const v4u raw = *(const v4u*)(zr + 512 + 8 * lane);
            float x[8];
#pragma unroll
            for (int i = 0; i < 4; ++i) { x[2 * i] = gelu_tanh_f(bflo(raw[i])); x[2 * i + 1] = gelu_tanh_f(bfhi(raw[i])); }
            float s = 0.f;
#pragma unroll
            for (int i = 0; i < 8; ++i) s += x[i];
            s += __shfl_xor(s, 1); s += __shfl_xor(s, 2); s += __shfl_xor(s, 4);
            const float mean = s * (1.f / 64.f);
            float q = 0.f;
#pragma unroll
            for (int i = 0; i < 8; ++i) { x[i] -= mean; q += x[i] * x[i]; }
            q += __shfl_xor(q, 1); q += __shfl_xor(q, 2); q += __shfl_xor(q, 4);
            const float rstd = rsqrtf(q * (1.f / 64.f) + EPS);
            const f32x4 g0 = *(const f32x4*)(lg + 8 * lane), g1 = *(const f32x4*)(lg + 8 * lane + 4), b0 = *(const f32x4*)(lb + 8 * lane), b1 = *(const f32x4*)(lb + 8 * lane + 4);
            f32x4 y0, y1;
#pragma unroll
            for (int i = 0; i < 4; ++i) { y0[i] = x[i] * rstd * g0[i] + b0[i]; y1[i] = x[4 + i] * rstd * g1[i] + b1[i]; }
            v4u o; o.x = pk2(y0[0], y0[1]); o.y = pk2(y0[2], y0[3]); o.z = pk2(y1[0], y1[1]); o.w = pk2(y1[2], y1[3]);
            *(v4u*)(F.w<bf16>(WS_VG) + (size_t)r * 512 + 8 * lane) = o;
            if (r >= TP) { float* d = F.out + O_SCV + (size_t)(r - TP) * 512 + 8 * lane; *(f32x4*)d = y0; *(f32x4*)(d + 4) = y1; }
        }
#pragma unroll
        for (int which = 0; which < 2; ++which) {
            const v2u raw = *(const v2u*)(zr + 1024 + 256 * which + 4 * lane);
            f32x4 x; x[0] = bflo(raw[0]); x[1] = bfhi(raw[0]); x[2] = bflo(raw[1]); x[3] = bfhi(raw[1]);
            const float ss = wave_sum((x[0] * x[0] + x[1] * x[1]) + (x[2] * x[2] + x[3] * x[3]));
            const float rstd = rsqrtf(ss * (1.f / 256.f) + EPS);
            const f32x4 g = *(const f32x4*)(F.inf(which ? I_GKVA : I_GQA) + 4 * lane);
            f32x4 y;
#pragma unroll
            for (int i = 0; i < 4; ++i) y[i] = x[i] * rstd * g[i];
            v2u o; o.x = pk2(y[0], y[1]); o.y = pk2(y[2], y[3]);
            *(v2u*)(F.w<bf16>(which ? WS_CKVN : WS_CQN) + (size_t)r * 256 + 4 * lane) = o;
            if (which) { float* d = (r < TP) ? F.out + O_PCKV + (size_t)r * 256 : F.out + O_SCKV + (size_t)(r - TP) * 256; *(f32x4*)(d + 4 * lane) = y; }
        }
        if (lane < 32) { float* d = (r < TP) ? F.out + O_PKPE + (size_t)r * 32 : F.out + O_SKPE + (size_t)(r - TP) * 32; d[lane] = bf2f(zr[1536 + lane]); }
    }
    const bf16* MKV = F.w<bf16>(WS_MKV);
    for (int r = gw; r < 2048; r += NGW) {
        const bf16* mr = MKV + (size_t)r * 1024;
        {
            const v4u raw = *(const v4u*)(mr + 8 * lane);
            float x[8];
#pragma unroll
            for (int i = 0; i < 4; ++i) { x[2 * i] = bflo(raw[i]); x[2 * i + 1] = bfhi(raw[i]); }
            float ss = 0.f;
#pragma unroll
            for (int i = 0; i < 8; ++i) ss += x[i] * x[i];
            ss += __shfl_xor(ss, 1); ss += __shfl_xor(ss, 2); ss += __shfl_xor(ss, 4); ss += __shfl_xor(ss, 8);
            const float rstd = rsqrtf(ss * (1.f / 128.f) + EPS);
            const float* g = F.inf(I_GMK) + ((8 * lane) & 127);
            f32x4 y0, y1;
#pragma unroll
            for (int i = 0; i < 4; ++i) { y0[i] = x[i] * rstd * g[i]; y1[i] = x[4 + i] * rstd * g[4 + i]; }
            float* d = F.out + O_PMK + (size_t)r * 512 + 8 * lane; *(f32x4*)d = y0; *(f32x4*)(d + 4) = y1;
            v4u o; o.x = pk2(y0[0], y0[1]); o.y = pk2(y0[2], y0[3]); o.z = pk2(y1[0], y1[1]); o.w = pk2(y1[2], y1[3]);
            *(v4u*)(F.w<bf16>(WS_MK) + (size_t)r * 512 + 8 * lane) = o;
        }
        {
            const v4u raw = *(const v4u*)(mr + 512 + 8 * lane);
            float x[8];
#pragma unroll
            for (int i = 0; i < 4; ++i) { x[2 * i] = bflo(raw[i]); x[2 * i + 1] = bfhi(raw[i]); }
            float* d = F.out + O_PMV + (size_t)r * 512 + 8 * lane; *(f32x4*)d = (f32x4){x[0], x[1], x[2], x[3]}; *(f32x4*)(d + 4) = (f32x4){x[4], x[5], x[6], x[7]};
            const int b = r >> 8, key = r & 255;
            bf16* mvt = F.w<bf16>(WS_MVT);
#pragma unroll
            for (int i = 0; i < 8; ++i) { const int col = 8 * lane + i, h = col >> 7, dv = col & 127; mvt[((size_t)(b * 4 + h) * 128 + dv) * 256 + key] = (i & 1) ? (bf16)(raw[i >> 1] >> 16) : (bf16)(raw[i >> 1] & 0xffffu); }
        }
    }
}
}
namespace mk {
__device__ __forceinline__ void p4_norm_rope_row(const bf16* nope, const bf16* pe, const float* g, const float* cs, const float* sn, int pos, float oscale, bf16* dst, int lane) {
    const int sub = lane & 7;
    const v4u raw = *(const v4u*)(nope + 8 * sub);
    const unsigned r1 = *(const unsigned*)(pe + 2 * sub), r2 = *(const unsigned*)(pe + 16 + 2 * sub);
    float x[8];
#pragma unroll
    for (int i = 0; i < 4; ++i) { x[2 * i] = bflo(raw[i]); x[2 * i + 1] = bfhi(raw[i]); }
    float a0 = bflo(r1), a1 = bfhi(r1), b0 = bflo(r2), b1 = bfhi(r2);
    float ss = (a0 * a0 + a1 * a1) + (b0 * b0 + b1 * b1);
#pragma unroll
    for (int i = 0; i < 8; ++i) ss += x[i] * x[i];
    ss += __shfl_xor(ss, 1); ss += __shfl_xor(ss, 2); ss += __shfl_xor(ss, 4);
    const float rs = rsqrtf(ss * (1.f / 96.f) + EPS) * oscale;
    const f32x4 g0 = *(const f32x4*)(g + 8 * sub), g1 = *(const f32x4*)(g + 8 * sub + 4);
    v4u o; o.x = pk2(x[0] * rs * g0[0], x[1] * rs * g0[1]); o.y = pk2(x[2] * rs * g0[2], x[3] * rs * g0[3]); o.z = pk2(x[4] * rs * g1[0], x[5] * rs * g1[1]); o.w = pk2(x[6] * rs * g1[2], x[7] * rs * g1[3]);
    *(v4u*)(dst + 8 * sub) = o;
    const int f = 2 * sub;
    a0 *= rs * g[64 + f]; a1 *= rs * g[65 + f]; b0 *= rs * g[80 + f]; b1 *= rs * g[81 + f];
    const float c0 = cs[pos * 16 + f], c1 = cs[pos * 16 + f + 1], s0 = sn[pos * 16 + f], s1 = sn[pos * 16 + f + 1];
    *(unsigned*)(dst + 64 + f) = pk2(a0 * c0 - b0 * s0, a1 * c1 - b1 * s1);
    *(unsigned*)(dst + 80 + f) = pk2(b0 * c0 + a0 * s0, b1 * c1 + a1 * s1);
}
__device__ __forceinline__ void p4_qk_norm_rope(Frame& F) {
    const int gw = F.bid * NWAVES + F.wave, NGW = F.G * NWAVES, lane = F.lane, h = lane >> 3;
    const float* cs = F.w<float>(WS_ROPE); const float* sn = cs + ROPE_N * 16;
    const bf16* QR = F.w<bf16>(WS_QR); const bf16* KNR = F.w<bf16>(WS_KNR); const bf16* Z = F.w<bf16>(WS_Z);
    for (int r = gw; r < T; r += NGW) {
        const int pos = r < TP ? (r & 2047) : PAST + ((r - TP) & 3);
        const bf16* q = QR + (size_t)r * 768 + 96 * h;
        p4_norm_rope_row(q, q + 64, F.inf(I_GQKQ), cs, sn, pos, QSCALE, F.w<bf16>(WS_QF) + (size_t)r * 768 + 96 * h, lane);
        if (r < TP) p4_norm_rope_row(KNR + (size_t)r * 512 + 64 * h, Z + (size_t)r * NINP + 1536, F.inf(I_GQKK), cs, sn, pos, 1.f, F.w<bf16>(WS_KF) + (size_t)r * 768 + 96 * h, lane);
    }
}
}
namespace mk {
__device__ __forceinline__ float wave_max(float v) {
#pragma unroll
    for (int o = 1; o < 64; o <<= 1) v = fmaxf(v, __shfl_xor(v, o));
    return v;
}
__device__ __forceinline__ float gain_absmax(const float* g, int n, int lane) { float m = 0.f; for (int i = lane; i < n; i += 64) m = fmaxf(m, fabsf(g[i])); return wave_max(m); }

__device__ __forceinline__ void attn_prompt_wave(Frame& F, int b, int h, int q0, float negM) {
    const int lane = F.lane, qc = lane & 31, hh = lane >> 5;
    const bf16* Qp = F.w<bf16>(WS_QF) + (size_t)(b * SEQ + q0 + qc) * 768 + h * 96 + 8 * hh;
    bf16x8 qf[6];
#pragma unroll
    for (int ks = 0; ks < 6; ++ks) qf[ks] = *(const bf16x8*)(Qp + 16 * ks);
    f32x16 o0 = {}, o1 = {}; float l = 0.f;
    const int nt = q0 / 32 + 1;
    const bf16* Kp = F.w<bf16>(WS_KF) + (size_t)(b * SEQ + qc) * 768 + h * 96 + 8 * hh;
    const bf16* Vp = F.w<bf16>(WS_VT) + (size_t)(h * 64 + qc) * TP + (size_t)b * SEQ + 4 * hh;
    bf16x8 kf[6]; s16x4 vf[2][2][2];
#define LOADT(kt) do { const bf16* kp_ = Kp + (size_t)(kt) * 32 * 768; _Pragma("unroll") for (int ks = 0; ks < 6; ++ks) kf[ks] = *(const bf16x8*)(kp_ + 16 * ks); \
        const bf16* vp_ = Vp + (kt) * 32; _Pragma("unroll") for (int dt = 0; dt < 2; ++dt) _Pragma("unroll") for (int s2 = 0; s2 < 2; ++s2) { \
            vf[dt][s2][0] = *(const s16x4*)(vp_ + (size_t)dt * 32 * TP + 16 * s2); vf[dt][s2][1] = *(const s16x4*)(vp_ + (size_t)dt * 32 * TP + 16 * s2 + 8); } } while (0)
    LOADT(0);
    for (int kt = 0; kt < nt; ++kt) {
        f32x16 s = {};
#pragma unroll
        for (int ks = 0; ks < 6; ++ks) s = __builtin_amdgcn_mfma_f32_32x32x16_bf16(kf[ks], qf[ks], s, 0, 0, 0);
        bf16x8 va[2][2];
#pragma unroll
        for (int dt = 0; dt < 2; ++dt)
#pragma unroll
            for (int s2 = 0; s2 < 2; ++s2) va[dt][s2] = (bf16x8){vf[dt][s2][0][0], vf[dt][s2][0][1], vf[dt][s2][0][2], vf[dt][s2][0][3], vf[dt][s2][1][0], vf[dt][s2][1][1], vf[dt][s2][1][2], vf[dt][s2][1][3]};
        if (kt + 1 < nt) LOADT(kt + 1);
        float p[16];
        const bool diag = (kt == nt - 1);
#pragma unroll
        for (int i = 0; i < 16; ++i) { float e = __builtin_amdgcn_exp2f(s[i] + negM); if (diag && ((i & 3) + 8 * (i >> 2) + 4 * hh) > qc) e = 0.f; p[i] = e; l += e; }
        bf16x8 pb[2];
#pragma unroll
        for (int s2 = 0; s2 < 2; ++s2) { v4u w; w.x = pg8::cvt_pk_bf16(p[8 * s2 + 0], p[8 * s2 + 1]); w.y = pg8::cvt_pk_bf16(p[8 * s2 + 2], p[8 * s2 + 3]); w.z = pg8::cvt_pk_bf16(p[8 * s2 + 4], p[8 * s2 + 5]); w.w = pg8::cvt_pk_bf16(p[8 * s2 + 6], p[8 * s2 + 7]); pb[s2] = __builtin_bit_cast(bf16x8, w); }
#pragma unroll
        for (int s2 = 0; s2 < 2; ++s2) { o0 = __builtin_amdgcn_mfma_f32_32x32x16_bf16(va[0][s2], pb[s2], o0, 0, 0, 0); o1 = __builtin_amdgcn_mfma_f32_32x32x16_bf16(va[1][s2], pb[s2], o1, 0, 0, 0); }
    }
#undef LOADT
    l += __shfl_xor(l, 32);
    const float rl = 1.f / l;
    bf16* Op = F.w<bf16>(WS_BO) + (size_t)(b * SEQ + q0 + qc) * 512 + h * 64 + 4 * hh;
#pragma unroll
    for (int g = 0; g < 4; ++g) {
        v2u w0; w0.x = pg8::cvt_pk_bf16(o0[4 * g] * rl, o0[4 * g + 1] * rl); w0.y = pg8::cvt_pk_bf16(o0[4 * g + 2] * rl, o0[4 * g + 3] * rl);
        v2u w1; w1.x = pg8::cvt_pk_bf16(o1[4 * g] * rl, o1[4 * g + 1] * rl); w1.y = pg8::cvt_pk_bf16(o1[4 * g + 2] * rl, o1[4 * g + 3] * rl);
        *(v2u*)(Op + 8 * g) = w0; *(v2u*)(Op + 32 + 8 * g) = w1;
    }
}
__device__ __forceinline__ void p5_attn_prompt(Frame& F, float negM) {
    for (int u = F.bid; u < 256; u += F.G) {
        const int bh = u >> 2, p = u & 3, b = bh >> 3, h = bh & 7;
        attn_prompt_wave(F, b, h, 256 * p + 32 * F.wave, negM);
        attn_prompt_wave(F, b, h, 256 * (7 - p) + 32 * (7 - F.wave), negM);
    }
}
}
namespace mk {
constexpr int SA_ROWB = 592;
constexpr int SA_RAW = 0, SA_KPR = 65536, SA_TILE = SA_KPR + 8192, SA_KP2 = SA_TILE + 64 * SA_ROWB, SA_R = SA_KP2 + 256, SA_PT = SA_R + 2048, SA_PTROW = 144, SA_QEXT = SA_PT + 32 * SA_PTROW,
              SA_END = SA_QEXT + 32 * SA_ROWB, SA_QK = SA_RAW;
static_assert(SA_END <= RING_BYTES, "sample attention LDS");
typedef short v4i16_t __attribute__((ext_vector_type(4)));
#define SA_BAR() do { asm volatile("s_waitcnt lgkmcnt(0)" ::: "memory"); __builtin_amdgcn_s_barrier(); asm volatile("" ::: "memory"); } while (0)

__device__ __forceinline__ void attn_sample_unit(Frame& F, int s, int split, float negM) {
    const int tid = F.tid, lane = F.lane, w = F.wave, hh = lane >> 5, l31 = lane & 31;
    LAS unsigned char* L = F.lds;
    const float* pool_ckv = F.inf(I_CKV); const float* pool_kpe = F.inf(I_KPE); const int* pt = (const int*)F.in[I_PT] + s * 64;
    const float* cs = F.w<float>(WS_ROPE); const float* sn = cs + ROPE_N * 16;
    const float* gk = F.inf(I_GQKK);
    {
        const bf16* QF = F.w<bf16>(WS_QF) + (size_t)(TP + 4 * s) * 768;
        for (int i = tid; i < 32 * 64; i += 512) { const int th = i >> 6, d = i & 63, t = th >> 3, h = th & 7;
            ((LAS float*)(L + SA_QK))[i] = bf2f(QF[t * 768 + h * 96 + d]) * gk[d]; }
        for (int i = tid; i < 32 * 32; i += 512) { const int th = i >> 5, e = i & 31, t = th >> 3, h = th & 7;
            *(LAS bf16*)(L + SA_QEXT + th * SA_ROWB + (256 + e) * 2) = QF[t * 768 + h * 96 + 64 + e]; }
    }
    __syncthreads();
    {
        const int c = tid & 255, thb = (tid >> 8) * 16;
        const float* wrow = F.inf(I_WUK) + (size_t)c * 512;
#pragma unroll 1
        for (int i = 0; i < 16; ++i) { const int th = thb + i, h = th & 7;
            const LAS float* qk = (const LAS float*)(L + SA_QK) + th * 64; const float* wp = wrow + h * 64;
            float a = 0.f;
#pragma unroll
            for (int d = 0; d < 64; d += 4) { const f32x4 wv = *(const f32x4*)(wp + d); const f32x4 qv = *(const LAS f32x4*)(qk + d); a += wv[0] * qv[0] + wv[1] * qv[1] + wv[2] * qv[2] + wv[3] * qv[3]; }
            *(LAS bf16*)(L + SA_QEXT + th * SA_ROWB + c * 2) = (bf16)f2bf(a); }
    }
    __syncthreads();
    bf16x8 Wf[2][16];
    { const bf16* Wp = F.w<bf16>(WS_W_UK) + (size_t)(w * 64 + l31) * 256 + 8 * hh;
#pragma unroll
      for (int dt = 0; dt < 2; ++dt)
#pragma unroll
          for (int ks = 0; ks < 16; ++ks) Wf[dt][ks] = *(const bf16x8*)(Wp + (size_t)dt * 32 * 256 + 16 * ks); }
    const int kbeg = split * 4096, NT = split ? 65 : 64;
    const int prow = tid >> 3, pc4 = tid & 7;
    const f32x4 gpe = *(const f32x4*)(gk + 64 + 4 * pc4);
#define SA_DMA(n) do { const int key0_ = kbeg + 64 * (n); const int page_ = pt[key0_ >> 7]; const size_t rb_ = (size_t)page_ * 128 + (key0_ & 127); \
        _Pragma("unroll") for (int i = 0; i < 8; ++i) __builtin_amdgcn_global_load_lds((const unsigned*)(pool_ckv + (rb_ + w + 8 * i) * 256 + 4 * lane), (LAS unsigned*)(L + SA_RAW + (w + 8 * i) * 1024), 16, 0, 0); \
        __builtin_amdgcn_global_load_lds((const unsigned*)(pool_kpe + (rb_ + 8 * w + (lane >> 3)) * 32 + 4 * (lane & 7)), (LAS unsigned*)(L + SA_KPR + w * 1024), 16, 0, 0); } while (0)
#define SA_CONVERT(n) do { const int key0_ = kbeg + 64 * (n); f32x4 pv; \
        if (key0_ < PAST) { \
            _Pragma("unroll") for (int i = 0; i < 8; ++i) { const f32x4 v_ = *(const LAS f32x4*)(L + SA_RAW + (w + 8 * i) * 1024 + 16 * lane); v2u o_; o_.x = pg8::cvt_pk_bf16(v_[0], v_[1]); o_.y = pg8::cvt_pk_bf16(v_[2], v_[3]); \
                *(LAS v2u*)(L + SA_TILE + (w + 8 * i) * SA_ROWB + 8 * lane) = o_; if (i & 1) __builtin_amdgcn_sched_barrier(0); } \
            pv = *(const LAS f32x4*)(L + SA_KPR + prow * 128 + 16 * pc4); \
        } else { \
            _Pragma("unroll") for (int i = 0; i < 8; ++i) { v2u o_ = (v2u){0u, 0u}; if (i == 0 && w < 4) o_ = *(const v2u*)(F.w<bf16>(WS_CKVN) + (size_t)(TP + 4 * s + w) * 256 + 4 * lane); \
                *(LAS v2u*)(L + SA_TILE + (w + 8 * i) * SA_ROWB + 8 * lane) = o_; } \
            pv = (f32x4){0.f, 0.f, 0.f, 0.f}; \
            if (prow < 4) { const v2u r_ = *(const v2u*)(F.w<bf16>(WS_Z) + (size_t)(TP + 4 * s + prow) * NINP + 1536 + 4 * pc4); pv = (f32x4){bflo(r_.x), bfhi(r_.x), bflo(r_.y), bfhi(r_.y)}; } \
        } \
        { float ss_ = (pv[0] * pv[0] + pv[1] * pv[1]) + (pv[2] * pv[2] + pv[3] * pv[3]); ss_ += __shfl_xor(ss_, 1); ss_ += __shfl_xor(ss_, 2); ss_ += __shfl_xor(ss_, 4); \
          if (pc4 == 0) ((LAS float*)(L + SA_KP2))[prow] = ss_; \
          const int pos_ = key0_ + prow; const int fb_ = 4 * (pc4 & 3); \
          const f32x4 c_ = *(const f32x4*)(cs + pos_ * 16 + fb_), s_ = *(const f32x4*)(sn + pos_ * 16 + fb_); \
          f32x4 x_ = pv * gpe, y_, o4_; y_[0] = __shfl_xor(x_[0], 4); y_[1] = __shfl_xor(x_[1], 4); y_[2] = __shfl_xor(x_[2], 4); y_[3] = __shfl_xor(x_[3], 4); \
          if (pc4 < 4) o4_ = x_ * c_ - y_ * s_; else o4_ = x_ * c_ + y_ * s_; \
          v2u o_; o_.x = pg8::cvt_pk_bf16(o4_[0], o4_[1]); o_.y = pg8::cvt_pk_bf16(o4_[2], o4_[3]); *(LAS v2u*)(L + SA_TILE + prow * SA_ROWB + 512 + pc4 * 8) = o_; } } while (0)
    f32x16 oacc = {}; float lsum = 0.f;
    SA_DMA(0);
    asm volatile("s_waitcnt vmcnt(0)" ::: "memory"); SA_BAR();
    SA_CONVERT(0);
    SA_BAR();
    if (NT > 1) SA_DMA(1);
    const int kb = w >> 1, cb = w & 1, l15 = lane & 15, l4 = lane >> 4;
    const int th_s = 16 * cb + l15, t_s = th_s >> 3, h_s = th_s & 7;
#pragma unroll 1
    for (int n = 0; n < NT; ++n) {
        LAS unsigned char* tb = L + SA_TILE;
#pragma unroll
        for (int kt2 = 0; kt2 < 2; ++kt2) {
            const LAS unsigned char* bp = tb + (32 * kt2 + l31) * SA_ROWB + 16 * hh;
            float ss = 0.f;
#pragma unroll
            for (int dt = 0; dt < 2; ++dt) {
                f32x16 a0 = {};
#pragma unroll
                for (int ks = 0; ks < 16; ++ks) { const bf16x8 bfr = *(const LAS bf16x8*)(bp + 32 * ks); a0 = __builtin_amdgcn_mfma_f32_32x32x16_bf16(Wf[dt][ks], bfr, a0, 0, 0, 0); if ((ks & 3) == 3) __builtin_amdgcn_sched_barrier(0); }
#pragma unroll
                for (int i = 0; i < 16; ++i) ss += a0[i] * a0[i];
            }
            ss += __shfl_xor(ss, 32);
            ss += ((const LAS float*)(L + SA_KP2))[32 * kt2 + l31];
            if (hh == 0) ((LAS float*)(L + SA_R))[w * 64 + 32 * kt2 + l31] = rsqrtf(ss * (1.f / 96.f) + EPS);
        }
        SA_BAR();
        {
            typedef float f32x4_t __attribute__((ext_vector_type(4)));
            f32x4_t sacc = {0.f, 0.f, 0.f, 0.f};
            const LAS unsigned char* ap = tb + (16 * kb + l15) * SA_ROWB + 16 * l4;
            const LAS unsigned char* qp = L + SA_QEXT + th_s * SA_ROWB + 16 * l4;
#pragma unroll
            for (int ks = 0; ks < 9; ++ks) { const bf16x8 af = *(const LAS bf16x8*)(ap + 64 * ks); const bf16x8 qf = *(const LAS bf16x8*)(qp + 64 * ks);
                sacc = __builtin_amdgcn_mfma_f32_16x16x32_bf16(af, qf, sacc, 0, 0, 0); if (ks % 3 == 2) __builtin_amdgcn_sched_barrier(0); }
            const f32x4 r4 = *(const LAS f32x4*)(L + SA_R + (h_s * 64 + 16 * kb + 4 * l4) * 4);
            float p[4];
            const int kg = kbeg + 64 * n + 16 * kb + 4 * l4;
#pragma unroll
            for (int i = 0; i < 4; ++i) { float e = __builtin_amdgcn_exp2f(sacc[i] * r4[i] + negM); if (kg + i > PAST + t_s) e = 0.f; p[i] = e; lsum += e; }
            v2u o; o.x = pg8::cvt_pk_bf16(p[0], p[1]); o.y = pg8::cvt_pk_bf16(p[2], p[3]);
            *(LAS v2u*)(L + SA_PT + th_s * SA_PTROW + (16 * kb + 4 * l4) * 2) = o;
        }
        SA_BAR();
        {
            const LAS unsigned char* trp = tb + (8 * hh + (l15 >> 2)) * SA_ROWB + (32 * w + 16 * (l4 & 1) + 4 * (l15 & 3)) * 2;
            const LAS unsigned char* pp = L + SA_PT + l31 * SA_PTROW + 16 * hh;
#pragma unroll
            for (int s2 = 0; s2 < 4; ++s2) {
                const s16x4 lo = __builtin_bit_cast(s16x4, __builtin_amdgcn_ds_read_tr16_b64_v4i16((LAS v4i16_t*)(trp + (16 * s2) * SA_ROWB)));
                const s16x4 hi = __builtin_bit_cast(s16x4, __builtin_amdgcn_ds_read_tr16_b64_v4i16((LAS v4i16_t*)(trp + (16 * s2 + 4) * SA_ROWB)));
                const bf16x8 af = (bf16x8){lo[0], lo[1], lo[2], lo[3], hi[0], hi[1], hi[2], hi[3]};
                const bf16x8 pf = *(const LAS bf16x8*)(pp + 32 * s2);
                oacc = __builtin_amdgcn_mfma_f32_32x32x16_bf16(af, pf, oacc, 0, 0, 0); if (s2 & 1) __builtin_amdgcn_sched_barrier(0);
            }
        }
        if (n + 1 < NT) {
            asm volatile("s_waitcnt vmcnt(0)" ::: "memory"); SA_BAR();
            SA_CONVERT(n + 1);
            SA_BAR();
            if (n + 2 < NT && kbeg + 64 * (n + 2) < PAST) SA_DMA(n + 2);
        }
    }
#undef SA_DMA
#undef SA_CONVERT
    float* part = (float*)(F.ws + WS_SPART + (size_t)(s * 2 + split) * SPART_STRIDE);
    lsum += __shfl_xor(lsum, 16); lsum += __shfl_xor(lsum, 32);
    __syncthreads();
    if (lane < 16) ((LAS float*)(L + SA_R))[kb * 32 + th_s] = lsum;
    __syncthreads();
    if (tid < 32) { const LAS float* lp = (const LAS float*)(L + SA_R); part[tid] = (lp[tid] + lp[32 + tid]) + (lp[64 + tid] + lp[96 + tid]); }
#pragma unroll
    for (int g = 0; g < 4; ++g) *(f32x4*)(part + 32 + l31 * 256 + 32 * w + 8 * g + 4 * hh) = (f32x4){oacc[4 * g], oacc[4 * g + 1], oacc[4 * g + 2], oacc[4 * g + 3]};
    __syncthreads();
}
}
namespace mk {
__device__ __forceinline__ void p6_gmlp_chunk(Frame& F, int chunk) {
    const int lane = F.lane, g = F.wave, hh = lane >> 5, l31 = lane & 31;
    LAS float* SS = (LAS float*)(F.lds + 131072);
    LAS unsigned char* VT_ = F.lds + g * 16384;
    const int row0 = chunk * 128;
    const bf16* VG = F.w<bf16>(WS_VG) + (size_t)row0 * 512 + g * 64;
    const bf16* Z = F.w<bf16>(WS_Z) + (size_t)row0 * NINP + g * 64;
    const float* Wg = F.inf(I_WS) + (size_t)g * 128 * 128;
    const float* bs = F.inf(I_BS) + g * 128;
#pragma unroll
    for (int i = 0; i < 16; ++i) { const int r = (lane >> 3) + 8 * i, ch = lane & 7; const v4u v = *(const v4u*)(VG + (size_t)r * 512 + 8 * ch); *(LAS v4u*)(VT_ + r * 128 + 16 * ch) = v;
        if ((i & 3) == 3) __builtin_amdgcn_sched_barrier(0); }
    LDS_WAIT(); asm volatile("" ::: "memory");
    const int l4 = lane >> 4, l15 = lane & 15;
    const LAS unsigned char* trb = VT_ + (8 * hh + (l15 >> 2)) * 128 + (16 * (l4 & 1) + 4 * (l15 & 3)) * 2;
    bf16* MRG = F.w<bf16>(WS_MRG) + (size_t)row0 * 1024 + g * 64;
#pragma unroll
    for (int tt = 0; tt < 4; ++tt) {
        const int t = 32 * tt + l31;
        f32x16 a0 = {}, a1 = {};
#pragma unroll
        for (int ks = 0; ks < 2 * tt + 2; ++ks) {
            const int s0 = 16 * ks + 8 * hh;
            const f32x4 w0 = *(const f32x4*)(Wg + (size_t)t * 128 + s0), w1 = *(const f32x4*)(Wg + (size_t)t * 128 + s0 + 4);
            float wv[8] = {w0[0], w0[1], w0[2], w0[3], w1[0], w1[1], w1[2], w1[3]};
            if (ks >= 2 * tt) {
#pragma unroll
                for (int j = 0; j < 8; ++j) if (s0 + j > t) wv[j] = 0.f;
            }
            v4u pk; pk.x = pg8::cvt_pk_bf16(wv[0], wv[1]); pk.y = pg8::cvt_pk_bf16(wv[2], wv[3]); pk.z = pg8::cvt_pk_bf16(wv[4], wv[5]); pk.w = pg8::cvt_pk_bf16(wv[6], wv[7]);
            const bf16x8 bfr = __builtin_bit_cast(bf16x8, pk);
            bf16x8 af[2];
#pragma unroll
            for (int dt = 0; dt < 2; ++dt) {
                const s16x4 lo = __builtin_bit_cast(s16x4, __builtin_amdgcn_ds_read_tr16_b64_v4i16((LAS v4i16_t*)(trb + (16 * ks) * 128 + 64 * dt)));
                const s16x4 hi = __builtin_bit_cast(s16x4, __builtin_amdgcn_ds_read_tr16_b64_v4i16((LAS v4i16_t*)(trb + (16 * ks + 4) * 128 + 64 * dt)));
                af[dt] = (bf16x8){lo[0], lo[1], lo[2], lo[3], hi[0], hi[1], hi[2], hi[3]};
            }
            a0 = __builtin_amdgcn_mfma_f32_32x32x16_bf16(af[0], bfr, a0, 0, 0, 0); a1 = __builtin_amdgcn_mfma_f32_32x32x16_bf16(af[1], bfr, a1, 0, 0, 0);
            if (ks & 1) __builtin_amdgcn_sched_barrier(0);
        }
        const float bt = bs[t];
        float ss = 0.f;
#pragma unroll
        for (int dt = 0; dt < 2; ++dt)
#pragma unroll
            for (int gq = 0; gq < 4; ++gq) {
                const v2u ur = *(const v2u*)(Z + (size_t)t * NINP + 32 * dt + 8 * gq + 4 * hh);
                const float u0 = gelu_tanh_f(bflo(ur.x)), u1 = gelu_tanh_f(bfhi(ur.x)), u2 = gelu_tanh_f(bflo(ur.y)), u3 = gelu_tanh_f(bfhi(ur.y));
                const f32x16& acc = dt ? a1 : a0;
                const float v0 = u0 * (acc[4 * gq] + bt), v1 = u1 * (acc[4 * gq + 1] + bt), v2 = u2 * (acc[4 * gq + 2] + bt), v3 = u3 * (acc[4 * gq + 3] + bt);
                ss += (v0 * v0 + v1 * v1) + (v2 * v2 + v3 * v3);
                v2u o; o.x = pg8::cvt_pk_bf16(v0, v1); o.y = pg8::cvt_pk_bf16(v2, v3); *(v2u*)(MRG + (size_t)t * 1024 + 32 * dt + 8 * gq + 4 * hh) = o;
            }
        ss += __shfl_xor(ss, 32);
        if (hh == 0) SS[g * 128 + t] = ss;
    }
    VM_WAIT();
    __syncthreads();
    const float* goa = F.inf(I_GOA) + g * 64;
#pragma unroll
    for (int tt = 0; tt < 4; ++tt) {
        const int t = 32 * tt + l31;
        float tot = 0.f;
#pragma unroll
        for (int k = 0; k < 8; ++k) tot += SS[k * 128 + t];
        const float rstd = rsqrtf(tot * (1.f / 512.f) + EPS);
#pragma unroll
        for (int dt = 0; dt < 2; ++dt)
#pragma unroll
            for (int gq = 0; gq < 4; ++gq) {
                const int d0 = 32 * dt + 8 * gq + 4 * hh;
                const f32x4 gg = *(const f32x4*)(goa + d0);
                const v2u v = *(const v2u*)(MRG + (size_t)t * 1024 + d0);
                v2u o; o.x = pg8::cvt_pk_bf16(bflo(v.x) * rstd * gg[0], bfhi(v.x) * rstd * gg[1]); o.y = pg8::cvt_pk_bf16(bflo(v.y) * rstd * gg[2], bfhi(v.y) * rstd * gg[3]);
                *(v2u*)(MRG + (size_t)t * 1024 + d0) = o;
            }
    }
    __syncthreads();
}
__device__ __forceinline__ void p6_sample_seq(Frame& F, int s) {
    const int tid = F.tid, lane = F.lane, w = F.wave;
    LAS float* OL = (LAS float*)F.lds;
    LAS float* RED = (LAS float*)(F.lds + 32768);
    const float* p0 = (const float*)(F.ws + WS_SPART + (size_t)(s * 2) * SPART_STRIDE); const float* p1 = (const float*)((const unsigned char*)p0 + SPART_STRIDE);
    { const int c = tid & 255, thb = (tid >> 8) * 16;
#pragma unroll 4
      for (int i = 0; i < 16; ++i) { const int th = thb + i; OL[th * 256 + c] = (p0[32 + th * 256 + c] + p1[32 + th * 256 + c]) / (p0[th] + p1[th]); } }
    __syncthreads();
    const int col = tid, h = col >> 6;
    float bo[4] = {0.f, 0.f, 0.f, 0.f};
    { const float* wuv = F.inf(I_WUV) + col;
#pragma unroll 4
      for (int c = 0; c < 256; ++c) { const float wv = wuv[(size_t)c * 512];
#pragma unroll
          for (int t = 0; t < 4; ++t) bo[t] += OL[(t * 8 + h) * 256 + c] * wv; } }
    float ao[4];
    { const int g = col >> 6; const bf16* VG = F.w<bf16>(WS_VG) + (size_t)(TP + 4 * s) * 512 + col; const bf16* Z = F.w<bf16>(WS_Z) + (size_t)(TP + 4 * s) * NINP + col;
      const float* Wg = F.inf(I_WS) + (size_t)g * 128 * 128; const float* bs = F.inf(I_BS) + g * 128;
      float vg[4];
#pragma unroll
      for (int t = 0; t < 4; ++t) vg[t] = bf2f(VG[(size_t)t * 512]);
#pragma unroll
      for (int t = 0; t < 4; ++t) { float m = bs[t];
#pragma unroll
          for (int s2 = 0; s2 <= t; ++s2) m += Wg[t * 128 + s2] * vg[s2];
          ao[t] = gelu_tanh_f(bf2f(Z[(size_t)t * NINP])) * m; } }
    float red[8];
#pragma unroll
    for (int t = 0; t < 4; ++t) { red[t] = wave_sum(ao[t] * ao[t]); red[4 + t] = wave_sum(bo[t] * bo[t]); }
    if (lane < 8) { float v = red[0];
#pragma unroll
        for (int k = 1; k < 8; ++k) v = (lane == k) ? red[k] : v;
        RED[w * 8 + lane] = v; }
    __syncthreads();
    const float ga = F.inf(I_GOA)[col], gb = F.inf(I_GOB)[col];
    bf16* MRG = F.w<bf16>(WS_MRG) + (size_t)(TP + 4 * s) * 1024; bf16* BO = F.w<bf16>(WS_BO) + (size_t)(TP + 4 * s) * 512;
#pragma unroll
    for (int t = 0; t < 4; ++t) {
        float sa = 0.f, sb = 0.f;
#pragma unroll
        for (int k = 0; k < 8; ++k) { sa += RED[k * 8 + t]; sb += RED[k * 8 + 4 + t]; }
        MRG[(size_t)t * 1024 + col] = (bf16)f2bf(ao[t] * rsqrtf(sa * (1.f / 512.f) + EPS) * ga);
        MRG[(size_t)t * 1024 + 512 + col] = (bf16)f2bf(bo[t] * rsqrtf(sb * (1.f / 512.f) + EPS) * gb);
        BO[(size_t)t * 512 + col] = (bf16)f2bf(bo[t]);
    }
    __syncthreads();
}
__device__ __forceinline__ void p6_merge(Frame& F) {
    for (int u = F.bid; u < 256; u += F.G) { if (u < 128) p6_gmlp_chunk(F, u); else p6_sample_seq(F, u - 128); }
    const int gw = F.bid * NWAVES + F.wave, NGW = F.G * NWAVES, lane = F.lane;
    const f32x4 g0 = *(const f32x4*)(F.inf(I_GOB) + 8 * lane), g1 = *(const f32x4*)(F.inf(I_GOB) + 8 * lane + 4);
    for (int r = gw; r < TP; r += NGW) {
        const v4u raw = *(const v4u*)(F.w<bf16>(WS_BO) + (size_t)r * 512 + 8 * lane);
        float x[8];
#pragma unroll
        for (int i = 0; i < 4; ++i) { x[2 * i] = bflo(raw[i]); x[2 * i + 1] = bfhi(raw[i]); }
        float ss = 0.f;
#pragma unroll
        for (int i = 0; i < 8; ++i) ss += x[i] * x[i];
        const float rstd = rsqrtf(wave_sum(ss) * (1.f / 512.f) + EPS);
        v4u o; o.x = pk2(x[0] * rstd * g0[0], x[1] * rstd * g0[1]); o.y = pk2(x[2] * rstd * g0[2], x[3] * rstd * g0[3]); o.z = pk2(x[4] * rstd * g1[0], x[5] * rstd * g1[1]); o.w = pk2(x[6] * rstd * g1[2], x[7] * rstd * g1[3]);
        *(v4u*)(F.w<bf16>(WS_MRG) + (size_t)r * 1024 + 512 + 8 * lane) = o;
    }
}
}
namespace mk {
__device__ __forceinline__ void p_rms_rows(Frame& F, size_t src_off, int gain_idx, size_t dst_off) {
    const int gw = F.bid * NWAVES + F.wave, NGW = F.G * NWAVES;
    for (int r = gw; r < T; r += NGW) rms_row_to_bf16(F.w<float>(src_off) + (size_t)r * D, F.inf(gain_idx), F.w<bf16>(dst_off) + (size_t)r * D, F.lane);
}

__device__ __forceinline__ void memattn_prompt_wave(Frame& F, int rb, int h, float negM) {
    const int lane = F.lane, l31 = lane & 31, hh = lane >> 5;
    const int row = 32 * rb + l31, b = rb >> 6;
    const bf16* Qp = F.w<bf16>(WS_MQ) + (size_t)row * 512 + h * 128 + 8 * hh;
    const float* g = F.inf(I_GMQ) + 8 * hh;
    bf16x8 qf[8];
    {
        v4u raw[8]; float ss = 0.f;
#pragma unroll
        for (int ks = 0; ks < 8; ++ks) { raw[ks] = *(const v4u*)(Qp + 16 * ks);
#pragma unroll
            for (int i = 0; i < 4; ++i) { const float a = bflo(raw[ks][i]), c = bfhi(raw[ks][i]); ss += a * a + c * c; } }
        ss += __shfl_xor(ss, 32);
        const float rs = rsqrtf(ss * (1.f / 128.f) + EPS) * MQSCALE;
#pragma unroll
        for (int ks = 0; ks < 8; ++ks) { const f32x4 g0 = *(const f32x4*)(g + 16 * ks), g1 = *(const f32x4*)(g + 16 * ks + 4); v4u o;
            o.x = pg8::cvt_pk_bf16(bflo(raw[ks][0]) * rs * g0[0], bfhi(raw[ks][0]) * rs * g0[1]); o.y = pg8::cvt_pk_bf16(bflo(raw[ks][1]) * rs * g0[2], bfhi(raw[ks][1]) * rs * g0[3]);
            o.z = pg8::cvt_pk_bf16(bflo(raw[ks][2]) * rs * g1[0], bfhi(raw[ks][2]) * rs * g1[1]); o.w = pg8::cvt_pk_bf16(bflo(raw[ks][3]) * rs * g1[2], bfhi(raw[ks][3]) * rs * g1[3]);
            qf[ks] = __builtin_bit_cast(bf16x8, o); }
    }
    f32x16 o[4]; o[0] = f32x16{}; o[1] = f32x16{}; o[2] = f32x16{}; o[3] = f32x16{};
    float l = 0.f;
    const bf16* Kp = F.w<bf16>(WS_MK) + (size_t)(b * 256 + l31) * 512 + h * 128 + 8 * hh;
    const bf16* Vp = F.w<bf16>(WS_MVT) + ((size_t)(b * 4 + h) * 128 + l31) * 256 + 4 * hh;
#pragma unroll 1
    for (int kt = 0; kt < 8; ++kt) {
        f32x16 s = {};
#pragma unroll
        for (int ks = 0; ks < 8; ++ks) { const bf16x8 kf = *(const bf16x8*)(Kp + (size_t)kt * 32 * 512 + 16 * ks); s = __builtin_amdgcn_mfma_f32_32x32x16_bf16(kf, qf[ks], s, 0, 0, 0); }
        float p[16];
#pragma unroll
        for (int i = 0; i < 16; ++i) { p[i] = __builtin_amdgcn_exp2f(s[i] + negM); l += p[i]; }
        bf16x8 pb[2];
#pragma unroll
        for (int s2 = 0; s2 < 2; ++s2) { v4u w; w.x = pg8::cvt_pk_bf16(p[8 * s2 + 0], p[8 * s2 + 1]); w.y = pg8::cvt_pk_bf16(p[8 * s2 + 2], p[8 * s2 + 3]); w.z = pg8::cvt_pk_bf16(p[8 * s2 + 4], p[8 * s2 + 5]); w.w = pg8::cvt_pk_bf16(p[8 * s2 + 6], p[8 * s2 + 7]); pb[s2] = __builtin_bit_cast(bf16x8, w); }
#pragma unroll
        for (int dt = 0; dt < 4; ++dt)
#pragma unroll
            for (int s2 = 0; s2 < 2; ++s2) { const bf16* vp = Vp + (size_t)dt * 32 * 256 + kt * 32 + 16 * s2; const s16x4 lo = *(const s16x4*)vp, hi = *(const s16x4*)(vp + 8);
                const bf16x8 va = (bf16x8){lo[0], lo[1], lo[2], lo[3], hi[0], hi[1], hi[2], hi[3]};
                o[dt] = __builtin_amdgcn_mfma_f32_32x32x16_bf16(va, pb[s2], o[dt], 0, 0, 0); }
    }
    l += __shfl_xor(l, 32);
    const float rl = 1.f / l;
    bf16* Op = F.w<bf16>(WS_MO) + (size_t)row * 512 + h * 128 + 4 * hh;
#pragma unroll
    for (int dt = 0; dt < 4; ++dt)
#pragma unroll
        for (int gq = 0; gq < 4; ++gq) { v2u w0; w0.x = pg8::cvt_pk_bf16(o[dt][4 * gq] * rl, o[dt][4 * gq + 1] * rl); w0.y = pg8::cvt_pk_bf16(o[dt][4 * gq + 2] * rl, o[dt][4 * gq + 3] * rl);
            *(v2u*)(Op + 32 * dt + 8 * gq) = w0; }
}
__device__ __forceinline__ void memattn_sample_wave(Frame& F, int s, int h) {
    const int lane = F.lane, l31 = lane & 31, hh = lane >> 5;
    LAS float* SC = (LAS float*)(F.lds + F.wave * 4096);
    f32x4 q[4];
    { const f32x4 g = *(const f32x4*)(F.inf(I_GMQ) + 4 * l31);
#pragma unroll
      for (int t = 0; t < 4; ++t) { const v2u raw = *(const v2u*)(F.w<bf16>(WS_MQ) + (size_t)(TP + 4 * s + t) * 512 + h * 128 + 4 * l31);
          f32x4 x = (f32x4){bflo(raw.x), bfhi(raw.x), bflo(raw.y), bfhi(raw.y)};
          float ss = (x[0] * x[0] + x[1] * x[1]) + (x[2] * x[2] + x[3] * x[3]);
          ss += __shfl_xor(ss, 1); ss += __shfl_xor(ss, 2); ss += __shfl_xor(ss, 4); ss += __shfl_xor(ss, 8); ss += __shfl_xor(ss, 16);
          const float rs = rsqrtf(ss * (1.f / 128.f) + EPS) * 0.08838834764831845f;
          q[t] = x * rs * g; } }
    const float* Kc = F.inf(I_CMK) + ((size_t)s * 256 * 4 + h) * 128 + 4 * l31;
    const float* Vc = F.inf(I_CMV) + ((size_t)s * 256 * 4 + h) * 128 + 4 * l31;
#pragma unroll 2
    for (int kp = 0; kp < 128; kp += 4) {
        f32x4 kv[4];
#pragma unroll
        for (int u = 0; u < 4; ++u) kv[u] = __builtin_nontemporal_load((const f32x4*)(Kc + (size_t)(2 * (kp + u) + hh) * 512));
#pragma unroll
        for (int u = 0; u < 4; ++u) {
            float d[4];
#pragma unroll
            for (int t = 0; t < 4; ++t) { float a = (kv[u][0] * q[t][0] + kv[u][1] * q[t][1]) + (kv[u][2] * q[t][2] + kv[u][3] * q[t][3]);
                a += __shfl_xor(a, 1); a += __shfl_xor(a, 2); a += __shfl_xor(a, 4); a += __shfl_xor(a, 8); a += __shfl_xor(a, 16); d[t] = a; }
            if (l31 < 4) { const float v = l31 == 0 ? d[0] : (l31 == 1 ? d[1] : (l31 == 2 ? d[2] : d[3])); SC[l31 * 256 + 2 * (kp + u) + hh] = v; }
        }
    }
    LDS_WAIT(); asm volatile("" ::: "memory");
    float rsum[4];
#pragma unroll
    for (int t = 0; t < 4; ++t) {
        f32x4 sc = *(const LAS f32x4*)(SC + t * 256 + 4 * lane);
        float m = fmaxf(fmaxf(sc[0], sc[1]), fmaxf(sc[2], sc[3]));
#pragma unroll
        for (int o = 1; o < 64; o <<= 1) m = fmaxf(m, __shfl_xor(m, o));
        f32x4 e; float sum = 0.f;
#pragma unroll
        for (int i = 0; i < 4; ++i) { e[i] = __expf(sc[i] - m); sum += e[i]; }
        rsum[t] = 1.f / wave_sum(sum);
        *(LAS f32x4*)(SC + t * 256 + 4 * lane) = e;
    }
    LDS_WAIT(); asm volatile("" ::: "memory");
    f32x4 o[4]; o[0] = o[1] = o[2] = o[3] = (f32x4){0.f, 0.f, 0.f, 0.f};
#pragma unroll 2
    for (int kp = 0; kp < 128; kp += 4) {
        f32x4 vv[4];
#pragma unroll
        for (int u = 0; u < 4; ++u) vv[u] = __builtin_nontemporal_load((const f32x4*)(Vc + (size_t)(2 * (kp + u) + hh) * 512));
#pragma unroll
        for (int u = 0; u < 4; ++u)
#pragma unroll
            for (int t = 0; t < 4; ++t) { const float p = SC[t * 256 + 2 * (kp + u) + hh]; o[t] += vv[u] * p; }
    }
#pragma unroll
    for (int t = 0; t < 4; ++t) {
#pragma unroll
        for (int i = 0; i < 4; ++i) o[t][i] += __shfl_xor(o[t][i], 32);
        if (hh == 0) { v2u w; w.x = pg8::cvt_pk_bf16(o[t][0] * rsum[t], o[t][1] * rsum[t]); w.y = pg8::cvt_pk_bf16(o[t][2] * rsum[t], o[t][3] * rsum[t]);
            *(v2u*)(F.w<bf16>(WS_MO) + (size_t)(TP + 4 * s + t) * 512 + h * 128 + 4 * l31) = w; }
    }
    LDS_WAIT(); asm volatile("" ::: "memory");
}
__device__ __forceinline__ void p10_memattn(Frame& F) {
    const float negM = -(LOG2E * 11.313708498984761f * gain_absmax(F.inf(I_GMQ), 128, F.lane) * gain_absmax(F.inf(I_GMK), 128, F.lane) * 1.01f);
    const int gw = F.bid * NWAVES + F.wave, NGW = F.G * NWAVES;
    for (int u = gw; u < 2048; u += NGW) memattn_prompt_wave(F, u >> 2, u & 3, negM);
    for (int u = gw; u < 512; u += NGW) memattn_sample_wave(F, u >> 2, u & 3);
}

__device__ __forceinline__ void p14_conv_gate(Frame& F) {
    const int gw = F.bid * NWAVES + F.wave, NGW = F.G * NWAVES, lane = F.lane;
    const bf16* UP = F.w<bf16>(WS_UP);
    const float* wc = F.inf(I_WCONV); const float* bc = F.inf(I_BCONV); const float* st = F.inf(I_CONVST);
    for (int r = gw; r < T; r += NGW) {
        const bool samp = r >= TP;
        const int t = samp ? ((r - TP) & 3) : (r & 2047);
        const int n = samp ? ((r - TP) >> 2) : (r >> 11);
        const bf16* g0p = UP + (size_t)r * (2 * DFF);
        float* cout = nullptr;
        if (!samp && t >= SEQ - 2) cout = F.out + O_PCONV + (size_t)(n * 2 + (t - (SEQ - 2))) * DFF;
        if (samp && t >= 2) cout = F.out + O_SCONV + (size_t)(n * 2 + (t - 2)) * DFF;
        for (int ch = lane; ch < DFF / 8; ch += 64) {
            const int f = 8 * ch;
            float g0[8], g1[8], g2[8], vv[8];
            { const v4u a = *(const v4u*)(g0p + f); const v4u v = *(const v4u*)(g0p + DFF + f);
#pragma unroll
              for (int i = 0; i < 4; ++i) { g0[2 * i] = bflo(a[i]); g0[2 * i + 1] = bfhi(a[i]); vv[2 * i] = bflo(v[i]); vv[2 * i + 1] = bfhi(v[i]); } }
#pragma unroll
            for (int k = 1; k <= 2; ++k) {
                float* dst = (k == 1) ? g1 : g2;
                if (t - k >= 0) { const v4u a = *(const v4u*)(g0p - (size_t)k * (2 * DFF) + f);
#pragma unroll
                    for (int i = 0; i < 4; ++i) { dst[2 * i] = bflo(a[i]); dst[2 * i + 1] = bfhi(a[i]); } }
                else if (samp) { const float* sp = st + (size_t)(n * 2 + (2 + t - k)) * DFF + f; const f32x4 a = *(const f32x4*)sp, b = *(const f32x4*)(sp + 4);
#pragma unroll
                    for (int i = 0; i < 4; ++i) { dst[i] = a[i]; dst[4 + i] = b[i]; } }
                else {
#pragma unroll
                    for (int i = 0; i < 8; ++i) dst[i] = 0.f; }
            }
            float hv[8];
#pragma unroll
            for (int half = 0; half < 2; ++half) {
                const f32x4 w0 = *(const f32x4*)(wc + f + 4 * half), w1 = *(const f32x4*)(wc + DFF + f + 4 * half), w2 = *(const f32x4*)(wc + 2 * DFF + f + 4 * half), bb = *(const f32x4*)(bc + f + 4 * half);
#pragma unroll
                for (int i = 0; i < 4; ++i) { const int e = 4 * half + i; const float c = bb[i] + g2[e] * w0[i] + g1[e] * w1[i] + g0[e] * w2[i];
                    hv[e] = c / (1.f + __expf(-c)) * vv[e]; }
            }
            v4u o; o.x = pk2(hv[0], hv[1]); o.y = pk2(hv[2], hv[3]); o.z = pk2(hv[4], hv[5]); o.w = pk2(hv[6], hv[7]);
            *(v4u*)(F.w<bf16>(WS_HID) + (size_t)r * DFF + f) = o;
            if (cout) { *(f32x4*)(cout + f) = (f32x4){g0[0], g0[1], g0[2], g0[3]}; *(f32x4*)(cout + f + 4) = (f32x4){g0[4], g0[5], g0[6], g0[7]}; }
        }
    }
}
}
namespace mk {
constexpr int N_PHASES = 16;
__global__ void __launch_bounds__(NWAVES * 64, 2) mk_fwd(Args args) {
    extern __shared__ __attribute__((aligned(16))) unsigned char lds[];
    Frame F;
    F.lds = (LAS unsigned char*)lds; F.lds_g = lds;
    F.tid = threadIdx.x; F.lane = F.tid & 63; F.wave = __builtin_amdgcn_readfirstlane(F.tid >> 6);
    F.G = gridDim.x; F.bid = blockIdx.x;
    F.ws = args.ws; F.out = args.out; F.in = (const float* const*)args.in;
    volatile LAS unsigned* MISC = (volatile LAS unsigned*)(F.lds + MISC_OFF);
    for (int u = F.tid; u < (LDS_BYTES - RING_BYTES) / 4; u += NWAVES * 64) ((LAS unsigned*)(F.lds + RING_BYTES))[u] = 0u;
    __syncthreads();
    unsigned* ctl = (unsigned*)(F.ws + WS_CTL);
    XcdBarrier bar = xcd_barrier_post(ctl + CW_BAR, MISC + 8);
    const int lo = args.ph_lo, hi = args.ph_hi;
    if (F.G != 256) return;
#define IN(k) (lo <= (k) && (k) < hi)
#define SEAM(k) do { if (IN(k) && IN((k) + 1)) xcd_barrier(bar); } while (0)

    if (IN(0)) { p0_prologue(F); }
    SEAM(0);
    if (IN(1)) {
        { pg8::Gemm g{F.w<bf16>(WS_XN), F.w<bf16>(WS_W_IN), T, NINP, D}; pg8::StaticOrder S; S.init(T, NINP, F.G, F.bid);
          pg8::EpiBf16 E{F.w<bf16>(WS_Z), NINP, 1.f};
          pg8::gemm_phase<pg8::EpiBf16, pg8::StaticOrder, true, true>(F.lds, g, S, E); }
        { pg8::Gemm g{F.w<bf16>(WS_MN), F.w<bf16>(WS_W_MKV), 2048, 1024, D}; pg8::StaticOrder S; S.init(2048, 1024, F.G, (F.bid + F.G - 206) % F.G);
          pg8::EpiBf16 E{F.w<bf16>(WS_MKV), 1024, 1.f};
          pg8::gemm_phase<pg8::EpiBf16, pg8::StaticOrder, true, true>(F.lds, g, S, E); }
    }
    SEAM(1);
    if (IN(2)) { p2_post_inproj(F); }
    SEAM(2);
    if (IN(3)) {
        { pg8::Gemm g{F.w<bf16>(WS_CQN), F.w<bf16>(WS_W_UQ), T, 768, 256}; pg8::StaticOrder S; S.init(T, 768, F.G, F.bid);
          pg8::EpiBf16 E{F.w<bf16>(WS_QR), 768, 1.f};
          pg8::gemm_phase<pg8::EpiBf16, pg8::StaticOrder, true, true>(F.lds, g, S, E); }
        { pg8::Gemm g{F.w<bf16>(WS_CKVN), F.w<bf16>(WS_W_UK), TP, 512, 256}; pg8::StaticOrder S; S.init(TP, 512, F.G, (F.bid + F.G - 198) % F.G);
          pg8::EpiBf16 E{F.w<bf16>(WS_KNR), 512, 1.f};
          pg8::gemm_phase<pg8::EpiBf16, pg8::StaticOrder, true, true>(F.lds, g, S, E); }
        { pg8::Gemm g{F.w<bf16>(WS_W_UV), F.w<bf16>(WS_CKVN), 512, TP, 256}; pg8::StaticOrder S; S.init(512, TP, F.G, (F.bid + F.G - 70) % F.G);
          pg8::EpiBf16 E{F.w<bf16>(WS_VT), TP, 1.f};
          pg8::gemm_phase<pg8::EpiBf16, pg8::StaticOrder, true, true>(F.lds, g, S, E); }
    }
    SEAM(3);
    if (IN(4)) { p4_qk_norm_rope(F); }
    SEAM(4);
    if (IN(5)) {
        const float mq_ = gain_absmax(F.inf(I_GQKQ), 96, F.lane), mk2_ = gain_absmax(F.inf(I_GQKK), 96, F.lane);
        const float negM = -(LOG2E * 9.797958971132712f * mq_ * mk2_ * 1.01f);
        if (F.bid & 1) p5_attn_prompt(F, negM);
        attn_sample_unit(F, F.bid >> 1, F.bid & 1, negM);
        if (!(F.bid & 1)) p5_attn_prompt(F, negM);
    }
    SEAM(5);
    if (IN(6)) { p6_merge(F); }
    SEAM(6);
    if (IN(7)) { pg8::Gemm g{F.w<bf16>(WS_MRG), F.w<bf16>(WS_W_O), T, 1024, 1024}; pg8::StaticOrder S; S.init(T, 1024, F.G, F.bid);
        pg8::EpiResF32 E{F.inf(I_XP), F.inf(I_XS), TP / 256, F.w<float>(WS_X1), 1024};
        pg8::gemm_phase<pg8::EpiResF32, pg8::StaticOrder, true, true>(F.lds, g, S, E); }
    SEAM(7);
    if (IN(8)) { p_rms_rows(F, WS_X1, I_GMEMX, WS_H2); }
    SEAM(8);
    if (IN(9)) { pg8::Gemm g{F.w<bf16>(WS_H2), F.w<bf16>(WS_W_MQ), T, 512, 1024}; pg8::StaticOrder S; S.init(T, 512, F.G, F.bid);
        pg8::EpiBf16 E{F.w<bf16>(WS_MQ), 512, 1.f};
        pg8::gemm_phase<pg8::EpiBf16, pg8::StaticOrder, true, true>(F.lds, g, S, E); }
    SEAM(9);
    if (IN(10)) { p10_memattn(F); }
    SEAM(10);
    if (IN(11)) { pg8::Gemm g{F.w<bf16>(WS_MO), F.w<bf16>(WS_W_MO), T, 1024, 512}; pg8::StaticOrder S; S.init(T, 1024, F.G, F.bid);
        pg8::EpiResF32 E{F.w<float>(WS_X1), F.w<float>(WS_X1), 1 << 20, F.w<float>(WS_X2), 1024};
        pg8::gemm_phase<pg8::EpiResF32, pg8::StaticOrder, true, true>(F.lds, g, S, E); }
    SEAM(11);
    if (IN(12)) { p_rms_rows(F, WS_X2, I_GFFN, WS_H3); }
    SEAM(12);
    if (IN(13)) { pg8::Gemm g{F.w<bf16>(WS_H3), F.w<bf16>(WS_W_UP), T, 2 * DFF, 1024}; pg8::StaticOrder S; S.init(T, 2 * DFF, F.G, F.bid);
        pg8::EpiBf16 E{F.w<bf16>(WS_UP), 2 * DFF, 1.f};
        pg8::gemm_phase<pg8::EpiBf16, pg8::StaticOrder, true, true>(F.lds, g, S, E); }
    SEAM(13);
    if (IN(14)) { p14_conv_gate(F); }
    SEAM(14);
    if (IN(15)) { pg8::Gemm g{F.w<bf16>(WS_HID), F.w<bf16>(WS_W_DN), T, 1024, DFF}; pg8::StaticOrder S; S.init(T, 1024, F.G, F.bid);
        pg8::EpiResF32 E{F.w<float>(WS_X2), F.w<float>(WS_X2), 1 << 20, F.out + O_YP, 1024};
        pg8::gemm_phase<pg8::EpiResF32, pg8::StaticOrder, true, true>(F.lds, g, S, E); }
#undef IN
#undef SEAM
}
}
extern "C" void kernel_launch(void* const* d_in, const int* in_sizes, int n_in, void* d_out, int out_size, void* d_ws, size_t ws_size, hipStream_t stream) {
    using namespace mk;
    static int ready = 0;
    if (ready == 0) {
        if (n_in != 38 || out_size != 25292800 || ws_size < WS_MK_END) { fprintf(stderr, "kernel_launch: unexpected n_in %d / out_size %d / ws %zu\n", n_in, out_size, ws_size); ready = -1; return; }
        if (hipFuncSetAttribute((const void*)mk_fwd, hipFuncAttributeMaxDynamicSharedMemorySize, LDS_BYTES) != hipSuccess) { fprintf(stderr, "kernel_launch: hipFuncSetAttribute failed\n"); ready = -1; return; }
        int dev = 0, cus = 0, per_cu = 0;
        (void)hipGetDevice(&dev); (void)hipDeviceGetAttribute(&cus, hipDeviceAttributeMultiprocessorCount, dev);
        (void)hipOccupancyMaxActiveBlocksPerMultiprocessor(&per_cu, (const void*)mk_fwd, NWAVES * 64, LDS_BYTES);
        if (cus < 256 || per_cu < 1) fprintf(stderr, "kernel_launch: note: %d CUs, occupancy query %d (this kernel needs 256 resident workgroups of %d B LDS)\n", cus, per_cu, LDS_BYTES);
        (void)hipGetLastError();
        ready = 1;
    }
    if (ready < 0) return;
    (void)hipMemsetAsync((unsigned char*)d_ws + WS_CTL, 0, CTL_ZERO_BYTES, stream);
    Args a{}; for (int i = 0; i < 38; ++i) a.in[i] = d_in[i];
    a.out = (float*)d_out; a.ws = (unsigned char*)d_ws; a.ph_lo = 0; a.ph_hi = N_PHASES;
    hipLaunchKernelGGL(mk_fwd, dim3(256), dim3(NWAVES * 64), LDS_BYTES, stream, a);
}
```

```cpp
#include <hip/hip_runtime.h>
#include <cstdio>
#include <cstdint>
#include <cmath>
#define GAS __attribute__((address_space(1)))
#define LAS __attribute__((address_space(3)))
typedef unsigned short bf16;
typedef unsigned v4u __attribute__((ext_vector_type(4)));
typedef unsigned v2u __attribute__((ext_vector_type(2)));
typedef float f32x4 __attribute__((ext_vector_type(4)));
typedef float f32x16 __attribute__((ext_vector_type(16)));
typedef short bf16x8 __attribute__((ext_vector_type(8)));
typedef short s16x4 __attribute__((ext_vector_type(4)));
#define LDS_WAIT() asm volatile("s_waitcnt lgkmcnt(0)" ::: "memory")
#define VM_WAIT() asm volatile("s_waitcnt vmcnt(0)" ::: "memory")
__device__ __forceinline__ unsigned f2bf(float f) { unsigned u = __builtin_bit_cast(unsigned, f); return (u + 0x7fffu + ((u >> 16) & 1u)) >> 16; }
__device__ __forceinline__ unsigned pk2(float lo, float hi) { return f2bf(lo) | (f2bf(hi) << 16); }
typedef float f32x2_t __attribute__((ext_vector_type(2))); typedef __bf16 bf16x2_t __attribute__((ext_vector_type(2)));
__device__ __forceinline__ unsigned cvtpk(float lo, float hi) { f32x2_t v = {lo, hi}; bf16x2_t b = __builtin_convertvector(v, bf16x2_t); return __builtin_bit_cast(unsigned, b); }
__device__ __forceinline__ float bf2f(unsigned short b) { return __builtin_bit_cast(float, (unsigned)b << 16); }
__device__ __forceinline__ float bflo(unsigned w) { return __builtin_bit_cast(float, w << 16); }
__device__ __forceinline__ float bfhi(unsigned w) { return __builtin_bit_cast(float, w & 0xffff0000u); }
__device__ __forceinline__ int opaque_i(int x) { asm volatile("" : "+v"(x)); return x; }
__device__ __forceinline__ float wave_sum(float v) {
#pragma unroll
    for (int o = 1; o < 64; o <<= 1) v += __shfl_xor(v, o);
    return v;
}
__device__ __forceinline__ float gelu_tanh_f(float x) {
    const float t = x * (-2.3022082062f - 0.1029432457f * x * x);
    return x * __builtin_amdgcn_rcpf(1.f + __builtin_amdgcn_exp2f(t));
}
namespace pg8 {
#define PG8_LAS __attribute__((address_space(3)))
typedef unsigned short bf16_t;
typedef short bf16x8 __attribute__((ext_vector_type(8)));
typedef float f32x4 __attribute__((ext_vector_type(4)));
typedef unsigned u32x4 __attribute__((ext_vector_type(4)));
constexpr int BM = 256, BK = 64, HALF = 128, HTB = HALF * BK * 2  , STAGE_BYTES = 8 * HTB, NXCD = 8, WGM = 8;

__host__ __device__ __forceinline__ int lds_byte(int r, int c) { const int st = (r >> 4) * 2 + (c >> 5), rr = r & 15, cc = c & 31, ob = rr * 64 + cc * 2; return st * 1024 + (ob ^ (((ob >> 9) & 1) << 5)); }
__host__ __device__ __forceinline__ void stage_rc(int b, int& R, int& C) { const int st = b / 1024, sb = b % 1024, swz = sb ^ (((sb >> 9) & 1) << 5); R = (st >> 1) * 16 + swz / 64; C = (st & 1) * 32 + (swz % 64) / 2; }
__host__ __device__ __forceinline__ int perm32(int rho) { const int n = rho >> 4, i = rho & 15; return 8 * (i >> 2) + 4 * n + (i & 3); }

struct Unit { int pm, pn; };
struct Gemm { const bf16_t* A; const bf16_t* Bt; int M, N, K; };

struct StaticOrder {
    int nM, nN, nwg, G, c;
    __host__ __device__ void init(int M, int N, int G_, int c_) { nM = M / BM; nN = N / BM; nwg = nM * nN; G = G_; c = c_; }
    __host__ __device__ bool next(int i, Unit& u) const {
        const long L = (long)i * G + c; if (L >= nwg) return false;
        int wgid = (int)L; { const int q = nwg / NXCD, r = nwg % NXCD, xcd = wgid % NXCD, off = wgid / NXCD; wgid = (xcd < r ? xcd * (q + 1) : r * (q + 1) + (xcd - r) * q) + off; }
        const int nig = WGM * nN, gid = wgid / nig, fm = gid * WGM, gsz = (nM - fm) < WGM ? (nM - fm) : WGM;
        u.pm = fm + ((wgid % nig) % gsz); u.pn = (wgid % nig) / gsz; return true;
    }
    __device__ __forceinline__ void a_ready(const Unit&) const {}
    __device__ __forceinline__ void done(const Unit&) const {}
};

__device__ __forceinline__ unsigned cvt_pk_bf16(float lo, float hi) { unsigned r; asm volatile("v_cvt_pk_bf16_f32 %0, %1, %2" : "=v"(r) : "v"(lo), "v"(hi)); return r; }
typedef float f32x2 __attribute__((ext_vector_type(2)));
struct EpiBf16 {
    static constexpr bool PERM = true, AFTER_DRAIN = false;
    bf16_t* O; int ldc; float scale;
    __device__ __forceinline__ void operator()(const f32x4 (&acc)[2][2][4][2], const Unit& u, int wr, int wc, int fr, int fq) const {
        const int row0 = u.pm * BM + wr * 64 + fr; const int col0 = u.pn * BM + wc * 32 + 8 * fq;
#pragma unroll
        for (int ai = 0; ai < 2; ++ai)
#pragma unroll
            for (int m = 0; m < 4; ++m) { bf16_t* rowp = O + (size_t)(row0 + ai * HALF + m * 16) * ldc + col0;
#pragma unroll
                for (int bj = 0; bj < 2; ++bj) { const f32x4 v0 = acc[ai][bj][m][0] * scale, v1 = acc[ai][bj][m][1] * scale;
                    u32x4 w; w.x = cvt_pk_bf16(v0[0], v0[1]); w.y = cvt_pk_bf16(v0[2], v0[3]); w.z = cvt_pk_bf16(v1[0], v1[1]); w.w = cvt_pk_bf16(v1[2], v1[3]);
                    *(u32x4*)(rowp + bj * HALF) = w; } }
    }
};
struct EpiResF32 {
    static constexpr bool PERM = false, AFTER_DRAIN = false;
    const float* res0; const float* res1; int split_pm; float* out; int ldc;
    __device__ __forceinline__ void operator()(const f32x4 (&acc)[2][2][4][2], const Unit& u, int wr, int wc, int fr, int fq) const {
        const int row0 = u.pm * BM + wr * 64 + fr; const int col0 = u.pn * BM + wc * 32 + 4 * fq;
        const float* rb = (u.pm < split_pm) ? res0 : res1 - (size_t)split_pm * BM * ldc;
#pragma unroll
        for (int ai = 0; ai < 2; ++ai)
#pragma unroll
            for (int m = 0; m < 4; ++m) { const size_t off = (size_t)(row0 + ai * HALF + m * 16) * ldc + col0;
#pragma unroll
                for (int bj = 0; bj < 2; ++bj)
#pragma unroll
                    for (int n = 0; n < 2; ++n) { const f32x4 r = *(const f32x4*)(rb + off + bj * HALF + n * 16); *(f32x4*)(out + off + bj * HALF + n * 16) = acc[ai][bj][m][n] + r; }
                if (m & 1) asm volatile("" ::: "memory"); }
    }
};
struct EpiResF32N {
    static constexpr bool PERM = false, AFTER_DRAIN = false;
    const float* res0; const float* res1; int split_pm; float* out; bf16_t* outb; float* ssq; int ldc;
    __device__ __forceinline__ void operator()(const f32x4 (&acc)[2][2][4][2], const Unit& u, int wr, int wc, int fr, int fq) const {
        const int row0 = u.pm * BM + wr * 64 + fr; const int col0 = u.pn * BM + wc * 32 + 4 * fq;
        const float* rb = (u.pm < split_pm) ? res0 : res1 - (size_t)split_pm * BM * ldc;
#pragma unroll
        for (int ai = 0; ai < 2; ++ai)
#pragma unroll
            for (int m = 0; m < 4; ++m) { const int row = row0 + ai * HALF + m * 16; const size_t off = (size_t)row * ldc + col0; float s = 0.f;
#pragma unroll
                for (int bj = 0; bj < 2; ++bj)
#pragma unroll
                    for (int n = 0; n < 2; ++n) { const f32x4 r = *(const f32x4*)(rb + off + bj * HALF + n * 16); const f32x4 v = acc[ai][bj][m][n] + r; *(f32x4*)(out + off + bj * HALF + n * 16) = v;
                        s += (v[0] * v[0] + v[1] * v[1]) + (v[2] * v[2] + v[3] * v[3]);
                        typedef unsigned u32x2_ __attribute__((ext_vector_type(2))); u32x2_ w; w.x = cvt_pk_bf16(v[0], v[1]); w.y = cvt_pk_bf16(v[2], v[3]); *(u32x2_*)(outb + off + bj * HALF + n * 16) = w; }
                s += __shfl_xor(s, 16); s += __shfl_xor(s, 32);
                if (fq == 0) ssq[(size_t)row * 16 + u.pn * 4 + wc] = s;
                if (m & 1) asm volatile("" ::: "memory"); }
    }
};
struct EpiBf16S {
    static constexpr bool PERM = true, AFTER_DRAIN = false;
    bf16_t* O; int ldc; const float* ssq; float eps;
    __device__ __forceinline__ void operator()(const f32x4 (&acc)[2][2][4][2], const Unit& u, int wr, int wc, int fr, int fq) const {
        const int row0 = u.pm * BM + wr * 64 + fr; const int col0 = u.pn * BM + wc * 32 + 8 * fq;
        f32x4 part[2][4];
#pragma unroll
        for (int ai = 0; ai < 2; ++ai)
#pragma unroll
            for (int m = 0; m < 4; ++m) part[ai][m] = *(const f32x4*)(ssq + (size_t)(row0 + ai * HALF + m * 16) * 16 + 4 * fq);
#pragma unroll
        for (int ai = 0; ai < 2; ++ai)
#pragma unroll
            for (int m = 0; m < 4; ++m) { const int row = row0 + ai * HALF + m * 16;
                float tot = (part[ai][m][0] + part[ai][m][1]) + (part[ai][m][2] + part[ai][m][3]);
                tot += __shfl_xor(tot, 16); tot += __shfl_xor(tot, 32);
                const float scale = __builtin_amdgcn_rsqf(tot * (1.0f / 1024.0f) + eps);
                bf16_t* rowp = O + (size_t)row * ldc + col0;
#pragma unroll
                for (int bj = 0; bj < 2; ++bj) { const f32x4 v0 = acc[ai][bj][m][0] * scale, v1 = acc[ai][bj][m][1] * scale;
                    u32x4 w; w.x = cvt_pk_bf16(v0[0], v0[1]); w.y = cvt_pk_bf16(v0[2], v0[3]); w.z = cvt_pk_bf16(v1[0], v1[1]); w.w = cvt_pk_bf16(v1[2], v1[3]);
                    *(u32x4*)(rowp + bj * HALF) = w; } }
    }
};
template <bool RES_BF16, bool OUT_BF16> struct EpiRes {
    static constexpr bool PERM = false, AFTER_DRAIN = false;
    const void* res0; const void* res1; int split_pm; void* out; int ldc;
    __device__ __forceinline__ void operator()(const f32x4 (&acc)[2][2][4][2], const Unit& u, int wr, int wc, int fr, int fq) const {
        typedef unsigned u32x2_ __attribute__((ext_vector_type(2)));
        const int row0 = u.pm * BM + wr * 64 + fr; const int col0 = u.pn * BM + wc * 32 + 4 * fq;
        const bool first = u.pm < split_pm;
#pragma unroll
        for (int ai = 0; ai < 2; ++ai)
#pragma unroll
            for (int m = 0; m < 4; ++m) { const int row = row0 + ai * HALF + m * 16; const size_t off = (size_t)row * ldc + col0; const size_t roff = first ? off : off - (size_t)split_pm * BM * ldc;
#pragma unroll
                for (int bj = 0; bj < 2; ++bj)
#pragma unroll
                    for (int n = 0; n < 2; ++n) { const size_t o2 = bj * HALF + n * 16; f32x4 r;
                        if (RES_BF16) { const u32x2_ rw = *(const u32x2_*)((const bf16_t*)(first ? res0 : res1) + roff + o2); r = (f32x4){__builtin_bit_cast(float, rw.x << 16), __builtin_bit_cast(float, rw.x & 0xffff0000u), __builtin_bit_cast(float, rw.y << 16), __builtin_bit_cast(float, rw.y & 0xffff0000u)}; }
                        else r = *(const f32x4*)((const float*)(first ? res0 : res1) + roff + o2);
                        const f32x4 v = acc[ai][bj][m][n] + r;
                        if (OUT_BF16) { u32x2_ w; w.x = cvt_pk_bf16(v[0], v[1]); w.y = cvt_pk_bf16(v[2], v[3]); *(u32x2_*)((bf16_t*)out + off + o2) = w; }
                        else *(f32x4*)((float*)out + off + o2) = v; }
                if (m & 1) asm volatile("" ::: "memory"); }
    }
};
template <bool RES_BF16> struct EpiResN {
    static constexpr bool PERM = false, AFTER_DRAIN = false;
    const void* res0; const void* res1; int split_pm; bf16_t* out; float* ssq; int ldc;
    __device__ __forceinline__ void operator()(const f32x4 (&acc)[2][2][4][2], const Unit& u, int wr, int wc, int fr, int fq) const {
        typedef unsigned u32x2_ __attribute__((ext_vector_type(2)));
        const int row0 = u.pm * BM + wr * 64 + fr; const int col0 = u.pn * BM + wc * 32 + 4 * fq;
        const bool first = u.pm < split_pm;
#pragma unroll
        for (int ai = 0; ai < 2; ++ai)
#pragma unroll
            for (int m = 0; m < 4; ++m) { const int row = row0 + ai * HALF + m * 16; const size_t off = (size_t)row * ldc + col0; const size_t roff = first ? off : off - (size_t)split_pm * BM * ldc; float s = 0.f;
#pragma unroll
                for (int bj = 0; bj < 2; ++bj)
#pragma unroll
                    for (int n = 0; n < 2; ++n) { const size_t o2 = bj * HALF + n * 16; f32x4 r;
                        if (RES_BF16) { const u32x2_ rw = *(const u32x2_*)((const bf16_t*)(first ? res0 : res1) + roff + o2); r = (f32x4){__builtin_bit_cast(float, rw.x << 16), __builtin_bit_cast(float, rw.x & 0xffff0000u), __builtin_bit_cast(float, rw.y << 16), __builtin_bit_cast(float, rw.y & 0xffff0000u)}; }
                        else r = *(const f32x4*)((const float*)(first ? res0 : res1) + roff + o2);
                        const f32x4 v = acc[ai][bj][m][n] + r;
                        s += (v[0] * v[0] + v[1] * v[1]) + (v[2] * v[2] + v[3] * v[3]);
                        u32x2_ w; w.x = cvt_pk_bf16(v[0], v[1]); w.y = cvt_pk_bf16(v[2], v[3]); *(u32x2_*)(out + off + o2) = w; }
                s += __shfl_xor(s, 16); s += __shfl_xor(s, 32);
                if (fq == 0) ssq[(size_t)row * 16 + u.pn * 4 + wc] = s;
                if (m & 1) asm volatile("" ::: "memory"); }
    }
};
__device__ __forceinline__ float dpp_ror1(float x) { return __builtin_bit_cast(float, __builtin_amdgcn_update_dpp(0, __builtin_bit_cast(int, x), 0x121, 0xf, 0xf, false)); }
__device__ __forceinline__ float dpp_ror2(float x) { return __builtin_bit_cast(float, __builtin_amdgcn_update_dpp(0, __builtin_bit_cast(int, x), 0x122, 0xf, 0xf, false)); }
struct EpiUpFused {
    static constexpr bool PERM = false, AFTER_DRAIN = false;
    bf16_t* HID; const float* wconv; const float* bconv; bf16_t* RAW01; float* RAWG; float* pconv; PG8_LAS float* halo; int dff; const PG8_LAS float* rstd;
    __device__ __forceinline__ void operator()(const f32x4 (&acc)[2][2][4][2], const Unit& u, int wr, int wc, int fr, int fq) const {
        typedef unsigned u32x2_ __attribute__((ext_vector_type(2)));
        const int lane = fq * 16 + fr;
        const int fb = u.pn * 128 + wc * 32 + 4 * fq;
        const int hc = wc * 32 + 4 * fq;
        float rs[2][4];
#pragma unroll
        for (int ai = 0; ai < 2; ++ai)
#pragma unroll
            for (int m = 0; m < 4; ++m) rs[ai][m] = rstd[(u.pm & 7) * BM + ai * HALF + wr * 64 + m * 16 + fr];
        if (fr >= 14) {
#pragma unroll
            for (int ai = 0; ai < 2; ++ai)
#pragma unroll
                for (int n = 0; n < 2; ++n) *(PG8_LAS f32x4*)(halo + ((ai * 2 + wr) * 2 + (fr - 14)) * 128 + hc + 16 * n) = acc[ai][0][3][n] * rs[ai][3];
        }
        asm volatile("s_waitcnt lgkmcnt(0)" ::: "memory"); __builtin_amdgcn_s_barrier(); asm volatile("" ::: "memory");
        const bool seq_tile = (u.pm & 7) == 0;
#pragma unroll
        for (int n = 0; n < 2; ++n) {
            const f32x4 w0 = *(const f32x4*)(wconv + fb + 16 * n), w1 = *(const f32x4*)(wconv + dff + fb + 16 * n), w2 = *(const f32x4*)(wconv + 2 * dff + fb + 16 * n), bb = *(const f32x4*)(bconv + fb + 16 * n);
#pragma unroll
            for (int ai = 0; ai < 2; ++ai) {
                f32x4 p14 = (f32x4){0.f, 0.f, 0.f, 0.f}, p15 = p14;
                const bool top = (ai == 0 && wr == 0);
                if (!top) { const int pg = (wr == 1) ? (ai * 2 + 0) : ((ai - 1) * 2 + 1); p14 = *(const PG8_LAS f32x4*)(halo + (pg * 2 + 0) * 128 + hc + 16 * n); p15 = *(const PG8_LAS f32x4*)(halo + (pg * 2 + 1) * 128 + hc + 16 * n); }
                f32x4 pr1, pr2;
#pragma unroll
                for (int e = 0; e < 4; ++e) { const float x0 = (fr == 14) ? p14[e] : p15[e]; pr1[e] = dpp_ror1(x0); pr2[e] = dpp_ror2(x0); }
#pragma unroll
                for (int m = 0; m < 4; ++m) {
                    const f32x4 cur = acc[ai][0][m][n] * rs[ai][m], val = acc[ai][1][m][n] * rs[ai][m];
                    f32x4 g1, g2, c1, c2;
#pragma unroll
                    for (int e = 0; e < 4; ++e) { c1[e] = dpp_ror1(cur[e]); c2[e] = dpp_ror2(cur[e]);
                        g1[e] = fr >= 1 ? c1[e] : pr1[e]; g2[e] = fr >= 2 ? c2[e] : pr2[e]; }
                    pr1 = c1; pr2 = c2;
                    const int row = u.pm * BM + ai * HALF + wr * 64 + m * 16 + fr;
                    const bool first2 = top && m == 0 && fr < 2;
                    if (first2 && seq_tile) { if (fr == 0) g1 = (f32x4){0.f, 0.f, 0.f, 0.f}; g2 = (f32x4){0.f, 0.f, 0.f, 0.f}; }
                    if (first2 && !seq_tile) {
                        u32x2_ wg_, wv_; wg_.x = cvt_pk_bf16(cur[0], cur[1]); wg_.y = cvt_pk_bf16(cur[2], cur[3]); wv_.x = cvt_pk_bf16(val[0], val[1]); wv_.y = cvt_pk_bf16(val[2], val[3]);
                        bf16_t* rp = RAW01 + ((size_t)u.pm * 2 + fr) * (2 * dff) + fb + 16 * n; *(u32x2_*)rp = wg_; *(u32x2_*)(rp + dff) = wv_;
                    } else {
                        f32x4 h;
#pragma unroll
                        for (int e = 0; e < 4; ++e) { const float c = bb[e] + g2[e] * w0[e] + g1[e] * w1[e] + cur[e] * w2[e]; h[e] = c * __builtin_amdgcn_rcpf(1.f + __expf(-c)) * val[e]; }
                        u32x2_ wh; wh.x = cvt_pk_bf16(h[0], h[1]); wh.y = cvt_pk_bf16(h[2], h[3]);
                        *(u32x2_*)(HID + (size_t)row * dff + fb + 16 * n) = wh;
                    }
                    if (ai == 1 && wr == 1 && m == 3 && fr >= 14) {
                        *(f32x4*)(RAWG + ((size_t)u.pm * 2 + (fr - 14)) * dff + fb + 16 * n) = cur;
                        if ((u.pm & 7) == 7) *(f32x4*)(pconv + ((size_t)(u.pm >> 3) * 2 + (fr - 14)) * dff + fb + 16 * n) = cur;
                    }
                }
            }
        }
        asm volatile("s_waitcnt lgkmcnt(0)" ::: "memory"); __builtin_amdgcn_s_barrier(); asm volatile("" ::: "memory");
    }
};
template <class Epi, class Sched, bool ALIGN_EPI = false, bool SP2 = false>
__device__ __forceinline__ void gemm_phase(PG8_LAS unsigned char* lds, const Gemm g, const Sched& S, const Epi& E) {
    const int tid = opaque_i(threadIdx.x), wid = __builtin_amdgcn_readfirstlane(tid >> 6), lane = tid & 63, wr = wid >> 2, wc = wid & 3, fr = lane & 15, fq = lane >> 4;
    const int K = g.K, nt = K / BK;
    unsigned voffA[2], voffB[2];
#pragma unroll
    for (int i = 0; i < 2; ++i) { int R, C; stage_rc(tid * 16 + i * 8192, R, C); const int Rb = Epi::PERM ? ((R & ~31) + perm32(R & 31)) : R;
        voffA[i] = (unsigned)(R * K + C) * 2u; voffB[i] = (unsigned)(Rb * K + C) * 2u; }
    const size_t kstep = (size_t)(BK * 2);
    const size_t hstep = (size_t)HALF * K * 2;
    const size_t tstep = 2 * hstep;
    const unsigned ldsw = (unsigned)wid * 1024u;
    const int aoff = lds_byte(wr * 64 + fr, fq * 8), boff = lds_byte(wc * 32 + fr, fq * 8);
#define PG8_SA(b, h) (((b) * 2 + (h)) * HTB)
#define PG8_SB(b, h) ((4 + (b) * 2 + (h)) * HTB)
#define PG8_STAGE(bufoff, gbase, voff) do { _Pragma("unroll") for (int _i = 0; _i < 2; ++_i) \
        __builtin_amdgcn_global_load_lds((const unsigned*)((const char*)(gbase) + (voff)[_i]), (PG8_LAS unsigned*)(lds + (bufoff) + ldsw + _i * 8192), 16, 0, 0); } while (0)
#define PG8_LDA(dst, b, h) do { _Pragma("unroll") for (int m = 0; m < 4; ++m) _Pragma("unroll") for (int k = 0; k < 2; ++k) dst[m][k] = *(const PG8_LAS bf16x8*)(lds + PG8_SA(b, h) + aoff + m * 2048 + k * 1024); } while (0)
#define PG8_LDB(dst, b, h) do { _Pragma("unroll") for (int n = 0; n < 2; ++n) _Pragma("unroll") for (int k = 0; k < 2; ++k) dst[n][k] = *(const PG8_LAS bf16x8*)(lds + PG8_SB(b, h) + boff + n * 2048 + k * 1024); } while (0)
#define PG8_MMA(ai, bj, At, Bt) do { __builtin_amdgcn_s_setprio(1); _Pragma("unroll") for (int m = 0; m < 4; ++m) _Pragma("unroll") for (int n = 0; n < 2; ++n) _Pragma("unroll") for (int k = 0; k < 2; ++k) \
        acc[ai][bj][m][n] = __builtin_amdgcn_mfma_f32_16x16x32_bf16(Bt[n][k], At[m][k], acc[ai][bj][m][n], 0, 0, 0); __builtin_amdgcn_s_setprio(0); } while (0)
#define PG8_WAIT_V(n) asm volatile("s_waitcnt vmcnt(" #n ")" ::: "memory")
#define PG8_WAIT_L(n) asm volatile("s_waitcnt lgkmcnt(" #n ")" ::: "memory")
#define PG8_BAR __builtin_amdgcn_s_barrier()
#define PG8_SCHED __builtin_amdgcn_sched_barrier(0)
    Unit cur, nxt; int ui = 0;
    if (!S.next(0, cur)) return;
    f32x4 acc[2][2][4][2];
#pragma unroll
    for (int a = 0; a < 2; ++a)
#pragma unroll
        for (int b = 0; b < 2; ++b)
#pragma unroll
            for (int m = 0; m < 4; ++m)
#pragma unroll
                for (int n = 0; n < 2; ++n) acc[a][b][m][n] = (f32x4){0.f, 0.f, 0.f, 0.f};
    bf16x8 At[4][2], B0[2][2], B1[2][2];
    const char* cA = (const char*)g.A + (size_t)cur.pm * tstep; const char* cB = (const char*)g.Bt + (size_t)cur.pn * tstep;
    S.a_ready(cur);
    if constexpr (SP2) {
        PG8_STAGE(PG8_SB(0, 0), cB, voffB); PG8_STAGE(PG8_SB(0, 1), cB + hstep, voffB); PG8_STAGE(PG8_SA(0, 0), cA, voffA); PG8_STAGE(PG8_SA(0, 1), cA + hstep, voffA);
        if (wr == 1) PG8_BAR;
        PG8_WAIT_V(2); PG8_BAR;
        PG8_STAGE(PG8_SB(1, 0), cB + kstep, voffB); PG8_STAGE(PG8_SA(1, 0), cA + kstep, voffA); PG8_STAGE(PG8_SB(1, 1), cB + hstep + kstep, voffB);
        PG8_WAIT_V(6); PG8_BAR;
    } else {
        PG8_STAGE(PG8_SB(0, 0), cB, voffB); PG8_STAGE(PG8_SA(0, 0), cA, voffA); PG8_STAGE(PG8_SB(0, 1), cB + hstep, voffB); PG8_STAGE(PG8_SA(0, 1), cA + hstep, voffA);
        if (wr == 1) PG8_BAR;
        PG8_WAIT_V(4); PG8_BAR;
        PG8_STAGE(PG8_SB(1, 0), cB + kstep, voffB); PG8_STAGE(PG8_SA(1, 0), cA + kstep, voffA); PG8_STAGE(PG8_SB(1, 1), cB + hstep + kstep, voffB);
        PG8_WAIT_V(6); PG8_BAR;
    }
    for (;;) {
        const bool has_next = S.next(ui + 1, nxt);
        const char* nA = has_next ? (const char*)g.A + (size_t)nxt.pm * tstep : cA; const char* nB = has_next ? (const char*)g.Bt + (size_t)nxt.pn * tstep : cB;
        for (int t = 0; t < nt; t += 2) {
            const bool last = (t == nt - 2);
            const char* a1 = cA + (size_t)(t + 1) * kstep;
            const char* a2 = last ? nA : cA + (size_t)(t + 2) * kstep; const char* b2 = last ? nB : cB + (size_t)(t + 2) * kstep;
            const char* a3 = a2 + kstep; const char* b3 = b2 + kstep;
            if (last && has_next) S.a_ready(nxt);
            if constexpr (SP2) {
            PG8_LDB(B0, 0, 0); PG8_LDB(B1, 0, 1); PG8_SCHED; PG8_LDA(At, 0, 0); PG8_STAGE(PG8_SA(1, 1), a1 + hstep, voffA);
            PG8_WAIT_V(8); PG8_WAIT_L(0); PG8_BAR; PG8_MMA(0, 0, At, B0); PG8_MMA(0, 1, At, B1); PG8_BAR; PG8_SCHED;
            PG8_LDA(At, 0, 1); PG8_STAGE(PG8_SB(0, 0), b2, voffB); PG8_STAGE(PG8_SB(0, 1), b2 + hstep, voffB); PG8_STAGE(PG8_SA(0, 0), a2, voffA);
            PG8_WAIT_V(8); PG8_WAIT_L(0); PG8_BAR; PG8_MMA(1, 0, At, B0); PG8_MMA(1, 1, At, B1); PG8_BAR; PG8_SCHED;
            PG8_LDB(B0, 1, 0); PG8_LDB(B1, 1, 1); PG8_SCHED; PG8_LDA(At, 1, 0); PG8_STAGE(PG8_SA(0, 1), a2 + hstep, voffA);
            PG8_WAIT_V(8); PG8_WAIT_L(0); PG8_BAR; PG8_MMA(0, 0, At, B0); PG8_MMA(0, 1, At, B1); PG8_BAR; PG8_SCHED;
            PG8_LDA(At, 1, 1); PG8_STAGE(PG8_SB(1, 0), b3, voffB); PG8_STAGE(PG8_SB(1, 1), b3 + hstep, voffB); PG8_STAGE(PG8_SA(1, 0), a3, voffA);
            PG8_WAIT_V(8); PG8_WAIT_L(0); PG8_BAR; PG8_MMA(1, 0, At, B0); PG8_MMA(1, 1, At, B1); PG8_BAR; PG8_SCHED;
            } else {
            PG8_LDB(B0, 0, 0); PG8_SCHED; PG8_LDA(At, 0, 0); PG8_STAGE(PG8_SA(1, 1), a1 + hstep, voffA);
            PG8_WAIT_L(8); PG8_BAR; PG8_WAIT_L(0); PG8_MMA(0, 0, At, B0); PG8_BAR; PG8_SCHED;
            PG8_LDB(B1, 0, 1); PG8_STAGE(PG8_SB(0, 0), b2, voffB);
            PG8_BAR; PG8_WAIT_L(0); PG8_MMA(0, 1, At, B1); PG8_BAR;
            PG8_LDA(At, 0, 1); PG8_STAGE(PG8_SA(0, 0), a2, voffA);
            PG8_BAR; PG8_WAIT_L(0); PG8_MMA(1, 0, At, B0); PG8_BAR; PG8_SCHED;
            PG8_STAGE(PG8_SB(0, 1), b2 + hstep, voffB);
            PG8_WAIT_V(6); PG8_BAR; PG8_MMA(1, 1, At, B1); PG8_BAR;
            PG8_LDB(B0, 1, 0); PG8_SCHED; PG8_LDA(At, 1, 0); PG8_STAGE(PG8_SA(0, 1), a2 + hstep, voffA);
            PG8_WAIT_L(8); PG8_BAR; PG8_WAIT_L(0); PG8_MMA(0, 0, At, B0); PG8_BAR; PG8_SCHED;
            PG8_LDB(B1, 1, 1); PG8_STAGE(PG8_SB(1, 0), b3, voffB);
            PG8_BAR; PG8_WAIT_L(0); PG8_MMA(0, 1, At, B1); PG8_BAR;
            PG8_LDA(At, 1, 1); PG8_STAGE(PG8_SA(1, 0), a3, voffA);
            PG8_BAR; PG8_WAIT_L(0); PG8_MMA(1, 0, At, B0); PG8_BAR; PG8_SCHED;
            PG8_STAGE(PG8_SB(1, 1), b3 + hstep, voffB);
            PG8_WAIT_V(6); PG8_BAR; PG8_MMA(1, 1, At, B1); PG8_BAR;
            }
        }
        if constexpr (ALIGN_EPI) { if (wr == 0) PG8_BAR; }
        if constexpr (!Epi::AFTER_DRAIN) { E(acc, cur, wr, wc, fr, fq); S.done(cur); }
        if (!has_next) break;
#pragma unroll
        for (int a = 0; a < 2; ++a)
#pragma unroll
            for (int b = 0; b < 2; ++b)
#pragma unroll
                for (int m = 0; m < 4; ++m)
#pragma unroll
                    for (int n = 0; n < 2; ++n) acc[a][b][m][n] = (f32x4){0.f, 0.f, 0.f, 0.f};
        cur = nxt; cA = nA; cB = nB; ++ui;
        if constexpr (ALIGN_EPI) { if (wr == 1) PG8_BAR; }
    }
    PG8_WAIT_V(0);
    if constexpr (!ALIGN_EPI) { if (wr == 0) PG8_BAR; }
    PG8_BAR;
    if constexpr (Epi::AFTER_DRAIN) { E.fused(acc, cur, wr, wc, fr, fq, lds, wid, lane); S.done(cur); }
#undef PG8_SA
#undef PG8_SB
#undef PG8_STAGE
#undef PG8_LDA
#undef PG8_LDB
#undef PG8_MMA
#undef PG8_WAIT_V
#undef PG8_WAIT_L
#undef PG8_BAR
#undef PG8_SCHED
}
}
#define XB_TMO      128
#define XB_XCNT(j)  (256  + 64 * (j))
#define XB_XSUB(j)  (1280 + 64 * (j))
#define XB_XGEN(j)  (2304 + 64 * (j))
#define XB_TOP      3328
#define XB_TOPGEN   3392
#define XCD_BAR_WORDS 3456
#define XB_SPIN_CAP (1u << 18)

__device__ __forceinline__ unsigned xb_ld(unsigned* p)              { return __hip_atomic_load(p, __ATOMIC_RELAXED, __HIP_MEMORY_SCOPE_AGENT); }
__device__ __forceinline__ unsigned xb_add(unsigned* p, unsigned v) { return __hip_atomic_fetch_add(p, v, __ATOMIC_RELAXED, __HIP_MEMORY_SCOPE_AGENT); }
__device__ __forceinline__ unsigned xb_xcc_id() { return (unsigned)__builtin_amdgcn_s_getreg((3 << 11) | 20) & 0xFu; }
#define XB_SPIN(cond, bar) do { unsigned _sp = 0; while (cond) { __builtin_amdgcn_s_sleep(1); \
    if ((++_sp & 255u) == 0u) { if (xb_ld(&(bar)[XB_TMO])) break; if (_sp > XB_SPIN_CAP) { atomicAdd(&(bar)[XB_TMO], 1u); break; } } } } while (0)

struct XcdBarrier {
    unsigned* bar; unsigned x;
    volatile LAS unsigned* st;
};

__device__ __forceinline__ XcdBarrier xcd_barrier_post(unsigned* bar, volatile LAS unsigned* st) {
    XcdBarrier b; b.bar = bar; b.x = xb_xcc_id(); b.st = st;
    if (threadIdx.x == 0) (void)xb_add(&bar[XB_XCNT(b.x)], 1u);
    return b;
}
__device__ __forceinline__ void xcd_barrier_complete(unsigned* bar, unsigned x, unsigned& nloc, unsigned& nx) {
    const unsigned G = gridDim.x * gridDim.y * gridDim.z;
    unsigned sum, cnt, mine, sp = 0u;
    for (;;) {
        sum = 0u; cnt = 0u; mine = 0u;
#pragma unroll
        for (unsigned j = 0; j < 16; ++j) { const unsigned c = xb_ld(&bar[XB_XCNT(j)]); sum += c; cnt += (c > 0u) ? 1u : 0u; mine = (j == x) ? c : mine; }
        if (sum == G) break;
        __builtin_amdgcn_s_sleep(1);
        if ((++sp & 255u) == 0u) { if (xb_ld(&bar[XB_TMO])) break; if (sp > XB_SPIN_CAP) { atomicAdd(&bar[XB_TMO], 1u); break; } }
    }
    nloc = mine > 0u ? mine : 1u; nx = cnt > 0u ? cnt : 1u;
}

__device__ __forceinline__ void xcd_barrier(const XcdBarrier& b) {
    asm volatile("s_waitcnt vmcnt(0)" ::: "memory");
    __syncthreads();
    if (threadIdx.x == 0) {
        unsigned* bar = b.bar;
        __builtin_amdgcn_s_waitcnt(0);
        unsigned nloc = b.st[0], nx = b.st[1];
        if (nloc == 0u) { xcd_barrier_complete(bar, b.x, nloc, nx); b.st[0] = nloc; b.st[1] = nx; }
        const unsigned old = xb_add(&bar[XB_XSUB(b.x)], 1u);
        const unsigned gen = old / nloc;
        if (old + 1u == (gen + 1u) * nloc) {
            __builtin_amdgcn_fence(__ATOMIC_RELEASE, "agent");
            asm volatile("s_waitcnt vmcnt(0)" ::: "memory");
            const unsigned og = xb_add(&bar[XB_TOP], 1u);
            const unsigned tg = og / nx;
            if (og + 1u == (tg + 1u) * nx) xb_add(&bar[XB_TOPGEN], 1u);
            else XB_SPIN(xb_ld(&bar[XB_TOPGEN]) == tg, bar);
            __builtin_amdgcn_fence(__ATOMIC_ACQUIRE, "agent");
            xb_add(&bar[XB_XGEN(b.x)], 1u);
            asm volatile("s_waitcnt vmcnt(0)" ::: "memory");
        } else {
            XB_SPIN(xb_ld(&bar[XB_XGEN(b.x)]) == gen, bar);
            __builtin_amdgcn_fence(__ATOMIC_ACQUIRE, "agent");
            asm volatile("s_waitcnt vmcnt(0)" ::: "memory");
        }
    }
    __syncthreads();
}
namespace mk {
constexpr int NWAVES = 8;
constexpr int D = 1024, TP = 16384, TSMP = 512, T = TP + TSMP, SEQ = 2048, NSEQ = 128, PAST = 8192;
constexpr int NIN = 1568, NINP = 1792, DFF = 2816;
constexpr float EPS = 1e-6f;
constexpr float LOG2E = 1.4426950408889634f;
constexpr float QSCALE = 0.10206207261596577f * LOG2E;
constexpr float MQSCALE = 0.08838834764831845f * LOG2E;

constexpr size_t O_YP = 0, O_YS = 16777216, O_PCKV = O_YS + 524288, O_PKPE = O_PCKV + 4194304, O_PMK = O_PKPE + 524288, O_PMV = O_PMK + 1048576,
                 O_PCONV = O_PMV + 1048576, O_SCKV = O_PCONV + 45056, O_SKPE = O_SCKV + 131072, O_SCV = O_SKPE + 16384, O_SCONV = O_SCV + 262144, O_END = O_SCONV + 720896;
static_assert(O_END == 25292800, "output size");

constexpr size_t al(size_t x) { return (x + 4095) & ~(size_t)4095; }
constexpr size_t WS_CTL = 0, CTL_ZERO_BYTES = 1u << 20;
constexpr size_t WS_W_IN = 1u << 20;
constexpr size_t WS_W_UQ = al(WS_W_IN + (size_t)NINP * D * 2);
constexpr size_t WS_W_UK = al(WS_W_UQ + (size_t)768 * 256 * 2);
constexpr size_t WS_W_UV = al(WS_W_UK + (size_t)512 * 256 * 2);
constexpr size_t WS_W_O = al(WS_W_UV + (size_t)512 * 256 * 2);
constexpr size_t WS_W_MQ = al(WS_W_O + (size_t)1024 * 1024 * 2);
constexpr size_t WS_W_MKV = al(WS_W_MQ + (size_t)512 * 1024 * 2);
constexpr size_t WS_W_MO = al(WS_W_MKV + (size_t)1024 * 1024 * 2);
constexpr size_t WS_W_UP = al(WS_W_MO + (size_t)1024 * 512 * 2);
constexpr size_t WS_W_DN = al(WS_W_UP + (size_t)2 * DFF * D * 2);
constexpr size_t WS_ROPE = al(WS_W_DN + (size_t)D * DFF * 2);
constexpr size_t ROPE_N = 8200;
constexpr size_t WS_XN = al(WS_ROPE + 2 * ROPE_N * 16 * 4);
constexpr size_t WS_MN = al(WS_XN + (size_t)T * D * 2);
constexpr size_t WS_Z = al(WS_MN + (size_t)2048 * D * 2);
constexpr size_t WS_MKV = al(WS_Z + (size_t)T * NINP * 2);
constexpr size_t WS_CQN = al(WS_MKV + (size_t)2048 * 1024 * 2);
constexpr size_t WS_CKVN = al(WS_CQN + (size_t)T * 256 * 2);
constexpr size_t WS_VG = al(WS_CKVN + (size_t)T * 256 * 2);
constexpr size_t WS_MK = al(WS_VG + (size_t)T * 512 * 2);
constexpr size_t WS_MVT = al(WS_MK + (size_t)2048 * 512 * 2);
constexpr size_t WS_QR = al(WS_MVT + (size_t)2048 * 512 * 2);
constexpr size_t WS_KNR = al(WS_QR + (size_t)T * 768 * 2);
constexpr size_t WS_VT = al(WS_KNR + (size_t)TP * 512 * 2);
constexpr size_t WS_QF = al(WS_VT + (size_t)512 * TP * 2);
constexpr size_t WS_KF = al(WS_QF + (size_t)T * 768 * 2);
constexpr size_t WS_BO = al(WS_KF + (size_t)TP * 768 * 2);
constexpr size_t WS_MRG = al(WS_BO + (size_t)T * 512 * 2);
constexpr size_t WS_X1 = al(WS_MRG + (size_t)T * 1024 * 2);
constexpr size_t WS_H2 = al(WS_X1 + (size_t)T * 1024 * 4);
constexpr size_t WS_MQ = al(WS_H2 + (size_t)T * 1024 * 2);
constexpr size_t WS_MO = al(WS_MQ + (size_t)T * 512 * 2);
constexpr size_t WS_X2 = al(WS_MO + (size_t)T * 512 * 2);
constexpr size_t WS_H3 = al(WS_X2 + (size_t)T * 1024 * 4);
constexpr size_t WS_UP = al(WS_H3 + (size_t)T * 1024 * 2);
constexpr size_t WS_HID = al(WS_UP + (size_t)T * 2 * DFF * 2);
constexpr size_t WS_SPART = al(WS_HID + (size_t)T * DFF * 2);
constexpr size_t SPART_STRIDE = (32 + 32 * 256) * 4;
constexpr size_t WS_QEXT = al(WS_SPART + (size_t)NSEQ * 2 * SPART_STRIDE);
constexpr size_t WS_W_SB = al(WS_QEXT + (size_t)NSEQ * 32 * 288 * 2);
constexpr size_t WS_SSQ1_PRE = al(WS_W_SB + (size_t)8 * 128 * 128 * 2);
constexpr size_t WS_RAW01 = WS_SSQ1_PRE;
constexpr size_t WS_RAWG = al(WS_RAW01 + (size_t)64 * 2 * 5632 * 2);
constexpr size_t WS_SSQ1 = al(WS_RAWG + (size_t)64 * 2 * 2816 * 4);
constexpr size_t WS_SSQ2 = al(WS_SSQ1 + (size_t)T * 16 * 4);
constexpr size_t WS_MK_END = al(WS_SSQ2 + (size_t)T * 16 * 4);
static_assert(WS_MK_END < (1000u << 20), "mk workspace under 1000 MiB");
constexpr int CW_BAR = 4096;
constexpr int CW_HIDS = 16384;

constexpr int RING_BYTES = 155648, MISC_OFF = RING_BYTES + 320, LDS_BYTES = 159744;

struct Args { const void* in[38]; float* out; unsigned char* ws; int ph_lo, ph_hi; };
static_assert(sizeof(Args) == 38 * 8 + 8 + 8 + 8, "Args has no padding");

struct Frame {
    LAS unsigned char* lds; unsigned char* lds_g;
    int tid, lane, wave, G, bid;
    unsigned char* ws; float* out;
    const float* const* in;
    template <class P> __device__ __forceinline__ P* w(size_t off) const { return (P*)(ws + off); }
    __device__ __forceinline__ const float* inf(int i) const { return (const float*)in[i]; }
};

enum { I_XP = 0, I_XS, I_CKV, I_KPE, I_CMK, I_CMV, I_CONVST, I_PT, I_MEMP, I_GMIX, I_WIN, I_LNG, I_LNB, I_WS, I_BS, I_GQA, I_WUQ, I_GKVA, I_WUK, I_WUV, I_GQKQ, I_GQKK,
       I_GOA, I_GOB, I_WO, I_GMEMX, I_GMEMIN, I_WMQ, I_WMK, I_WMV, I_GMQ, I_GMK, I_WMO, I_GFFN, I_WUP, I_WCONV, I_BCONV, I_WDOWN };

struct P0Item { float v[32]; float g; };
__device__ __forceinline__ void p0_item_load(P0Item& x, const float* W, int K, int N, int item, int lane, const float* gain) {
    const int nblk = N / 32, kb = item / nblk, nb = item % nblk, k0 = 64 * kb, n0 = 32 * nb;
#pragma unroll
    for (int i = 0; i < 32; ++i) { const int kk = 2 * i + (lane >> 5); x.v[i] = W[(size_t)(k0 + kk) * N + n0 + (lane & 31)]; }
    x.g = gain ? gain[k0 + lane] : 1.f;
}
__device__ __forceinline__ void p0_item_finish(const P0Item& x, int K, int N, bf16* WT, int row_off, LAS float* scr, int item, int lane, bool has_gain) {
    const int nblk = N / 32, kb = item / nblk, nb = item % nblk, k0 = 64 * kb, n0 = 32 * nb;
#pragma unroll
    for (int i = 0; i < 32; ++i) { const int kk = 2 * i + (lane >> 5); float wv_ = x.v[i]; if (has_gain) wv_ *= __shfl(x.g, kk); scr[kk * 33 + (lane & 31)] = wv_; }
    LDS_WAIT(); asm volatile("" ::: "memory");
    const int c = lane & 7;
#pragma unroll
    for (int j = 0; j < 4; ++j) { const int n = (lane >> 3) + 8 * j; const LAS float* s = scr + (8 * c) * 33 + n;
        v4u o; o.x = pk2(s[0 * 33], s[1 * 33]); o.y = pk2(s[2 * 33], s[3 * 33]); o.z = pk2(s[4 * 33], s[5 * 33]); o.w = pk2(s[6 * 33], s[7 * 33]);
        *(v4u*)(WT + (size_t)(row_off + n0 + n) * K + k0 + 8 * c) = o; }
    LDS_WAIT(); asm volatile("" ::: "memory");
}
__device__ __forceinline__ void rms_row_to_bf16(const float* xrow, const float* g, bf16* orow, int lane) {
    const f32x4* xr = (const f32x4*)xrow + lane; const f32x4* gr = (const f32x4*)g + lane;
    f32x4 v[4]; float s = 0.f;
#pragma unroll
    for (int j = 0; j < 4; ++j) { v[j] = xr[64 * j]; s += (v[j].x * v[j].x + v[j].y * v[j].y) + (v[j].z * v[j].z + v[j].w * v[j].w); }
    const float rstd = rsqrtf(wave_sum(s) * (1.f / 1024.f) + EPS);
    unsigned long long* o8 = (unsigned long long*)orow + lane;
#pragma unroll
    for (int j = 0; j < 4; ++j) { const f32x4 gg = gr[64 * j];
        o8[64 * j] = (unsigned long long)pk2(v[j].x * rstd * gg.x, v[j].y * rstd * gg.y) | ((unsigned long long)pk2(v[j].z * rstd * gg.z, v[j].w * rstd * gg.w) << 32); }
}
__device__ __forceinline__ const float* xrow_ptr(const Frame& F, int r) { return r < TP ? F.inf(I_XP) + (size_t)r * D : F.inf(I_XS) + (size_t)(r - TP) * D; }

template <int M_LO, int M_HI>
__device__ __forceinline__ void p0_transposes(Frame& F, int gw, int NGW) {
    LAS float* scr = (LAS float*)(F.lds + F.wave * 16384);
    constexpr int NI = 11;
    const int srcs[NI] = {I_WIN, I_WUQ, I_WUK, I_WUV, I_WO, I_WMQ, I_WMK, I_WMV, I_WMO, I_WUP, I_WDOWN};
    const int Ks[NI] = {1024, 256, 256, 256, 1024, 1024, 1024, 1024, 512, 1024, 2816};
    const int Ns[NI] = {1568, 768, 512, 512, 1024, 512, 512, 512, 1024, 5632, 1024};
    const size_t dsts[NI] = {WS_W_IN, WS_W_UQ, WS_W_UK, WS_W_UV, WS_W_O, WS_W_MQ, WS_W_MKV, WS_W_MKV, WS_W_MO, WS_W_UP, WS_W_DN};
    const int roffs[NI] = {0, 0, 0, 0, 0, 0, 0, 512, 0, 0, 0};
    const int gains[NI] = {-1, -1, -1, -1, -1, I_GMEMX, -1, -1, -1, I_GFFN, -1};
    int base = 0;
#pragma unroll
    for (int m = M_LO; m < M_HI; ++m) {
        const int cnt = (Ks[m] / 64) * (Ns[m] / 32);
        int first = gw - (base % NGW); if (first < 0) first += NGW;
        const float* gp = gains[m] >= 0 ? F.inf(gains[m]) : nullptr;
        P0Item cur_, nxt_;
        if (first < cnt) p0_item_load(cur_, F.inf(srcs[m]), Ks[m], Ns[m], first, F.lane, gp);
        for (int it = first; it < cnt; it += NGW) {
            const bool more = it + NGW < cnt;
            if (more) p0_item_load(nxt_, F.inf(srcs[m]), Ks[m], Ns[m], it + NGW, F.lane, gp);
            int roff = roffs[m];
            if (m == 9) {
                const int n0 = 32 * (it % (Ns[m] / 32)); const int f0 = n0 < DFF ? n0 : n0 - DFF; roff = 256 * (f0 >> 7) + (n0 < DFF ? 0 : 128) + (f0 & 127) - n0; }
            p0_item_finish(cur_, Ks[m], Ns[m], F.w<bf16>(dsts[m]), roff, scr, it, F.lane, gains[m] >= 0);
            if (more) cur_ = nxt_;
        }
        base += cnt;
    }
}
__device__ __forceinline__ void p0_prologue(Frame& F) {
    const int gw = F.bid * NWAVES + F.wave, NGW = F.G * NWAVES;
    p0_transposes<0, 9>(F, gw, NGW);
    for (int r = gw; r < NINP - NIN; r += NGW) { v4u* p = (v4u*)(F.w<bf16>(WS_W_IN) + (size_t)(NIN + r) * D) + F.lane; p[0] = (v4u){0, 0, 0, 0}; p[64] = (v4u){0, 0, 0, 0}; }
    for (int r = gw; r < T + 2048; r += 2 * NGW) {
        f32x4 v[2][4]; const float* gp[2]; bf16* op[2]; bool ok[2];
#pragma unroll
        for (int k = 0; k < 2; ++k) { const int rr = r + k * NGW; ok[k] = rr < T + 2048;
            const float* xr = !ok[k] ? F.inf(I_XP) : (rr < T ? xrow_ptr(F, rr) : F.inf(I_MEMP) + (size_t)(rr - T) * D);
            gp[k] = (rr < T) ? F.inf(I_GMIX) : F.inf(I_GMEMIN); op[k] = (rr < T) ? F.w<bf16>(WS_XN) + (size_t)rr * D : F.w<bf16>(WS_MN) + (size_t)(rr - T) * D;
#pragma unroll
            for (int j = 0; j < 4; ++j) v[k][j] = ((const f32x4*)xr)[F.lane + 64 * j]; }
#pragma unroll
        for (int k = 0; k < 2; ++k) if (ok[k]) {
            float sq = 0.f;
#pragma unroll
            for (int j = 0; j < 4; ++j) sq += (v[k][j].x * v[k][j].x + v[k][j].y * v[k][j].y) + (v[k][j].z * v[k][j].z + v[k][j].w * v[k][j].w);
            const float rstd = rsqrtf(wave_sum(sq) * (1.f / 1024.f) + EPS);
            unsigned long long* o8 = (unsigned long long*)op[k] + F.lane;
#pragma unroll
            for (int j = 0; j < 4; ++j) { const f32x4 gg = ((const f32x4*)gp[k])[F.lane + 64 * j];
                o8[64 * j] = (unsigned long long)pk2(v[k][j].x * rstd * gg.x, v[k][j].y * rstd * gg.y) | ((unsigned long long)pk2(v[k][j].z * rstd * gg.z, v[k][j].w * rstd * gg.w) << 32); }
        }
    }
    { const float* wsrc = F.inf(I_WS); bf16* wdst = F.w<bf16>(WS_W_SB);
      for (int i = F.bid * 512 + F.tid; i < 8 * 128 * 128 / 4; i += F.G * 512) { const f32x4 v = *(const f32x4*)(wsrc + 4 * i); v2u o; o.x = pk2(v[0], v[1]); o.y = pk2(v[2], v[3]); *(v2u*)(wdst + 4 * i) = o; } }
    { float* cs = F.w<float>(WS_ROPE); float* sn = cs + ROPE_N * 16;
      for (int i = F.bid * 512 + F.tid; i < (int)ROPE_N * 16; i += F.G * 512) { const int pos = i >> 4, f = i & 15;
          const double ang = (double)pos * pow(10000.0, -(double)f / 16.0); cs[i] = (float)cos(ang); sn[i] = (float)sin(ang); } }
}

__device__ __forceinline__ void p2_post_inproj(Frame& F) {
    const int gw = F.bid * NWAVES + F.wave, NGW = F.G * NWAVES, lane = F.lane;
    const bf16* Z = F.w<bf16>(WS_Z);
    const float* lg = F.inf(I_LNG); const float* lb = F.inf(I_LNB);
    const f32x4 lg0 = *(const f32x4*)(lg + 8 * lane), lg1 = *(const f32x4*)(lg + 8 * lane + 4), lb0 = *(const f32x4*)(lb + 8 * lane), lb1 = *(const f32x4*)(lb + 8 * lane + 4);
    const f32x4 gqa = *(const f32x4*)(F.inf(I_GQA) + 4 * lane), gkva = *(const f32x4*)(F.inf(I_GKVA) + 4 * lane);
    for (int r0 = gw; r0 < T; r0 += 4 * NGW) {
        v4u rawv[4]; v2u rawq[4], rawk[4]; bf16 rawp[4];
#pragma unroll
        for (int k = 0; k < 4; ++k) { const int r = r0 + k * NGW; if (r < T) { const bf16* zr = Z + (size_t)r * NINP;
            rawv[k] = *(const v4u*)(zr + 512 + 8 * lane); rawq[k] = *(const v2u*)(zr + 1024 + 4 * lane); rawk[k] = *(const v2u*)(zr + 1280 + 4 * lane); rawp[k] = zr[1536 + (lane & 31)]; } }
#pragma unroll
        for (int k = 0; k < 4; ++k) { const int r = r0 + k * NGW; if (r < T) {
        {
            const v4u raw = rawv[k];
            float x[8];
#pragma unroll
            for (int i = 0; i < 4; ++i) { x[2 * i] = gelu_tanh_f(bflo(raw[i])); x[2 * i + 1] = gelu_tanh_f(bfhi(raw[i])); }
            float s = 0.f;
#pragma unroll
            for (int i = 0; i < 8; ++i) s += x[i];
            s += __shfl_xor(s, 1); s += __shfl_xor(s, 2); s += __shfl_xor(s, 4);
            const float mean = s * (1.f / 64.f);
            float q = 0.f;
#pragma unroll
            for (int i = 0; i < 8; ++i) { x[i] -= mean; q += x[i] * x[i]; }
            q += __shfl_xor(q, 1); q += __shfl_xor(q, 2); q += __shfl_xor(q, 4);
            const float rstd = rsqrtf(q * (1.f / 64.f) + EPS);
            f32x4 y0, y1;
#pragma unroll
            for (int i = 0; i < 4; ++i) { y0[i] = x[i] * rstd * lg0[i] + lb0[i]; y1[i] = x[4 + i] * rstd * lg1[i] + lb1[i]; }
            v4u o; o.x = pk2(y0[0], y0[1]); o.y = pk2(y0[2], y0[3]); o.z = pk2(y1[0], y1[1]); o.w = pk2(y1[2], y1[3]);
            *(v4u*)(F.w<bf16>(WS_VG) + (size_t)r * 512 + 8 * lane) = o;
            if (r >= TP) { float* d = F.out + O_SCV + (size_t)(r - TP) * 512 + 8 * lane; *(f32x4*)d = y0; *(f32x4*)(d + 4) = y1; }
        }
#pragma unroll
        for (int which = 0; which < 2; ++which) {
            const v2u raw = which ? rawk[k] : rawq[k];
            f32x4 x; x[0] = bflo(raw[0]); x[1] = bfhi(raw[0]); x[2] = bflo(raw[1]); x[3] = bfhi(raw[1]);
            const float ss = wave_sum((x[0] * x[0] + x[1] * x[1]) + (x[2] * x[2] + x[3] * x[3]));
            const float rstd = rsqrtf(ss * (1.f / 256.f) + EPS);
            const f32x4 g = which ? gkva : gqa;
            f32x4 y;
#pragma unroll
            for (int i = 0; i < 4; ++i) y[i] = x[i] * rstd * g[i];
            v2u o; o.x = pk2(y[0], y[1]); o.y = pk2(y[2], y[3]);
            *(v2u*)(F.w<bf16>(which ? WS_CKVN : WS_CQN) + (size_t)r * 256 + 4 * lane) = o;
            if (which) { float* d = (r < TP) ? F.out + O_PCKV + (size_t)r * 256 : F.out + O_SCKV + (size_t)(r - TP) * 256; *(f32x4*)(d + 4 * lane) = y; }
        }
        if (lane < 32) { float* d = (r < TP) ? F.out + O_PKPE + (size_t)r * 32 : F.out + O_SKPE + (size_t)(r - TP) * 32; d[lane] = bf2f(rawp[k]); }
        } }
    }
    const bf16* MKV = F.w<bf16>(WS_MKV);
    for (int r = gw; r < 2048; r += NGW) {
        const bf16* mr = MKV + (size_t)r * 1024;
        {
            const v4u raw = *(const v4u*)(mr + 8 * lane);
            float x[8];
#pragma unroll
            for (int i = 0; i < 4; ++i) { x[2 * i] = bflo(raw[i]); x[2 * i + 1] = bfhi(raw[i]); }
            float ss = 0.f;
#pragma unroll
            for (int i = 0; i < 8; ++i) ss += x[i] * x[i];
            ss += __shfl_xor(ss, 1); ss += __shfl_xor(ss, 2); ss += __shfl_xor(ss, 4); ss += __shfl_xor(ss, 8);
            const float rstd = rsqrtf(ss * (1.f / 128.f) + EPS);
            const float* g = F.inf(I_GMK) + ((8 * lane) & 127);
            f32x4 y0, y1;
#pragma unroll
            for (int i = 0; i < 4; ++i) { y0[i] = x[i] * rstd * g[i]; y1[i] = x[4 + i] * rstd * g[4 + i]; }
            float* d = F.out + O_PMK + (size_t)r * 512 + 8 * lane; *(f32x4*)d = y0; *(f32x4*)(d + 4) = y1;
            v4u o; o.x = pk2(y0[0], y0[1]); o.y = pk2(y0[2], y0[3]); o.z = pk2(y1[0], y1[1]); o.w = pk2(y1[2], y1[3]);
            *(v4u*)(F.w<bf16>(WS_MK) + (size_t)r * 512 + 8 * lane) = o;
        }
        {
            const v4u raw = *(const v4u*)(mr + 512 + 8 * lane);
            float x[8];
#pragma unroll
            for (int i = 0; i < 4; ++i) { x[2 * i] = bflo(raw[i]); x[2 * i + 1] = bfhi(raw[i]); }
            float* d = F.out + O_PMV + (size_t)r * 512 + 8 * lane; *(f32x4*)d = (f32x4){x[0], x[1], x[2], x[3]}; *(f32x4*)(d + 4) = (f32x4){x[4], x[5], x[6], x[7]};
        }
    }
    for (int g8 = gw; g8 < 256; g8 += NGW) {
        v4u rw[8];
#pragma unroll
        for (int k = 0; k < 8; ++k) rw[k] = *(const v4u*)(MKV + (size_t)(8 * g8 + k) * 1024 + 512 + 8 * lane);
        const int b = (8 * g8) >> 8, key0 = (8 * g8) & 255;
        bf16* mvt = F.w<bf16>(WS_MVT);
#pragma unroll
        for (int i = 0; i < 8; ++i) { const int col = 8 * lane + i, h = col >> 7, dv = col & 127; v4u o;
#pragma unroll
            for (int j = 0; j < 4; ++j) { const unsigned lo = (i & 1) ? (rw[2 * j][i >> 1] >> 16) : (rw[2 * j][i >> 1] & 0xffffu), hi = (i & 1) ? (rw[2 * j + 1][i >> 1] >> 16) : (rw[2 * j + 1][i >> 1] & 0xffffu); o[j] = lo | (hi << 16); }
            *(v4u*)(mvt + ((size_t)(b * 4 + h) * 128 + dv) * 256 + key0) = o; }
    }
}
}
namespace mk {
struct P4Raw { v4u raw; unsigned r1, r2; };
__device__ __forceinline__ P4Raw p4_load_row(const bf16* nope, const bf16* pe, int lane) { const int sub = lane & 7; P4Raw x; x.raw = *(const v4u*)(nope + 8 * sub); x.r1 = *(const unsigned*)(pe + 2 * sub); x.r2 = *(const unsigned*)(pe + 16 + 2 * sub); return x; }
__device__ __forceinline__ void p4_norm_rope_row(const P4Raw in, const float* g, const float* cs, const float* sn, int pos, float oscale, bf16* dst, int lane, bf16* dst2 = nullptr) {
    const int sub = lane & 7;
    const v4u raw = in.raw;
    const unsigned r1 = in.r1, r2 = in.r2;
    float x[8];
#pragma unroll
    for (int i = 0; i < 4; ++i) { x[2 * i] = bflo(raw[i]); x[2 * i + 1] = bfhi(raw[i]); }
    float a0 = bflo(r1), a1 = bfhi(r1), b0 = bflo(r2), b1 = bfhi(r2);
    float ss = (a0 * a0 + a1 * a1) + (b0 * b0 + b1 * b1);
#pragma unroll
    for (int i = 0; i < 8; ++i) ss += x[i] * x[i];
    ss += __shfl_xor(ss, 1); ss += __shfl_xor(ss, 2); ss += __shfl_xor(ss, 4);
    const float rs = rsqrtf(ss * (1.f / 96.f) + EPS) * oscale;
    const f32x4 g0 = *(const f32x4*)(g + 8 * sub), g1 = *(const f32x4*)(g + 8 * sub + 4);
    v4u o; o.x = pk2(x[0] * rs * g0[0], x[1] * rs * g0[1]); o.y = pk2(x[2] * rs * g0[2], x[3] * rs * g0[3]); o.z = pk2(x[4] * rs * g1[0], x[5] * rs * g1[1]); o.w = pk2(x[6] * rs * g1[2], x[7] * rs * g1[3]);
    *(v4u*)(dst + 8 * sub) = o;
    const int f = 2 * sub;
    a0 *= rs * g[64 + f]; a1 *= rs * g[65 + f]; b0 *= rs * g[80 + f]; b1 *= rs * g[81 + f];
    const float c0 = cs[pos * 16 + f], c1 = cs[pos * 16 + f + 1], s0 = sn[pos * 16 + f], s1 = sn[pos * 16 + f + 1];
    const unsigned o1_ = pk2(a0 * c0 - b0 * s0, a1 * c1 - b1 * s1), o2_ = pk2(b0 * c0 + a0 * s0, b1 * c1 + a1 * s1);
    *(unsigned*)(dst + 64 + f) = o1_; *(unsigned*)(dst + 80 + f) = o2_;
    if (dst2) { *(unsigned*)(dst2 + f) = o1_; *(unsigned*)(dst2 + 16 + f) = o2_; }
}
__device__ __forceinline__ void p4_qk_norm_rope(Frame& F) {
    const int gw = F.bid * NWAVES + F.wave, NGW = F.G * NWAVES, lane = F.lane, h = lane >> 3;
    const float* cs = F.w<float>(WS_ROPE); const float* sn = cs + ROPE_N * 16;
    const bf16* QR = F.w<bf16>(WS_QR); const bf16* KNR = F.w<bf16>(WS_KNR); const bf16* Z = F.w<bf16>(WS_Z);
    for (int r0 = gw; r0 < T; r0 += 4 * NGW) {
        P4Raw qin[4], kin[4];
#pragma unroll
        for (int k = 0; k < 4; ++k) { const int r = r0 + k * NGW; if (r < T) { const bf16* q = QR + (size_t)r * 768 + 96 * h; qin[k] = p4_load_row(q, q + 64, lane);
            if (r < TP) kin[k] = p4_load_row(KNR + (size_t)r * 512 + 64 * h, Z + (size_t)r * NINP + 1536, lane); } }
#pragma unroll
        for (int k = 0; k < 4; ++k) { const int r = r0 + k * NGW; if (r < T) {
            const int pos = r < TP ? (r & 2047) : PAST + ((r - TP) & 3);
            bf16* qx = nullptr;
            if (r >= TP) { const int sq = (r - TP) >> 2, tq = (r - TP) & 3; qx = F.w<bf16>(WS_QEXT) + ((size_t)sq * 32 + tq * 8 + h) * 288 + 256; }
            p4_norm_rope_row(qin[k], F.inf(I_GQKQ), cs, sn, pos, QSCALE, F.w<bf16>(WS_QF) + (size_t)r * 768 + 96 * h, lane, qx);
            if (r < TP) p4_norm_rope_row(kin[k], F.inf(I_GQKK), cs, sn, pos, 1.f, F.w<bf16>(WS_KF) + (size_t)r * 768 + 96 * h, lane);
        } }
    }
}
__device__ __forceinline__ void p4_qext(Frame& F) {
    const int gw = F.bid * NWAVES + F.wave, NGW = F.G * NWAVES, lane = F.lane, l31 = lane & 31, hh = lane >> 5;
    const float* gq = F.inf(I_GQKQ); const float* gk = F.inf(I_GQKK);
    for (int u = gw; u < 1024; u += NGW) {
        const int h = u & 7, cbk = (u >> 3) & 7, rbk = u >> 6;
        const int row = TP + 32 * rbk + l31;
        const bf16* qp = F.w<bf16>(WS_QR) + (size_t)row * 768 + 96 * h;
        v4u raw[4]; float ss = 0.f;
#pragma unroll
        for (int ks = 0; ks < 4; ++ks) { raw[ks] = *(const v4u*)(qp + 16 * ks + 8 * hh);
#pragma unroll
            for (int i = 0; i < 4; ++i) { const float a = bflo(raw[ks][i]), c = bfhi(raw[ks][i]); ss += a * a + c * c; } }
        { const v4u r0 = *(const v4u*)(qp + 64 + 16 * hh), r1 = *(const v4u*)(qp + 64 + 16 * hh + 8);
#pragma unroll
          for (int i = 0; i < 4; ++i) { const float a = bflo(r0[i]), c = bfhi(r0[i]), d = bflo(r1[i]), e = bfhi(r1[i]); ss += (a * a + c * c) + (d * d + e * e); } }
        ss += __shfl_xor(ss, 32);
        const float rs = rsqrtf(ss * (1.f / 96.f) + EPS) * QSCALE;
        f32x16 acc = {};
        const float* wp = F.inf(I_WUK) + (size_t)(32 * cbk + l31) * 512 + h * 64 + 8 * hh;
#pragma unroll
        for (int ks = 0; ks < 4; ++ks) {
            const int d0 = 16 * ks + 8 * hh;
            const f32x4 w0 = *(const f32x4*)(wp + 16 * ks), w1 = *(const f32x4*)(wp + 16 * ks + 4);
            v4u wa; wa.x = cvtpk(w0[0], w0[1]); wa.y = cvtpk(w0[2], w0[3]); wa.z = cvtpk(w1[0], w1[1]); wa.w = cvtpk(w1[2], w1[3]);
            const f32x4 q0 = *(const f32x4*)(gq + d0), q1 = *(const f32x4*)(gq + d0 + 4), k0 = *(const f32x4*)(gk + d0), k1 = *(const f32x4*)(gk + d0 + 4);
            v4u qb; qb.x = cvtpk(bflo(raw[ks][0]) * rs * q0[0] * k0[0], bfhi(raw[ks][0]) * rs * q0[1] * k0[1]); qb.y = cvtpk(bflo(raw[ks][1]) * rs * q0[2] * k0[2], bfhi(raw[ks][1]) * rs * q0[3] * k0[3]);
            qb.z = cvtpk(bflo(raw[ks][2]) * rs * q1[0] * k1[0], bfhi(raw[ks][2]) * rs * q1[1] * k1[1]); qb.w = cvtpk(bflo(raw[ks][3]) * rs * q1[2] * k1[2], bfhi(raw[ks][3]) * rs * q1[3] * k1[3]);
            acc = __builtin_amdgcn_mfma_f32_32x32x16_bf16(__builtin_bit_cast(bf16x8, wa), __builtin_bit_cast(bf16x8, qb), acc, 0, 0, 0);
        }
        const int sq = (32 * rbk + l31) >> 2, tq = l31 & 3;
        bf16* dst = F.w<bf16>(WS_QEXT) + ((size_t)sq * 32 + tq * 8 + h) * 288 + 32 * cbk + 4 * hh;
#pragma unroll
        for (int g = 0; g < 4; ++g) { v2u o; o.x = cvtpk(acc[4 * g], acc[4 * g + 1]); o.y = cvtpk(acc[4 * g + 2], acc[4 * g + 3]); *(v2u*)(dst + 8 * g) = o; }
    }
}
}
namespace mk {
__device__ __forceinline__ float wave_max(float v) {
#pragma unroll
    for (int o = 1; o < 64; o <<= 1) v = fmaxf(v, __shfl_xor(v, o));
    return v;
}
__device__ __forceinline__ float gain_absmax(const float* g, int n, int lane) { float m = 0.f; for (int i = lane; i < n; i += 64) m = fmaxf(m, fabsf(g[i])); return wave_max(m); }

constexpr int PA_KROW = 208, PA_VROW = 144, PA_KBUF = 0, PA_VBUF = 2 * 64 * PA_KROW, PA_END = PA_VBUF + 2 * 64 * PA_VROW;
__device__ __forceinline__ void attn_prompt_unit(Frame& F, int b, int h, int qb, float negM) {
    const int tid = F.tid, lane = F.lane, wv = F.wave, l31 = lane & 31, hh = lane >> 5;
    LAS unsigned char* L = F.lds;
    const int q0w = 256 * qb + 32 * wv;
    const bf16* Qp = F.w<bf16>(WS_QF) + (size_t)(b * SEQ + q0w + l31) * 768 + h * 96 + 8 * hh;
    bf16x8 qf[6];
#pragma unroll
    for (int ks = 0; ks < 6; ++ks) qf[ks] = *(const bf16x8*)(Qp + 16 * ks);
    const bf16* Kg = F.w<bf16>(WS_KF) + (size_t)(b * SEQ) * 768 + h * 96;
    const bf16* Vg = F.w<bf16>(WS_VT) + (size_t)(h * 64) * TP + (size_t)b * SEQ;
    const int keyA = tid / 12, cA = tid % 12, keyB = (512 + tid) / 12, cB = (512 + tid) % 12, dvv = tid >> 3, cv = tid & 7;
    const int NT = 4 * qb + 4;
    v4u ka, kb2 = (v4u){0, 0, 0, 0}, vv_;
#define PA_LOAD(kt) do { ka = *(const v4u*)(Kg + (size_t)(64 * (kt) + keyA) * 768 + 8 * cA); if (tid < 256) kb2 = *(const v4u*)(Kg + (size_t)(64 * (kt) + keyB) * 768 + 8 * cB); \
        vv_ = *(const v4u*)(Vg + (size_t)dvv * TP + 64 * (kt) + 8 * cv); } while (0)
#define PA_STORE(buf) do { *(LAS v4u*)(L + PA_KBUF + (buf) * 64 * PA_KROW + keyA * PA_KROW + 16 * cA) = ka; if (tid < 256) *(LAS v4u*)(L + PA_KBUF + (buf) * 64 * PA_KROW + keyB * PA_KROW + 16 * cB) = kb2; \
        *(LAS v4u*)(L + PA_VBUF + (buf) * 64 * PA_VROW + dvv * PA_VROW + 16 * cv) = vv_; } while (0)
    PA_LOAD(0); PA_STORE(0);
    __syncthreads();
    if (NT > 1) PA_LOAD(1);
    f32x16 o0 = {}, o1 = {}; float l = 0.f;
#pragma unroll 1
    for (int kt = 0; kt < NT; ++kt) {
        const int buf = kt & 1;
        if (64 * kt <= q0w + 31) {
            const bool part = (64 * kt + 63 > q0w);
            const LAS unsigned char* kbp = L + PA_KBUF + buf * 64 * PA_KROW + l31 * PA_KROW + 16 * hh;
            const LAS unsigned char* vbp = L + PA_VBUF + buf * 64 * PA_VROW + l31 * PA_VROW + 8 * hh;
            bf16x8 kfa[6], kfb[6], vfa[2][2], vfb[2][2];
#define PA_VFRAG(dst, sub_) do { _Pragma("unroll") for (int s2 = 0; s2 < 2; ++s2) _Pragma("unroll") for (int dt = 0; dt < 2; ++dt) { const LAS unsigned char* vp = vbp + dt * 32 * PA_VROW + (32 * (sub_) + 16 * s2) * 2; \
                const s16x4 lo = *(const LAS s16x4*)vp, hi = *(const LAS s16x4*)(vp + 16); dst[s2][dt] = (bf16x8){lo[0], lo[1], lo[2], lo[3], hi[0], hi[1], hi[2], hi[3]}; } } while (0)
#define PA_EXP(s, sub_, pb, MASK) do { float p[16]; \
                _Pragma("unroll") for (int i = 0; i < 16; ++i) { float e = __builtin_amdgcn_exp2f(s[i] + negM); if (MASK && (64 * kt + 32 * (sub_) + (i & 3) + 8 * (i >> 2) + 4 * hh) > q0w + l31) e = 0.f; p[i] = e; l += e; } \
                _Pragma("unroll") for (int s2 = 0; s2 < 2; ++s2) { v4u w; w.x = cvtpk(p[8 * s2 + 0], p[8 * s2 + 1]); w.y = cvtpk(p[8 * s2 + 2], p[8 * s2 + 3]); w.z = cvtpk(p[8 * s2 + 4], p[8 * s2 + 5]); w.w = cvtpk(p[8 * s2 + 6], p[8 * s2 + 7]); pb[s2] = __builtin_bit_cast(bf16x8, w); } } while (0)
#pragma unroll
            for (int ks = 0; ks < 6; ++ks) kfa[ks] = *(const LAS bf16x8*)(kbp + 32 * ks);
            __builtin_amdgcn_sched_barrier(0);
            f32x16 sA = {}, sB = {};
#pragma unroll
            for (int ks = 0; ks < 6; ++ks) kfb[ks] = *(const LAS bf16x8*)(kbp + 32 * PA_KROW + 32 * ks);
#pragma unroll
            for (int ks = 0; ks < 6; ++ks) sA = __builtin_amdgcn_mfma_f32_32x32x16_bf16(kfa[ks], qf[ks], sA, 0, 0, 0);
            __builtin_amdgcn_sched_barrier(0);
            PA_VFRAG(vfa, 0);
#pragma unroll
            for (int ks = 0; ks < 6; ++ks) sB = __builtin_amdgcn_mfma_f32_32x32x16_bf16(kfb[ks], qf[ks], sB, 0, 0, 0);
            __builtin_amdgcn_sched_barrier(0);
            bf16x8 pbA[2], pbB[2];
            if (part) PA_EXP(sA, 0, pbA, true); else PA_EXP(sA, 0, pbA, false);
            __builtin_amdgcn_sched_barrier(0);
            PA_VFRAG(vfb, 1);
#pragma unroll
            for (int s2 = 0; s2 < 2; ++s2) { o0 = __builtin_amdgcn_mfma_f32_32x32x16_bf16(vfa[s2][0], pbA[s2], o0, 0, 0, 0); o1 = __builtin_amdgcn_mfma_f32_32x32x16_bf16(vfa[s2][1], pbA[s2], o1, 0, 0, 0); }
            __builtin_amdgcn_sched_barrier(0);
            if (part) PA_EXP(sB, 1, pbB, true); else PA_EXP(sB, 1, pbB, false);
            __builtin_amdgcn_sched_barrier(0);
#pragma unroll
            for (int s2 = 0; s2 < 2; ++s2) { o0 = __builtin_amdgcn_mfma_f32_32x32x16_bf16(vfb[s2][0], pbB[s2], o0, 0, 0, 0); o1 = __builtin_amdgcn_mfma_f32_32x32x16_bf16(vfb[s2][1], pbB[s2], o1, 0, 0, 0); }
            __builtin_amdgcn_sched_barrier(0);
#undef PA_VFRAG
#undef PA_EXP
        }
        if (kt + 1 < NT) PA_STORE(buf ^ 1);
        __syncthreads();
        if (kt + 2 < NT) PA_LOAD(kt + 2);
    }
#undef PA_LOAD
#undef PA_STORE
    l += __shfl_xor(l, 32);
    const float rl = 1.f / l;
    bf16* Op = F.w<bf16>(WS_BO) + (size_t)(b * SEQ + q0w + l31) * 512 + h * 64 + 4 * hh;
#pragma unroll
    for (int g = 0; g < 4; ++g) {
        v2u w0; w0.x = cvtpk(o0[4 * g] * rl, o0[4 * g + 1] * rl); w0.y = cvtpk(o0[4 * g + 2] * rl, o0[4 * g + 3] * rl);
        v2u w1; w1.x = cvtpk(o1[4 * g] * rl, o1[4 * g + 1] * rl); w1.y = cvtpk(o1[4 * g + 2] * rl, o1[4 * g + 3] * rl);
        *(v2u*)(Op + 8 * g) = w0; *(v2u*)(Op + 32 + 8 * g) = w1;
    }
}
__device__ __forceinline__ void p5_attn_prompt(Frame& F, float negM) {
    for (int u = F.bid; u < 256; u += F.G) {
        const int bh = u >> 2, p = u & 3, b = bh >> 3, h = bh & 7;
        attn_prompt_unit(F, b, h, p, negM);
        attn_prompt_unit(F, b, h, 7 - p, negM);
    }
}
}
namespace mk {
constexpr int SA_ROWB = 592;
constexpr int SA_TILE = 0, SA_T8 = 2 * 64 * SA_ROWB, SA_T8ROW = 272, SA_KP2 = SA_T8 + 64 * SA_T8ROW, SA_GPE = SA_KP2 + 256, SA_R = SA_GPE + 128, SA_PT = SA_R + 2048, SA_PTROW = 144,
              SA_QEXT = SA_PT + 32 * SA_PTROW, SA_RBASE = SA_QEXT + 32 * SA_ROWB  , SA_RDEL = SA_RBASE + 65 * 128  , SA_END = SA_RDEL + 64 * 128;
static_assert(SA_END <= RING_BYTES, "sample attention LDS");
typedef short v4i16_t __attribute__((ext_vector_type(4)));
#define SA_BAR() do { asm volatile("s_waitcnt lgkmcnt(0)" ::: "memory"); __builtin_amdgcn_s_barrier(); asm volatile("" ::: "memory"); } while (0)

__device__ __forceinline__ void attn_sample_unit(Frame& F, int s, int split, float negM) {
    const int tid = F.tid, lane = F.lane, w = F.wave, hh = lane >> 5, l31 = lane & 31;
    LAS unsigned char* L = F.lds;
    const float* pool_ckv = F.inf(I_CKV); const float* pool_kpe = F.inf(I_KPE); const int* pt = (const int*)F.in[I_PT] + s * 64;
    const float* cs = F.w<float>(WS_ROPE); const float* sn = cs + ROPE_N * 16;
    const float* gk = F.inf(I_GQKK);
    const int kbeg = split * 4096, NT = split ? 65 : 64;
    const int prow = tid >> 3, pc4 = tid & 7;
    const int mypage = pt[split * 32 + l31];
    f32x4 va[8], vb[8], pe;
#define SA_LOADC(n, V) do { const int key0_ = kbeg + 64 * (n); const int page_ = __builtin_amdgcn_readlane(mypage, (n) >> 1); const size_t rb_ = (size_t)page_ * 128 + (key0_ & 127); \
        const float* cp_ = pool_ckv + (rb_ + w) * 256 + 4 * lane; \
        _Pragma("unroll") for (int i = 0; i < 8; ++i) V[i] = __builtin_nontemporal_load((const f32x4*)(cp_ + (size_t)i * 2048)); } while (0)
#define SA_LOADPC(n) do { const int key0_ = kbeg + 64 * (n); const int page_ = __builtin_amdgcn_readlane(mypage, (n) >> 1); const size_t rb_ = (size_t)page_ * 128 + (key0_ & 127); \
        pe = __builtin_nontemporal_load((const f32x4*)(pool_kpe + (rb_ + prow) * 32 + 4 * pc4)); } while (0)
#define SA_LOADP(n) do { if (kbeg + 64 * (n) < PAST) SA_LOADPC(n); else { pe = (f32x4){0.f, 0.f, 0.f, 0.f}; \
            if (prow < 4) { const v2u r_ = *(const v2u*)(F.w<bf16>(WS_Z) + (size_t)(TP + 4 * s + prow) * NINP + 1536 + 4 * pc4); pe = (f32x4){bflo(r_.x), bfhi(r_.x), bflo(r_.y), bfhi(r_.y)}; } } } while (0)
#define SA_LOAD(n, V) do { \
        if (kbeg + 64 * (n) < PAST) SA_LOADC(n, V); else { \
            _Pragma("unroll") for (int i = 0; i < 8; ++i) V[i] = (f32x4){0.f, 0.f, 0.f, 0.f}; \
            if (w < 4) { const v2u o_ = *(const v2u*)(F.w<bf16>(WS_CKVN) + (size_t)(TP + 4 * s + w) * 256 + 4 * lane); V[0] = (f32x4){bflo(o_.x), bfhi(o_.x), bflo(o_.y), bfhi(o_.y)}; } \
        } } while (0)
#define SA_CONVERT(n, V) do { LAS unsigned char* tb_ = L + SA_TILE + ((n) & 1) * 64 * SA_ROWB; \
        _Pragma("unroll") for (int i = 0; i < 8; ++i) { v2u o_; o_.x = cvtpk(V[i][0], V[i][1]); o_.y = cvtpk(V[i][2], V[i][3]); \
            *(LAS v2u*)(tb_ + (w + 8 * i) * SA_ROWB + 8 * lane) = o_; \
            int f8_ = 0; f8_ = __builtin_amdgcn_cvt_pk_fp8_f32(V[i][0], V[i][1], f8_, false); f8_ = __builtin_amdgcn_cvt_pk_fp8_f32(V[i][2], V[i][3], f8_, true); \
            *(LAS int*)(L + SA_T8 + (w + 8 * i) * SA_T8ROW + 4 * lane) = f8_; } \
        { const f32x4 pv = pe; float ss_ = (pv[0] * pv[0] + pv[1] * pv[1]) + (pv[2] * pv[2] + pv[3] * pv[3]); ss_ += __shfl_xor(ss_, 1); ss_ += __shfl_xor(ss_, 2); ss_ += __shfl_xor(ss_, 4); \
          if (pc4 == 0) ((LAS float*)(L + SA_KP2))[prow] = ss_; \
          const LAS float* rb_ = (const LAS float*)(L + SA_RBASE) + (n) * 32 + 4 * (pc4 & 3); const LAS float* rd_ = (const LAS float*)(L + SA_RDEL) + prow * 32 + 4 * (pc4 & 3); \
          const f32x4 cb_ = *(const LAS f32x4*)rb_, sb_ = *(const LAS f32x4*)(rb_ + 16), cd_ = *(const LAS f32x4*)rd_, sd_ = *(const LAS f32x4*)(rd_ + 16); \
          const f32x4 c_ = cb_ * cd_ - sb_ * sd_, s_ = sb_ * cd_ + cb_ * sd_; \
          f32x4 x_ = pv * *(const LAS f32x4*)(L + SA_GPE + 16 * pc4), y_, o4_; y_[0] = __shfl_xor(x_[0], 4); y_[1] = __shfl_xor(x_[1], 4); y_[2] = __shfl_xor(x_[2], 4); y_[3] = __shfl_xor(x_[3], 4); \
          if (pc4 < 4) o4_ = x_ * c_ - y_ * s_; else o4_ = x_ * c_ + y_ * s_; \
          v2u o_; o_.x = cvtpk(o4_[0], o4_[1]); o_.y = cvtpk(o4_[2], o4_[3]); *(LAS v2u*)(tb_ + prow * SA_ROWB + 512 + pc4 * 8) = o_; } } while (0)
    SA_LOADPC(0); SA_LOADC(0, va);
    __builtin_amdgcn_sched_barrier(0);
    SA_LOADC(1, vb);
    __builtin_amdgcn_sched_barrier(0);
    { const bf16* qx = F.w<bf16>(WS_QEXT) + (size_t)s * 32 * 288;
      for (int ch = tid; ch < 32 * 36; ch += 512) { const int r_ = ch / 36, c_ = ch % 36; *(LAS v4u*)(L + SA_QEXT + r_ * SA_ROWB + 16 * c_) = *(const v4u*)(qx + r_ * 288 + 8 * c_); } }
    typedef int v8i_t __attribute__((ext_vector_type(8)));
    v8i_t Wf[2][4];
    { const bf16* Wp = F.w<bf16>(WS_W_UK) + (size_t)(w * 64 + l31) * 256 + 32 * hh;
#pragma unroll
      for (int dt = 0; dt < 2; ++dt)
#pragma unroll
          for (int ks = 0; ks < 4; ++ks) { v8i_t fr;
#pragma unroll
              for (int q = 0; q < 4; ++q) { const v4u raw = *(const v4u*)(Wp + (size_t)dt * 32 * 256 + 64 * ks + 8 * q);
                  int d0 = 0, d1 = 0;
                  d0 = __builtin_amdgcn_cvt_pk_fp8_f32(bflo(raw.x) * 16.f, bfhi(raw.x) * 16.f, d0, false); d0 = __builtin_amdgcn_cvt_pk_fp8_f32(bflo(raw.y) * 16.f, bfhi(raw.y) * 16.f, d0, true);
                  d1 = __builtin_amdgcn_cvt_pk_fp8_f32(bflo(raw.z) * 16.f, bfhi(raw.z) * 16.f, d1, false); d1 = __builtin_amdgcn_cvt_pk_fp8_f32(bflo(raw.w) * 16.f, bfhi(raw.w) * 16.f, d1, true);
                  fr[2 * q] = d0; fr[2 * q + 1] = d1; }
              Wf[dt][ks] = fr; } }
    if (tid < 32) ((LAS float*)(L + SA_GPE))[tid] = gk[64 + tid];
    for (int i = tid; i < 65 * 8; i += 512) { const int n_ = i >> 3, c_ = i & 7; *(LAS f32x4*)(L + SA_RBASE + n_ * 128 + 16 * c_) = *(const f32x4*)((c_ < 4 ? cs : sn - 16) + (size_t)(kbeg + 64 * n_) * 16 + 4 * c_); }
    { const int r_ = tid >> 3, c_ = tid & 7; *(LAS f32x4*)(L + SA_RDEL + r_ * 128 + 16 * c_) = *(const f32x4*)((c_ < 4 ? cs : sn - 16) + (size_t)r_ * 16 + 4 * c_); }
    SA_BAR();
    f32x16 oacc = {}, oacc1 = {}; float lsum = 0.f;
    SA_CONVERT(0, va);
    __builtin_amdgcn_sched_barrier(0);
    SA_LOADPC(1);
    __builtin_amdgcn_sched_barrier(0);
    SA_LOADC(2, va);
    __builtin_amdgcn_sched_barrier(0);
    SA_BAR();
    const int lane_ = lane, tid_ = tid;
#define SA_STEP(n, V, DO_CONV, DO_LOADP, LOADPM, DO_LOAD, LOADM) do { \
        const int lane = opaque_i(lane_), tid = opaque_i(tid_), hh = lane >> 5, l31 = lane & 31, prow = tid >> 3, pc4 = tid & 7, l15 = lane & 15, l4 = lane >> 4;     \
        const LAS unsigned char* tb = L + SA_TILE + ((n) & 1) * 64 * SA_ROWB; \
          \
        _Pragma("unroll") for (int kt2 = 0; kt2 < 2; ++kt2) { \
            const LAS unsigned char* bp = L + SA_T8 + (32 * kt2 + l31) * SA_T8ROW + 32 * hh; \
            f32x16 a0 = {}, a1 = {}; \
            v8i_t fbv[4];                         \
            _Pragma("unroll") for (int ks = 0; ks < 4; ++ks) { const v4u lo = *(const LAS v4u*)(bp + 64 * ks), hi = *(const LAS v4u*)(bp + 64 * ks + 16); \
                fbv[ks] = (v8i_t){(int)lo.x, (int)lo.y, (int)lo.z, (int)lo.w, (int)hi.x, (int)hi.y, (int)hi.z, (int)hi.w}; } \
            __builtin_amdgcn_sched_barrier(0); \
            _Pragma("unroll") for (int ks = 0; ks < 4; ++ks) { \
                a0 = __builtin_amdgcn_mfma_scale_f32_32x32x64_f8f6f4(Wf[0][ks], fbv[ks], a0, 0, 0, 0, 0x7B7B7B7B, 0, 0x7F7F7F7F); \
                a1 = __builtin_amdgcn_mfma_scale_f32_32x32x64_f8f6f4(Wf[1][ks], fbv[ks], a1, 0, 0, 0, 0x7B7B7B7B, 0, 0x7F7F7F7F); } \
            __builtin_amdgcn_sched_barrier(0); \
            float ss = 0.f; \
            _Pragma("unroll") for (int i = 0; i < 16; ++i) ss += a0[i] * a0[i] + a1[i] * a1[i]; \
            ss += __shfl_xor(ss, 32); \
            ss += ((const LAS float*)(L + SA_KP2))[32 * kt2 + l31]; \
            if (hh == 0) ((LAS float*)(L + SA_R))[w * 64 + 32 * kt2 + l31] = rsqrtf(ss * (1.f / 96.f) + EPS); \
        } \
        SA_BAR(); \
        if (DO_CONV) SA_CONVERT((n) + 1, V); \
        __builtin_amdgcn_sched_barrier(0); \
        if (DO_LOADP) LOADPM((n) + 2); \
        __builtin_amdgcn_sched_barrier(0); \
        if (DO_LOAD) LOADM((n) + 3, V); \
        __builtin_amdgcn_sched_barrier(0); \
          \
        if (w < 2) { \
            f32x16 sa0 = {}, sa1 = {}; \
            const LAS unsigned char* ap = tb + (32 * w + l31) * SA_ROWB + 16 * hh; \
            const LAS unsigned char* qp = L + SA_QEXT + l31 * SA_ROWB + 16 * hh; \
            _Pragma("unroll") for (int k0 = 0; k0 < 18; k0 += 3) { bf16x8 afr[3], qfr[3]; \
                _Pragma("unroll") for (int ks = 0; ks < 3; ++ks) { afr[ks] = *(const LAS bf16x8*)(ap + 32 * (k0 + ks)); qfr[ks] = *(const LAS bf16x8*)(qp + 32 * (k0 + ks)); } \
                __builtin_amdgcn_sched_barrier(0); \
                _Pragma("unroll") for (int ks = 0; ks < 3; ++ks) { if ((k0 + ks) & 1) sa1 = __builtin_amdgcn_mfma_f32_32x32x16_bf16(afr[ks], qfr[ks], sa1, 0, 0, 0); else sa0 = __builtin_amdgcn_mfma_f32_32x32x16_bf16(afr[ks], qfr[ks], sa0, 0, 0, 0); } \
                __builtin_amdgcn_sched_barrier(0); } \
            const int t_q = l31 >> 3, h_q = l31 & 7; \
            _Pragma("unroll") for (int g = 0; g < 4; ++g) { \
                const f32x4 r4 = *(const LAS f32x4*)(L + SA_R + (h_q * 64 + 32 * w + 8 * g + 4 * hh) * 4); \
                const int kg = kbeg + 64 * (n) + 32 * w + 8 * g + 4 * hh; \
                float p[4]; \
                _Pragma("unroll") for (int i = 0; i < 4; ++i) { float e = __builtin_amdgcn_exp2f((sa0[4 * g + i] + sa1[4 * g + i]) * r4[i] + negM); if (kg + i > PAST + t_q) e = 0.f; p[i] = e; lsum += e; } \
                v2u o; o.x = cvtpk(p[0], p[1]); o.y = cvtpk(p[2], p[3]); \
                *(LAS v2u*)(L + SA_PT + l31 * SA_PTROW + (32 * w + 8 * g + 4 * hh) * 2) = o; } \
        } \
        SA_BAR(); \
          \
        { \
            const LAS unsigned char* trp = tb + (8 * hh + (l15 >> 2)) * SA_ROWB + (32 * w + 16 * (l4 & 1) + 4 * (l15 & 3)) * 2; \
            const LAS unsigned char* pp = L + SA_PT + l31 * SA_PTROW + 16 * hh; \
            bf16x8 afv[4], pfv[4];                \
            _Pragma("unroll") for (int s2 = 0; s2 < 4; ++s2) { \
                const s16x4 lo = __builtin_bit_cast(s16x4, __builtin_amdgcn_ds_read_tr16_b64_v4i16((LAS v4i16_t*)(trp + (16 * s2) * SA_ROWB))); \
                const s16x4 hi = __builtin_bit_cast(s16x4, __builtin_amdgcn_ds_read_tr16_b64_v4i16((LAS v4i16_t*)(trp + (16 * s2 + 4) * SA_ROWB))); \
                afv[s2] = (bf16x8){lo[0], lo[1], lo[2], lo[3], hi[0], hi[1], hi[2], hi[3]}; \
                pfv[s2] = *(const LAS bf16x8*)(pp + 32 * s2); } \
            __builtin_amdgcn_sched_barrier(0); \
            _Pragma("unroll") for (int s2 = 0; s2 < 4; ++s2) { if (s2 & 1) oacc1 = __builtin_amdgcn_mfma_f32_32x32x16_bf16(afv[s2], pfv[s2], oacc1, 0, 0, 0); else oacc = __builtin_amdgcn_mfma_f32_32x32x16_bf16(afv[s2], pfv[s2], oacc, 0, 0, 0); } \
            __builtin_amdgcn_sched_barrier(0); \
        } } while (0)
#pragma unroll 1
    for (int n = 0; n < 60; n += 2) {
        SA_STEP(n, vb, true, true, SA_LOADPC, true, SA_LOADC);
        SA_STEP(n + 1, va, true, true, SA_LOADPC, true, SA_LOADC);
    }
#pragma unroll 1
    for (int n = 60; n < NT; n += 2) {
        SA_STEP(n, vb, n + 1 < NT, n + 2 < NT, SA_LOADP, n + 3 < NT, SA_LOAD);
        if (n + 1 < NT) SA_STEP(n + 1, va, n + 2 < NT, n + 3 < NT, SA_LOADP, n + 4 < NT, SA_LOAD);
    }
#undef SA_STEP
#undef SA_LOAD
#undef SA_LOADC
#undef SA_LOADP
#undef SA_LOADPC
#undef SA_CONVERT
    float* part = (float*)(F.ws + WS_SPART + (size_t)(s * 2 + split) * SPART_STRIDE);
    lsum += __shfl_xor(lsum, 32);
    __syncthreads();
    if (w < 2 && lane < 32) ((LAS float*)(L + SA_R))[w * 32 + lane] = lsum;
    __syncthreads();
    if (tid < 32) { const LAS float* lp = (const LAS float*)(L + SA_R); part[tid] = lp[tid] + lp[32 + tid]; }
#pragma unroll
    for (int g = 0; g < 4; ++g) *(f32x4*)(part + 32 + l31 * 256 + 32 * w + 8 * g + 4 * hh) = (f32x4){oacc[4 * g] + oacc1[4 * g], oacc[4 * g + 1] + oacc1[4 * g + 1], oacc[4 * g + 2] + oacc1[4 * g + 2], oacc[4 * g + 3] + oacc1[4 * g + 3]};
    __syncthreads();
}
}
namespace mk {
__device__ __forceinline__ void p6_gmlp_chunk(Frame& F, int chunk) {
    const int lane = F.lane, g = F.wave, hh = lane >> 5, l31 = lane & 31;
    LAS float* SS = (LAS float*)(F.lds + 131072);
    LAS unsigned char* VT_ = F.lds + g * 16384;
    const int row0 = chunk * 128;
    const bf16* VG = F.w<bf16>(WS_VG) + (size_t)row0 * 512 + g * 64;
    const bf16* Z = F.w<bf16>(WS_Z) + (size_t)row0 * NINP + g * 64;
    const bf16* Wg = F.w<bf16>(WS_W_SB) + (size_t)g * 128 * 128;
    const float* bs = F.inf(I_BS) + g * 128;
    v4u wf[4][8];
#pragma unroll
    for (int tt = 0; tt < 4; ++tt)
#pragma unroll
        for (int ks = 0; ks < 2 * tt + 2; ++ks) wf[tt][ks] = *(const v4u*)(Wg + (size_t)(32 * tt + l31) * 128 + 16 * ks + 8 * hh);
#pragma unroll
    for (int i = 0; i < 16; ++i) { const int r = (lane >> 3) + 8 * i, ch = lane & 7; const v4u v = *(const v4u*)(VG + (size_t)r * 512 + 8 * ch); *(LAS v4u*)(VT_ + r * 128 + 16 * ch) = v;
        if ((i & 3) == 3) __builtin_amdgcn_sched_barrier(0); }
    LDS_WAIT(); asm volatile("" ::: "memory");
    const int l4 = lane >> 4, l15 = lane & 15;
    const LAS unsigned char* trb = VT_ + (8 * hh + (l15 >> 2)) * 128 + (16 * (l4 & 1) + 4 * (l15 & 3)) * 2;
    v2u pa[4][2][4];
    v2u ura[4][2][4]; float bta[4];
#pragma unroll
    for (int tt = 0; tt < 4; ++tt) { const int t = 32 * tt + l31; bta[tt] = bs[t];
#pragma unroll
        for (int dt = 0; dt < 2; ++dt)
#pragma unroll
            for (int gq = 0; gq < 4; ++gq) ura[tt][dt][gq] = *(const v2u*)(Z + (size_t)t * NINP + 32 * dt + 8 * gq + 4 * hh); }
#pragma unroll
    for (int tt = 0; tt < 4; ++tt) {
        const int t = 32 * tt + l31;
        const v2u (&ur)[2][4] = ura[tt];
        const float bt = bta[tt];
        f32x16 a0 = {}, a1 = {};
#pragma unroll
        for (int ks = 0; ks < 2 * tt + 2; ++ks) {
            v4u pk = wf[tt][ks];
            if (ks >= 2 * tt) {
                const int s0 = 16 * ks + 8 * hh;
#pragma unroll
                for (int i = 0; i < 4; ++i) { unsigned wv = pk[i]; if (s0 + 2 * i > t) wv = 0u; else if (s0 + 2 * i + 1 > t) wv &= 0xffffu; pk[i] = wv; }
            }
            const bf16x8 bfr = __builtin_bit_cast(bf16x8, pk);
            bf16x8 af[2];
#pragma unroll
            for (int dt = 0; dt < 2; ++dt) {
                const s16x4 lo = __builtin_bit_cast(s16x4, __builtin_amdgcn_ds_read_tr16_b64_v4i16((LAS v4i16_t*)(trb + (16 * ks) * 128 + 64 * dt)));
                const s16x4 hi = __builtin_bit_cast(s16x4, __builtin_amdgcn_ds_read_tr16_b64_v4i16((LAS v4i16_t*)(trb + (16 * ks + 4) * 128 + 64 * dt)));
                af[dt] = (bf16x8){lo[0], lo[1], lo[2], lo[3], hi[0], hi[1], hi[2], hi[3]};
            }
            a0 = __builtin_amdgcn_mfma_f32_32x32x16_bf16(af[0], bfr, a0, 0, 0, 0); a1 = __builtin_amdgcn_mfma_f32_32x32x16_bf16(af[1], bfr, a1, 0, 0, 0);
        }
        float ss = 0.f;
#pragma unroll
        for (int dt = 0; dt < 2; ++dt)
#pragma unroll
            for (int gq = 0; gq < 4; ++gq) {
                const v2u u2 = ur[dt][gq];
                const float u0 = gelu_tanh_f(bflo(u2.x)), u1 = gelu_tanh_f(bfhi(u2.x)), u2f = gelu_tanh_f(bflo(u2.y)), u3 = gelu_tanh_f(bfhi(u2.y));
                const f32x16& acc = dt ? a1 : a0;
                const float v0 = u0 * (acc[4 * gq] + bt), v1 = u1 * (acc[4 * gq + 1] + bt), v2 = u2f * (acc[4 * gq + 2] + bt), v3 = u3 * (acc[4 * gq + 3] + bt);
                ss += (v0 * v0 + v1 * v1) + (v2 * v2 + v3 * v3);
                v2u o; o.x = cvtpk(v0, v1); o.y = cvtpk(v2, v3); pa[tt][dt][gq] = o;
            }
        ss += __shfl_xor(ss, 32);
        if (hh == 0) SS[g * 128 + t] = ss;
    }
    __syncthreads();
    const float* goa = F.inf(I_GOA) + g * 64;
    bf16* MRG = F.w<bf16>(WS_MRG) + (size_t)row0 * 1024 + g * 64;
#pragma unroll
    for (int tt = 0; tt < 4; ++tt) {
        const int t = 32 * tt + l31;
        float tot = 0.f;
#pragma unroll
        for (int k = 0; k < 8; ++k) tot += SS[k * 128 + t];
        const float rstd = rsqrtf(tot * (1.f / 512.f) + EPS);
#pragma unroll
        for (int dt = 0; dt < 2; ++dt)
#pragma unroll
            for (int gq = 0; gq < 4; ++gq) {
                const int d0 = 32 * dt + 8 * gq + 4 * hh;
                const f32x4 gg = *(const f32x4*)(goa + d0);
                const v2u v = pa[tt][dt][gq];
                v2u o; o.x = cvtpk(bflo(v.x) * rstd * gg[0], bfhi(v.x) * rstd * gg[1]); o.y = cvtpk(bflo(v.y) * rstd * gg[2], bfhi(v.y) * rstd * gg[3]);
                *(v2u*)(MRG + (size_t)t * 1024 + d0) = o;
            }
    }
    __syncthreads();
}
__device__ __forceinline__ void p6_sample_seq(Frame& F, int s) {
    const int tid = F.tid, lane = F.lane, w = F.wave, l31 = lane & 31, hh = lane >> 5;
    LAS float* RED = (LAS float*)(F.lds + 32768);
    const float* p0 = (const float*)(F.ws + WS_SPART + (size_t)(s * 2) * SPART_STRIDE); const float* p1 = (const float*)((const unsigned char*)p0 + SPART_STRIDE);
    f32x16 a0 = {}, a1 = {};
    {
        const int th = (l31 & 3) * 8 + w;
        const float inv_l = 1.f / (p0[th] + p1[th]);
        const float* o0 = p0 + 32 + th * 256 + 8 * hh; const float* o1 = p1 + 32 + th * 256 + 8 * hh;
        const bf16* Wp = F.w<bf16>(WS_W_UV) + (size_t)(w * 64 + l31) * 256 + 8 * hh;
#pragma unroll
        for (int k0 = 0; k0 < 16; k0 += 4) {
            f32x4 x0[4], x1[4], y0[4], y1[4]; bf16x8 b0[4], b1[4];
#pragma unroll
            for (int i = 0; i < 4; ++i) { const int ks = k0 + i; x0[i] = *(const f32x4*)(o0 + 16 * ks); x1[i] = *(const f32x4*)(o0 + 16 * ks + 4); y0[i] = *(const f32x4*)(o1 + 16 * ks); y1[i] = *(const f32x4*)(o1 + 16 * ks + 4);
                b0[i] = *(const bf16x8*)(Wp + 16 * ks); b1[i] = *(const bf16x8*)(Wp + (size_t)32 * 256 + 16 * ks); }
#pragma unroll
            for (int i = 0; i < 4; ++i) { const f32x4 u0 = (x0[i] + y0[i]) * inv_l, u1 = (x1[i] + y1[i]) * inv_l;
                v4u pk; pk.x = cvtpk(u0[0], u0[1]); pk.y = cvtpk(u0[2], u0[3]); pk.z = cvtpk(u1[0], u1[1]); pk.w = cvtpk(u1[2], u1[3]);
                if (l31 >= 4) pk = (v4u){0u, 0u, 0u, 0u};
                const bf16x8 af = __builtin_bit_cast(bf16x8, pk);
                a0 = __builtin_amdgcn_mfma_f32_32x32x16_bf16(af, b0[i], a0, 0, 0, 0); a1 = __builtin_amdgcn_mfma_f32_32x32x16_bf16(af, b1[i], a1, 0, 0, 0); }
        }
    }
    const int col = tid;
    float ao[4];
    { const int g = col >> 6; const bf16* VG = F.w<bf16>(WS_VG) + (size_t)(TP + 4 * s) * 512 + col; const bf16* Z = F.w<bf16>(WS_Z) + (size_t)(TP + 4 * s) * NINP + col;
      const float* Wg = F.inf(I_WS) + (size_t)g * 128 * 128; const float* bs = F.inf(I_BS) + g * 128;
      float vg[4];
#pragma unroll
      for (int t = 0; t < 4; ++t) vg[t] = bf2f(VG[(size_t)t * 512]);
#pragma unroll
      for (int t = 0; t < 4; ++t) { float m = bs[t];
#pragma unroll
          for (int s2 = 0; s2 <= t; ++s2) m += Wg[t * 128 + s2] * vg[s2];
          ao[t] = gelu_tanh_f(bf2f(Z[(size_t)t * NINP])) * m; } }
    float red[8];
#pragma unroll
    for (int t = 0; t < 4; ++t) { red[t] = wave_sum(ao[t] * ao[t]); const float bq = (hh == 0) ? (a0[t] * a0[t] + a1[t] * a1[t]) : 0.f; red[4 + t] = wave_sum(bq); }
    if (lane < 8) { float v = red[0];
#pragma unroll
        for (int k = 1; k < 8; ++k) v = (lane == k) ? red[k] : v;
        RED[w * 8 + lane] = v; }
    __syncthreads();
    const float ga = F.inf(I_GOA)[col];
    bf16* MRG = F.w<bf16>(WS_MRG) + (size_t)(TP + 4 * s) * 1024; bf16* BO = F.w<bf16>(WS_BO) + (size_t)(TP + 4 * s) * 512;
    const float gb0 = F.inf(I_GOB)[w * 64 + l31], gb1 = F.inf(I_GOB)[w * 64 + 32 + l31];
#pragma unroll
    for (int t = 0; t < 4; ++t) {
        float sa = 0.f, sb = 0.f;
#pragma unroll
        for (int k = 0; k < 8; ++k) { sa += RED[k * 8 + t]; sb += RED[k * 8 + 4 + t]; }
        MRG[(size_t)t * 1024 + col] = (bf16)f2bf(ao[t] * rsqrtf(sa * (1.f / 512.f) + EPS) * ga);
        if (hh == 0) { const float rb = rsqrtf(sb * (1.f / 512.f) + EPS);
            MRG[(size_t)t * 1024 + 512 + w * 64 + l31] = (bf16)f2bf(a0[t] * rb * gb0); MRG[(size_t)t * 1024 + 512 + w * 64 + 32 + l31] = (bf16)f2bf(a1[t] * rb * gb1);
            BO[(size_t)t * 512 + w * 64 + l31] = (bf16)f2bf(a0[t]); BO[(size_t)t * 512 + w * 64 + 32 + l31] = (bf16)f2bf(a1[t]); }
    }
    __syncthreads();
}
static_assert(TP % (4 * 256 * NWAVES) == 0, "b_out norm loop: four rows per wave iteration");
__device__ __forceinline__ void p6_merge(Frame& F) {
#ifdef MK_TIMING
    unsigned long long* st_ = (unsigned long long*)(F.ws + WS_CTL + (768 << 10)) + F.bid * 32;
#define P6ST(k) do { if (F.tid == 0) st_[k] = __builtin_amdgcn_s_memrealtime(); } while (0)
#else
#define P6ST(k) do {} while (0)
#endif
    { const int u = F.bid; if (u < 128) { P6ST(24); p6_gmlp_chunk(F, u); P6ST(25); } else { P6ST(26); p6_sample_seq(F, u - 128); P6ST(27); } }
    P6ST(28);
    const int gw = F.bid * NWAVES + F.wave, NGW = F.G * NWAVES, lane = F.lane;
    const f32x4 g0 = *(const f32x4*)(F.inf(I_GOB) + 8 * lane), g1 = *(const f32x4*)(F.inf(I_GOB) + 8 * lane + 4);
    for (int r0 = gw; r0 < TP; r0 += 4 * NGW) {
        v4u raws[4];
#pragma unroll
        for (int k = 0; k < 4; ++k) raws[k] = *(const v4u*)(F.w<bf16>(WS_BO) + (size_t)(r0 + k * NGW) * 512 + 8 * lane);
#pragma unroll
        for (int k = 0; k < 4; ++k) { const int r = r0 + k * NGW; const v4u raw = raws[k];
        float x[8];
#pragma unroll
        for (int i = 0; i < 4; ++i) { x[2 * i] = bflo(raw[i]); x[2 * i + 1] = bfhi(raw[i]); }
        float ss = 0.f;
#pragma unroll
        for (int i = 0; i < 8; ++i) ss += x[i] * x[i];
        const float rstd = rsqrtf(wave_sum(ss) * (1.f / 512.f) + EPS);
        v4u o; o.x = pk2(x[0] * rstd * g0[0], x[1] * rstd * g0[1]); o.y = pk2(x[2] * rstd * g0[2], x[3] * rstd * g0[3]); o.z = pk2(x[4] * rstd * g1[0], x[5] * rstd * g1[1]); o.w = pk2(x[6] * rstd * g1[2], x[7] * rstd * g1[3]);
        *(v4u*)(F.w<bf16>(WS_MRG) + (size_t)r * 1024 + 512 + 8 * lane) = o;
        }
    }
    P6ST(29);
}
}
namespace mk {
__device__ __forceinline__ void rms_rowb_finish(const v4u a, const v4u b, const f32x4 g0, const f32x4 g1, const f32x4 g2, const f32x4 g3, bf16* orow, int lane) {
    float x[16];
#pragma unroll
    for (int i = 0; i < 4; ++i) { x[2 * i] = bflo(a[i]); x[2 * i + 1] = bfhi(a[i]); x[8 + 2 * i] = bflo(b[i]); x[8 + 2 * i + 1] = bfhi(b[i]); }
    float s = 0.f;
#pragma unroll
    for (int i = 0; i < 16; ++i) s += x[i] * x[i];
    const float rstd = rsqrtf(wave_sum(s) * (1.f / 1024.f) + EPS);
    v4u o0, o1;
    o0.x = pk2(x[0] * rstd * g0[0], x[1] * rstd * g0[1]); o0.y = pk2(x[2] * rstd * g0[2], x[3] * rstd * g0[3]); o0.z = pk2(x[4] * rstd * g1[0], x[5] * rstd * g1[1]); o0.w = pk2(x[6] * rstd * g1[2], x[7] * rstd * g1[3]);
    o1.x = pk2(x[8] * rstd * g2[0], x[9] * rstd * g2[1]); o1.y = pk2(x[10] * rstd * g2[2], x[11] * rstd * g2[3]); o1.z = pk2(x[12] * rstd * g3[0], x[13] * rstd * g3[1]); o1.w = pk2(x[14] * rstd * g3[2], x[15] * rstd * g3[3]);
    *(v4u*)(orow + 8 * lane) = o0; *(v4u*)(orow + 512 + 8 * lane) = o1;
}
__device__ __forceinline__ void p_rms_rows(Frame& F, size_t src_off, int gain_idx, size_t dst_off) {
    const int gw = F.bid * NWAVES + F.wave, NGW = F.G * NWAVES, lane = F.lane;
    const float* g = F.inf(gain_idx);
    const f32x4 g0 = *(const f32x4*)(g + 8 * lane), g1 = *(const f32x4*)(g + 8 * lane + 4), g2 = *(const f32x4*)(g + 512 + 8 * lane), g3 = *(const f32x4*)(g + 512 + 8 * lane + 4);
    const bf16* src = F.w<bf16>(src_off); bf16* dst = F.w<bf16>(dst_off);
    for (int r = gw; r < T; r += 4 * NGW) {
        v4u a[4], b[4];
#pragma unroll
        for (int k = 0; k < 4; ++k) { const int rr = r + k * NGW; if (rr < T) { a[k] = *(const v4u*)(src + (size_t)rr * D + 8 * lane); b[k] = *(const v4u*)(src + (size_t)rr * D + 512 + 8 * lane); } }
#pragma unroll
        for (int k = 0; k < 4; ++k) { const int rr = r + k * NGW; if (rr < T) rms_rowb_finish(a[k], b[k], g0, g1, g2, g3, dst + (size_t)rr * D, lane); }
    }
}

constexpr int MA_KROW = 272, MA_VROW = 528, MA_K = 0, MA_V = 256 * MA_KROW;
static_assert(MA_V + 128 * MA_VROW <= RING_BYTES, "memory attention LDS");
__device__ __forceinline__ void memattn_prompt_unit(Frame& F, int pb, int h, float negM) {
    const int tid = F.tid, lane = F.lane, l31 = lane & 31, hh = lane >> 5;
    const int b = pb >> 3, row = 256 * pb + 32 * F.wave + l31;
    LAS unsigned char* L = F.lds;
    {
        const bf16* Kg = F.w<bf16>(WS_MK) + (size_t)(b * 256) * 512 + h * 128;
        const bf16* Vg = F.w<bf16>(WS_MVT) + (size_t)(b * 4 + h) * 128 * 256;
        v4u kr[8], vr[8];
#pragma unroll
        for (int i = 0; i < 8; ++i) { const int ch = tid + 512 * i; kr[i] = *(const v4u*)(Kg + (size_t)(ch >> 4) * 512 + 8 * (ch & 15)); vr[i] = *(const v4u*)(Vg + (size_t)(ch >> 5) * 256 + 8 * (ch & 31)); }
#pragma unroll
        for (int i = 0; i < 8; ++i) { const int ch = tid + 512 * i; *(LAS v4u*)(L + MA_K + (ch >> 4) * MA_KROW + 16 * (ch & 15)) = kr[i]; *(LAS v4u*)(L + MA_V + (ch >> 5) * MA_VROW + 16 * (ch & 31)) = vr[i]; }
    }
    const bf16* Qp = F.w<bf16>(WS_MQ) + (size_t)row * 512 + h * 128 + 8 * hh;
    const float* g = F.inf(I_GMQ) + 8 * hh;
    bf16x8 qf[8];
    {
        v4u raw[8]; float ss = 0.f;
#pragma unroll
        for (int ks = 0; ks < 8; ++ks) { raw[ks] = *(const v4u*)(Qp + 16 * ks);
#pragma unroll
            for (int i = 0; i < 4; ++i) { const float a = bflo(raw[ks][i]), c = bfhi(raw[ks][i]); ss += a * a + c * c; } }
        ss += __shfl_xor(ss, 32);
        const float rs = rsqrtf(ss * (1.f / 128.f) + EPS) * MQSCALE;
#pragma unroll
        for (int ks = 0; ks < 8; ++ks) { const f32x4 g0 = *(const f32x4*)(g + 16 * ks), g1 = *(const f32x4*)(g + 16 * ks + 4); v4u o;
            o.x = cvtpk(bflo(raw[ks][0]) * rs * g0[0], bfhi(raw[ks][0]) * rs * g0[1]); o.y = cvtpk(bflo(raw[ks][1]) * rs * g0[2], bfhi(raw[ks][1]) * rs * g0[3]);
            o.z = cvtpk(bflo(raw[ks][2]) * rs * g1[0], bfhi(raw[ks][2]) * rs * g1[1]); o.w = cvtpk(bflo(raw[ks][3]) * rs * g1[2], bfhi(raw[ks][3]) * rs * g1[3]);
            qf[ks] = __builtin_bit_cast(bf16x8, o); }
    }
    __syncthreads();
    f32x16 o[4]; o[0] = f32x16{}; o[1] = f32x16{}; o[2] = f32x16{}; o[3] = f32x16{};
    float l = 0.f;
    const LAS unsigned char* Kp = L + MA_K + l31 * MA_KROW + 16 * hh;
    const LAS unsigned char* Vp = L + MA_V + l31 * MA_VROW + 8 * hh;
#pragma unroll 1
    for (int kt = 0; kt < 8; ++kt) {
        f32x16 s = {};
#pragma unroll
        for (int ks = 0; ks < 8; ++ks) { const bf16x8 kf = *(const LAS bf16x8*)(Kp + kt * 32 * MA_KROW + 32 * ks); s = __builtin_amdgcn_mfma_f32_32x32x16_bf16(kf, qf[ks], s, 0, 0, 0); }
        float p[16];
#pragma unroll
        for (int i = 0; i < 16; ++i) { p[i] = __builtin_amdgcn_exp2f(s[i] + negM); l += p[i]; }
        bf16x8 pb2[2];
#pragma unroll
        for (int s2 = 0; s2 < 2; ++s2) { v4u w; w.x = cvtpk(p[8 * s2 + 0], p[8 * s2 + 1]); w.y = cvtpk(p[8 * s2 + 2], p[8 * s2 + 3]); w.z = cvtpk(p[8 * s2 + 4], p[8 * s2 + 5]); w.w = cvtpk(p[8 * s2 + 6], p[8 * s2 + 7]); pb2[s2] = __builtin_bit_cast(bf16x8, w); }
#pragma unroll
        for (int dt = 0; dt < 4; ++dt)
#pragma unroll
            for (int s2 = 0; s2 < 2; ++s2) { const LAS unsigned char* vp = Vp + dt * 32 * MA_VROW + (kt * 32 + 16 * s2) * 2; const s16x4 lo = *(const LAS s16x4*)vp, hi = *(const LAS s16x4*)(vp + 16);
                const bf16x8 va = (bf16x8){lo[0], lo[1], lo[2], lo[3], hi[0], hi[1], hi[2], hi[3]};
                o[dt] = __builtin_amdgcn_mfma_f32_32x32x16_bf16(va, pb2[s2], o[dt], 0, 0, 0); }
    }
    l += __shfl_xor(l, 32);
    const float rl = 1.f / l;
    bf16* Op = F.w<bf16>(WS_MO) + (size_t)row * 512 + h * 128 + 4 * hh;
#pragma unroll
    for (int dt = 0; dt < 4; ++dt)
#pragma unroll
        for (int gq = 0; gq < 4; ++gq) { v2u w0; w0.x = cvtpk(o[dt][4 * gq] * rl, o[dt][4 * gq + 1] * rl); w0.y = cvtpk(o[dt][4 * gq + 2] * rl, o[dt][4 * gq + 3] * rl);
            *(v2u*)(Op + 32 * dt + 8 * gq) = w0; }
    __syncthreads();
}
__device__ __forceinline__ void memattn_sample_wg(Frame& F, int U) {
    const int lane = F.lane, l31 = lane & 31, hh = lane >> 5, pair = F.wave >> 2, kq = F.wave & 3;
    const int sh = 2 * U + pair, s = sh >> 2, h = sh & 3;
    LAS float* SC = (LAS float*)(F.lds + pair * 4096);
    LAS float* OP = (LAS float*)(F.lds + 8192 + pair * 8192);
    f32x4 q[4];
    { const f32x4 g = *(const f32x4*)(F.inf(I_GMQ) + 4 * l31);
#pragma unroll
      for (int t = 0; t < 4; ++t) { const v2u raw = *(const v2u*)(F.w<bf16>(WS_MQ) + (size_t)(TP + 4 * s + t) * 512 + h * 128 + 4 * l31);
          f32x4 x = (f32x4){bflo(raw.x), bfhi(raw.x), bflo(raw.y), bfhi(raw.y)};
          float ss = (x[0] * x[0] + x[1] * x[1]) + (x[2] * x[2] + x[3] * x[3]);
          ss += __shfl_xor(ss, 1); ss += __shfl_xor(ss, 2); ss += __shfl_xor(ss, 4); ss += __shfl_xor(ss, 8); ss += __shfl_xor(ss, 16);
          const float rs = rsqrtf(ss * (1.f / 128.f) + EPS) * 0.08838834764831845f;
          q[t] = x * rs * g; } }
    const size_t cbase = ((size_t)(s * 256 + 64 * kq) * 4 + h) * 128 + 4 * l31;
    const float* Kc = F.inf(I_CMK) + cbase; const float* Vc = F.inf(I_CMV) + cbase;
    const bool b4 = (l31 & 16) != 0, b3 = (l31 & 8) != 0, b2 = (l31 & 4) != 0, b1 = (l31 & 2) != 0;
#pragma unroll 1
    for (int kp = 0; kp < 32; kp += 16) {
        f32x4 kv[16];
#pragma unroll
        for (int u = 0; u < 16; ++u) kv[u] = __builtin_nontemporal_load((const f32x4*)(Kc + (size_t)(2 * (kp + u) + hh) * 512));
#pragma unroll
        for (int t = 0; t < 4; ++t) {
            float pt[16], v8[8], v4[4], v2[2];
#pragma unroll
            for (int u = 0; u < 16; ++u) pt[u] = (kv[u][0] * q[t][0] + kv[u][1] * q[t][1]) + (kv[u][2] * q[t][2] + kv[u][3] * q[t][3]);
#pragma unroll
            for (int i = 0; i < 8; ++i) { const float send = b4 ? pt[i] : pt[8 + i], keep = b4 ? pt[8 + i] : pt[i]; v8[i] = keep + __shfl_xor(send, 16); }
#pragma unroll
            for (int i = 0; i < 4; ++i) { const float send = b3 ? v8[i] : v8[4 + i], keep = b3 ? v8[4 + i] : v8[i]; v4[i] = keep + __shfl_xor(send, 8); }
#pragma unroll
            for (int i = 0; i < 2; ++i) { const float send = b2 ? v4[i] : v4[2 + i], keep = b2 ? v4[2 + i] : v4[i]; v2[i] = keep + __shfl_xor(send, 4); }
            float v1; { const float send = b1 ? v2[0] : v2[1], keep = b1 ? v2[1] : v2[0]; v1 = keep + __shfl_xor(send, 2); }
            v1 += __shfl_xor(v1, 1);
            if ((l31 & 1) == 0) SC[t * 256 + 64 * kq + 2 * (kp + (l31 >> 1)) + hh] = v1;
        }
    }
    f32x4 vv[16];
#pragma unroll
    for (int u = 0; u < 16; ++u) vv[u] = __builtin_nontemporal_load((const f32x4*)(Vc + (size_t)(2 * u + hh) * 512));
    __syncthreads();
    LAS float* PS = (LAS float*)(F.lds + 24576 + pair * 4096);
    float rsum[4];
#pragma unroll
    for (int t = 0; t < 4; ++t) {
        const f32x4 sc = *(const LAS f32x4*)(SC + t * 256 + 4 * lane);
        float m = fmaxf(fmaxf(sc[0], sc[1]), fmaxf(sc[2], sc[3]));
#pragma unroll
        for (int o = 1; o < 64; o <<= 1) m = fmaxf(m, __shfl_xor(m, o));
        f32x4 e; float sum = 0.f;
#pragma unroll
        for (int i = 0; i < 4; ++i) { e[i] = __expf(sc[i] - m); sum += e[i]; }
        *(LAS f32x4*)(PS + t * 256 + 4 * lane) = e;
        rsum[t] = 1.f / wave_sum(sum);
    }
    LDS_WAIT(); asm volatile("" ::: "memory");
    f32x4 o[4]; o[0] = o[1] = o[2] = o[3] = (f32x4){0.f, 0.f, 0.f, 0.f};
#pragma unroll 1
    for (int kp = 0; kp < 32; kp += 16) {
#pragma unroll
        for (int u = 0; u < 16; ++u)
#pragma unroll
            for (int t = 0; t < 4; ++t) { const float p = PS[t * 256 + 64 * kq + 2 * (kp + u) + hh]; o[t] += vv[u] * p; }
        if (kp + 16 < 32) {
#pragma unroll
            for (int u = 0; u < 16; ++u) vv[u] = __builtin_nontemporal_load((const f32x4*)(Vc + (size_t)(2 * (kp + 16 + u) + hh) * 512));
        }
    }
#pragma unroll
    for (int t = 0; t < 4; ++t) {
#pragma unroll
        for (int i = 0; i < 4; ++i) o[t][i] += __shfl_xor(o[t][i], 32);
        if (hh == 0) *(LAS f32x4*)(OP + (kq * 4 + t) * 128 + 4 * l31) = o[t];
    }
    __syncthreads();
    {
        const int t = kq;
        float a0 = 0.f, a1 = 0.f;
#pragma unroll
        for (int k = 0; k < 4; ++k) { a0 += OP[(k * 4 + t) * 128 + 2 * lane]; a1 += OP[(k * 4 + t) * 128 + 2 * lane + 1]; }
        float rs = rsum[0]; rs = (t == 1) ? rsum[1] : rs; rs = (t == 2) ? rsum[2] : rs; rs = (t == 3) ? rsum[3] : rs;
        *(unsigned*)(F.w<bf16>(WS_MO) + (size_t)(TP + 4 * s + t) * 512 + h * 128 + 2 * lane) = cvtpk(a0 * rs, a1 * rs);
    }
    __syncthreads();
}
__device__ __forceinline__ void p10_memattn(Frame& F) {
    const float negM = -(LOG2E * 11.313708498984761f * gain_absmax(F.inf(I_GMQ), 128, F.lane) * gain_absmax(F.inf(I_GMK), 128, F.lane) * 1.01f);
    const int gw = F.bid * NWAVES + F.wave, NGW = F.G * NWAVES;
#pragma unroll 1
    for (int pass = 0; pass < 2; ++pass) {
        F.tid = opaque_i(F.tid); F.lane = F.tid & 63;
        if ((pass == 0) == (((F.bid >> 3) & 1) == 0)) memattn_prompt_unit(F, F.bid >> 2, F.bid & 3, negM);
        else memattn_sample_wg(F, F.bid);
    }
}

__device__ __forceinline__ void p15_pre(Frame& F, int pm) {
    const float* wc = F.inf(I_WCONV); const float* bc = F.inf(I_BCONV);
    {
        const bf16* UPS = F.w<bf16>(WS_UP); const float* st = F.inf(I_CONVST);
        for (int it = F.bid * 512 + F.tid; it < TSMP * 352; it += F.G * 512) {
            const int rs = it / 352, ch = it % 352, f = 8 * ch, t = rs & 3, n = rs >> 2;
            const int cg = 256 * (f >> 7) + (f & 127);
            float g0[8], g1[8], g2[8], vv[8];
            { const v4u a = *(const v4u*)(UPS + (size_t)rs * (2 * DFF) + cg), v = *(const v4u*)(UPS + (size_t)rs * (2 * DFF) + cg + 128);
#pragma unroll
              for (int i = 0; i < 4; ++i) { g0[2 * i] = bflo(a[i]); g0[2 * i + 1] = bfhi(a[i]); vv[2 * i] = bflo(v[i]); vv[2 * i + 1] = bfhi(v[i]); } }
            if (t >= 1) { const v4u a = *(const v4u*)(UPS + (size_t)(rs - 1) * (2 * DFF) + cg);
#pragma unroll
                for (int i = 0; i < 4; ++i) { g1[2 * i] = bflo(a[i]); g1[2 * i + 1] = bfhi(a[i]); } }
            else { const float* sp = st + (size_t)(n * 2 + 1) * DFF + f; const f32x4 a = *(const f32x4*)sp, b = *(const f32x4*)(sp + 4);
#pragma unroll
                for (int i = 0; i < 4; ++i) { g1[i] = a[i]; g1[4 + i] = b[i]; } }
            if (t >= 2) { const v4u a = *(const v4u*)(UPS + (size_t)(rs - 2) * (2 * DFF) + cg);
#pragma unroll
                for (int i = 0; i < 4; ++i) { g2[2 * i] = bflo(a[i]); g2[2 * i + 1] = bfhi(a[i]); } }
            else { const float* sp = st + (size_t)(n * 2 + t) * DFF + f; const f32x4 a = *(const f32x4*)sp, b = *(const f32x4*)(sp + 4);
#pragma unroll
                for (int i = 0; i < 4; ++i) { g2[i] = a[i]; g2[4 + i] = b[i]; } }
            float hv[8];
#pragma unroll
            for (int i = 0; i < 8; ++i) { const float c = bc[f + i] + g2[i] * wc[f + i] + g1[i] * wc[DFF + f + i] + g0[i] * wc[2 * DFF + f + i]; hv[i] = c / (1.f + __expf(-c)) * vv[i]; }
            v4u o; o.x = cvtpk(hv[0], hv[1]); o.y = cvtpk(hv[2], hv[3]); o.z = cvtpk(hv[4], hv[5]); o.w = cvtpk(hv[6], hv[7]);
            *(v4u*)(F.w<bf16>(WS_HID) + (size_t)(TP + rs) * DFF + f) = o;
            if (t >= 2) { float* co = F.out + O_SCONV + (size_t)(n * 2 + (t - 2)) * DFF + f; *(f32x4*)co = (f32x4){g0[0], g0[1], g0[2], g0[3]}; *(f32x4*)(co + 4) = (f32x4){g0[4], g0[5], g0[6], g0[7]}; }
        }
    }
    if ((pm & 7) != 0) {
        const bf16* R0 = F.w<bf16>(WS_RAW01) + (size_t)pm * 2 * (2 * DFF); const float* G = F.w<float>(WS_RAWG) + (size_t)(pm - 1) * 2 * DFF;
        if (F.tid < DFF / 8) {
            const int f = 8 * F.tid;
            const v4u rg0 = *(const v4u*)(R0 + f), rv0 = *(const v4u*)(R0 + DFF + f), rg1 = *(const v4u*)(R0 + 2 * DFF + f), rv1 = *(const v4u*)(R0 + 3 * DFF + f);
            float hv0[8], hv1[8];
#pragma unroll
            for (int q = 0; q < 2; ++q) {
                const f32x4 gm2 = *(const f32x4*)(G + f + 4 * q), gm1 = *(const f32x4*)(G + DFF + f + 4 * q);
                const f32x4 w0 = *(const f32x4*)(wc + f + 4 * q), w1 = *(const f32x4*)(wc + DFF + f + 4 * q), w2 = *(const f32x4*)(wc + 2 * DFF + f + 4 * q), b = *(const f32x4*)(bc + f + 4 * q);
#pragma unroll
                for (int e = 0; e < 4; ++e) { const int i = 4 * q + e; const unsigned wg0 = rg0[i >> 1], wv0 = rv0[i >> 1], wg1 = rg1[i >> 1], wv1 = rv1[i >> 1];
                    const float g0 = (i & 1) ? bfhi(wg0) : bflo(wg0), v0 = (i & 1) ? bfhi(wv0) : bflo(wv0), g1 = (i & 1) ? bfhi(wg1) : bflo(wg1), v1 = (i & 1) ? bfhi(wv1) : bflo(wv1);
                    const float c0 = b[e] + gm2[e] * w0[e] + gm1[e] * w1[e] + g0 * w2[e], c1 = b[e] + gm1[e] * w0[e] + g0 * w1[e] + g1 * w2[e];
                    hv0[i] = c0 / (1.f + __expf(-c0)) * v0; hv1[i] = c1 / (1.f + __expf(-c1)) * v1; }
            }
            v4u o0, o1; o0.x = cvtpk(hv0[0], hv0[1]); o0.y = cvtpk(hv0[2], hv0[3]); o0.z = cvtpk(hv0[4], hv0[5]); o0.w = cvtpk(hv0[6], hv0[7]);
            o1.x = cvtpk(hv1[0], hv1[1]); o1.y = cvtpk(hv1[2], hv1[3]); o1.z = cvtpk(hv1[4], hv1[5]); o1.w = cvtpk(hv1[6], hv1[7]);
            *(v4u*)(F.w<bf16>(WS_HID) + (size_t)(256 * pm) * DFF + f) = o0; *(v4u*)(F.w<bf16>(WS_HID) + (size_t)(256 * pm + 1) * DFF + f) = o1;
        }
    }
    VM_WAIT();
    __syncthreads();
}
}
namespace mk {
template <int K, bool RES_BF16, bool OUT_BF16, bool HAS_RES = true>
__device__ __forceinline__ void small_gemm_unit(Frame& F, const bf16* A, const bf16* Bt, int rbk, int cbk, const void* res, void* out, int ldc, float* ssq_out = nullptr, const float* ssq_in = nullptr) {
    static_assert(K % 64 == 0, "K in chunks of 64");
    constexpr int NCH = K / 64;
    const int lane = F.lane, w = F.wave, l31 = lane & 31, hh = lane >> 5, tid = F.tid, lr = lane >> 3, lc = lane & 7;
    LAS unsigned char* Tl = F.lds + w * 16384;
    const bf16* Ag = A + (size_t)(32 * rbk + lr) * K + 8 * lc;
    const bf16* Bg = Bt + (size_t)(64 * cbk + lr) * K + 8 * lc;
    f32x16 a0 = {}, a1 = {};
    v4u ra[4], rbv[8];
    int c = w;
    if (c < NCH) {
#pragma unroll
        for (int j = 0; j < 4; ++j) ra[j] = *(const v4u*)(Ag + (size_t)(8 * j) * K + 64 * c);
#pragma unroll
        for (int j = 0; j < 8; ++j) rbv[j] = *(const v4u*)(Bg + (size_t)(8 * j) * K + 64 * c);
    }
#pragma unroll 1
    for (; c < NCH; c += 8) {
#pragma unroll
        for (int j = 0; j < 4; ++j) *(LAS v4u*)(Tl + (lr + 8 * j) * 144 + 16 * lc) = ra[j];
#pragma unroll
        for (int j = 0; j < 8; ++j) *(LAS v4u*)(Tl + (32 + lr + 8 * j) * 144 + 16 * lc) = rbv[j];
        LDS_WAIT(); asm volatile("" ::: "memory");
        if (c + 8 < NCH) {
#pragma unroll
            for (int j = 0; j < 4; ++j) ra[j] = *(const v4u*)(Ag + (size_t)(8 * j) * K + 64 * (c + 8));
#pragma unroll
            for (int j = 0; j < 8; ++j) rbv[j] = *(const v4u*)(Bg + (size_t)(8 * j) * K + 64 * (c + 8));
        }
#pragma unroll
        for (int s = 0; s < 4; ++s) {
            const bf16x8 af = *(const LAS bf16x8*)(Tl + l31 * 144 + 32 * s + 16 * hh), b0 = *(const LAS bf16x8*)(Tl + (32 + l31) * 144 + 32 * s + 16 * hh), b1 = *(const LAS bf16x8*)(Tl + (64 + l31) * 144 + 32 * s + 16 * hh);
            a0 = __builtin_amdgcn_mfma_f32_32x32x16_bf16(af, b0, a0, 0, 0, 0); a1 = __builtin_amdgcn_mfma_f32_32x32x16_bf16(af, b1, a1, 0, 0, 0);
        }
        LDS_WAIT(); asm volatile("" ::: "memory");
    }
    __syncthreads();
    LAS float* RED = (LAS float*)F.lds + w * 2048;
#pragma unroll
    for (int i = 0; i < 16; ++i) { const int r = (i & 3) + 8 * (i >> 2) + 4 * hh; RED[r * 64 + l31] = a0[i]; RED[r * 64 + 32 + l31] = a1[i]; }
    __syncthreads();
    { const int r = tid >> 4, c4 = (tid & 15) * 4; const size_t off = (size_t)(32 * rbk + r) * ldc + 64 * cbk + c4;
      f32x4 sum;
      if (!HAS_RES) sum = (f32x4){0.f, 0.f, 0.f, 0.f}; else if (RES_BF16) { const v2u rw = *(const v2u*)((const bf16*)res + off); sum = (f32x4){bflo(rw.x), bfhi(rw.x), bflo(rw.y), bfhi(rw.y)}; } else sum = *(const f32x4*)((const float*)res + off);
#pragma unroll
      for (int k = 0; k < 8; ++k) sum += *(const LAS f32x4*)((LAS float*)F.lds + k * 2048 + r * 64 + c4);
      if (ssq_in) { float t = ssq_in[(size_t)(32 * rbk + r) * 16 + (tid & 15)]; t += __shfl_xor(t, 1); t += __shfl_xor(t, 2); t += __shfl_xor(t, 4); t += __shfl_xor(t, 8); sum = sum * rsqrtf(t * (1.f / 1024.f) + EPS); }
      if (ssq_out) { float s2 = (sum[0] * sum[0] + sum[1] * sum[1]) + (sum[2] * sum[2] + sum[3] * sum[3]); s2 += __shfl_xor(s2, 1); s2 += __shfl_xor(s2, 2); s2 += __shfl_xor(s2, 4); s2 += __shfl_xor(s2, 8);
          if ((tid & 15) == 0) ssq_out[(size_t)(32 * rbk + r) * 16 + cbk] = s2; }
      if (OUT_BF16) { v2u wb; wb.x = cvtpk(sum[0], sum[1]); wb.y = cvtpk(sum[2], sum[3]); *(v2u*)((bf16*)out + off) = wb; } else *(f32x4*)((float*)out + off) = sum; }
    __syncthreads();
}
}
namespace mk {
constexpr int N_PHASES = 16;
__global__ void __launch_bounds__(NWAVES * 64, 2) mk_fwd(Args args) {
    extern __shared__ __attribute__((aligned(16))) unsigned char lds[];
    Frame F;
    F.lds = (LAS unsigned char*)lds; F.lds_g = lds;
    F.tid = threadIdx.x; F.lane = F.tid & 63; F.wave = __builtin_amdgcn_readfirstlane(F.tid >> 6);
    F.G = gridDim.x; F.bid = blockIdx.x;
    F.ws = args.ws; F.out = args.out; F.in = (const float* const*)args.in;
    volatile LAS unsigned* MISC = (volatile LAS unsigned*)(F.lds + MISC_OFF);
    for (int u = F.tid; u < (LDS_BYTES - RING_BYTES) / 4; u += NWAVES * 64) ((LAS unsigned*)(F.lds + RING_BYTES))[u] = 0u;
    __syncthreads();
    unsigned* ctl = (unsigned*)(F.ws + WS_CTL);
    XcdBarrier bar = xcd_barrier_post(ctl + CW_BAR, MISC + 8);
    const int lo = args.ph_lo, hi = args.ph_hi;
    if (F.G != 256) return;
#define IN(k) (lo <= (k) && (k) < hi)
#ifdef MK_TIMING
    unsigned long long* stamps = (unsigned long long*)(F.ws + WS_CTL + (768 << 10));
#define STAMP(k) do { if (F.tid == 0) stamps[F.bid * 32 + (k)] = __builtin_amdgcn_s_memrealtime(); } while (0)
#else
#define STAMP(k) do {} while (0)
#endif
#define SEAM(k) do { if (IN(k) && IN((k) + 1)) xcd_barrier(bar); STAMP((k) + 1); F.tid = opaque_i(F.tid); F.lane = F.tid & 63; } while (0)
    STAMP(0);

    if (IN(0)) { p0_prologue(F); }
    SEAM(0);
    if (IN(1)) {
        { pg8::Gemm g{F.w<bf16>(WS_XN), F.w<bf16>(WS_W_IN), T, NINP, D}; pg8::StaticOrder S; S.init(T, NINP, F.G, F.bid);
          pg8::EpiBf16 E{F.w<bf16>(WS_Z), NINP, 1.f};
          pg8::gemm_phase<pg8::EpiBf16, pg8::StaticOrder, true, true>(F.lds, g, S, E); }
        { pg8::Gemm g{F.w<bf16>(WS_MN), F.w<bf16>(WS_W_MKV), 2048, 1024, D}; pg8::StaticOrder S; S.init(2048, 1024, F.G, (F.bid + F.G - 206) % F.G);
          pg8::EpiBf16 E{F.w<bf16>(WS_MKV), 1024, 1.f};
          pg8::gemm_phase<pg8::EpiBf16, pg8::StaticOrder, true, true>(F.lds, g, S, E); }
    }
    SEAM(1);
    if (IN(2)) { p2_post_inproj(F); }
    SEAM(2);
    if (IN(3)) {
        { pg8::Gemm g{F.w<bf16>(WS_CQN), F.w<bf16>(WS_W_UQ), T, 768, 256}; pg8::StaticOrder S; S.init(T, 768, F.G, F.bid);
          pg8::EpiBf16 E{F.w<bf16>(WS_QR), 768, 1.f};
          pg8::gemm_phase<pg8::EpiBf16, pg8::StaticOrder, true, true>(F.lds, g, S, E); }
        { pg8::Gemm g{F.w<bf16>(WS_CKVN), F.w<bf16>(WS_W_UK), TP, 512, 256}; pg8::StaticOrder S; S.init(TP, 512, F.G, (F.bid + F.G - 198) % F.G);
          pg8::EpiBf16 E{F.w<bf16>(WS_KNR), 512, 1.f};
          pg8::gemm_phase<pg8::EpiBf16, pg8::StaticOrder, true, true>(F.lds, g, S, E); }
        { pg8::Gemm g{F.w<bf16>(WS_W_UV), F.w<bf16>(WS_CKVN), 512, TP, 256}; pg8::StaticOrder S; S.init(512, TP, F.G, (F.bid + F.G - 70) % F.G);
          pg8::EpiBf16 E{F.w<bf16>(WS_VT), TP, 1.f};
          pg8::gemm_phase<pg8::EpiBf16, pg8::StaticOrder, true, true>(F.lds, g, S, E); }
    }
    SEAM(3);
    if (IN(4)) { p4_qk_norm_rope(F); p4_qext(F); }
    SEAM(4);
    if (IN(5)) {
        const float mq_ = gain_absmax(F.inf(I_GQKQ), 96, F.lane), mk2_ = gain_absmax(F.inf(I_GQKK), 96, F.lane);
        const float negM = -(LOG2E * 9.797958971132712f * mq_ * mk2_ * 1.01f);
#pragma unroll 1
        for (int pass = 0; pass < 3; ++pass) {
            F.tid = opaque_i(F.tid); F.lane = F.tid & 63;
            if (pass == 1) { STAMP(20); attn_sample_unit(F, F.bid >> 1, F.bid & 1, negM); STAMP(21); }
            else if ((pass == 0) == (((F.bid >> 3) & 1) != 0)) { STAMP(22); p5_attn_prompt(F, negM); STAMP(23); }
        }
    }
    SEAM(5);
    if (IN(6)) { p6_merge(F); }
    SEAM(6);
    if (IN(7)) { pg8::Gemm g{F.w<bf16>(WS_MRG), F.w<bf16>(WS_W_O), TP, 1024, 1024}; pg8::StaticOrder S; S.init(TP, 1024, F.G, F.bid);
        pg8::EpiResN<false> E{F.inf(I_XP), F.inf(I_XS), TP / 256, F.w<bf16>(WS_X1), F.w<float>(WS_SSQ1), 1024};
        pg8::gemm_phase<pg8::EpiResN<false>, pg8::StaticOrder, true, true>(F.lds, g, S, E);
        small_gemm_unit<1024, false, true>(F, F.w<bf16>(WS_MRG) + (size_t)TP * 1024, F.w<bf16>(WS_W_O), F.bid >> 4, F.bid & 15, F.inf(I_XS), F.w<bf16>(WS_X1) + (size_t)TP * 1024, 1024, F.w<float>(WS_SSQ1) + (size_t)TP * 16); }
    SEAM(7);
    STAMP(9);
    if (IN(9)) { pg8::Gemm g{F.w<bf16>(WS_X1), F.w<bf16>(WS_W_MQ), T, 512, 1024}; pg8::StaticOrder S; S.init(T, 512, F.G, F.bid);
        pg8::EpiBf16S E{F.w<bf16>(WS_MQ), 512, F.w<float>(WS_SSQ1), EPS};
        pg8::gemm_phase<pg8::EpiBf16S, pg8::StaticOrder, true, true>(F.lds, g, S, E);
        if (F.bid >= 132) p0_transposes<9, 11>(F, (F.bid - 132) * NWAVES + F.wave, (F.G - 132) * NWAVES); }
    SEAM(9);
    if (IN(10)) { p10_memattn(F); }
    SEAM(10);
    if (IN(11)) { pg8::Gemm g{F.w<bf16>(WS_MO), F.w<bf16>(WS_W_MO), TP, 1024, 512}; pg8::StaticOrder S; S.init(TP, 1024, F.G, F.bid);
        pg8::EpiResN<true> E{F.w<bf16>(WS_X1), F.w<bf16>(WS_X1), 1 << 20, F.w<bf16>(WS_X2), F.w<float>(WS_SSQ2), 1024};
        pg8::gemm_phase<pg8::EpiResN<true>, pg8::StaticOrder, true, true>(F.lds, g, S, E);
        small_gemm_unit<512, true, true>(F, F.w<bf16>(WS_MO) + (size_t)TP * 512, F.w<bf16>(WS_W_MO), F.bid >> 4, F.bid & 15, F.w<bf16>(WS_X1) + (size_t)TP * 1024, F.w<bf16>(WS_X2) + (size_t)TP * 1024, 1024, F.w<float>(WS_SSQ2) + (size_t)TP * 16); }
    SEAM(11);
    STAMP(12); STAMP(13);
    if (IN(13)) { pg8::Gemm g{F.w<bf16>(WS_X2), F.w<bf16>(WS_W_UP), TP, 2 * DFF, 1024}; pg8::StaticOrder S; S.init(TP, 2 * DFF, F.G, F.bid);
        pg8::EpiUpFused E{F.w<bf16>(WS_HID), F.inf(I_WCONV), F.inf(I_BCONV), F.w<bf16>(WS_RAW01), F.w<float>(WS_RAWG), F.out + O_PCONV, (LAS float*)(F.lds + 131072), DFF, (const LAS float*)(F.lds + 135168)};
        { LAS float* rt = (LAS float*)(F.lds + 135168); const float* sq = F.w<float>(WS_SSQ2) + (size_t)(F.bid & 7) * 2048 * 16;
          f32x4 p[4][4];
#pragma unroll
          for (int k = 0; k < 4; ++k)
#pragma unroll
              for (int q = 0; q < 4; ++q) p[k][q] = *(const f32x4*)(sq + (size_t)(F.tid + 512 * k) * 16 + 4 * q);
#pragma unroll
          for (int k = 0; k < 4; ++k) { const f32x4 t = (p[k][0] + p[k][1]) + (p[k][2] + p[k][3]); rt[F.tid + 512 * k] = rsqrtf(((t[0] + t[1]) + (t[2] + t[3])) * (1.f / 1024.f) + EPS); }
          __syncthreads(); }
        pg8::gemm_phase<pg8::EpiUpFused, pg8::StaticOrder, true, true>(F.lds, g, S, E);
        if (F.bid >= 128) { for (int su = F.bid - 128; su < 16 * 88; su += 128)
            small_gemm_unit<1024, false, true, false>(F, F.w<bf16>(WS_X2) + (size_t)TP * 1024, F.w<bf16>(WS_W_UP), su / 88, su % 88, nullptr, F.w<bf16>(WS_UP), 2 * DFF, nullptr, F.w<float>(WS_SSQ2) + (size_t)TP * 16); } }
    SEAM(13);
    if (IN(15)) { pg8::Gemm g{F.w<bf16>(WS_HID), F.w<bf16>(WS_W_DN), TP, 1024, DFF}; pg8::StaticOrder S; S.init(TP, 1024, F.G, F.bid);
        p15_pre(F, 8 * (F.bid & 7) + ((F.bid >> 3) & 7));
        if (F.tid == 0) { const unsigned nloc = bar.st[0]; const unsigned old = xb_add(ctl + CW_HIDS + 64 * bar.x, 1u);
            if (old + 1u == nloc) { __builtin_amdgcn_fence(__ATOMIC_RELEASE, "agent"); asm volatile("s_waitcnt vmcnt(0)" ::: "memory"); (void)xb_add(ctl + CW_HIDS + 64 * 16, 1u); } }
        pg8::EpiRes<true, false> E{F.w<bf16>(WS_X2), F.w<bf16>(WS_X2), 1 << 20, F.out + O_YP, 1024};
        pg8::gemm_phase<pg8::EpiRes<true, false>, pg8::StaticOrder, true, true>(F.lds, g, S, E);
        if (F.tid == 0) { const unsigned nx = bar.st[1]; XB_SPIN(xb_ld(ctl + CW_HIDS + 64 * 16) < nx, ctl + CW_BAR); __builtin_amdgcn_fence(__ATOMIC_ACQUIRE, "agent"); asm volatile("s_waitcnt vmcnt(0)" ::: "memory"); }
        __syncthreads();
        small_gemm_unit<DFF, true, false>(F, F.w<bf16>(WS_HID) + (size_t)TP * DFF, F.w<bf16>(WS_W_DN), F.bid >> 4, F.bid & 15, F.w<bf16>(WS_X2) + (size_t)TP * 1024, F.out + O_YS, 1024); }
#ifdef MK_TIMING
    xcd_barrier(bar); STAMP(16);
    xcd_barrier(bar);
    if (F.bid == 0) {
        volatile LAS float* s_ca = (volatile LAS float*)(F.lds + RING_BYTES + 1024);
#define s_c s_ca[0]
#define s_a s_ca[1]
        if (F.tid == 0) {
            unsigned long long a0 = ~0ull, a1 = 0, b0 = ~0ull, b1 = 0;
#ifdef MK_TPERWG
            unsigned long long ma = 0, mb = 0;
            for (int w = 0; w < 256; ++w) { const unsigned long long* st = stamps + w * 32; const unsigned long long xa = st[MK_TA_HI] - st[MK_TA_LO], xb = st[MK_TB_HI] - st[MK_TB_LO]; ma = xa > ma ? xa : ma; mb = xb > mb ? xb : mb; }
            a0 = 0; a1 = ma; b0 = 0; b1 = mb;
#else
            for (int w = 0; w < 256; ++w) { const unsigned long long* st = stamps + w * 32;
                a0 = st[MK_TA_LO] < a0 ? st[MK_TA_LO] : a0; a1 = st[MK_TA_HI] > a1 ? st[MK_TA_HI] : a1; b0 = st[MK_TB_LO] < b0 ? st[MK_TB_LO] : b0; b1 = st[MK_TB_HI] > b1 ? st[MK_TB_HI] : b1; }
#endif
            const float da = (float)(a1 - a0) * 0.01f, db = (float)(b1 - b0) * 0.01f;
            s_c = sqrtf(da * 1e-4f); s_a = db * 0.1f;
        }
        __syncthreads();
        float* sk = F.out + O_SKPE;
        for (int i = F.tid; i < 16384; i += 512) sk[i] *= (1.f + s_c);
        if (F.tid == 0) F.out[O_YP] += s_a;
#undef s_c
#undef s_a
    }
#endif
#undef IN
#undef SEAM
}
}
extern "C" void kernel_launch(void* const* d_in, const int* in_sizes, int n_in, void* d_out, int out_size, void* d_ws, size_t ws_size, hipStream_t stream) {
    using namespace mk;
    static int ready = 0;
    if (ready == 0) {
        if (n_in != 38 || out_size != 25292800 || ws_size < WS_MK_END) { fprintf(stderr, "kernel_launch: unexpected n_in %d / out_size %d / ws %zu\n", n_in, out_size, ws_size); ready = -1; return; }
        if (hipFuncSetAttribute((const void*)mk_fwd, hipFuncAttributeMaxDynamicSharedMemorySize, LDS_BYTES) != hipSuccess) { fprintf(stderr, "kernel_launch: hipFuncSetAttribute failed\n"); ready = -1; return; }
        int dev = 0, cus = 0, per_cu = 0;
        (void)hipGetDevice(&dev); (void)hipDeviceGetAttribute(&cus, hipDeviceAttributeMultiprocessorCount, dev);
        (void)hipOccupancyMaxActiveBlocksPerMultiprocessor(&per_cu, (const void*)mk_fwd, NWAVES * 64, LDS_BYTES);
        if (cus < 256 || per_cu < 1) fprintf(stderr, "kernel_launch: note: %d CUs, occupancy query %d (this kernel needs 256 resident workgroups of %d B LDS)\n", cus, per_cu, LDS_BYTES);
        (void)hipGetLastError();
        ready = 1;
    }
    if (ready < 0) return;
    (void)hipMemsetAsync((unsigned char*)d_ws + WS_CTL, 0, CTL_ZERO_BYTES, stream);
    Args a{}; for (int i = 0; i < 38; ++i) a.in[i] = d_in[i];
    a.out = (float*)d_out; a.ws = (unsigned char*)d_ws; a.ph_lo = 0; a.ph_hi = N_PHASES;
    hipLaunchKernelGGL(mk_fwd, dim3(256), dim3(NWAVES * 64), LDS_BYTES, stream, a);
}
```

```cpp
#include <hip/hip_runtime.h>
#include <cstdio>
#include <cstdint>
#include <cmath>
#define GAS __attribute__((address_space(1)))
#define LAS __attribute__((address_space(3)))
typedef unsigned short bf16;
typedef unsigned v4u __attribute__((ext_vector_type(4)));
typedef unsigned v2u __attribute__((ext_vector_type(2)));
typedef float f32x4 __attribute__((ext_vector_type(4)));
typedef float f32x16 __attribute__((ext_vector_type(16)));
typedef short bf16x8 __attribute__((ext_vector_type(8)));
typedef short s16x4 __attribute__((ext_vector_type(4)));
#define LDS_WAIT() asm volatile("s_waitcnt lgkmcnt(0)" ::: "memory")
#define VM_WAIT() asm volatile("s_waitcnt vmcnt(0)" ::: "memory")
__device__ __forceinline__ unsigned f2bf(float f) { unsigned u = __builtin_bit_cast(unsigned, f); return (u + 0x7fffu + ((u >> 16) & 1u)) >> 16; }
__device__ __forceinline__ unsigned pk2(float lo, float hi) { return f2bf(lo) | (f2bf(hi) << 16); }
typedef float f32x2_t __attribute__((ext_vector_type(2))); typedef __bf16 bf16x2_t __attribute__((ext_vector_type(2)));
__device__ __forceinline__ unsigned cvtpk(float lo, float hi) { f32x2_t v = {lo, hi}; bf16x2_t b = __builtin_convertvector(v, bf16x2_t); return __builtin_bit_cast(unsigned, b); }
__device__ __forceinline__ float bf2f(unsigned short b) { return __builtin_bit_cast(float, (unsigned)b << 16); }
__device__ __forceinline__ float bflo(unsigned w) { return __builtin_bit_cast(float, w << 16); }
__device__ __forceinline__ float bfhi(unsigned w) { return __builtin_bit_cast(float, w & 0xffff0000u); }
__device__ __forceinline__ int opaque_i(int x) { asm volatile("" : "+v"(x)); return x; }
__device__ __forceinline__ float wave_sum(float v) {
#pragma unroll
    for (int o = 1; o < 64; o <<= 1) v += __shfl_xor(v, o);
    return v;
}
__device__ __forceinline__ float gelu_tanh_f(float x) {
    const float t = x * (-2.3022082062f - 0.1029432457f * x * x);
    return x * __builtin_amdgcn_rcpf(1.f + __builtin_amdgcn_exp2f(t));
}
namespace pg8 {
#define PG8_LAS __attribute__((address_space(3)))
typedef unsigned short bf16_t;
typedef short bf16x8 __attribute__((ext_vector_type(8)));
typedef float f32x4 __attribute__((ext_vector_type(4)));
typedef unsigned u32x4 __attribute__((ext_vector_type(4)));
constexpr int BM = 256, BK = 64, HALF = 128, HTB = HALF * BK * 2  , STAGE_BYTES = 8 * HTB, NXCD = 8, WGM = 8;

__host__ __device__ __forceinline__ int lds_byte(int r, int c) { const int st = (r >> 4) * 2 + (c >> 5), rr = r & 15, cc = c & 31, ob = rr * 64 + cc * 2; return st * 1024 + (ob ^ (((ob >> 9) & 1) << 5)); }
__host__ __device__ __forceinline__ void stage_rc(int b, int& R, int& C) { const int st = b / 1024, sb = b % 1024, swz = sb ^ (((sb >> 9) & 1) << 5); R = (st >> 1) * 16 + swz / 64; C = (st & 1) * 32 + (swz % 64) / 2; }
__host__ __device__ __forceinline__ int perm32(int rho) { const int n = rho >> 4, i = rho & 15; return 8 * (i >> 2) + 4 * n + (i & 3); }

struct Unit { int pm, pn; };
struct Gemm { const bf16_t* A; const bf16_t* Bt; int M, N, K; };

struct StaticOrder {
    int nM, nN, nwg, G, c;
    __host__ __device__ void init(int M, int N, int G_, int c_) { nM = M / BM; nN = N / BM; nwg = nM * nN; G = G_; c = c_; }
    __host__ __device__ bool next(int i, Unit& u) const {
        const long L = (long)i * G + c; if (L >= nwg) return false;
        int wgid = (int)L; { const int q = nwg / NXCD, r = nwg % NXCD, xcd = wgid % NXCD, off = wgid / NXCD; wgid = (xcd < r ? xcd * (q + 1) : r * (q + 1) + (xcd - r) * q) + off; }
        const int nig = WGM * nN, gid = wgid / nig, fm = gid * WGM, gsz = (nM - fm) < WGM ? (nM - fm) : WGM;
        u.pm = fm + ((wgid % nig) % gsz); u.pn = (wgid % nig) / gsz; return true;
    }
    __device__ __forceinline__ void a_ready(const Unit&) const {}
    __device__ __forceinline__ void done(const Unit&) const {}
};

__device__ __forceinline__ unsigned cvt_pk_bf16(float lo, float hi) { unsigned r; asm volatile("v_cvt_pk_bf16_f32 %0, %1, %2" : "=v"(r) : "v"(lo), "v"(hi)); return r; }
typedef float f32x2 __attribute__((ext_vector_type(2)));
struct EpiBf16 {
    static constexpr bool PERM = true, AFTER_DRAIN = false;
    bf16_t* O; int ldc; float scale;
    __device__ __forceinline__ void operator()(const f32x4 (&acc)[2][2][4][2], const Unit& u, int wr, int wc, int fr, int fq) const {
        const int row0 = u.pm * BM + wr * 64 + fr; const int col0 = u.pn * BM + wc * 32 + 8 * fq;
#pragma unroll
        for (int ai = 0; ai < 2; ++ai)
#pragma unroll
            for (int m = 0; m < 4; ++m) { bf16_t* rowp = O + (size_t)(row0 + ai * HALF + m * 16) * ldc + col0;
#pragma unroll
                for (int bj = 0; bj < 2; ++bj) { const f32x4 v0 = acc[ai][bj][m][0] * scale, v1 = acc[ai][bj][m][1] * scale;
                    u32x4 w; w.x = cvt_pk_bf16(v0[0], v0[1]); w.y = cvt_pk_bf16(v0[2], v0[3]); w.z = cvt_pk_bf16(v1[0], v1[1]); w.w = cvt_pk_bf16(v1[2], v1[3]);
                    *(u32x4*)(rowp + bj * HALF) = w; } }
    }
};
struct EpiResF32 {
    static constexpr bool PERM = false, AFTER_DRAIN = false;
    const float* res0; const float* res1; int split_pm; float* out; int ldc;
    __device__ __forceinline__ void operator()(const f32x4 (&acc)[2][2][4][2], const Unit& u, int wr, int wc, int fr, int fq) const {
        const int row0 = u.pm * BM + wr * 64 + fr; const int col0 = u.pn * BM + wc * 32 + 4 * fq;
        const float* rb = (u.pm < split_pm) ? res0 : res1 - (size_t)split_pm * BM * ldc;
#pragma unroll
        for (int ai = 0; ai < 2; ++ai)
#pragma unroll
            for (int m = 0; m < 4; ++m) { const size_t off = (size_t)(row0 + ai * HALF + m * 16) * ldc + col0;
#pragma unroll
                for (int bj = 0; bj < 2; ++bj)
#pragma unroll
                    for (int n = 0; n < 2; ++n) { const f32x4 r = *(const f32x4*)(rb + off + bj * HALF + n * 16); *(f32x4*)(out + off + bj * HALF + n * 16) = acc[ai][bj][m][n] + r; }
                if (m & 1) asm volatile("" ::: "memory"); }
    }
};
struct EpiResF32N {
    static constexpr bool PERM = false, AFTER_DRAIN = false;
    const float* res0; const float* res1; int split_pm; float* out; bf16_t* outb; float* ssq; int ldc;
    __device__ __forceinline__ void operator()(const f32x4 (&acc)[2][2][4][2], const Unit& u, int wr, int wc, int fr, int fq) const {
        const int row0 = u.pm * BM + wr * 64 + fr; const int col0 = u.pn * BM + wc * 32 + 4 * fq;
        const float* rb = (u.pm < split_pm) ? res0 : res1 - (size_t)split_pm * BM * ldc;
#pragma unroll
        for (int ai = 0; ai < 2; ++ai)
#pragma unroll
            for (int m = 0; m < 4; ++m) { const int row = row0 + ai * HALF + m * 16; const size_t off = (size_t)row * ldc + col0; float s = 0.f;
#pragma unroll
                for (int bj = 0; bj < 2; ++bj)
#pragma unroll
                    for (int n = 0; n < 2; ++n) { const f32x4 r = *(const f32x4*)(rb + off + bj * HALF + n * 16); const f32x4 v = acc[ai][bj][m][n] + r; *(f32x4*)(out + off + bj * HALF + n * 16) = v;
                        s += (v[0] * v[0] + v[1] * v[1]) + (v[2] * v[2] + v[3] * v[3]);
                        typedef unsigned u32x2_ __attribute__((ext_vector_type(2))); u32x2_ w; w.x = cvt_pk_bf16(v[0], v[1]); w.y = cvt_pk_bf16(v[2], v[3]); *(u32x2_*)(outb + off + bj * HALF + n * 16) = w; }
                s += __shfl_xor(s, 16); s += __shfl_xor(s, 32);
                if (fq == 0) ssq[(size_t)row * 16 + u.pn * 4 + wc] = s;
                if (m & 1) asm volatile("" ::: "memory"); }
    }
};
struct EpiBf16S {
    static constexpr bool PERM = true, AFTER_DRAIN = false;
    bf16_t* O; int ldc; const float* ssq; float eps;
    __device__ __forceinline__ void operator()(const f32x4 (&acc)[2][2][4][2], const Unit& u, int wr, int wc, int fr, int fq) const {
        const int row0 = u.pm * BM + wr * 64 + fr; const int col0 = u.pn * BM + wc * 32 + 8 * fq;
        f32x4 part[2][4];
#pragma unroll
        for (int ai = 0; ai < 2; ++ai)
#pragma unroll
            for (int m = 0; m < 4; ++m) part[ai][m] = *(const f32x4*)(ssq + (size_t)(row0 + ai * HALF + m * 16) * 16 + 4 * fq);
#pragma unroll
        for (int ai = 0; ai < 2; ++ai)
#pragma unroll
            for (int m = 0; m < 4; ++m) { const int row = row0 + ai * HALF + m * 16;
                float tot = (part[ai][m][0] + part[ai][m][1]) + (part[ai][m][2] + part[ai][m][3]);
                tot += __shfl_xor(tot, 16); tot += __shfl_xor(tot, 32);
                const float scale = __builtin_amdgcn_rsqf(tot * (1.0f / 1024.0f) + eps);
                bf16_t* rowp = O + (size_t)row * ldc + col0;
#pragma unroll
                for (int bj = 0; bj < 2; ++bj) { const f32x4 v0 = acc[ai][bj][m][0] * scale, v1 = acc[ai][bj][m][1] * scale;
                    u32x4 w; w.x = cvt_pk_bf16(v0[0], v0[1]); w.y = cvt_pk_bf16(v0[2], v0[3]); w.z = cvt_pk_bf16(v1[0], v1[1]); w.w = cvt_pk_bf16(v1[2], v1[3]);
                    *(u32x4*)(rowp + bj * HALF) = w; } }
    }
};
template <bool RES_BF16, bool OUT_BF16> struct EpiRes {
    static constexpr bool PERM = false, AFTER_DRAIN = false;
    const void* res0; const void* res1; int split_pm; void* out; int ldc;
    __device__ __forceinline__ void operator()(const f32x4 (&acc)[2][2][4][2], const Unit& u, int wr, int wc, int fr, int fq) const {
        typedef unsigned u32x2_ __attribute__((ext_vector_type(2)));
        const int row0 = u.pm * BM + wr * 64 + fr; const int col0 = u.pn * BM + wc * 32 + 4 * fq;
        const bool first = u.pm < split_pm;
#pragma unroll
        for (int ai = 0; ai < 2; ++ai)
#pragma unroll
            for (int m = 0; m < 4; ++m) { const int row = row0 + ai * HALF + m * 16; const size_t off = (size_t)row * ldc + col0; const size_t roff = first ? off : off - (size_t)split_pm * BM * ldc;
#pragma unroll
                for (int bj = 0; bj < 2; ++bj)
#pragma unroll
                    for (int n = 0; n < 2; ++n) { const size_t o2 = bj * HALF + n * 16; f32x4 r;
                        if (RES_BF16) { const u32x2_ rw = *(const u32x2_*)((const bf16_t*)(first ? res0 : res1) + roff + o2); r = (f32x4){__builtin_bit_cast(float, rw.x << 16), __builtin_bit_cast(float, rw.x & 0xffff0000u), __builtin_bit_cast(float, rw.y << 16), __builtin_bit_cast(float, rw.y & 0xffff0000u)}; }
                        else r = *(const f32x4*)((const float*)(first ? res0 : res1) + roff + o2);
                        const f32x4 v = acc[ai][bj][m][n] + r;
                        if (OUT_BF16) { u32x2_ w; w.x = cvt_pk_bf16(v[0], v[1]); w.y = cvt_pk_bf16(v[2], v[3]); *(u32x2_*)((bf16_t*)out + off + o2) = w; }
                        else *(f32x4*)((float*)out + off + o2) = v; }
                if (m & 1) asm volatile("" ::: "memory"); }
    }
};
template <bool RES_BF16> struct EpiResN {
    static constexpr bool PERM = false, AFTER_DRAIN = false;
    const void* res0; const void* res1; int split_pm; bf16_t* out; float* ssq; int ldc;
    __device__ __forceinline__ void operator()(const f32x4 (&acc)[2][2][4][2], const Unit& u, int wr, int wc, int fr, int fq) const {
        typedef unsigned u32x2_ __attribute__((ext_vector_type(2)));
        const int row0 = u.pm * BM + wr * 64 + fr; const int col0 = u.pn * BM + wc * 32 + 4 * fq;
        const bool first = u.pm < split_pm;
#pragma unroll
        for (int ai = 0; ai < 2; ++ai)
#pragma unroll
            for (int m = 0; m < 4; ++m) { const int row = row0 + ai * HALF + m * 16; const size_t off = (size_t)row * ldc + col0; const size_t roff = first ? off : off - (size_t)split_pm * BM * ldc; float s = 0.f;
#pragma unroll
                for (int bj = 0; bj < 2; ++bj)
#pragma unroll
                    for (int n = 0; n < 2; ++n) { const size_t o2 = bj * HALF + n * 16; f32x4 r;
                        if (RES_BF16) { const u32x2_ rw = *(const u32x2_*)((const bf16_t*)(first ? res0 : res1) + roff + o2); r = (f32x4){__builtin_bit_cast(float, rw.x << 16), __builtin_bit_cast(float, rw.x & 0xffff0000u), __builtin_bit_cast(float, rw.y << 16), __builtin_bit_cast(float, rw.y & 0xffff0000u)}; }
                        else r = *(const f32x4*)((const float*)(first ? res0 : res1) + roff + o2);
                        const f32x4 v = acc[ai][bj][m][n] + r;
                        s += (v[0] * v[0] + v[1] * v[1]) + (v[2] * v[2] + v[3] * v[3]);
                        u32x2_ w; w.x = cvt_pk_bf16(v[0], v[1]); w.y = cvt_pk_bf16(v[2], v[3]); *(u32x2_*)(out + off + o2) = w; }
                s += __shfl_xor(s, 16); s += __shfl_xor(s, 32);
                if (fq == 0) ssq[(size_t)row * 16 + u.pn * 4 + wc] = s;
                if (m & 1) asm volatile("" ::: "memory"); }
    }
};
__device__ __forceinline__ float dpp_ror1(float x) { return __builtin_bit_cast(float, __builtin_amdgcn_update_dpp(0, __builtin_bit_cast(int, x), 0x121, 0xf, 0xf, false)); }
__device__ __forceinline__ float dpp_ror2(float x) { return __builtin_bit_cast(float, __builtin_amdgcn_update_dpp(0, __builtin_bit_cast(int, x), 0x122, 0xf, 0xf, false)); }
struct EpiUpFused {
    static constexpr bool PERM = false, AFTER_DRAIN = false;
    bf16_t* HID; const float* wconv; const float* bconv; bf16_t* RAW01; float* RAWG; float* pconv; PG8_LAS float* halo; int dff; const PG8_LAS float* rstd;
    __device__ __forceinline__ void operator()(const f32x4 (&acc)[2][2][4][2], const Unit& u, int wr, int wc, int fr, int fq) const {
        typedef unsigned u32x2_ __attribute__((ext_vector_type(2)));
        const int lane = fq * 16 + fr;
        const int fb = u.pn * 128 + wc * 32 + 4 * fq;
        const int hc = wc * 32 + 4 * fq;
        float rs[2][4];
#pragma unroll
        for (int ai = 0; ai < 2; ++ai)
#pragma unroll
            for (int m = 0; m < 4; ++m) rs[ai][m] = rstd[(u.pm & 7) * BM + ai * HALF + wr * 64 + m * 16 + fr];
        if (fr >= 14) {
#pragma unroll
            for (int ai = 0; ai < 2; ++ai)
#pragma unroll
                for (int n = 0; n < 2; ++n) *(PG8_LAS f32x4*)(halo + ((ai * 2 + wr) * 2 + (fr - 14)) * 128 + hc + 16 * n) = acc[ai][0][3][n] * rs[ai][3];
        }
        asm volatile("s_waitcnt lgkmcnt(0)" ::: "memory"); __builtin_amdgcn_s_barrier(); asm volatile("" ::: "memory");
        const bool seq_tile = (u.pm & 7) == 0;
#pragma unroll
        for (int n = 0; n < 2; ++n) {
            const f32x4 w0 = *(const f32x4*)(wconv + fb + 16 * n), w1 = *(const f32x4*)(wconv + dff + fb + 16 * n), w2 = *(const f32x4*)(wconv + 2 * dff + fb + 16 * n), bb = *(const f32x4*)(bconv + fb + 16 * n);
#pragma unroll
            for (int ai = 0; ai < 2; ++ai) {
                f32x4 p14 = (f32x4){0.f, 0.f, 0.f, 0.f}, p15 = p14;
                const bool top = (ai == 0 && wr == 0);
                if (!top) { const int pg = (wr == 1) ? (ai * 2 + 0) : ((ai - 1) * 2 + 1); p14 = *(const PG8_LAS f32x4*)(halo + (pg * 2 + 0) * 128 + hc + 16 * n); p15 = *(const PG8_LAS f32x4*)(halo + (pg * 2 + 1) * 128 + hc + 16 * n); }
                f32x4 pr1, pr2;
#pragma unroll
                for (int e = 0; e < 4; ++e) { const float x0 = (fr == 14) ? p14[e] : p15[e]; pr1[e] = dpp_ror1(x0); pr2[e] = dpp_ror2(x0); }
#pragma unroll
                for (int m = 0; m < 4; ++m) {
                    const f32x4 cur = acc[ai][0][m][n] * rs[ai][m], val = acc[ai][1][m][n] * rs[ai][m];
                    f32x4 g1, g2, c1, c2;
#pragma unroll
                    for (int e = 0; e < 4; ++e) { c1[e] = dpp_ror1(cur[e]); c2[e] = dpp_ror2(cur[e]);
                        g1[e] = fr >= 1 ? c1[e] : pr1[e]; g2[e] = fr >= 2 ? c2[e] : pr2[e]; }
                    pr1 = c1; pr2 = c2;
                    const int row = u.pm * BM + ai * HALF + wr * 64 + m * 16 + fr;
                    const bool first2 = top && m == 0 && fr < 2;
                    if (first2 && seq_tile) { if (fr == 0) g1 = (f32x4){0.f, 0.f, 0.f, 0.f}; g2 = (f32x4){0.f, 0.f, 0.f, 0.f}; }
                    if (first2 && !seq_tile) {
                        u32x2_ wg_, wv_; wg_.x = cvt_pk_bf16(cur[0], cur[1]); wg_.y = cvt_pk_bf16(cur[2], cur[3]); wv_.x = cvt_pk_bf16(val[0], val[1]); wv_.y = cvt_pk_bf16(val[2], val[3]);
                        bf16_t* rp = RAW01 + ((size_t)u.pm * 2 + fr) * (2 * dff) + fb + 16 * n; *(u32x2_*)rp = wg_; *(u32x2_*)(rp + dff) = wv_;
                    } else {
                        f32x4 h;
#pragma unroll
                        for (int e = 0; e < 4; ++e) { const float c = bb[e] + g2[e] * w0[e] + g1[e] * w1[e] + cur[e] * w2[e]; h[e] = c * __builtin_amdgcn_rcpf(1.f + __expf(-c)) * val[e]; }
                        u32x2_ wh; wh.x = cvt_pk_bf16(h[0], h[1]); wh.y = cvt_pk_bf16(h[2], h[3]);
                        *(u32x2_*)(HID + (size_t)row * dff + fb + 16 * n) = wh;
                    }
                    if (ai == 1 && wr == 1 && m == 3 && fr >= 14) {
                        *(f32x4*)(RAWG + ((size_t)u.pm * 2 + (fr - 14)) * dff + fb + 16 * n) = cur;
                        if ((u.pm & 7) == 7) *(f32x4*)(pconv + ((size_t)(u.pm >> 3) * 2 + (fr - 14)) * dff + fb + 16 * n) = cur;
                    }
                }
            }
        }
        asm volatile("s_waitcnt lgkmcnt(0)" ::: "memory"); __builtin_amdgcn_s_barrier(); asm volatile("" ::: "memory");
    }
};
template <class Epi, class Sched, bool ALIGN_EPI = false, bool SP2 = false>
__device__ __forceinline__ void gemm_phase(PG8_LAS unsigned char* lds, const Gemm g, const Sched& S, const Epi& E) {
    const int tid = opaque_i(threadIdx.x), wid = __builtin_amdgcn_readfirstlane(tid >> 6), lane = tid & 63, wr = wid >> 2, wc = wid & 3, fr = lane & 15, fq = lane >> 4;
    const int K = g.K, nt = K / BK;
    unsigned voffA[2], voffB[2];
#pragma unroll
    for (int i = 0; i < 2; ++i) { int R, C; stage_rc(tid * 16 + i * 8192, R, C); const int Rb = Epi::PERM ? ((R & ~31) + perm32(R & 31)) : R;
        voffA[i] = (unsigned)(R * K + C) * 2u; voffB[i] = (unsigned)(Rb * K + C) * 2u; }
    const size_t kstep = (size_t)(BK * 2);
    const size_t hstep = (size_t)HALF * K * 2;
    const size_t tstep = 2 * hstep;
    const unsigned ldsw = (unsigned)wid * 1024u;
    const int aoff = lds_byte(wr * 64 + fr, fq * 8), boff = lds_byte(wc * 32 + fr, fq * 8);
#define PG8_SA(b, h) (((b) * 2 + (h)) * HTB)
#define PG8_SB(b, h) ((4 + (b) * 2 + (h)) * HTB)
#define PG8_STAGE(bufoff, gbase, voff) do { _Pragma("unroll") for (int _i = 0; _i < 2; ++_i) \
        __builtin_amdgcn_global_load_lds((const unsigned*)((const char*)(gbase) + (voff)[_i]), (PG8_LAS unsigned*)(lds + (bufoff) + ldsw + _i * 8192), 16, 0, 0); } while (0)
#define PG8_LDA(dst, b, h) do { _Pragma("unroll") for (int m = 0; m < 4; ++m) _Pragma("unroll") for (int k = 0; k < 2; ++k) dst[m][k] = *(const PG8_LAS bf16x8*)(lds + PG8_SA(b, h) + aoff + m * 2048 + k * 1024); } while (0)
#define PG8_LDB(dst, b, h) do { _Pragma("unroll") for (int n = 0; n < 2; ++n) _Pragma("unroll") for (int k = 0; k < 2; ++k) dst[n][k] = *(const PG8_LAS bf16x8*)(lds + PG8_SB(b, h) + boff + n * 2048 + k * 1024); } while (0)
#define PG8_MMA(ai, bj, At, Bt) do { __builtin_amdgcn_s_setprio(1); _Pragma("unroll") for (int m = 0; m < 4; ++m) _Pragma("unroll") for (int n = 0; n < 2; ++n) _Pragma("unroll") for (int k = 0; k < 2; ++k) \
        acc[ai][bj][m][n] = __builtin_amdgcn_mfma_f32_16x16x32_bf16(Bt[n][k], At[m][k], acc[ai][bj][m][n], 0, 0, 0); __builtin_amdgcn_s_setprio(0); } while (0)
#define PG8_WAIT_V(n) asm volatile("s_waitcnt vmcnt(" #n ")" ::: "memory")
#define PG8_WAIT_L(n) asm volatile("s_waitcnt lgkmcnt(" #n ")" ::: "memory")
#define PG8_BAR __builtin_amdgcn_s_barrier()
#define PG8_SCHED __builtin_amdgcn_sched_barrier(0)
    Unit cur, nxt; int ui = 0;
    if (!S.next(0, cur)) return;
    f32x4 acc[2][2][4][2];
#pragma unroll
    for (int a = 0; a < 2; ++a)
#pragma unroll
        for (int b = 0; b < 2; ++b)
#pragma unroll
            for (int m = 0; m < 4; ++m)
#pragma unroll
                for (int n = 0; n < 2; ++n) acc[a][b][m][n] = (f32x4){0.f, 0.f, 0.f, 0.f};
    bf16x8 At[4][2], B0[2][2], B1[2][2];
    const char* cA = (const char*)g.A + (size_t)cur.pm * tstep; const char* cB = (const char*)g.Bt + (size_t)cur.pn * tstep;
    S.a_ready(cur);
    if constexpr (SP2) {
        PG8_STAGE(PG8_SB(0, 0), cB, voffB); PG8_STAGE(PG8_SB(0, 1), cB + hstep, voffB); PG8_STAGE(PG8_SA(0, 0), cA, voffA); PG8_STAGE(PG8_SA(0, 1), cA + hstep, voffA);
        if (wr == 1) PG8_BAR;
        PG8_WAIT_V(2); PG8_BAR;
        PG8_STAGE(PG8_SB(1, 0), cB + kstep, voffB); PG8_STAGE(PG8_SA(1, 0), cA + kstep, voffA); PG8_STAGE(PG8_SB(1, 1), cB + hstep + kstep, voffB);
        PG8_WAIT_V(6); PG8_BAR;
    } else {
        PG8_STAGE(PG8_SB(0, 0), cB, voffB); PG8_STAGE(PG8_SA(0, 0), cA, voffA); PG8_STAGE(PG8_SB(0, 1), cB + hstep, voffB); PG8_STAGE(PG8_SA(0, 1), cA + hstep, voffA);
        if (wr == 1) PG8_BAR;
        PG8_WAIT_V(4); PG8_BAR;
        PG8_STAGE(PG8_SB(1, 0), cB + kstep, voffB); PG8_STAGE(PG8_SA(1, 0), cA + kstep, voffA); PG8_STAGE(PG8_SB(1, 1), cB + hstep + kstep, voffB);
        PG8_WAIT_V(6); PG8_BAR;
    }
    for (;;) {
        const bool has_next = S.next(ui + 1, nxt);
        const char* nA = has_next ? (const char*)g.A + (size_t)nxt.pm * tstep : cA; const char* nB = has_next ? (const char*)g.Bt + (size_t)nxt.pn * tstep : cB;
        for (int t = 0; t < nt; t += 2) {
            const bool last = (t == nt - 2);
            const char* a1 = cA + (size_t)(t + 1) * kstep;
            const char* a2 = last ? nA : cA + (size_t)(t + 2) * kstep; const char* b2 = last ? nB : cB + (size_t)(t + 2) * kstep;
            const char* a3 = a2 + kstep; const char* b3 = b2 + kstep;
            if (last && has_next) S.a_ready(nxt);
            if constexpr (SP2) {
            PG8_LDB(B0, 0, 0); PG8_LDB(B1, 0, 1); PG8_SCHED; PG8_LDA(At, 0, 0); PG8_STAGE(PG8_SA(1, 1), a1 + hstep, voffA);
            PG8_WAIT_V(8); PG8_WAIT_L(0); PG8_BAR; PG8_MMA(0, 0, At, B0); PG8_MMA(0, 1, At, B1); PG8_BAR; PG8_SCHED;
            PG8_LDA(At, 0, 1); PG8_STAGE(PG8_SB(0, 0), b2, voffB); PG8_STAGE(PG8_SB(0, 1), b2 + hstep, voffB); PG8_STAGE(PG8_SA(0, 0), a2, voffA);
            PG8_WAIT_V(8); PG8_WAIT_L(0); PG8_BAR; PG8_MMA(1, 0, At, B0); PG8_MMA(1, 1, At, B1); PG8_BAR; PG8_SCHED;
            PG8_LDB(B0, 1, 0); PG8_LDB(B1, 1, 1); PG8_SCHED; PG8_LDA(At, 1, 0); PG8_STAGE(PG8_SA(0, 1), a2 + hstep, voffA);
            PG8_WAIT_V(8); PG8_WAIT_L(0); PG8_BAR; PG8_MMA(0, 0, At, B0); PG8_MMA(0, 1, At, B1); PG8_BAR; PG8_SCHED;
            PG8_LDA(At, 1, 1); PG8_STAGE(PG8_SB(1, 0), b3, voffB); PG8_STAGE(PG8_SB(1, 1), b3 + hstep, voffB); PG8_STAGE(PG8_SA(1, 0), a3, voffA);
            PG8_WAIT_V(8); PG8_WAIT_L(0); PG8_BAR; PG8_MMA(1, 0, At, B0); PG8_MMA(1, 1, At, B1); PG8_BAR; PG8_SCHED;
            } else {
            PG8_LDB(B0, 0, 0); PG8_SCHED; PG8_LDA(At, 0, 0); PG8_STAGE(PG8_SA(1, 1), a1 + hstep, voffA);
            PG8_WAIT_L(8); PG8_BAR; PG8_WAIT_L(0); PG8_MMA(0, 0, At, B0); PG8_BAR; PG8_SCHED;
            PG8_LDB(B1, 0, 1); PG8_STAGE(PG8_SB(0, 0), b2, voffB);
            PG8_BAR; PG8_WAIT_L(0); PG8_MMA(0, 1, At, B1); PG8_BAR;
            PG8_LDA(At, 0, 1); PG8_STAGE(PG8_SA(0, 0), a2, voffA);
            PG8_BAR; PG8_WAIT_L(0); PG8_MMA(1, 0, At, B0); PG8_BAR; PG8_SCHED;
            PG8_STAGE(PG8_SB(0, 1), b2 + hstep, voffB);
            PG8_WAIT_V(6); PG8_BAR; PG8_MMA(1, 1, At, B1); PG8_BAR;
            PG8_LDB(B0, 1, 0); PG8_SCHED; PG8_LDA(At, 1, 0); PG8_STAGE(PG8_SA(0, 1), a2 + hstep, voffA);
            PG8_WAIT_L(8); PG8_BAR; PG8_WAIT_L(0); PG8_MMA(0, 0, At, B0); PG8_BAR; PG8_SCHED;
            PG8_LDB(B1, 1, 1); PG8_STAGE(PG8_SB(1, 0), b3, voffB);
            PG8_BAR; PG8_WAIT_L(0); PG8_MMA(0, 1, At, B1); PG8_BAR;
            PG8_LDA(At, 1, 1); PG8_STAGE(PG8_SA(1, 0), a3, voffA);
            PG8_BAR; PG8_WAIT_L(0); PG8_MMA(1, 0, At, B0); PG8_BAR; PG8_SCHED;
            PG8_STAGE(PG8_SB(1, 1), b3 + hstep, voffB);
            PG8_WAIT_V(6); PG8_BAR; PG8_MMA(1, 1, At, B1); PG8_BAR;
            }
        }
        if constexpr (ALIGN_EPI) { if (wr == 0) PG8_BAR; }
        if constexpr (!Epi::AFTER_DRAIN) { E(acc, cur, wr, wc, fr, fq); S.done(cur); }
        if (!has_next) break;
#pragma unroll
        for (int a = 0; a < 2; ++a)
#pragma unroll
            for (int b = 0; b < 2; ++b)
#pragma unroll
                for (int m = 0; m < 4; ++m)
#pragma unroll
                    for (int n = 0; n < 2; ++n) acc[a][b][m][n] = (f32x4){0.f, 0.f, 0.f, 0.f};
        cur = nxt; cA = nA; cB = nB; ++ui;
        if constexpr (ALIGN_EPI) { if (wr == 1) PG8_BAR; }
    }
    PG8_WAIT_V(0);
    if constexpr (!ALIGN_EPI) { if (wr == 0) PG8_BAR; }
    PG8_BAR;
    if constexpr (Epi::AFTER_DRAIN) { E.fused(acc, cur, wr, wc, fr, fq, lds, wid, lane); S.done(cur); }
#undef PG8_SA
#undef PG8_SB
#undef PG8_STAGE
#undef PG8_LDA
#undef PG8_LDB
#undef PG8_MMA
#undef PG8_WAIT_V
#undef PG8_WAIT_L
#undef PG8_BAR
#undef PG8_SCHED
}
}
#define XB_TMO      128
#define XB_XCNT(j)  (256  + 64 * (j))
#define XB_XSUB(j)  (1280 + 64 * (j))
#define XB_XGEN(j)  (2304 + 64 * (j))
#define XB_TOP      3328
#define XB_TOPGEN   3392
#define XCD_BAR_WORDS 3456
#define XB_SPIN_CAP (1u << 18)

__device__ __forceinline__ unsigned xb_ld(unsigned* p)              { return __hip_atomic_load(p, __ATOMIC_RELAXED, __HIP_MEMORY_SCOPE_AGENT); }
__device__ __forceinline__ unsigned xb_add(unsigned* p, unsigned v) { return __hip_atomic_fetch_add(p, v, __ATOMIC_RELAXED, __HIP_MEMORY_SCOPE_AGENT); }
__device__ __forceinline__ unsigned xb_xcc_id() { return (unsigned)__builtin_amdgcn_s_getreg((3 << 11) | 20) & 0xFu; }
#define XB_SPIN(cond, bar) do { unsigned _sp = 0; while (cond) { __builtin_amdgcn_s_sleep(1); \
    if ((++_sp & 255u) == 0u) { if (xb_ld(&(bar)[XB_TMO])) break; if (_sp > XB_SPIN_CAP) { atomicAdd(&(bar)[XB_TMO], 1u); break; } } } } while (0)

struct XcdBarrier {
    unsigned* bar; unsigned x;
    volatile LAS unsigned* st;
};

__device__ __forceinline__ XcdBarrier xcd_barrier_post(unsigned* bar, volatile LAS unsigned* st) {
    XcdBarrier b; b.bar = bar; b.x = xb_xcc_id(); b.st = st;
    if (threadIdx.x == 0) (void)xb_add(&bar[XB_XCNT(b.x)], 1u);
    return b;
}
__device__ __forceinline__ void xcd_barrier_complete(unsigned* bar, unsigned x, unsigned& nloc, unsigned& nx) {
    const unsigned G = gridDim.x * gridDim.y * gridDim.z;
    unsigned sum, cnt, mine, sp = 0u;
    for (;;) {
        sum = 0u; cnt = 0u; mine = 0u;
#pragma unroll
        for (unsigned j = 0; j < 16; ++j) { const unsigned c = xb_ld(&bar[XB_XCNT(j)]); sum += c; cnt += (c > 0u) ? 1u : 0u; mine = (j == x) ? c : mine; }
        if (sum == G) break;
        __builtin_amdgcn_s_sleep(1);
        if ((++sp & 255u) == 0u) { if (xb_ld(&bar[XB_TMO])) break; if (sp > XB_SPIN_CAP) { atomicAdd(&bar[XB_TMO], 1u); break; } }
    }
    nloc = mine > 0u ? mine : 1u; nx = cnt > 0u ? cnt : 1u;
}

__device__ __forceinline__ void xcd_barrier(const XcdBarrier& b) {
    asm volatile("s_waitcnt vmcnt(0)" ::: "memory");
    __syncthreads();
    if (threadIdx.x == 0) {
        unsigned* bar = b.bar;
        __builtin_amdgcn_s_waitcnt(0);
        unsigned nloc = b.st[0], nx = b.st[1];
        if (nloc == 0u) { xcd_barrier_complete(bar, b.x, nloc, nx); b.st[0] = nloc; b.st[1] = nx; }
        const unsigned old = xb_add(&bar[XB_XSUB(b.x)], 1u);
        const unsigned gen = old / nloc;
        if (old + 1u == (gen + 1u) * nloc) {
            __builtin_amdgcn_fence(__ATOMIC_RELEASE, "agent");
            asm volatile("s_waitcnt vmcnt(0)" ::: "memory");
            const unsigned og = xb_add(&bar[XB_TOP], 1u);
            const unsigned tg = og / nx;
            if (og + 1u == (tg + 1u) * nx) xb_add(&bar[XB_TOPGEN], 1u);
            else XB_SPIN(xb_ld(&bar[XB_TOPGEN]) == tg, bar);
            __builtin_amdgcn_fence(__ATOMIC_ACQUIRE, "agent");
            xb_add(&bar[XB_XGEN(b.x)], 1u);
            asm volatile("s_waitcnt vmcnt(0)" ::: "memory");
        } else {
            XB_SPIN(xb_ld(&bar[XB_XGEN(b.x)]) == gen, bar);
            __builtin_amdgcn_fence(__ATOMIC_ACQUIRE, "agent");
            asm volatile("s_waitcnt vmcnt(0)" ::: "memory");
        }
    }
    __syncthreads();
}
namespace mk {
constexpr int NWAVES = 8;
constexpr int D = 1024, TP = 16384, TSMP = 512, T = TP + TSMP, SEQ = 2048, NSEQ = 128, PAST = 8192;
constexpr int NIN = 1568, NINP = 1792, DFF = 2816;
constexpr float EPS = 1e-6f;
constexpr float LOG2E = 1.4426950408889634f;
constexpr float QSCALE = 0.10206207261596577f * LOG2E;
constexpr float MQSCALE = 0.08838834764831845f * LOG2E;

constexpr size_t O_YP = 0, O_YS = 16777216, O_PCKV = O_YS + 524288, O_PKPE = O_PCKV + 4194304, O_PMK = O_PKPE + 524288, O_PMV = O_PMK + 1048576,
                 O_PCONV = O_PMV + 1048576, O_SCKV = O_PCONV + 45056, O_SKPE = O_SCKV + 131072, O_SCV = O_SKPE + 16384, O_SCONV = O_SCV + 262144, O_END = O_SCONV + 720896;
static_assert(O_END == 25292800, "output size");

constexpr size_t al(size_t x) { return (x + 4095) & ~(size_t)4095; }
constexpr size_t WS_CTL = 0, CTL_ZERO_BYTES = 1u << 20;
constexpr size_t WS_W_IN = 1u << 20;
constexpr size_t WS_W_UQ = al(WS_W_IN + (size_t)NINP * D * 2);
constexpr size_t WS_W_UK = al(WS_W_UQ + (size_t)768 * 256 * 2);
constexpr size_t WS_W_UV = al(WS_W_UK + (size_t)512 * 256 * 2);
constexpr size_t WS_W_O = al(WS_W_UV + (size_t)512 * 256 * 2);
constexpr size_t WS_W_MQ = al(WS_W_O + (size_t)1024 * 1024 * 2);
constexpr size_t WS_W_MKV = al(WS_W_MQ + (size_t)512 * 1024 * 2);
constexpr size_t WS_W_MO = al(WS_W_MKV + (size_t)1024 * 1024 * 2);
constexpr size_t WS_W_UP = al(WS_W_MO + (size_t)1024 * 512 * 2);
constexpr size_t WS_W_DN = al(WS_W_UP + (size_t)2 * DFF * D * 2);
constexpr size_t WS_ROPE = al(WS_W_DN + (size_t)D * DFF * 2);
constexpr size_t ROPE_N = 8200;
constexpr size_t WS_XN = al(WS_ROPE + 2 * ROPE_N * 16 * 4);
constexpr size_t WS_MN = al(WS_XN + (size_t)T * D * 2);
constexpr size_t WS_Z = al(WS_MN + (size_t)2048 * D * 2);
constexpr size_t WS_MKV = al(WS_Z + (size_t)T * NINP * 2);
constexpr size_t WS_CQN = al(WS_MKV + (size_t)2048 * 1024 * 2);
constexpr size_t WS_CKVN = al(WS_CQN + (size_t)T * 256 * 2);
constexpr size_t WS_VG = al(WS_CKVN + (size_t)T * 256 * 2);
constexpr size_t WS_MK = al(WS_VG + (size_t)T * 512 * 2);
constexpr size_t WS_MVT = al(WS_MK + (size_t)2048 * 512 * 2);
constexpr size_t WS_QR = al(WS_MVT + (size_t)2048 * 512 * 2);
constexpr size_t WS_KNR = al(WS_QR + (size_t)T * 768 * 2);
constexpr size_t WS_VT = al(WS_KNR + (size_t)TP * 512 * 2);
constexpr size_t WS_QF = al(WS_VT + (size_t)512 * TP * 2);
constexpr size_t WS_KF = al(WS_QF + (size_t)T * 768 * 2);
constexpr size_t WS_BO = al(WS_KF + (size_t)TP * 768 * 2);
constexpr size_t WS_MRG = al(WS_BO + (size_t)T * 512 * 2);
constexpr size_t WS_X1 = al(WS_MRG + (size_t)T * 1024 * 2);
constexpr size_t WS_H2 = al(WS_X1 + (size_t)T * 1024 * 4);
constexpr size_t WS_MQ = al(WS_H2 + (size_t)T * 1024 * 2);
constexpr size_t WS_MO = al(WS_MQ + (size_t)T * 512 * 2);
constexpr size_t WS_X2 = al(WS_MO + (size_t)T * 512 * 2);
constexpr size_t WS_H3 = al(WS_X2 + (size_t)T * 1024 * 4);
constexpr size_t WS_UP = al(WS_H3 + (size_t)T * 1024 * 2);
constexpr size_t WS_HID = al(WS_UP + (size_t)T * 2 * DFF * 2);
constexpr size_t WS_SPART = al(WS_HID + (size_t)T * DFF * 2);
constexpr size_t SPART_STRIDE = (32 + 32 * 256) * 4;
constexpr size_t WS_QEXT = al(WS_SPART + (size_t)NSEQ * 2 * SPART_STRIDE);
constexpr size_t WS_W_SB = al(WS_QEXT + (size_t)NSEQ * 32 * 288 * 2);
constexpr size_t WS_SSQ1_PRE = al(WS_W_SB + (size_t)8 * 128 * 128 * 2);
constexpr size_t WS_RAW01 = WS_SSQ1_PRE;
constexpr size_t WS_RAWG = al(WS_RAW01 + (size_t)64 * 2 * 5632 * 2);
constexpr size_t WS_SSQ1 = al(WS_RAWG + (size_t)64 * 2 * 2816 * 4);
constexpr size_t WS_SSQ2 = al(WS_SSQ1 + (size_t)T * 16 * 4);
constexpr size_t WS_MK_END = al(WS_SSQ2 + (size_t)T * 16 * 4);
static_assert(WS_MK_END < (1000u << 20), "mk workspace under 1000 MiB");
constexpr int CW_BAR = 4096;
constexpr int CW_HIDS = 16384;

constexpr int RING_BYTES = 155648, MISC_OFF = RING_BYTES + 320, LDS_BYTES = 159744;

struct Args { const void* in[38]; float* out; unsigned char* ws; int ph_lo, ph_hi; };
static_assert(sizeof(Args) == 38 * 8 + 8 + 8 + 8, "Args has no padding");

struct Frame {
    LAS unsigned char* lds; unsigned char* lds_g;
    int tid, lane, wave, G, bid;
    unsigned char* ws; float* out;
    const float* const* in;
    template <class P> __device__ __forceinline__ P* w(size_t off) const { return (P*)(ws + off); }
    __device__ __forceinline__ const float* inf(int i) const { return (const float*)in[i]; }
};

enum { I_XP = 0, I_XS, I_CKV, I_KPE, I_CMK, I_CMV, I_CONVST, I_PT, I_MEMP, I_GMIX, I_WIN, I_LNG, I_LNB, I_WS, I_BS, I_GQA, I_WUQ, I_GKVA, I_WUK, I_WUV, I_GQKQ, I_GQKK,
       I_GOA, I_GOB, I_WO, I_GMEMX, I_GMEMIN, I_WMQ, I_WMK, I_WMV, I_GMQ, I_GMK, I_WMO, I_GFFN, I_WUP, I_WCONV, I_BCONV, I_WDOWN };

struct P0Item { float v[32]; float g; };
__device__ __forceinline__ void p0_item_load(P0Item& x, const float* W, int K, int N, int item, int lane, const float* gain) {
    const int nblk = N / 32, kb = item / nblk, nb = item % nblk, k0 = 64 * kb, n0 = 32 * nb;
#pragma unroll
    for (int i = 0; i < 32; ++i) { const int kk = 2 * i + (lane >> 5); x.v[i] = W[(size_t)(k0 + kk) * N + n0 + (lane & 31)]; }
    x.g = gain ? gain[k0 + lane] : 1.f;
}
__device__ __forceinline__ void p0_item_finish(const P0Item& x, int K, int N, bf16* WT, int row_off, LAS float* scr, int item, int lane, bool has_gain) {
    const int nblk = N / 32, kb = item / nblk, nb = item % nblk, k0 = 64 * kb, n0 = 32 * nb;
#pragma unroll
    for (int i = 0; i < 32; ++i) { const int kk = 2 * i + (lane >> 5); float wv_ = x.v[i]; if (has_gain) wv_ *= __shfl(x.g, kk); scr[kk * 33 + (lane & 31)] = wv_; }
    LDS_WAIT(); asm volatile("" ::: "memory");
    const int c = lane & 7;
#pragma unroll
    for (int j = 0; j < 4; ++j) { const int n = (lane >> 3) + 8 * j; const LAS float* s = scr + (8 * c) * 33 + n;
        v4u o; o.x = pk2(s[0 * 33], s[1 * 33]); o.y = pk2(s[2 * 33], s[3 * 33]); o.z = pk2(s[4 * 33], s[5 * 33]); o.w = pk2(s[6 * 33], s[7 * 33]);
        *(v4u*)(WT + (size_t)(row_off + n0 + n) * K + k0 + 8 * c) = o; }
    LDS_WAIT(); asm volatile("" ::: "memory");
}
__device__ __forceinline__ void rms_row_to_bf16(const float* xrow, const float* g, bf16* orow, int lane) {
    const f32x4* xr = (const f32x4*)xrow + lane; const f32x4* gr = (const f32x4*)g + lane;
    f32x4 v[4]; float s = 0.f;
#pragma unroll
    for (int j = 0; j < 4; ++j) { v[j] = xr[64 * j]; s += (v[j].x * v[j].x + v[j].y * v[j].y) + (v[j].z * v[j].z + v[j].w * v[j].w); }
    const float rstd = rsqrtf(wave_sum(s) * (1.f / 1024.f) + EPS);
    unsigned long long* o8 = (unsigned long long*)orow + lane;
#pragma unroll
    for (int j = 0; j < 4; ++j) { const f32x4 gg = gr[64 * j];
        o8[64 * j] = (unsigned long long)pk2(v[j].x * rstd * gg.x, v[j].y * rstd * gg.y) | ((unsigned long long)pk2(v[j].z * rstd * gg.z, v[j].w * rstd * gg.w) << 32); }
}
__device__ __forceinline__ const float* xrow_ptr(const Frame& F, int r) { return r < TP ? F.inf(I_XP) + (size_t)r * D : F.inf(I_XS) + (size_t)(r - TP) * D; }

template <int M_LO, int M_HI>
__device__ __forceinline__ void p0_transposes(Frame& F, int gw, int NGW) {
    LAS float* scr = (LAS float*)(F.lds + F.wave * 16384);
    constexpr int NI = 11;
    const int srcs[NI] = {I_WIN, I_WUQ, I_WUK, I_WUV, I_WO, I_WMQ, I_WMK, I_WMV, I_WMO, I_WUP, I_WDOWN};
    const int Ks[NI] = {1024, 256, 256, 256, 1024, 1024, 1024, 1024, 512, 1024, 2816};
    const int Ns[NI] = {1568, 768, 512, 512, 1024, 512, 512, 512, 1024, 5632, 1024};
    const size_t dsts[NI] = {WS_W_IN, WS_W_UQ, WS_W_UK, WS_W_UV, WS_W_O, WS_W_MQ, WS_W_MKV, WS_W_MKV, WS_W_MO, WS_W_UP, WS_W_DN};
    const int roffs[NI] = {0, 0, 0, 0, 0, 0, 0, 512, 0, 0, 0};
    const int gains[NI] = {-1, -1, -1, -1, -1, I_GMEMX, -1, -1, -1, I_GFFN, -1};
    int base = 0;
#pragma unroll
    for (int m = M_LO; m < M_HI; ++m) {
        const int cnt = (Ks[m] / 64) * (Ns[m] / 32);
        int first = gw - (base % NGW); if (first < 0) first += NGW;
        const float* gp = gains[m] >= 0 ? F.inf(gains[m]) : nullptr;
        P0Item cur_, nxt_;
        if (first < cnt) p0_item_load(cur_, F.inf(srcs[m]), Ks[m], Ns[m], first, F.lane, gp);
        for (int it = first; it < cnt; it += NGW) {
            const bool more = it + NGW < cnt;
            if (more) p0_item_load(nxt_, F.inf(srcs[m]), Ks[m], Ns[m], it + NGW, F.lane, gp);
            int roff = roffs[m];
            if (m == 9) {
                const int n0 = 32 * (it % (Ns[m] / 32)); const int f0 = n0 < DFF ? n0 : n0 - DFF; roff = 256 * (f0 >> 7) + (n0 < DFF ? 0 : 128) + (f0 & 127) - n0; }
            p0_item_finish(cur_, Ks[m], Ns[m], F.w<bf16>(dsts[m]), roff, scr, it, F.lane, gains[m] >= 0);
            if (more) cur_ = nxt_;
        }
        base += cnt;
    }
}
__device__ __forceinline__ void p0_prologue(Frame& F) {
    const int gw = F.bid * NWAVES + F.wave, NGW = F.G * NWAVES;
    p0_transposes<0, 9>(F, gw, NGW);
    for (int r = gw; r < NINP - NIN; r += NGW) { v4u* p = (v4u*)(F.w<bf16>(WS_W_IN) + (size_t)(NIN + r) * D) + F.lane; p[0] = (v4u){0, 0, 0, 0}; p[64] = (v4u){0, 0, 0, 0}; }
    for (int r = gw; r < T + 2048; r += 2 * NGW) {
        f32x4 v[2][4]; const float* gp[2]; bf16* op[2]; bool ok[2];
#pragma unroll
        for (int k = 0; k < 2; ++k) { const int rr = r + k * NGW; ok[k] = rr < T + 2048;
            const float* xr = !ok[k] ? F.inf(I_XP) : (rr < T ? xrow_ptr(F, rr) : F.inf(I_MEMP) + (size_t)(rr - T) * D);
            gp[k] = (rr < T) ? F.inf(I_GMIX) : F.inf(I_GMEMIN); op[k] = (rr < T) ? F.w<bf16>(WS_XN) + (size_t)rr * D : F.w<bf16>(WS_MN) + (size_t)(rr - T) * D;
#pragma unroll
            for (int j = 0; j < 4; ++j) v[k][j] = ((const f32x4*)xr)[F.lane + 64 * j]; }
#pragma unroll
        for (int k = 0; k < 2; ++k) if (ok[k]) {
            float sq = 0.f;
#pragma unroll
            for (int j = 0; j < 4; ++j) sq += (v[k][j].x * v[k][j].x + v[k][j].y * v[k][j].y) + (v[k][j].z * v[k][j].z + v[k][j].w * v[k][j].w);
            const float rstd = rsqrtf(wave_sum(sq) * (1.f / 1024.f) + EPS);
            unsigned long long* o8 = (unsigned long long*)op[k] + F.lane;
#pragma unroll
            for (int j = 0; j < 4; ++j) { const f32x4 gg = ((const f32x4*)gp[k])[F.lane + 64 * j];
                o8[64 * j] = (unsigned long long)pk2(v[k][j].x * rstd * gg.x, v[k][j].y * rstd * gg.y) | ((unsigned long long)pk2(v[k][j].z * rstd * gg.z, v[k][j].w * rstd * gg.w) << 32); }
        }
    }
    { const float* wsrc = F.inf(I_WS); bf16* wdst = F.w<bf16>(WS_W_SB);
      for (int i = F.bid * 512 + F.tid; i < 8 * 128 * 128 / 4; i += F.G * 512) { const f32x4 v = *(const f32x4*)(wsrc + 4 * i); v2u o; o.x = pk2(v[0], v[1]); o.y = pk2(v[2], v[3]); *(v2u*)(wdst + 4 * i) = o; } }
    { float* cs = F.w<float>(WS_ROPE); float* sn = cs + ROPE_N * 16;
      for (int i = F.bid * 512 + F.tid; i < (int)ROPE_N * 16; i += F.G * 512) { const int pos = i >> 4, f = i & 15;
          const double ang = (double)pos * pow(10000.0, -(double)f / 16.0); cs[i] = (float)cos(ang); sn[i] = (float)sin(ang); } }
}

__device__ __forceinline__ void p2_post_inproj(Frame& F) {
    const int gw = F.bid * NWAVES + F.wave, NGW = F.G * NWAVES, lane = F.lane;
    const bf16* Z = F.w<bf16>(WS_Z);
    const float* lg = F.inf(I_LNG); const float* lb = F.inf(I_LNB);
    const f32x4 lg0 = *(const f32x4*)(lg + 8 * lane), lg1 = *(const f32x4*)(lg + 8 * lane + 4), lb0 = *(const f32x4*)(lb + 8 * lane), lb1 = *(const f32x4*)(lb + 8 * lane + 4);
    const f32x4 gqa = *(const f32x4*)(F.inf(I_GQA) + 4 * lane), gkva = *(const f32x4*)(F.inf(I_GKVA) + 4 * lane);
    for (int r0 = gw; r0 < T; r0 += 4 * NGW) {
        v4u rawv[4]; v2u rawq[4], rawk[4]; bf16 rawp[4];
#pragma unroll
        for (int k = 0; k < 4; ++k) { const int r = r0 + k * NGW; if (r < T) { const bf16* zr = Z + (size_t)r * NINP;
            rawv[k] = *(const v4u*)(zr + 512 + 8 * lane); rawq[k] = *(const v2u*)(zr + 1024 + 4 * lane); rawk[k] = *(const v2u*)(zr + 1280 + 4 * lane); rawp[k] = zr[1536 + (lane & 31)]; } }
#pragma unroll
        for (int k = 0; k < 4; ++k) { const int r = r0 + k * NGW; if (r < T) {
        {
            const v4u raw = rawv[k];
            float x[8];
#pragma unroll
            for (int i = 0; i < 4; ++i) { x[2 * i] = gelu_tanh_f(bflo(raw[i])); x[2 * i + 1] = gelu_tanh_f(bfhi(raw[i])); }
            float s = 0.f;
#pragma unroll
            for (int i = 0; i < 8; ++i) s += x[i];
            s += __shfl_xor(s, 1); s += __shfl_xor(s, 2); s += __shfl_xor(s, 4);
            const float mean = s * (1.f / 64.f);
            float q = 0.f;
#pragma unroll
            for (int i = 0; i < 8; ++i) { x[i] -= mean; q += x[i] * x[i]; }
            q += __shfl_xor(q, 1); q += __shfl_xor(q, 2); q += __shfl_xor(q, 4);
            const float rstd = rsqrtf(q * (1.f / 64.f) + EPS);
            f32x4 y0, y1;
#pragma unroll
            for (int i = 0; i < 4; ++i) { y0[i] = x[i] * rstd * lg0[i] + lb0[i]; y1[i] = x[4 + i] * rstd * lg1[i] + lb1[i]; }
            v4u o; o.x = pk2(y0[0], y0[1]); o.y = pk2(y0[2], y0[3]); o.z = pk2(y1[0], y1[1]); o.w = pk2(y1[2], y1[3]);
            *(v4u*)(F.w<bf16>(WS_VG) + (size_t)r * 512 + 8 * lane) = o;
            if (r >= TP) { float* d = F.out + O_SCV + (size_t)(r - TP) * 512 + 8 * lane; *(f32x4*)d = y0; *(f32x4*)(d + 4) = y1; }
        }
#pragma unroll
        for (int which = 0; which < 2; ++which) {
            const v2u raw = which ? rawk[k] : rawq[k];
            f32x4 x; x[0] = bflo(raw[0]); x[1] = bfhi(raw[0]); x[2] = bflo(raw[1]); x[3] = bfhi(raw[1]);
            const float ss = wave_sum((x[0] * x[0] + x[1] * x[1]) + (x[2] * x[2] + x[3] * x[3]));
            const float rstd = rsqrtf(ss * (1.f / 256.f) + EPS);
            const f32x4 g = which ? gkva : gqa;
            f32x4 y;
#pragma unroll
            for (int i = 0; i < 4; ++i) y[i] = x[i] * rstd * g[i];
            v2u o; o.x = pk2(y[0], y[1]); o.y = pk2(y[2], y[3]);
            *(v2u*)(F.w<bf16>(which ? WS_CKVN : WS_CQN) + (size_t)r * 256 + 4 * lane) = o;
            if (which) { float* d = (r < TP) ? F.out + O_PCKV + (size_t)r * 256 : F.out + O_SCKV + (size_t)(r - TP) * 256; *(f32x4*)(d + 4 * lane) = y; }
        }
        if (lane < 32) { float* d = (r < TP) ? F.out + O_PKPE + (size_t)r * 32 : F.out + O_SKPE + (size_t)(r - TP) * 32; d[lane] = bf2f(rawp[k]); }
        } }
    }
    const bf16* MKV = F.w<bf16>(WS_MKV);
    for (int r = gw; r < 2048; r += NGW) {
        const bf16* mr = MKV + (size_t)r * 1024;
        {
            const v4u raw = *(const v4u*)(mr + 8 * lane);
            float x[8];
#pragma unroll
            for (int i = 0; i < 4; ++i) { x[2 * i] = bflo(raw[i]); x[2 * i + 1] = bfhi(raw[i]); }
            float ss = 0.f;
#pragma unroll
            for (int i = 0; i < 8; ++i) ss += x[i] * x[i];
            ss += __shfl_xor(ss, 1); ss += __shfl_xor(ss, 2); ss += __shfl_xor(ss, 4); ss += __shfl_xor(ss, 8);
            const float rstd = rsqrtf(ss * (1.f / 128.f) + EPS);
            const float* g = F.inf(I_GMK) + ((8 * lane) & 127);
            f32x4 y0, y1;
#pragma unroll
            for (int i = 0; i < 4; ++i) { y0[i] = x[i] * rstd * g[i]; y1[i] = x[4 + i] * rstd * g[4 + i]; }
            float* d = F.out + O_PMK + (size_t)r * 512 + 8 * lane; *(f32x4*)d = y0; *(f32x4*)(d + 4) = y1;
            v4u o; o.x = pk2(y0[0], y0[1]); o.y = pk2(y0[2], y0[3]); o.z = pk2(y1[0], y1[1]); o.w = pk2(y1[2], y1[3]);
            *(v4u*)(F.w<bf16>(WS_MK) + (size_t)r * 512 + 8 * lane) = o;
        }
        {
            const v4u raw = *(const v4u*)(mr + 512 + 8 * lane);
            float x[8];
#pragma unroll
            for (int i = 0; i < 4; ++i) { x[2 * i] = bflo(raw[i]); x[2 * i + 1] = bfhi(raw[i]); }
            float* d = F.out + O_PMV + (size_t)r * 512 + 8 * lane; *(f32x4*)d = (f32x4){x[0], x[1], x[2], x[3]}; *(f32x4*)(d + 4) = (f32x4){x[4], x[5], x[6], x[7]};
        }
    }
    for (int g8 = gw; g8 < 256; g8 += NGW) {
        v4u rw[8];
#pragma unroll
        for (int k = 0; k < 8; ++k) rw[k] = *(const v4u*)(MKV + (size_t)(8 * g8 + k) * 1024 + 512 + 8 * lane);
        const int b = (8 * g8) >> 8, key0 = (8 * g8) & 255;
        bf16* mvt = F.w<bf16>(WS_MVT);
#pragma unroll
        for (int i = 0; i < 8; ++i) { const int col = 8 * lane + i, h = col >> 7, dv = col & 127; v4u o;
#pragma unroll
            for (int j = 0; j < 4; ++j) { const unsigned lo = (i & 1) ? (rw[2 * j][i >> 1] >> 16) : (rw[2 * j][i >> 1] & 0xffffu), hi = (i & 1) ? (rw[2 * j + 1][i >> 1] >> 16) : (rw[2 * j + 1][i >> 1] & 0xffffu); o[j] = lo | (hi << 16); }
            *(v4u*)(mvt + ((size_t)(b * 4 + h) * 128 + dv) * 256 + key0) = o; }
    }
}
}
namespace mk {
struct P4Raw { v4u raw; unsigned r1, r2; };
__device__ __forceinline__ P4Raw p4_load_row(const bf16* nope, const bf16* pe, int lane) { const int sub = lane & 7; P4Raw x; x.raw = *(const v4u*)(nope + 8 * sub); x.r1 = *(const unsigned*)(pe + 2 * sub); x.r2 = *(const unsigned*)(pe + 16 + 2 * sub); return x; }
__device__ __forceinline__ void p4_norm_rope_row(const P4Raw in, const float* g, const float* cs, const float* sn, int pos, float oscale, bf16* dst, int lane, bf16* dst2 = nullptr) {
    const int sub = lane & 7;
    const v4u raw = in.raw;
    const unsigned r1 = in.r1, r2 = in.r2;
    float x[8];
#pragma unroll
    for (int i = 0; i < 4; ++i) { x[2 * i] = bflo(raw[i]); x[2 * i + 1] = bfhi(raw[i]); }
    float a0 = bflo(r1), a1 = bfhi(r1), b0 = bflo(r2), b1 = bfhi(r2);
    float ss = (a0 * a0 + a1 * a1) + (b0 * b0 + b1 * b1);
#pragma unroll
    for (int i = 0; i < 8; ++i) ss += x[i] * x[i];
    ss += __shfl_xor(ss, 1); ss += __shfl_xor(ss, 2); ss += __shfl_xor(ss, 4);
    const float rs = rsqrtf(ss * (1.f / 96.f) + EPS) * oscale;
    const f32x4 g0 = *(const f32x4*)(g + 8 * sub), g1 = *(const f32x4*)(g + 8 * sub + 4);
    v4u o; o.x = pk2(x[0] * rs * g0[0], x[1] * rs * g0[1]); o.y = pk2(x[2] * rs * g0[2], x[3] * rs * g0[3]); o.z = pk2(x[4] * rs * g1[0], x[5] * rs * g1[1]); o.w = pk2(x[6] * rs * g1[2], x[7] * rs * g1[3]);
    *(v4u*)(dst + 8 * sub) = o;
    const int f = 2 * sub;
    a0 *= rs * g[64 + f]; a1 *= rs * g[65 + f]; b0 *= rs * g[80 + f]; b1 *= rs * g[81 + f];
    const float c0 = cs[pos * 16 + f], c1 = cs[pos * 16 + f + 1], s0 = sn[pos * 16 + f], s1 = sn[pos * 16 + f + 1];
    const unsigned o1_ = pk2(a0 * c0 - b0 * s0, a1 * c1 - b1 * s1), o2_ = pk2(b0 * c0 + a0 * s0, b1 * c1 + a1 * s1);
    *(unsigned*)(dst + 64 + f) = o1_; *(unsigned*)(dst + 80 + f) = o2_;
    if (dst2) { *(unsigned*)(dst2 + f) = o1_; *(unsigned*)(dst2 + 16 + f) = o2_; }
}
__device__ __forceinline__ void p4_qk_norm_rope(Frame& F) {
    const int gw = F.bid * NWAVES + F.wave, NGW = F.G * NWAVES, lane = F.lane, h = lane >> 3;
    const float* cs = F.w<float>(WS_ROPE); const float* sn = cs + ROPE_N * 16;
    const bf16* QR = F.w<bf16>(WS_QR); const bf16* KNR = F.w<bf16>(WS_KNR); const bf16* Z = F.w<bf16>(WS_Z);
    for (int r0 = gw; r0 < T; r0 += 4 * NGW) {
        P4Raw qin[4], kin[4];
#pragma unroll
        for (int k = 0; k < 4; ++k) { const int r = r0 + k * NGW; if (r < T) { const bf16* q = QR + (size_t)r * 768 + 96 * h; qin[k] = p4_load_row(q, q + 64, lane);
            if (r < TP) kin[k] = p4_load_row(KNR + (size_t)r * 512 + 64 * h, Z + (size_t)r * NINP + 1536, lane); } }
#pragma unroll
        for (int k = 0; k < 4; ++k) { const int r = r0 + k * NGW; if (r < T) {
            const int pos = r < TP ? (r & 2047) : PAST + ((r - TP) & 3);
            bf16* qx = nullptr;
            if (r >= TP) { const int sq = (r - TP) >> 2, tq = (r - TP) & 3; qx = F.w<bf16>(WS_QEXT) + ((size_t)sq * 32 + tq * 8 + h) * 288 + 256; }
            p4_norm_rope_row(qin[k], F.inf(I_GQKQ), cs, sn, pos, QSCALE, F.w<bf16>(WS_QF) + (size_t)r * 768 + 96 * h, lane, qx);
            if (r < TP) p4_norm_rope_row(kin[k], F.inf(I_GQKK), cs, sn, pos, 1.f, F.w<bf16>(WS_KF) + (size_t)r * 768 + 96 * h, lane);
        } }
    }
}
__device__ __forceinline__ void p4_qext(Frame& F) {
    const int gw = F.bid * NWAVES + F.wave, NGW = F.G * NWAVES, lane = F.lane, l31 = lane & 31, hh = lane >> 5;
    const float* gq = F.inf(I_GQKQ); const float* gk = F.inf(I_GQKK);
    for (int u = gw; u < 1024; u += NGW) {
        const int h = u & 7, cbk = (u >> 3) & 7, rbk = u >> 6;
        const int row = TP + 32 * rbk + l31;
        const bf16* qp = F.w<bf16>(WS_QR) + (size_t)row * 768 + 96 * h;
        v4u raw[4]; float ss = 0.f;
#pragma unroll
        for (int ks = 0; ks < 4; ++ks) { raw[ks] = *(const v4u*)(qp + 16 * ks + 8 * hh);
#pragma unroll
            for (int i = 0; i < 4; ++i) { const float a = bflo(raw[ks][i]), c = bfhi(raw[ks][i]); ss += a * a + c * c; } }
        { const v4u r0 = *(const v4u*)(qp + 64 + 16 * hh), r1 = *(const v4u*)(qp + 64 + 16 * hh + 8);
#pragma unroll
          for (int i = 0; i < 4; ++i) { const float a = bflo(r0[i]), c = bfhi(r0[i]), d = bflo(r1[i]), e = bfhi(r1[i]); ss += (a * a + c * c) + (d * d + e * e); } }
        ss += __shfl_xor(ss, 32);
        const float rs = rsqrtf(ss * (1.f / 96.f) + EPS) * QSCALE;
        f32x16 acc = {};
        const float* wp = F.inf(I_WUK) + (size_t)(32 * cbk + l31) * 512 + h * 64 + 8 * hh;
#pragma unroll
        for (int ks = 0; ks < 4; ++ks) {
            const int d0 = 16 * ks + 8 * hh;
            const f32x4 w0 = *(const f32x4*)(wp + 16 * ks), w1 = *(const f32x4*)(wp + 16 * ks + 4);
            v4u wa; wa.x = cvtpk(w0[0], w0[1]); wa.y = cvtpk(w0[2], w0[3]); wa.z = cvtpk(w1[0], w1[1]); wa.w = cvtpk(w1[2], w1[3]);
            const f32x4 q0 = *(const f32x4*)(gq + d0), q1 = *(const f32x4*)(gq + d0 + 4), k0 = *(const f32x4*)(gk + d0), k1 = *(const f32x4*)(gk + d0 + 4);
            v4u qb; qb.x = cvtpk(bflo(raw[ks][0]) * rs * q0[0] * k0[0], bfhi(raw[ks][0]) * rs * q0[1] * k0[1]); qb.y = cvtpk(bflo(raw[ks][1]) * rs * q0[2] * k0[2], bfhi(raw[ks][1]) * rs * q0[3] * k0[3]);
            qb.z = cvtpk(bflo(raw[ks][2]) * rs * q1[0] * k1[0], bfhi(raw[ks][2]) * rs * q1[1] * k1[1]); qb.w = cvtpk(bflo(raw[ks][3]) * rs * q1[2] * k1[2], bfhi(raw[ks][3]) * rs * q1[3] * k1[3]);
            acc = __builtin_amdgcn_mfma_f32_32x32x16_bf16(__builtin_bit_cast(bf16x8, wa), __builtin_bit_cast(bf16x8, qb), acc, 0, 0, 0);
        }
        const int sq = (32 * rbk + l31) >> 2, tq = l31 & 3;
        bf16* dst = F.w<bf16>(WS_QEXT) + ((size_t)sq * 32 + tq * 8 + h) * 288 + 32 * cbk + 4 * hh;
#pragma unroll
        for (int g = 0; g < 4; ++g) { v2u o; o.x = cvtpk(acc[4 * g], acc[4 * g + 1]); o.y = cvtpk(acc[4 * g + 2], acc[4 * g + 3]); *(v2u*)(dst + 8 * g) = o; }
    }
}
}
namespace mk {
__device__ __forceinline__ float wave_max(float v) {
#pragma unroll
    for (int o = 1; o < 64; o <<= 1) v = fmaxf(v, __shfl_xor(v, o));
    return v;
}
__device__ __forceinline__ float gain_absmax(const float* g, int n, int lane) { float m = 0.f; for (int i = lane; i < n; i += 64) m = fmaxf(m, fabsf(g[i])); return wave_max(m); }

constexpr int PA_KROW = 208, PA_VROW = 144, PA_KBUF = 0, PA_VBUF = 2 * 64 * PA_KROW, PA_END = PA_VBUF + 2 * 64 * PA_VROW;
__device__ __forceinline__ void attn_prompt_unit(Frame& F, int b, int h, int qb, float negM) {
    const int tid = F.tid, lane = F.lane, wv = F.wave, l31 = lane & 31, hh = lane >> 5;
    LAS unsigned char* L = F.lds;
    const int q0w = 256 * qb + 32 * wv;
    const bf16* Qp = F.w<bf16>(WS_QF) + (size_t)(b * SEQ + q0w + l31) * 768 + h * 96 + 8 * hh;
    bf16x8 qf[6];
#pragma unroll
    for (int ks = 0; ks < 6; ++ks) qf[ks] = *(const bf16x8*)(Qp + 16 * ks);
    const bf16* Kg = F.w<bf16>(WS_KF) + (size_t)(b * SEQ) * 768 + h * 96;
    const bf16* Vg = F.w<bf16>(WS_VT) + (size_t)(h * 64) * TP + (size_t)b * SEQ;
    const int keyA = tid / 12, cA = tid % 12, keyB = (512 + tid) / 12, cB = (512 + tid) % 12, dvv = tid >> 3, cv = tid & 7;
    const int NT = 4 * qb + 4;
    v4u ka0, kb0 = (v4u){0, 0, 0, 0}, vv0, ka1, kb1 = (v4u){0, 0, 0, 0}, vv1;
#define PA_LOAD(kt, KA, KB, VV) do { const int kt_ = (kt) < NT ? (kt) : NT - 1; KA = *(const v4u*)(Kg + (size_t)(64 * kt_ + keyA) * 768 + 8 * cA); if (tid < 256) KB = *(const v4u*)(Kg + (size_t)(64 * kt_ + keyB) * 768 + 8 * cB); \
        VV = *(const v4u*)(Vg + (size_t)dvv * TP + 64 * kt_ + 8 * cv); } while (0)
#define PA_STORE(buf, KA, KB, VV) do { *(LAS v4u*)(L + PA_KBUF + (buf) * 64 * PA_KROW + keyA * PA_KROW + 16 * cA) = KA; if (tid < 256) *(LAS v4u*)(L + PA_KBUF + (buf) * 64 * PA_KROW + keyB * PA_KROW + 16 * cB) = KB; \
        *(LAS v4u*)(L + PA_VBUF + (buf) * 64 * PA_VROW + dvv * PA_VROW + 16 * cv) = VV; } while (0)
    PA_LOAD(0, ka0, kb0, vv0); PA_STORE(0, ka0, kb0, vv0);
    __syncthreads();
    PA_LOAD(1, ka1, kb1, vv1);
    __builtin_amdgcn_sched_barrier(0);
    PA_LOAD(2, ka0, kb0, vv0);
    f32x16 o0 = {}, o1 = {}; float l = 0.f;
    auto pa_compute = [&](const int kt) __attribute__((always_inline)) {
        const int buf = kt & 1;
        if (64 * kt <= q0w + 31) {
            const bool part = (64 * kt + 63 > q0w);
            const LAS unsigned char* kbp = L + PA_KBUF + buf * 64 * PA_KROW + l31 * PA_KROW + 16 * hh;
            const LAS unsigned char* vbp = L + PA_VBUF + buf * 64 * PA_VROW + l31 * PA_VROW + 8 * hh;
            bf16x8 kfa[6], kfb[6], vfa[2][2], vfb[2][2];
#define PA_VFRAG(dst, sub_) do { _Pragma("unroll") for (int s2 = 0; s2 < 2; ++s2) _Pragma("unroll") for (int dt = 0; dt < 2; ++dt) { const LAS unsigned char* vp = vbp + dt * 32 * PA_VROW + (32 * (sub_) + 16 * s2) * 2; \
                const s16x4 lo = *(const LAS s16x4*)vp, hi = *(const LAS s16x4*)(vp + 16); dst[s2][dt] = (bf16x8){lo[0], lo[1], lo[2], lo[3], hi[0], hi[1], hi[2], hi[3]}; } } while (0)
#define PA_EXP(s, sub_, pb, MASK) do { float p[16]; \
                _Pragma("unroll") for (int i = 0; i < 16; ++i) { float e = __builtin_amdgcn_exp2f(s[i] + negM); if (MASK && (64 * kt + 32 * (sub_) + (i & 3) + 8 * (i >> 2) + 4 * hh) > q0w + l31) e = 0.f; p[i] = e; l += e; } \
                _Pragma("unroll") for (int s2 = 0; s2 < 2; ++s2) { v4u w; w.x = cvtpk(p[8 * s2 + 0], p[8 * s2 + 1]); w.y = cvtpk(p[8 * s2 + 2], p[8 * s2 + 3]); w.z = cvtpk(p[8 * s2 + 4], p[8 * s2 + 5]); w.w = cvtpk(p[8 * s2 + 6], p[8 * s2 + 7]); pb[s2] = __builtin_bit_cast(bf16x8, w); } } while (0)
#pragma unroll
            for (int ks = 0; ks < 6; ++ks) kfa[ks] = *(const LAS bf16x8*)(kbp + 32 * ks);
            __builtin_amdgcn_sched_barrier(0);
            f32x16 sA = {}, sB = {};
#pragma unroll
            for (int ks = 0; ks < 6; ++ks) kfb[ks] = *(const LAS bf16x8*)(kbp + 32 * PA_KROW + 32 * ks);
#pragma unroll
            for (int ks = 0; ks < 6; ++ks) sA = __builtin_amdgcn_mfma_f32_32x32x16_bf16(kfa[ks], qf[ks], sA, 0, 0, 0);
            __builtin_amdgcn_sched_barrier(0);
            PA_VFRAG(vfa, 0);
#pragma unroll
            for (int ks = 0; ks < 6; ++ks) sB = __builtin_amdgcn_mfma_f32_32x32x16_bf16(kfb[ks], qf[ks], sB, 0, 0, 0);
            __builtin_amdgcn_sched_barrier(0);
            bf16x8 pbA[2], pbB[2];
            if (part) PA_EXP(sA, 0, pbA, true); else PA_EXP(sA, 0, pbA, false);
            __builtin_amdgcn_sched_barrier(0);
            PA_VFRAG(vfb, 1);
#pragma unroll
            for (int s2 = 0; s2 < 2; ++s2) { o0 = __builtin_amdgcn_mfma_f32_32x32x16_bf16(vfa[s2][0], pbA[s2], o0, 0, 0, 0); o1 = __builtin_amdgcn_mfma_f32_32x32x16_bf16(vfa[s2][1], pbA[s2], o1, 0, 0, 0); }
            __builtin_amdgcn_sched_barrier(0);
            if (part) PA_EXP(sB, 1, pbB, true); else PA_EXP(sB, 1, pbB, false);
            __builtin_amdgcn_sched_barrier(0);
#pragma unroll
            for (int s2 = 0; s2 < 2; ++s2) { o0 = __builtin_amdgcn_mfma_f32_32x32x16_bf16(vfb[s2][0], pbB[s2], o0, 0, 0, 0); o1 = __builtin_amdgcn_mfma_f32_32x32x16_bf16(vfb[s2][1], pbB[s2], o1, 0, 0, 0); }
            __builtin_amdgcn_sched_barrier(0);
#undef PA_VFRAG
#undef PA_EXP
        }
    };
#pragma unroll 1
    for (int kt = 0; kt < NT; kt += 2) {
        pa_compute(kt);
        PA_STORE(1, ka1, kb1, vv1);
        __syncthreads();
        PA_LOAD(kt + 3, ka1, kb1, vv1);
        pa_compute(kt + 1);
        if (kt + 2 < NT) PA_STORE(0, ka0, kb0, vv0);
        __syncthreads();
        PA_LOAD(kt + 4, ka0, kb0, vv0);
    }
#undef PA_LOAD
#undef PA_STORE
    l += __shfl_xor(l, 32);
    const float rl = 1.f / l;
    bf16* Op = F.w<bf16>(WS_BO) + (size_t)(b * SEQ + q0w + l31) * 512 + h * 64 + 4 * hh;
#pragma unroll
    for (int g = 0; g < 4; ++g) {
        v2u w0; w0.x = cvtpk(o0[4 * g] * rl, o0[4 * g + 1] * rl); w0.y = cvtpk(o0[4 * g + 2] * rl, o0[4 * g + 3] * rl);
        v2u w1; w1.x = cvtpk(o1[4 * g] * rl, o1[4 * g + 1] * rl); w1.y = cvtpk(o1[4 * g + 2] * rl, o1[4 * g + 3] * rl);
        *(v2u*)(Op + 8 * g) = w0; *(v2u*)(Op + 32 + 8 * g) = w1;
    }
}
__device__ __forceinline__ void p5_attn_prompt(Frame& F, float negM) {
    for (int u = F.bid; u < 256; u += F.G) {
        const int bh = u >> 2, p = u & 3, b = bh >> 3, h = bh & 7;
        attn_prompt_unit(F, b, h, p, negM);
        attn_prompt_unit(F, b, h, 7 - p, negM);
    }
}
}
namespace mk {
constexpr int SA_ROWB = 592;
constexpr int SA_TILE = 0, SA_T8 = 2 * 64 * SA_ROWB, SA_T8ROW = 272, SA_KP2 = SA_T8 + 64 * SA_T8ROW, SA_GPE = SA_KP2 + 256, SA_R = SA_GPE + 128, SA_PT = SA_R + 2048, SA_PTROW = 144,
              SA_QEXT = SA_PT + 32 * SA_PTROW, SA_RBASE = SA_QEXT + 32 * SA_ROWB  , SA_RDEL = SA_RBASE + 65 * 128  , SA_END = SA_RDEL + 64 * 128;
static_assert(SA_END <= RING_BYTES, "sample attention LDS");
typedef short v4i16_t __attribute__((ext_vector_type(4)));
#define SA_BAR() do { asm volatile("s_waitcnt lgkmcnt(0)" ::: "memory"); __builtin_amdgcn_s_barrier(); asm volatile("" ::: "memory"); } while (0)

__device__ __forceinline__ void attn_sample_unit(Frame& F, int s, int split, float negM) {
    const int tid = F.tid, lane = F.lane, w = F.wave, hh = lane >> 5, l31 = lane & 31;
    LAS unsigned char* L = F.lds;
    const float* pool_ckv = F.inf(I_CKV); const float* pool_kpe = F.inf(I_KPE); const int* pt = (const int*)F.in[I_PT] + s * 64;
    const float* cs = F.w<float>(WS_ROPE); const float* sn = cs + ROPE_N * 16;
    const float* gk = F.inf(I_GQKK);
    const int kbeg = split * 4096, NT = split ? 65 : 64;
    const int prow = tid >> 3, pc4 = tid & 7;
    const int mypage = pt[split * 32 + l31];
    f32x4 va[8], vb[8], pe;
#define SA_LOADC(n, V) do { const int key0_ = kbeg + 64 * (n); const int page_ = __builtin_amdgcn_readlane(mypage, (n) >> 1); const size_t rb_ = (size_t)page_ * 128 + (key0_ & 127); \
        const float* cp_ = pool_ckv + (rb_ + w) * 256 + 4 * lane; \
        _Pragma("unroll") for (int i = 0; i < 8; ++i) V[i] = __builtin_nontemporal_load((const f32x4*)(cp_ + (size_t)i * 2048)); } while (0)
#define SA_LOADPC(n) do { const int key0_ = kbeg + 64 * (n); const int page_ = __builtin_amdgcn_readlane(mypage, (n) >> 1); const size_t rb_ = (size_t)page_ * 128 + (key0_ & 127); \
        pe = __builtin_nontemporal_load((const f32x4*)(pool_kpe + (rb_ + prow) * 32 + 4 * pc4)); } while (0)
#define SA_LOADP(n) do { if (kbeg + 64 * (n) < PAST) SA_LOADPC(n); else { pe = (f32x4){0.f, 0.f, 0.f, 0.f}; \
            if (prow < 4) { const v2u r_ = *(const v2u*)(F.w<bf16>(WS_Z) + (size_t)(TP + 4 * s + prow) * NINP + 1536 + 4 * pc4); pe = (f32x4){bflo(r_.x), bfhi(r_.x), bflo(r_.y), bfhi(r_.y)}; } } } while (0)
#define SA_LOAD(n, V) do { \
        if (kbeg + 64 * (n) < PAST) SA_LOADC(n, V); else { \
            _Pragma("unroll") for (int i = 0; i < 8; ++i) V[i] = (f32x4){0.f, 0.f, 0.f, 0.f}; \
            if (w < 4) { const v2u o_ = *(const v2u*)(F.w<bf16>(WS_CKVN) + (size_t)(TP + 4 * s + w) * 256 + 4 * lane); V[0] = (f32x4){bflo(o_.x), bfhi(o_.x), bflo(o_.y), bfhi(o_.y)}; } \
        } } while (0)
#define SA_CONVERT(n, V) do { LAS unsigned char* tb_ = L + SA_TILE + ((n) & 1) * 64 * SA_ROWB; \
        _Pragma("unroll") for (int i = 0; i < 8; ++i) { v2u o_; o_.x = cvtpk(V[i][0], V[i][1]); o_.y = cvtpk(V[i][2], V[i][3]); \
            *(LAS v2u*)(tb_ + (w + 8 * i) * SA_ROWB + 8 * lane) = o_; \
            int f8_ = 0; f8_ = __builtin_amdgcn_cvt_pk_fp8_f32(V[i][0], V[i][1], f8_, false); f8_ = __builtin_amdgcn_cvt_pk_fp8_f32(V[i][2], V[i][3], f8_, true); \
            *(LAS int*)(L + SA_T8 + (w + 8 * i) * SA_T8ROW + 4 * lane) = f8_; } \
        { const f32x4 pv = pe; float ss_ = (pv[0] * pv[0] + pv[1] * pv[1]) + (pv[2] * pv[2] + pv[3] * pv[3]); ss_ += __shfl_xor(ss_, 1); ss_ += __shfl_xor(ss_, 2); ss_ += __shfl_xor(ss_, 4); \
          if (pc4 == 0) ((LAS float*)(L + SA_KP2))[prow] = ss_; \
          const LAS float* rb_ = (const LAS float*)(L + SA_RBASE) + (n) * 32 + 4 * (pc4 & 3); const LAS float* rd_ = (const LAS float*)(L + SA_RDEL) + prow * 32 + 4 * (pc4 & 3); \
          const f32x4 cb_ = *(const LAS f32x4*)rb_, sb_ = *(const LAS f32x4*)(rb_ + 16), cd_ = *(const LAS f32x4*)rd_, sd_ = *(const LAS f32x4*)(rd_ + 16); \
          const f32x4 c_ = cb_ * cd_ - sb_ * sd_, s_ = sb_ * cd_ + cb_ * sd_; \
          f32x4 x_ = pv * *(const LAS f32x4*)(L + SA_GPE + 16 * pc4), y_, o4_; y_[0] = __shfl_xor(x_[0], 4); y_[1] = __shfl_xor(x_[1], 4); y_[2] = __shfl_xor(x_[2], 4); y_[3] = __shfl_xor(x_[3], 4); \
          if (pc4 < 4) o4_ = x_ * c_ - y_ * s_; else o4_ = x_ * c_ + y_ * s_; \
          v2u o_; o_.x = cvtpk(o4_[0], o4_[1]); o_.y = cvtpk(o4_[2], o4_[3]); *(LAS v2u*)(tb_ + prow * SA_ROWB + 512 + pc4 * 8) = o_; } } while (0)
    SA_LOADPC(0); SA_LOADC(0, va);
    __builtin_amdgcn_sched_barrier(0);
    SA_LOADC(1, vb);
    __builtin_amdgcn_sched_barrier(0);
    { const bf16* qx = F.w<bf16>(WS_QEXT) + (size_t)s * 32 * 288;
      for (int ch = tid; ch < 32 * 36; ch += 512) { const int r_ = ch / 36, c_ = ch % 36; *(LAS v4u*)(L + SA_QEXT + r_ * SA_ROWB + 16 * c_) = *(const v4u*)(qx + r_ * 288 + 8 * c_); } }
    typedef int v8i_t __attribute__((ext_vector_type(8)));
    v8i_t Wf[2][4];
    { const bf16* Wp = F.w<bf16>(WS_W_UK) + (size_t)(w * 64 + l31) * 256 + 32 * hh;
#pragma unroll
      for (int dt = 0; dt < 2; ++dt)
#pragma unroll
          for (int ks = 0; ks < 4; ++ks) { v8i_t fr;
#pragma unroll
              for (int q = 0; q < 4; ++q) { const v4u raw = *(const v4u*)(Wp + (size_t)dt * 32 * 256 + 64 * ks + 8 * q);
                  int d0 = 0, d1 = 0;
                  d0 = __builtin_amdgcn_cvt_pk_fp8_f32(bflo(raw.x) * 16.f, bfhi(raw.x) * 16.f, d0, false); d0 = __builtin_amdgcn_cvt_pk_fp8_f32(bflo(raw.y) * 16.f, bfhi(raw.y) * 16.f, d0, true);
                  d1 = __builtin_amdgcn_cvt_pk_fp8_f32(bflo(raw.z) * 16.f, bfhi(raw.z) * 16.f, d1, false); d1 = __builtin_amdgcn_cvt_pk_fp8_f32(bflo(raw.w) * 16.f, bfhi(raw.w) * 16.f, d1, true);
                  fr[2 * q] = d0; fr[2 * q + 1] = d1; }
              Wf[dt][ks] = fr; } }
    if (tid < 32) ((LAS float*)(L + SA_GPE))[tid] = gk[64 + tid];
    for (int i = tid; i < 65 * 8; i += 512) { const int n_ = i >> 3, c_ = i & 7; *(LAS f32x4*)(L + SA_RBASE + n_ * 128 + 16 * c_) = *(const f32x4*)((c_ < 4 ? cs : sn - 16) + (size_t)(kbeg + 64 * n_) * 16 + 4 * c_); }
    { const int r_ = tid >> 3, c_ = tid & 7; *(LAS f32x4*)(L + SA_RDEL + r_ * 128 + 16 * c_) = *(const f32x4*)((c_ < 4 ? cs : sn - 16) + (size_t)r_ * 16 + 4 * c_); }
    SA_BAR();
    f32x16 oacc = {}; float lsum = 0.f;
    SA_CONVERT(0, va);
    __builtin_amdgcn_sched_barrier(0);
    SA_LOADPC(1);
    __builtin_amdgcn_sched_barrier(0);
    SA_LOADC(2, va);
    __builtin_amdgcn_sched_barrier(0);
    SA_BAR();
    const int lane_ = lane, tid_ = tid;
#define SA_STEP(n, V, DO_CONV, DO_LOADP, LOADPM, DO_LOAD, LOADM) do { \
        const int lane = opaque_i(lane_), tid = opaque_i(tid_), hh = lane >> 5, l31 = lane & 31, prow = tid >> 3, pc4 = tid & 7, l15 = lane & 15, l4 = lane >> 4;     \
        const LAS unsigned char* tb = L + SA_TILE + ((n) & 1) * 64 * SA_ROWB; \
          \
        _Pragma("unroll") for (int kt2 = 0; kt2 < 2; ++kt2) { \
            const LAS unsigned char* bp = L + SA_T8 + (32 * kt2 + l31) * SA_T8ROW + 32 * hh; \
            f32x16 a0 = {}, a1 = {}; \
            _Pragma("unroll") for (int ks = 0; ks < 4; ++ks) { const v4u lo = *(const LAS v4u*)(bp + 64 * ks), hi = *(const LAS v4u*)(bp + 64 * ks + 16); \
                const v8i_t fb = (v8i_t){(int)lo.x, (int)lo.y, (int)lo.z, (int)lo.w, (int)hi.x, (int)hi.y, (int)hi.z, (int)hi.w}; \
                a0 = __builtin_amdgcn_mfma_scale_f32_32x32x64_f8f6f4(Wf[0][ks], fb, a0, 0, 0, 0, 0x7B7B7B7B, 0, 0x7F7F7F7F); \
                a1 = __builtin_amdgcn_mfma_scale_f32_32x32x64_f8f6f4(Wf[1][ks], fb, a1, 0, 0, 0, 0x7B7B7B7B, 0, 0x7F7F7F7F); \
                if (ks & 1) __builtin_amdgcn_sched_barrier(0); } \
            float ss = 0.f; \
            _Pragma("unroll") for (int i = 0; i < 16; ++i) ss += a0[i] * a0[i] + a1[i] * a1[i]; \
            ss += __shfl_xor(ss, 32); \
            ss += ((const LAS float*)(L + SA_KP2))[32 * kt2 + l31]; \
            if (hh == 0) ((LAS float*)(L + SA_R))[w * 64 + 32 * kt2 + l31] = rsqrtf(ss * (1.f / 96.f) + EPS); \
        } \
        SA_BAR(); \
        if (DO_CONV) SA_CONVERT((n) + 1, V); \
        __builtin_amdgcn_sched_barrier(0); \
        if (DO_LOADP) LOADPM((n) + 2); \
        __builtin_amdgcn_sched_barrier(0); \
        if (DO_LOAD) LOADM((n) + 3, V); \
        __builtin_amdgcn_sched_barrier(0); \
          \
        if (w < 2) { \
            f32x16 sa0 = {}, sa1 = {}; \
            const LAS unsigned char* ap = tb + (32 * w + l31) * SA_ROWB + 16 * hh; \
            const LAS unsigned char* qp = L + SA_QEXT + l31 * SA_ROWB + 16 * hh; \
            _Pragma("unroll") for (int k0 = 0; k0 < 18; k0 += 3) { bf16x8 afr[3], qfr[3]; \
                _Pragma("unroll") for (int ks = 0; ks < 3; ++ks) { afr[ks] = *(const LAS bf16x8*)(ap + 32 * (k0 + ks)); qfr[ks] = *(const LAS bf16x8*)(qp + 32 * (k0 + ks)); } \
                __builtin_amdgcn_sched_barrier(0); \
                _Pragma("unroll") for (int ks = 0; ks < 3; ++ks) { if ((k0 + ks) & 1) sa1 = __builtin_amdgcn_mfma_f32_32x32x16_bf16(afr[ks], qfr[ks], sa1, 0, 0, 0); else sa0 = __builtin_amdgcn_mfma_f32_32x32x16_bf16(afr[ks], qfr[ks], sa0, 0, 0, 0); } \
                __builtin_amdgcn_sched_barrier(0); } \
            const int t_q = l31 >> 3, h_q = l31 & 7; \
            _Pragma("unroll") for (int g = 0; g < 4; ++g) { \
                const f32x4 r4 = *(const LAS f32x4*)(L + SA_R + (h_q * 64 + 32 * w + 8 * g + 4 * hh) * 4); \
                const int kg = kbeg + 64 * (n) + 32 * w + 8 * g + 4 * hh; \
                float p[4]; \
                _Pragma("unroll") for (int i = 0; i < 4; ++i) { float e = __builtin_amdgcn_exp2f((sa0[4 * g + i] + sa1[4 * g + i]) * r4[i] + negM); if (kg + i > PAST + t_q) e = 0.f; p[i] = e; lsum += e; } \
                v2u o; o.x = cvtpk(p[0], p[1]); o.y = cvtpk(p[2], p[3]); \
                *(LAS v2u*)(L + SA_PT + l31 * SA_PTROW + (32 * w + 8 * g + 4 * hh) * 2) = o; } \
        } \
        SA_BAR(); \
          \
        { \
            const LAS unsigned char* trp = tb + (8 * hh + (l15 >> 2)) * SA_ROWB + (32 * w + 16 * (l4 & 1) + 4 * (l15 & 3)) * 2; \
            const LAS unsigned char* pp = L + SA_PT + l31 * SA_PTROW + 16 * hh; \
            _Pragma("unroll") for (int s2 = 0; s2 < 4; ++s2) { \
                const s16x4 lo = __builtin_bit_cast(s16x4, __builtin_amdgcn_ds_read_tr16_b64_v4i16((LAS v4i16_t*)(trp + (16 * s2) * SA_ROWB))); \
                const s16x4 hi = __builtin_bit_cast(s16x4, __builtin_amdgcn_ds_read_tr16_b64_v4i16((LAS v4i16_t*)(trp + (16 * s2 + 4) * SA_ROWB))); \
                const bf16x8 af = (bf16x8){lo[0], lo[1], lo[2], lo[3], hi[0], hi[1], hi[2], hi[3]}; \
                const bf16x8 pf = *(const LAS bf16x8*)(pp + 32 * s2); \
                oacc = __builtin_amdgcn_mfma_f32_32x32x16_bf16(af, pf, oacc, 0, 0, 0); if (s2 & 1) __builtin_amdgcn_sched_barrier(0); \
            } \
        } } while (0)
#pragma unroll 1
    for (int n = 0; n < 60; n += 2) {
        SA_STEP(n, vb, true, true, SA_LOADPC, true, SA_LOADC);
        SA_STEP(n + 1, va, true, true, SA_LOADPC, true, SA_LOADC);
    }
#pragma unroll 1
    for (int n = 60; n < NT; n += 2) {
        SA_STEP(n, vb, n + 1 < NT, n + 2 < NT, SA_LOADP, n + 3 < NT, SA_LOAD);
        if (n + 1 < NT) SA_STEP(n + 1, va, n + 2 < NT, n + 3 < NT, SA_LOADP, n + 4 < NT, SA_LOAD);
    }
#undef SA_STEP
#undef SA_LOAD
#undef SA_LOADC
#undef SA_LOADP
#undef SA_LOADPC
#undef SA_CONVERT
    float* part = (float*)(F.ws + WS_SPART + (size_t)(s * 2 + split) * SPART_STRIDE);
    lsum += __shfl_xor(lsum, 32);
    __syncthreads();
    if (w < 2 && lane < 32) ((LAS float*)(L + SA_R))[w * 32 + lane] = lsum;
    __syncthreads();
    if (tid < 32) { const LAS float* lp = (const LAS float*)(L + SA_R); part[tid] = lp[tid] + lp[32 + tid]; }
#pragma unroll
    for (int g = 0; g < 4; ++g) *(f32x4*)(part + 32 + l31 * 256 + 32 * w + 8 * g + 4 * hh) = (f32x4){oacc[4 * g], oacc[4 * g + 1], oacc[4 * g + 2], oacc[4 * g + 3]};
    __syncthreads();
}
}
namespace mk {
__device__ __forceinline__ void p6_gmlp_chunk(Frame& F, int chunk) {
    const int lane = F.lane, g = F.wave, hh = lane >> 5, l31 = lane & 31;
    LAS float* SS = (LAS float*)(F.lds + 131072);
    LAS unsigned char* VT_ = F.lds + g * 16384;
    const int row0 = chunk * 128;
    const bf16* VG = F.w<bf16>(WS_VG) + (size_t)row0 * 512 + g * 64;
    const bf16* Z = F.w<bf16>(WS_Z) + (size_t)row0 * NINP + g * 64;
    const bf16* Wg = F.w<bf16>(WS_W_SB) + (size_t)g * 128 * 128;
    const float* bs = F.inf(I_BS) + g * 128;
    v4u wf[4][8];
#pragma unroll
    for (int tt = 0; tt < 4; ++tt)
#pragma unroll
        for (int ks = 0; ks < 2 * tt + 2; ++ks) wf[tt][ks] = *(const v4u*)(Wg + (size_t)(32 * tt + l31) * 128 + 16 * ks + 8 * hh);
#pragma unroll
    for (int i = 0; i < 16; ++i) { const int r = (lane >> 3) + 8 * i, ch = lane & 7; const v4u v = *(const v4u*)(VG + (size_t)r * 512 + 8 * ch); *(LAS v4u*)(VT_ + r * 128 + 16 * ch) = v;
        if ((i & 3) == 3) __builtin_amdgcn_sched_barrier(0); }
    LDS_WAIT(); asm volatile("" ::: "memory");
    const int l4 = lane >> 4, l15 = lane & 15;
    const LAS unsigned char* trb = VT_ + (8 * hh + (l15 >> 2)) * 128 + (16 * (l4 & 1) + 4 * (l15 & 3)) * 2;
    v2u pa[4][2][4];
    v2u ura[4][2][4]; float bta[4];
#pragma unroll
    for (int tt = 0; tt < 4; ++tt) { const int t = 32 * tt + l31; bta[tt] = bs[t];
#pragma unroll
        for (int dt = 0; dt < 2; ++dt)
#pragma unroll
            for (int gq = 0; gq < 4; ++gq) ura[tt][dt][gq] = *(const v2u*)(Z + (size_t)t * NINP + 32 * dt + 8 * gq + 4 * hh); }
#pragma unroll
    for (int tt = 0; tt < 4; ++tt) {
        const int t = 32 * tt + l31;
        const v2u (&ur)[2][4] = ura[tt];
        const float bt = bta[tt];
        f32x16 a0 = {}, a1 = {};
#pragma unroll
        for (int ks = 0; ks < 2 * tt + 2; ++ks) {
            v4u pk = wf[tt][ks];
            if (ks >= 2 * tt) {
                const int s0 = 16 * ks + 8 * hh;
#pragma unroll
                for (int i = 0; i < 4; ++i) { unsigned wv = pk[i]; if (s0 + 2 * i > t) wv = 0u; else if (s0 + 2 * i + 1 > t) wv &= 0xffffu; pk[i] = wv; }
            }
            const bf16x8 bfr = __builtin_bit_cast(bf16x8, pk);
            bf16x8 af[2];
#pragma unroll
            for (int dt = 0; dt < 2; ++dt) {
                const s16x4 lo = __builtin_bit_cast(s16x4, __builtin_amdgcn_ds_read_tr16_b64_v4i16((LAS v4i16_t*)(trb + (16 * ks) * 128 + 64 * dt)));
                const s16x4 hi = __builtin_bit_cast(s16x4, __builtin_amdgcn_ds_read_tr16_b64_v4i16((LAS v4i16_t*)(trb + (16 * ks + 4) * 128 + 64 * dt)));
                af[dt] = (bf16x8){lo[0], lo[1], lo[2], lo[3], hi[0], hi[1], hi[2], hi[3]};
            }
            a0 = __builtin_amdgcn_mfma_f32_32x32x16_bf16(af[0], bfr, a0, 0, 0, 0); a1 = __builtin_amdgcn_mfma_f32_32x32x16_bf16(af[1], bfr, a1, 0, 0, 0);
        }
        float ss = 0.f;
#pragma unroll
        for (int dt = 0; dt < 2; ++dt)
#pragma unroll
            for (int gq = 0; gq < 4; ++gq) {
                const v2u u2 = ur[dt][gq];
                const float u0 = gelu_tanh_f(bflo(u2.x)), u1 = gelu_tanh_f(bfhi(u2.x)), u2f = gelu_tanh_f(bflo(u2.y)), u3 = gelu_tanh_f(bfhi(u2.y));
                const f32x16& acc = dt ? a1 : a0;
                const float v0 = u0 * (acc[4 * gq] + bt), v1 = u1 * (acc[4 * gq + 1] + bt), v2 = u2f * (acc[4 * gq + 2] + bt), v3 = u3 * (acc[4 * gq + 3] + bt);
                ss += (v0 * v0 + v1 * v1) + (v2 * v2 + v3 * v3);
                v2u o; o.x = cvtpk(v0, v1); o.y = cvtpk(v2, v3); pa[tt][dt][gq] = o;
            }
        ss += __shfl_xor(ss, 32);
        if (hh == 0) SS[g * 128 + t] = ss;
    }
    __syncthreads();
    const float* goa = F.inf(I_GOA) + g * 64;
    bf16* MRG = F.w<bf16>(WS_MRG) + (size_t)row0 * 1024 + g * 64;
#pragma unroll
    for (int tt = 0; tt < 4; ++tt) {
        const int t = 32 * tt + l31;
        float tot = 0.f;
#pragma unroll
        for (int k = 0; k < 8; ++k) tot += SS[k * 128 + t];
        const float rstd = rsqrtf(tot * (1.f / 512.f) + EPS);
#pragma unroll
        for (int dt = 0; dt < 2; ++dt)
#pragma unroll
            for (int gq = 0; gq < 4; ++gq) {
                const int d0 = 32 * dt + 8 * gq + 4 * hh;
                const f32x4 gg = *(const f32x4*)(goa + d0);
                const v2u v = pa[tt][dt][gq];
                v2u o; o.x = cvtpk(bflo(v.x) * rstd * gg[0], bfhi(v.x) * rstd * gg[1]); o.y = cvtpk(bflo(v.y) * rstd * gg[2], bfhi(v.y) * rstd * gg[3]);
                *(v2u*)(MRG + (size_t)t * 1024 + d0) = o;
            }
    }
    __syncthreads();
}
__device__ __forceinline__ void p6_sample_seq(Frame& F, int s) {
    const int tid = F.tid, lane = F.lane, w = F.wave, l31 = lane & 31, hh = lane >> 5;
    LAS float* RED = (LAS float*)(F.lds + 32768);
    const float* p0 = (const float*)(F.ws + WS_SPART + (size_t)(s * 2) * SPART_STRIDE); const float* p1 = (const float*)((const unsigned char*)p0 + SPART_STRIDE);
    f32x16 a0 = {}, a1 = {};
    {
        const int th = (l31 & 3) * 8 + w;
        const float inv_l = 1.f / (p0[th] + p1[th]);
        const float* o0 = p0 + 32 + th * 256 + 8 * hh; const float* o1 = p1 + 32 + th * 256 + 8 * hh;
        const bf16* Wp = F.w<bf16>(WS_W_UV) + (size_t)(w * 64 + l31) * 256 + 8 * hh;
#pragma unroll
        for (int k0 = 0; k0 < 16; k0 += 4) {
            f32x4 x0[4], x1[4], y0[4], y1[4]; bf16x8 b0[4], b1[4];
#pragma unroll
            for (int i = 0; i < 4; ++i) { const int ks = k0 + i; x0[i] = *(const f32x4*)(o0 + 16 * ks); x1[i] = *(const f32x4*)(o0 + 16 * ks + 4); y0[i] = *(const f32x4*)(o1 + 16 * ks); y1[i] = *(const f32x4*)(o1 + 16 * ks + 4);
                b0[i] = *(const bf16x8*)(Wp + 16 * ks); b1[i] = *(const bf16x8*)(Wp + (size_t)32 * 256 + 16 * ks); }
#pragma unroll
            for (int i = 0; i < 4; ++i) { const f32x4 u0 = (x0[i] + y0[i]) * inv_l, u1 = (x1[i] + y1[i]) * inv_l;
                v4u pk; pk.x = cvtpk(u0[0], u0[1]); pk.y = cvtpk(u0[2], u0[3]); pk.z = cvtpk(u1[0], u1[1]); pk.w = cvtpk(u1[2], u1[3]);
                if (l31 >= 4) pk = (v4u){0u, 0u, 0u, 0u};
                const bf16x8 af = __builtin_bit_cast(bf16x8, pk);
                a0 = __builtin_amdgcn_mfma_f32_32x32x16_bf16(af, b0[i], a0, 0, 0, 0); a1 = __builtin_amdgcn_mfma_f32_32x32x16_bf16(af, b1[i], a1, 0, 0, 0); }
        }
    }
    const int col = tid;
    float ao[4];
    { const int g = col >> 6; const bf16* VG = F.w<bf16>(WS_VG) + (size_t)(TP + 4 * s) * 512 + col; const bf16* Z = F.w<bf16>(WS_Z) + (size_t)(TP + 4 * s) * NINP + col;
      const float* Wg = F.inf(I_WS) + (size_t)g * 128 * 128; const float* bs = F.inf(I_BS) + g * 128;
      float vg[4];
#pragma unroll
      for (int t = 0; t < 4; ++t) vg[t] = bf2f(VG[(size_t)t * 512]);
#pragma unroll
      for (int t = 0; t < 4; ++t) { float m = bs[t];
#pragma unroll
          for (int s2 = 0; s2 <= t; ++s2) m += Wg[t * 128 + s2] * vg[s2];
          ao[t] = gelu_tanh_f(bf2f(Z[(size_t)t * NINP])) * m; } }
    float red[8];
#pragma unroll
    for (int t = 0; t < 4; ++t) { red[t] = wave_sum(ao[t] * ao[t]); const float bq = (hh == 0) ? (a0[t] * a0[t] + a1[t] * a1[t]) : 0.f; red[4 + t] = wave_sum(bq); }
    if (lane < 8) { float v = red[0];
#pragma unroll
        for (int k = 1; k < 8; ++k) v = (lane == k) ? red[k] : v;
        RED[w * 8 + lane] = v; }
    __syncthreads();
    const float ga = F.inf(I_GOA)[col];
    bf16* MRG = F.w<bf16>(WS_MRG) + (size_t)(TP + 4 * s) * 1024; bf16* BO = F.w<bf16>(WS_BO) + (size_t)(TP + 4 * s) * 512;
    const float gb0 = F.inf(I_GOB)[w * 64 + l31], gb1 = F.inf(I_GOB)[w * 64 + 32 + l31];
#pragma unroll
    for (int t = 0; t < 4; ++t) {
        float sa = 0.f, sb = 0.f;
#pragma unroll
        for (int k = 0; k < 8; ++k) { sa += RED[k * 8 + t]; sb += RED[k * 8 + 4 + t]; }
        MRG[(size_t)t * 1024 + col] = (bf16)f2bf(ao[t] * rsqrtf(sa * (1.f / 512.f) + EPS) * ga);
        if (hh == 0) { const float rb = rsqrtf(sb * (1.f / 512.f) + EPS);
            MRG[(size_t)t * 1024 + 512 + w * 64 + l31] = (bf16)f2bf(a0[t] * rb * gb0); MRG[(size_t)t * 1024 + 512 + w * 64 + 32 + l31] = (bf16)f2bf(a1[t] * rb * gb1);
            BO[(size_t)t * 512 + w * 64 + l31] = (bf16)f2bf(a0[t]); BO[(size_t)t * 512 + w * 64 + 32 + l31] = (bf16)f2bf(a1[t]); }
    }
    __syncthreads();
}
static_assert(TP % (4 * 256 * NWAVES) == 0, "b_out norm loop: four rows per wave iteration");
__device__ __forceinline__ void p6_merge(Frame& F) {
#ifdef MK_TIMING
    unsigned long long* st_ = (unsigned long long*)(F.ws + WS_CTL + (768 << 10)) + F.bid * 32;
#define P6ST(k) do { if (F.tid == 0) st_[k] = __builtin_amdgcn_s_memrealtime(); } while (0)
#else
#define P6ST(k) do {} while (0)
#endif
    { const int u = F.bid; if (u < 128) { P6ST(24); p6_gmlp_chunk(F, u); P6ST(25); } else { P6ST(26); p6_sample_seq(F, u - 128); P6ST(27); } }
    P6ST(28);
    const int gw = F.bid * NWAVES + F.wave, NGW = F.G * NWAVES, lane = F.lane;
    const f32x4 g0 = *(const f32x4*)(F.inf(I_GOB) + 8 * lane), g1 = *(const f32x4*)(F.inf(I_GOB) + 8 * lane + 4);
    for (int r0 = gw; r0 < TP; r0 += 4 * NGW) {
        v4u raws[4];
#pragma unroll
        for (int k = 0; k < 4; ++k) raws[k] = *(const v4u*)(F.w<bf16>(WS_BO) + (size_t)(r0 + k * NGW) * 512 + 8 * lane);
#pragma unroll
        for (int k = 0; k < 4; ++k) { const int r = r0 + k * NGW; const v4u raw = raws[k];
        float x[8];
#pragma unroll
        for (int i = 0; i < 4; ++i) { x[2 * i] = bflo(raw[i]); x[2 * i + 1] = bfhi(raw[i]); }
        float ss = 0.f;
#pragma unroll
        for (int i = 0; i < 8; ++i) ss += x[i] * x[i];
        const float rstd = rsqrtf(wave_sum(ss) * (1.f / 512.f) + EPS);
        v4u o; o.x = pk2(x[0] * rstd * g0[0], x[1] * rstd * g0[1]); o.y = pk2(x[2] * rstd * g0[2], x[3] * rstd * g0[3]); o.z = pk2(x[4] * rstd * g1[0], x[5] * rstd * g1[1]); o.w = pk2(x[6] * rstd * g1[2], x[7] * rstd * g1[3]);
        *(v4u*)(F.w<bf16>(WS_MRG) + (size_t)r * 1024 + 512 + 8 * lane) = o;
        }
    }
    P6ST(29);
}
}
namespace mk {
__device__ __forceinline__ void rms_rowb_finish(const v4u a, const v4u b, const f32x4 g0, const f32x4 g1, const f32x4 g2, const f32x4 g3, bf16* orow, int lane) {
    float x[16];
#pragma unroll
    for (int i = 0; i < 4; ++i) { x[2 * i] = bflo(a[i]); x[2 * i + 1] = bfhi(a[i]); x[8 + 2 * i] = bflo(b[i]); x[8 + 2 * i + 1] = bfhi(b[i]); }
    float s = 0.f;
#pragma unroll
    for (int i = 0; i < 16; ++i) s += x[i] * x[i];
    const float rstd = rsqrtf(wave_sum(s) * (1.f / 1024.f) + EPS);
    v4u o0, o1;
    o0.x = pk2(x[0] * rstd * g0[0], x[1] * rstd * g0[1]); o0.y = pk2(x[2] * rstd * g0[2], x[3] * rstd * g0[3]); o0.z = pk2(x[4] * rstd * g1[0], x[5] * rstd * g1[1]); o0.w = pk2(x[6] * rstd * g1[2], x[7] * rstd * g1[3]);
    o1.x = pk2(x[8] * rstd * g2[0], x[9] * rstd * g2[1]); o1.y = pk2(x[10] * rstd * g2[2], x[11] * rstd * g2[3]); o1.z = pk2(x[12] * rstd * g3[0], x[13] * rstd * g3[1]); o1.w = pk2(x[14] * rstd * g3[2], x[15] * rstd * g3[3]);
    *(v4u*)(orow + 8 * lane) = o0; *(v4u*)(orow + 512 + 8 * lane) = o1;
}
__device__ __forceinline__ void p_rms_rows(Frame& F, size_t src_off, int gain_idx, size_t dst_off) {
    const int gw = F.bid * NWAVES + F.wave, NGW = F.G * NWAVES, lane = F.lane;
    const float* g = F.inf(gain_idx);
    const f32x4 g0 = *(const f32x4*)(g + 8 * lane), g1 = *(const f32x4*)(g + 8 * lane + 4), g2 = *(const f32x4*)(g + 512 + 8 * lane), g3 = *(const f32x4*)(g + 512 + 8 * lane + 4);
    const bf16* src = F.w<bf16>(src_off); bf16* dst = F.w<bf16>(dst_off);
    for (int r = gw; r < T; r += 4 * NGW) {
        v4u a[4], b[4];
#pragma unroll
        for (int k = 0; k < 4; ++k) { const int rr = r + k * NGW; if (rr < T) { a[k] = *(const v4u*)(src + (size_t)rr * D + 8 * lane); b[k] = *(const v4u*)(src + (size_t)rr * D + 512 + 8 * lane); } }
#pragma unroll
        for (int k = 0; k < 4; ++k) { const int rr = r + k * NGW; if (rr < T) rms_rowb_finish(a[k], b[k], g0, g1, g2, g3, dst + (size_t)rr * D, lane); }
    }
}

constexpr int MA_KROW = 272, MA_VROW = 528, MA_K = 0, MA_V = 256 * MA_KROW;
static_assert(MA_V + 128 * MA_VROW <= RING_BYTES, "memory attention LDS");
__device__ __forceinline__ void memattn_prompt_unit(Frame& F, int pb, int h, float negM) {
    const int tid = F.tid, lane = F.lane, l31 = lane & 31, hh = lane >> 5;
    const int b = pb >> 3, row = 256 * pb + 32 * F.wave + l31;
    LAS unsigned char* L = F.lds;
    {
        const bf16* Kg = F.w<bf16>(WS_MK) + (size_t)(b * 256) * 512 + h * 128;
        const bf16* Vg = F.w<bf16>(WS_MVT) + (size_t)(b * 4 + h) * 128 * 256;
        v4u kr[8], vr[8];
#pragma unroll
        for (int i = 0; i < 8; ++i) { const int ch = tid + 512 * i; kr[i] = *(const v4u*)(Kg + (size_t)(ch >> 4) * 512 + 8 * (ch & 15)); vr[i] = *(const v4u*)(Vg + (size_t)(ch >> 5) * 256 + 8 * (ch & 31)); }
#pragma unroll
        for (int i = 0; i < 8; ++i) { const int ch = tid + 512 * i; *(LAS v4u*)(L + MA_K + (ch >> 4) * MA_KROW + 16 * (ch & 15)) = kr[i]; *(LAS v4u*)(L + MA_V + (ch >> 5) * MA_VROW + 16 * (ch & 31)) = vr[i]; }
    }
    const bf16* Qp = F.w<bf16>(WS_MQ) + (size_t)row * 512 + h * 128 + 8 * hh;
    const float* g = F.inf(I_GMQ) + 8 * hh;
    bf16x8 qf[8];
    {
        v4u raw[8]; float ss = 0.f;
#pragma unroll
        for (int ks = 0; ks < 8; ++ks) { raw[ks] = *(const v4u*)(Qp + 16 * ks);
#pragma unroll
            for (int i = 0; i < 4; ++i) { const float a = bflo(raw[ks][i]), c = bfhi(raw[ks][i]); ss += a * a + c * c; } }
        ss += __shfl_xor(ss, 32);
        const float rs = rsqrtf(ss * (1.f / 128.f) + EPS) * MQSCALE;
#pragma unroll
        for (int ks = 0; ks < 8; ++ks) { const f32x4 g0 = *(const f32x4*)(g + 16 * ks), g1 = *(const f32x4*)(g + 16 * ks + 4); v4u o;
            o.x = cvtpk(bflo(raw[ks][0]) * rs * g0[0], bfhi(raw[ks][0]) * rs * g0[1]); o.y = cvtpk(bflo(raw[ks][1]) * rs * g0[2], bfhi(raw[ks][1]) * rs * g0[3]);
            o.z = cvtpk(bflo(raw[ks][2]) * rs * g1[0], bfhi(raw[ks][2]) * rs * g1[1]); o.w = cvtpk(bflo(raw[ks][3]) * rs * g1[2], bfhi(raw[ks][3]) * rs * g1[3]);
            qf[ks] = __builtin_bit_cast(bf16x8, o); }
    }
    __syncthreads();
    f32x16 o[4]; o[0] = f32x16{}; o[1] = f32x16{}; o[2] = f32x16{}; o[3] = f32x16{};
    float l = 0.f;
    const LAS unsigned char* Kp = L + MA_K + l31 * MA_KROW + 16 * hh;
    const LAS unsigned char* Vp = L + MA_V + l31 * MA_VROW + 8 * hh;
#pragma unroll 1
    for (int kt = 0; kt < 8; ++kt) {
        f32x16 s = {};
#pragma unroll
        for (int ks = 0; ks < 8; ++ks) { const bf16x8 kf = *(const LAS bf16x8*)(Kp + kt * 32 * MA_KROW + 32 * ks); s = __builtin_amdgcn_mfma_f32_32x32x16_bf16(kf, qf[ks], s, 0, 0, 0); }
        float p[16];
#pragma unroll
        for (int i = 0; i < 16; ++i) { p[i] = __builtin_amdgcn_exp2f(s[i] + negM); l += p[i]; }
        bf16x8 pb2[2];
#pragma unroll
        for (int s2 = 0; s2 < 2; ++s2) { v4u w; w.x = cvtpk(p[8 * s2 + 0], p[8 * s2 + 1]); w.y = cvtpk(p[8 * s2 + 2], p[8 * s2 + 3]); w.z = cvtpk(p[8 * s2 + 4], p[8 * s2 + 5]); w.w = cvtpk(p[8 * s2 + 6], p[8 * s2 + 7]); pb2[s2] = __builtin_bit_cast(bf16x8, w); }
#pragma unroll
        for (int dt = 0; dt < 4; ++dt)
#pragma unroll
            for (int s2 = 0; s2 < 2; ++s2) { const LAS unsigned char* vp = Vp + dt * 32 * MA_VROW + (kt * 32 + 16 * s2) * 2; const s16x4 lo = *(const LAS s16x4*)vp, hi = *(const LAS s16x4*)(vp + 16);
                const bf16x8 va = (bf16x8){lo[0], lo[1], lo[2], lo[3], hi[0], hi[1], hi[2], hi[3]};
                o[dt] = __builtin_amdgcn_mfma_f32_32x32x16_bf16(va, pb2[s2], o[dt], 0, 0, 0); }
    }
    l += __shfl_xor(l, 32);
    const float rl = 1.f / l;
    bf16* Op = F.w<bf16>(WS_MO) + (size_t)row * 512 + h * 128 + 4 * hh;
#pragma unroll
    for (int dt = 0; dt < 4; ++dt)
#pragma unroll
        for (int gq = 0; gq < 4; ++gq) { v2u w0; w0.x = cvtpk(o[dt][4 * gq] * rl, o[dt][4 * gq + 1] * rl); w0.y = cvtpk(o[dt][4 * gq + 2] * rl, o[dt][4 * gq + 3] * rl);
            *(v2u*)(Op + 32 * dt + 8 * gq) = w0; }
    __syncthreads();
}
__device__ __forceinline__ void memattn_sample_wg(Frame& F, int U) {
    const int lane = F.lane, l31 = lane & 31, hh = lane >> 5, pair = F.wave >> 2, kq = F.wave & 3;
    const int sh = 2 * U + pair, s = sh >> 2, h = sh & 3;
    LAS float* SC = (LAS float*)(F.lds + pair * 4096);
    LAS float* OP = (LAS float*)(F.lds + 8192 + pair * 8192);
    f32x4 q[4];
    { const f32x4 g = *(const f32x4*)(F.inf(I_GMQ) + 4 * l31);
#pragma unroll
      for (int t = 0; t < 4; ++t) { const v2u raw = *(const v2u*)(F.w<bf16>(WS_MQ) + (size_t)(TP + 4 * s + t) * 512 + h * 128 + 4 * l31);
          f32x4 x = (f32x4){bflo(raw.x), bfhi(raw.x), bflo(raw.y), bfhi(raw.y)};
          float ss = (x[0] * x[0] + x[1] * x[1]) + (x[2] * x[2] + x[3] * x[3]);
          ss += __shfl_xor(ss, 1); ss += __shfl_xor(ss, 2); ss += __shfl_xor(ss, 4); ss += __shfl_xor(ss, 8); ss += __shfl_xor(ss, 16);
          const float rs = rsqrtf(ss * (1.f / 128.f) + EPS) * 0.08838834764831845f;
          q[t] = x * rs * g; } }
    const size_t cbase = ((size_t)(s * 256 + 64 * kq) * 4 + h) * 128 + 4 * l31;
    const float* Kc = F.inf(I_CMK) + cbase; const float* Vc = F.inf(I_CMV) + cbase;
    const bool b4 = (l31 & 16) != 0, b3 = (l31 & 8) != 0, b2 = (l31 & 4) != 0, b1 = (l31 & 2) != 0;
#pragma unroll 1
    for (int kp = 0; kp < 32; kp += 16) {
        f32x4 kv[16];
#pragma unroll
        for (int u = 0; u < 16; ++u) kv[u] = __builtin_nontemporal_load((const f32x4*)(Kc + (size_t)(2 * (kp + u) + hh) * 512));
#pragma unroll
        for (int t = 0; t < 4; ++t) {
            float pt[16], v8[8], v4[4], v2[2];
#pragma unroll
            for (int u = 0; u < 16; ++u) pt[u] = (kv[u][0] * q[t][0] + kv[u][1] * q[t][1]) + (kv[u][2] * q[t][2] + kv[u][3] * q[t][3]);
#pragma unroll
            for (int i = 0; i < 8; ++i) { const float send = b4 ? pt[i] : pt[8 + i], keep = b4 ? pt[8 + i] : pt[i]; v8[i] = keep + __shfl_xor(send, 16); }
#pragma unroll
            for (int i = 0; i < 4; ++i) { const float send = b3 ? v8[i] : v8[4 + i], keep = b3 ? v8[4 + i] : v8[i]; v4[i] = keep + __shfl_xor(send, 8); }
#pragma unroll
            for (int i = 0; i < 2; ++i) { const float send = b2 ? v4[i] : v4[2 + i], keep = b2 ? v4[2 + i] : v4[i]; v2[i] = keep + __shfl_xor(send, 4); }
            float v1; { const float send = b1 ? v2[0] : v2[1], keep = b1 ? v2[1] : v2[0]; v1 = keep + __shfl_xor(send, 2); }
            v1 += __shfl_xor(v1, 1);
            if ((l31 & 1) == 0) SC[t * 256 + 64 * kq + 2 * (kp + (l31 >> 1)) + hh] = v1;
        }
    }
    f32x4 vv[16];
#pragma unroll
    for (int u = 0; u < 16; ++u) vv[u] = __builtin_nontemporal_load((const f32x4*)(Vc + (size_t)(2 * u + hh) * 512));
    __syncthreads();
    LAS float* PS = (LAS float*)(F.lds + 24576 + pair * 4096);
    float rsum[4];
#pragma unroll
    for (int t = 0; t < 4; ++t) {
        const f32x4 sc = *(const LAS f32x4*)(SC + t * 256 + 4 * lane);
        float m = fmaxf(fmaxf(sc[0], sc[1]), fmaxf(sc[2], sc[3]));
#pragma unroll
        for (int o = 1; o < 64; o <<= 1) m = fmaxf(m, __shfl_xor(m, o));
        f32x4 e; float sum = 0.f;
#pragma unroll
        for (int i = 0; i < 4; ++i) { e[i] = __expf(sc[i] - m); sum += e[i]; }
        *(LAS f32x4*)(PS + t * 256 + 4 * lane) = e;
        rsum[t] = 1.f / wave_sum(sum);
    }
    LDS_WAIT(); asm volatile("" ::: "memory");
    f32x4 o[4]; o[0] = o[1] = o[2] = o[3] = (f32x4){0.f, 0.f, 0.f, 0.f};
#pragma unroll 1
    for (int kp = 0; kp < 32; kp += 16) {
#pragma unroll
        for (int u = 0; u < 16; ++u)
#pragma unroll
            for (int t = 0; t < 4; ++t) { const float p = PS[t * 256 + 64 * kq + 2 * (kp + u) + hh]; o[t] += vv[u] * p; }
        if (kp + 16 < 32) {
#pragma unroll
            for (int u = 0; u < 16; ++u) vv[u] = __builtin_nontemporal_load((const f32x4*)(Vc + (size_t)(2 * (kp + 16 + u) + hh) * 512));
        }
    }
#pragma unroll
    for (int t = 0; t < 4; ++t) {
#pragma unroll
        for (int i = 0; i < 4; ++i) o[t][i] += __shfl_xor(o[t][i], 32);
        if (hh == 0) *(LAS f32x4*)(OP + (kq * 4 + t) * 128 + 4 * l31) = o[t];
    }
    __syncthreads();
    {
        const int t = kq;
        float a0 = 0.f, a1 = 0.f;
#pragma unroll
        for (int k = 0; k < 4; ++k) { a0 += OP[(k * 4 + t) * 128 + 2 * lane]; a1 += OP[(k * 4 + t) * 128 + 2 * lane + 1]; }
        float rs = rsum[0]; rs = (t == 1) ? rsum[1] : rs; rs = (t == 2) ? rsum[2] : rs; rs = (t == 3) ? rsum[3] : rs;
        *(unsigned*)(F.w<bf16>(WS_MO) + (size_t)(TP + 4 * s + t) * 512 + h * 128 + 2 * lane) = cvtpk(a0 * rs, a1 * rs);
    }
    __syncthreads();
}
__device__ __forceinline__ void p10_memattn(Frame& F) {
    const float negM = -(LOG2E * 11.313708498984761f * gain_absmax(F.inf(I_GMQ), 128, F.lane) * gain_absmax(F.inf(I_GMK), 128, F.lane) * 1.01f);
    const int gw = F.bid * NWAVES + F.wave, NGW = F.G * NWAVES;
#pragma unroll 1
    for (int pass = 0; pass < 2; ++pass) {
        F.tid = opaque_i(F.tid); F.lane = F.tid & 63;
        if ((pass == 0) == (((F.bid >> 3) & 1) == 0)) memattn_prompt_unit(F, F.bid >> 2, F.bid & 3, negM);
        else memattn_sample_wg(F, F.bid);
    }
}

__device__ __forceinline__ void p15_pre(Frame& F, int pm) {
    const float* wc = F.inf(I_WCONV); const float* bc = F.inf(I_BCONV);
    {
        const bf16* UPS = F.w<bf16>(WS_UP); const float* st = F.inf(I_CONVST);
        for (int it = F.bid * 512 + F.tid; it < TSMP * 352; it += F.G * 512) {
            const int rs = it / 352, ch = it % 352, f = 8 * ch, t = rs & 3, n = rs >> 2;
            const int cg = 256 * (f >> 7) + (f & 127);
            float g0[8], g1[8], g2[8], vv[8];
            { const v4u a = *(const v4u*)(UPS + (size_t)rs * (2 * DFF) + cg), v = *(const v4u*)(UPS + (size_t)rs * (2 * DFF) + cg + 128);
#pragma unroll
              for (int i = 0; i < 4; ++i) { g0[2 * i] = bflo(a[i]); g0[2 * i + 1] = bfhi(a[i]); vv[2 * i] = bflo(v[i]); vv[2 * i + 1] = bfhi(v[i]); } }
            if (t >= 1) { const v4u a = *(const v4u*)(UPS + (size_t)(rs - 1) * (2 * DFF) + cg);
#pragma unroll
                for (int i = 0; i < 4; ++i) { g1[2 * i] = bflo(a[i]); g1[2 * i + 1] = bfhi(a[i]); } }
            else { const float* sp = st + (size_t)(n * 2 + 1) * DFF + f; const f32x4 a = *(const f32x4*)sp, b = *(const f32x4*)(sp + 4);
#pragma unroll
                for (int i = 0; i < 4; ++i) { g1[i] = a[i]; g1[4 + i] = b[i]; } }
            if (t >= 2) { const v4u a = *(const v4u*)(UPS + (size_t)(rs - 2) * (2 * DFF) + cg);
#pragma unroll
                for (int i = 0; i < 4; ++i) { g2[2 * i] = bflo(a[i]); g2[2 * i + 1] = bfhi(a[i]); } }
            else { const float* sp = st + (size_t)(n * 2 + t) * DFF + f; const f32x4 a = *(const f32x4*)sp, b = *(const f32x4*)(sp + 4);
#pragma unroll
                for (int i = 0; i < 4; ++i) { g2[i] = a[i]; g2[4 + i] = b[i]; } }
            float hv[8];
#pragma unroll
            for (int i = 0; i < 8; ++i) { const float c = bc[f + i] + g2[i] * wc[f + i] + g1[i] * wc[DFF + f + i] + g0[i] * wc[2 * DFF + f + i]; hv[i] = c / (1.f + __expf(-c)) * vv[i]; }
            v4u o; o.x = cvtpk(hv[0], hv[1]); o.y = cvtpk(hv[2], hv[3]); o.z = cvtpk(hv[4], hv[5]); o.w = cvtpk(hv[6], hv[7]);
            *(v4u*)(F.w<bf16>(WS_HID) + (size_t)(TP + rs) * DFF + f) = o;
            if (t >= 2) { float* co = F.out + O_SCONV + (size_t)(n * 2 + (t - 2)) * DFF + f; *(f32x4*)co = (f32x4){g0[0], g0[1], g0[2], g0[3]}; *(f32x4*)(co + 4) = (f32x4){g0[4], g0[5], g0[6], g0[7]}; }
        }
    }
    if ((pm & 7) != 0) {
        const bf16* R0 = F.w<bf16>(WS_RAW01) + (size_t)pm * 2 * (2 * DFF); const float* G = F.w<float>(WS_RAWG) + (size_t)(pm - 1) * 2 * DFF;
        if (F.tid < DFF / 8) {
            const int f = 8 * F.tid;
            const v4u rg0 = *(const v4u*)(R0 + f), rv0 = *(const v4u*)(R0 + DFF + f), rg1 = *(const v4u*)(R0 + 2 * DFF + f), rv1 = *(const v4u*)(R0 + 3 * DFF + f);
            float hv0[8], hv1[8];
#pragma unroll
            for (int q = 0; q < 2; ++q) {
                const f32x4 gm2 = *(const f32x4*)(G + f + 4 * q), gm1 = *(const f32x4*)(G + DFF + f + 4 * q);
                const f32x4 w0 = *(const f32x4*)(wc + f + 4 * q), w1 = *(const f32x4*)(wc + DFF + f + 4 * q), w2 = *(const f32x4*)(wc + 2 * DFF + f + 4 * q), b = *(const f32x4*)(bc + f + 4 * q);
#pragma unroll
                for (int e = 0; e < 4; ++e) { const int i = 4 * q + e; const unsigned wg0 = rg0[i >> 1], wv0 = rv0[i >> 1], wg1 = rg1[i >> 1], wv1 = rv1[i >> 1];
                    const float g0 = (i & 1) ? bfhi(wg0) : bflo(wg0), v0 = (i & 1) ? bfhi(wv0) : bflo(wv0), g1 = (i & 1) ? bfhi(wg1) : bflo(wg1), v1 = (i & 1) ? bfhi(wv1) : bflo(wv1);
                    const float c0 = b[e] + gm2[e] * w0[e] + gm1[e] * w1[e] + g0 * w2[e], c1 = b[e] + gm1[e] * w0[e] + g0 * w1[e] + g1 * w2[e];
                    hv0[i] = c0 / (1.f + __expf(-c0)) * v0; hv1[i] = c1 / (1.f + __expf(-c1)) * v1; }
            }
            v4u o0, o1; o0.x = cvtpk(hv0[0], hv0[1]); o0.y = cvtpk(hv0[2], hv0[3]); o0.z = cvtpk(hv0[4], hv0[5]); o0.w = cvtpk(hv0[6], hv0[7]);
            o1.x = cvtpk(hv1[0], hv1[1]); o1.y = cvtpk(hv1[2], hv1[3]); o1.z = cvtpk(hv1[4], hv1[5]); o1.w = cvtpk(hv1[6], hv1[7]);
            *(v4u*)(F.w<bf16>(WS_HID) + (size_t)(256 * pm) * DFF + f) = o0; *(v4u*)(F.w<bf16>(WS_HID) + (size_t)(256 * pm + 1) * DFF + f) = o1;
        }
    }
    VM_WAIT();
    __syncthreads();
}
}
namespace mk {
template <int K, bool RES_BF16, bool OUT_BF16, bool HAS_RES = true>
__device__ __forceinline__ void small_gemm_unit(Frame& F, const bf16* A, const bf16* Bt, int rbk, int cbk, const void* res, void* out, int ldc, float* ssq_out = nullptr, const float* ssq_in = nullptr) {
    static_assert(K % 64 == 0, "K in chunks of 64");
    constexpr int NCH = K / 64;
    const int lane = F.lane, w = F.wave, l31 = lane & 31, hh = lane >> 5, tid = F.tid, lr = lane >> 3, lc = lane & 7;
    LAS unsigned char* Tl = F.lds + w * 16384;
    const bf16* Ag = A + (size_t)(32 * rbk + lr) * K + 8 * lc;
    const bf16* Bg = Bt + (size_t)(64 * cbk + lr) * K + 8 * lc;
    f32x16 a0 = {}, a1 = {};
    v4u ra[4], rbv[8];
    int c = w;
    if (c < NCH) {
#pragma unroll
        for (int j = 0; j < 4; ++j) ra[j] = *(const v4u*)(Ag + (size_t)(8 * j) * K + 64 * c);
#pragma unroll
        for (int j = 0; j < 8; ++j) rbv[j] = *(const v4u*)(Bg + (size_t)(8 * j) * K + 64 * c);
    }
#pragma unroll 1
    for (; c < NCH; c += 8) {
#pragma unroll
        for (int j = 0; j < 4; ++j) *(LAS v4u*)(Tl + (lr + 8 * j) * 144 + 16 * lc) = ra[j];
#pragma unroll
        for (int j = 0; j < 8; ++j) *(LAS v4u*)(Tl + (32 + lr + 8 * j) * 144 + 16 * lc) = rbv[j];
        LDS_WAIT(); asm volatile("" ::: "memory");
        if (c + 8 < NCH) {
#pragma unroll
            for (int j = 0; j < 4; ++j) ra[j] = *(const v4u*)(Ag + (size_t)(8 * j) * K + 64 * (c + 8));
#pragma unroll
            for (int j = 0; j < 8; ++j) rbv[j] = *(const v4u*)(Bg + (size_t)(8 * j) * K + 64 * (c + 8));
        }
#pragma unroll
        for (int s = 0; s < 4; ++s) {
            const bf16x8 af = *(const LAS bf16x8*)(Tl + l31 * 144 + 32 * s + 16 * hh), b0 = *(const LAS bf16x8*)(Tl + (32 + l31) * 144 + 32 * s + 16 * hh), b1 = *(const LAS bf16x8*)(Tl + (64 + l31) * 144 + 32 * s + 16 * hh);
            a0 = __builtin_amdgcn_mfma_f32_32x32x16_bf16(af, b0, a0, 0, 0, 0); a1 = __builtin_amdgcn_mfma_f32_32x32x16_bf16(af, b1, a1, 0, 0, 0);
        }
        LDS_WAIT(); asm volatile("" ::: "memory");
    }
    __syncthreads();
    LAS float* RED = (LAS float*)F.lds + w * 2048;
#pragma unroll
    for (int i = 0; i < 16; ++i) { const int r = (i & 3) + 8 * (i >> 2) + 4 * hh; RED[r * 64 + l31] = a0[i]; RED[r * 64 + 32 + l31] = a1[i]; }
    __syncthreads();
    { const int r = tid >> 4, c4 = (tid & 15) * 4; const size_t off = (size_t)(32 * rbk + r) * ldc + 64 * cbk + c4;
      f32x4 sum;
      if (!HAS_RES) sum = (f32x4){0.f, 0.f, 0.f, 0.f}; else if (RES_BF16) { const v2u rw = *(const v2u*)((const bf16*)res + off); sum = (f32x4){bflo(rw.x), bfhi(rw.x), bflo(rw.y), bfhi(rw.y)}; } else sum = *(const f32x4*)((const float*)res + off);
#pragma unroll
      for (int k = 0; k < 8; ++k) sum += *(const LAS f32x4*)((LAS float*)F.lds + k * 2048 + r * 64 + c4);
      if (ssq_in) { float t = ssq_in[(size_t)(32 * rbk + r) * 16 + (tid & 15)]; t += __shfl_xor(t, 1); t += __shfl_xor(t, 2); t += __shfl_xor(t, 4); t += __shfl_xor(t, 8); sum = sum * rsqrtf(t * (1.f / 1024.f) + EPS); }
      if (ssq_out) { float s2 = (sum[0] * sum[0] + sum[1] * sum[1]) + (sum[2] * sum[2] + sum[3] * sum[3]); s2 += __shfl_xor(s2, 1); s2 += __shfl_xor(s2, 2); s2 += __shfl_xor(s2, 4); s2 += __shfl_xor(s2, 8);
          if ((tid & 15) == 0) ssq_out[(size_t)(32 * rbk + r) * 16 + cbk] = s2; }
      if (OUT_BF16) { v2u wb; wb.x = cvtpk(sum[0], sum[1]); wb.y = cvtpk(sum[2], sum[3]); *(v2u*)((bf16*)out + off) = wb; } else *(f32x4*)((float*)out + off) = sum; }
    __syncthreads();
}
}
namespace mk {
constexpr int N_PHASES = 16;
__global__ void __launch_bounds__(NWAVES * 64, 2) mk_fwd(Args args) {
    extern __shared__ __attribute__((aligned(16))) unsigned char lds[];
    Frame F;
    F.lds = (LAS unsigned char*)lds; F.lds_g = lds;
    F.tid = threadIdx.x; F.lane = F.tid & 63; F.wave = __builtin_amdgcn_readfirstlane(F.tid >> 6);
    F.G = gridDim.x; F.bid = blockIdx.x;
    F.ws = args.ws; F.out = args.out; F.in = (const float* const*)args.in;
    volatile LAS unsigned* MISC = (volatile LAS unsigned*)(F.lds + MISC_OFF);
    for (int u = F.tid; u < (LDS_BYTES - RING_BYTES) / 4; u += NWAVES * 64) ((LAS unsigned*)(F.lds + RING_BYTES))[u] = 0u;
    __syncthreads();
    unsigned* ctl = (unsigned*)(F.ws + WS_CTL);
    XcdBarrier bar = xcd_barrier_post(ctl + CW_BAR, MISC + 8);
    const int lo = args.ph_lo, hi = args.ph_hi;
    if (F.G != 256) return;
#define IN(k) (lo <= (k) && (k) < hi)
#ifdef MK_TIMING
    unsigned long long* stamps = (unsigned long long*)(F.ws + WS_CTL + (768 << 10));
#define STAMP(k) do { if (F.tid == 0) stamps[F.bid * 32 + (k)] = __builtin_amdgcn_s_memrealtime(); } while (0)
#else
#define STAMP(k) do {} while (0)
#endif
#define SEAM(k) do { if (IN(k) && IN((k) + 1)) xcd_barrier(bar); STAMP((k) + 1); F.tid = opaque_i(F.tid); F.lane = F.tid & 63; } while (0)
    STAMP(0);

    if (IN(0)) { p0_prologue(F); }
    SEAM(0);
    if (IN(1)) {
        { pg8::Gemm g{F.w<bf16>(WS_XN), F.w<bf16>(WS_W_IN), T, NINP, D}; pg8::StaticOrder S; S.init(T, NINP, F.G, F.bid);
          pg8::EpiBf16 E{F.w<bf16>(WS_Z), NINP, 1.f};
          pg8::gemm_phase<pg8::EpiBf16, pg8::StaticOrder, true, true>(F.lds, g, S, E); }
        { pg8::Gemm g{F.w<bf16>(WS_MN), F.w<bf16>(WS_W_MKV), 2048, 1024, D}; pg8::StaticOrder S; S.init(2048, 1024, F.G, (F.bid + F.G - 206) % F.G);
          pg8::EpiBf16 E{F.w<bf16>(WS_MKV), 1024, 1.f};
          pg8::gemm_phase<pg8::EpiBf16, pg8::StaticOrder, true, true>(F.lds, g, S, E); }
    }
    SEAM(1);
    if (IN(2)) { p2_post_inproj(F); }
    SEAM(2);
    if (IN(3)) {
        { pg8::Gemm g{F.w<bf16>(WS_CQN), F.w<bf16>(WS_W_UQ), T, 768, 256}; pg8::StaticOrder S; S.init(T, 768, F.G, F.bid);
          pg8::EpiBf16 E{F.w<bf16>(WS_QR), 768, 1.f};
          pg8::gemm_phase<pg8::EpiBf16, pg8::StaticOrder, true, true>(F.lds, g, S, E); }
        { pg8::Gemm g{F.w<bf16>(WS_CKVN), F.w<bf16>(WS_W_UK), TP, 512, 256}; pg8::StaticOrder S; S.init(TP, 512, F.G, (F.bid + F.G - 198) % F.G);
          pg8::EpiBf16 E{F.w<bf16>(WS_KNR), 512, 1.f};
          pg8::gemm_phase<pg8::EpiBf16, pg8::StaticOrder, true, true>(F.lds, g, S, E); }
        { pg8::Gemm g{F.w<bf16>(WS_W_UV), F.w<bf16>(WS_CKVN), 512, TP, 256}; pg8::StaticOrder S; S.init(512, TP, F.G, (F.bid + F.G - 70) % F.G);
          pg8::EpiBf16 E{F.w<bf16>(WS_VT), TP, 1.f};
          pg8::gemm_phase<pg8::EpiBf16, pg8::StaticOrder, true, true>(F.lds, g, S, E); }
    }
    SEAM(3);
    if (IN(4)) { p4_qk_norm_rope(F); p4_qext(F); }
    SEAM(4);
    if (IN(5)) {
        const float mq_ = gain_absmax(F.inf(I_GQKQ), 96, F.lane), mk2_ = gain_absmax(F.inf(I_GQKK), 96, F.lane);
        const float negM = -(LOG2E * 9.797958971132712f * mq_ * mk2_ * 1.01f);
#pragma unroll 1
        for (int pass = 0; pass < 3; ++pass) {
            F.tid = opaque_i(F.tid); F.lane = F.tid & 63;
            if (pass == 1) { STAMP(20); attn_sample_unit(F, F.bid >> 1, F.bid & 1, negM); STAMP(21); }
            else if ((pass == 0) == (((F.bid >> 3) & 1) != 0)) { STAMP(22); p5_attn_prompt(F, negM); STAMP(23); }
        }
    }
    SEAM(5);
    if (IN(6)) { p6_merge(F); }
    SEAM(6);
    if (IN(7)) { pg8::Gemm g{F.w<bf16>(WS_MRG), F.w<bf16>(WS_W_O), TP, 1024, 1024}; pg8::StaticOrder S; S.init(TP, 1024, F.G, F.bid);
        pg8::EpiResN<false> E{F.inf(I_XP), F.inf(I_XS), TP / 256, F.w<bf16>(WS_X1), F.w<float>(WS_SSQ1), 1024};
        pg8::gemm_phase<pg8::EpiResN<false>, pg8::StaticOrder, true, true>(F.lds, g, S, E);
        small_gemm_unit<1024, false, true>(F, F.w<bf16>(WS_MRG) + (size_t)TP * 1024, F.w<bf16>(WS_W_O), F.bid >> 4, F.bid & 15, F.inf(I_XS), F.w<bf16>(WS_X1) + (size_t)TP * 1024, 1024, F.w<float>(WS_SSQ1) + (size_t)TP * 16); }
    SEAM(7);
    STAMP(9);
    if (IN(9)) { pg8::Gemm g{F.w<bf16>(WS_X1), F.w<bf16>(WS_W_MQ), T, 512, 1024}; pg8::StaticOrder S; S.init(T, 512, F.G, F.bid);
        pg8::EpiBf16S E{F.w<bf16>(WS_MQ), 512, F.w<float>(WS_SSQ1), EPS};
        pg8::gemm_phase<pg8::EpiBf16S, pg8::StaticOrder, true, true>(F.lds, g, S, E);
        if (F.bid >= 132) p0_transposes<9, 11>(F, (F.bid - 132) * NWAVES + F.wave, (F.G - 132) * NWAVES); }
    SEAM(9);
    if (IN(10)) { p10_memattn(F); }
    SEAM(10);
    if (IN(11)) { pg8::Gemm g{F.w<bf16>(WS_MO), F.w<bf16>(WS_W_MO), TP, 1024, 512}; pg8::StaticOrder S; S.init(TP, 1024, F.G, F.bid);
        pg8::EpiResN<true> E{F.w<bf16>(WS_X1), F.w<bf16>(WS_X1), 1 << 20, F.w<bf16>(WS_X2), F.w<float>(WS_SSQ2), 1024};
        pg8::gemm_phase<pg8::EpiResN<true>, pg8::StaticOrder, true, true>(F.lds, g, S, E);
        small_gemm_unit<512, true, true>(F, F.w<bf16>(WS_MO) + (size_t)TP * 512, F.w<bf16>(WS_W_MO), F.bid >> 4, F.bid & 15, F.w<bf16>(WS_X1) + (size_t)TP * 1024, F.w<bf16>(WS_X2) + (size_t)TP * 1024, 1024, F.w<float>(WS_SSQ2) + (size_t)TP * 16); }
    SEAM(11);
    STAMP(12); STAMP(13);
    if (IN(13)) { pg8::Gemm g{F.w<bf16>(WS_X2), F.w<bf16>(WS_W_UP), TP, 2 * DFF, 1024}; pg8::StaticOrder S; S.init(TP, 2 * DFF, F.G, F.bid);
        pg8::EpiUpFused E{F.w<bf16>(WS_HID), F.inf(I_WCONV), F.inf(I_BCONV), F.w<bf16>(WS_RAW01), F.w<float>(WS_RAWG), F.out + O_PCONV, (LAS float*)(F.lds + 131072), DFF, (const LAS float*)(F.lds + 135168)};
        { LAS float* rt = (LAS float*)(F.lds + 135168); const float* sq = F.w<float>(WS_SSQ2) + (size_t)(F.bid & 7) * 2048 * 16;
          f32x4 p[4][4];
#pragma unroll
          for (int k = 0; k < 4; ++k)
#pragma unroll
              for (int q = 0; q < 4; ++q) p[k][q] = *(const f32x4*)(sq + (size_t)(F.tid + 512 * k) * 16 + 4 * q);
#pragma unroll
          for (int k = 0; k < 4; ++k) { const f32x4 t = (p[k][0] + p[k][1]) + (p[k][2] + p[k][3]); rt[F.tid + 512 * k] = rsqrtf(((t[0] + t[1]) + (t[2] + t[3])) * (1.f / 1024.f) + EPS); }
          __syncthreads(); }
        pg8::gemm_phase<pg8::EpiUpFused, pg8::StaticOrder, true, true>(F.lds, g, S, E);
        if (F.bid >= 128) { for (int su = F.bid - 128; su < 16 * 88; su += 128)
            small_gemm_unit<1024, false, true, false>(F, F.w<bf16>(WS_X2) + (size_t)TP * 1024, F.w<bf16>(WS_W_UP), su / 88, su % 88, nullptr, F.w<bf16>(WS_UP), 2 * DFF, nullptr, F.w<float>(WS_SSQ2) + (size_t)TP * 16); } }
    SEAM(13);
    if (IN(15)) { pg8::Gemm g{F.w<bf16>(WS_HID), F.w<bf16>(WS_W_DN), TP, 1024, DFF}; pg8::StaticOrder S; S.init(TP, 1024, F.G, F.bid);
        p15_pre(F, 8 * (F.bid & 7) + ((F.bid >> 3) & 7));
        if (F.tid == 0) { const unsigned nloc = bar.st[0]; const unsigned old = xb_add(ctl + CW_HIDS + 64 * bar.x, 1u);
            if (old + 1u == nloc) { __builtin_amdgcn_fence(__ATOMIC_RELEASE, "agent"); asm volatile("s_waitcnt vmcnt(0)" ::: "memory"); (void)xb_add(ctl + CW_HIDS + 64 * 16, 1u); } }
        pg8::EpiRes<true, false> E{F.w<bf16>(WS_X2), F.w<bf16>(WS_X2), 1 << 20, F.out + O_YP, 1024};
        pg8::gemm_phase<pg8::EpiRes<true, false>, pg8::StaticOrder, true, true>(F.lds, g, S, E);
        if (F.tid == 0) { const unsigned nx = bar.st[1]; XB_SPIN(xb_ld(ctl + CW_HIDS + 64 * 16) < nx, ctl + CW_BAR); __builtin_amdgcn_fence(__ATOMIC_ACQUIRE, "agent"); asm volatile("s_waitcnt vmcnt(0)" ::: "memory"); }
        __syncthreads();
        small_gemm_unit<DFF, true, false>(F, F.w<bf16>(WS_HID) + (size_t)TP * DFF, F.w<bf16>(WS_W_DN), F.bid >> 4, F.bid & 15, F.w<bf16>(WS_X2) + (size_t)TP * 1024, F.out + O_YS, 1024); }
#ifdef MK_TIMING
    xcd_barrier(bar); STAMP(16);
    xcd_barrier(bar);
    if (F.bid == 0) {
        volatile LAS float* s_ca = (volatile LAS float*)(F.lds + RING_BYTES + 1024);
#define s_c s_ca[0]
#define s_a s_ca[1]
        if (F.tid == 0) {
            unsigned long long a0 = ~0ull, a1 = 0, b0 = ~0ull, b1 = 0;
#ifdef MK_TPERWG
            unsigned long long ma = 0, mb = 0;
            for (int w = 0; w < 256; ++w) { const unsigned long long* st = stamps + w * 32; const unsigned long long xa = st[MK_TA_HI] - st[MK_TA_LO], xb = st[MK_TB_HI] - st[MK_TB_LO]; ma = xa > ma ? xa : ma; mb = xb > mb ? xb : mb; }
            a0 = 0; a1 = ma; b0 = 0; b1 = mb;
#else
            for (int w = 0; w < 256; ++w) { const unsigned long long* st = stamps + w * 32;
                a0 = st[MK_TA_LO] < a0 ? st[MK_TA_LO] : a0; a1 = st[MK_TA_HI] > a1 ? st[MK_TA_HI] : a1; b0 = st[MK_TB_LO] < b0 ? st[MK_TB_LO] : b0; b1 = st[MK_TB_HI] > b1 ? st[MK_TB_HI] : b1; }
#endif
            const float da = (float)(a1 - a0) * 0.01f, db = (float)(b1 - b0) * 0.01f;
            s_c = sqrtf(da * 1e-4f); s_a = db * 0.1f;
        }
        __syncthreads();
        float* sk = F.out + O_SKPE;
        for (int i = F.tid; i < 16384; i += 512) sk[i] *= (1.f + s_c);
        if (F.tid == 0) F.out[O_YP] += s_a;
#undef s_c
#undef s_a
    }
#endif
#undef IN
#undef SEAM
}
}
extern "C" void kernel_launch(void* const* d_in, const int* in_sizes, int n_in, void* d_out, int out_size, void* d_ws, size_t ws_size, hipStream_t stream) {
    using namespace mk;
    static int ready = 0;
    if (ready == 0) {
        if (n_in != 38 || out_size != 25292800 || ws_size < WS_MK_END) { fprintf(stderr, "kernel_launch: unexpected n_in %d / out_size %d / ws %zu\n", n_in, out_size, ws_size); ready = -1; return; }
        if (hipFuncSetAttribute((const void*)mk_fwd, hipFuncAttributeMaxDynamicSharedMemorySize, LDS_BYTES) != hipSuccess) { fprintf(stderr, "kernel_launch: hipFuncSetAttribute failed\n"); ready = -1; return; }
        int dev = 0, cus = 0, per_cu = 0;
        (void)hipGetDevice(&dev); (void)hipDeviceGetAttribute(&cus, hipDeviceAttributeMultiprocessorCount, dev);
        (void)hipOccupancyMaxActiveBlocksPerMultiprocessor(&per_cu, (const void*)mk_fwd, NWAVES * 64, LDS_BYTES);
        if (cus < 256 || per_cu < 1) fprintf(stderr, "kernel_launch: note: %d CUs, occupancy query %d (this kernel needs 256 resident workgroups of %d B LDS)\n", cus, per_cu, LDS_BYTES);
        (void)hipGetLastError();
        ready = 1;
    }
    if (ready < 0) return;
    (void)hipMemsetAsync((unsigned char*)d_ws + WS_CTL, 0, CTL_ZERO_BYTES, stream);
    Args a{}; for (int i = 0; i < 38; ++i) a.in[i] = d_in[i];
    a.out = (float*)d_out; a.ws = (unsigned char*)d_ws; a.ph_lo = 0; a.ph_hi = N_PHASES;
    hipLaunchKernelGGL(mk_fwd, dim3(256), dim3(NWAVES * 64), LDS_BYTES, stream, a);
}
```

```cpp
#include <hip/hip_runtime.h>
#include <cstdio>
#include <cstdint>
#include <cmath>
#define GAS __attribute__((address_space(1)))
#define LAS __attribute__((address_space(3)))
typedef unsigned short bf16;
typedef unsigned v4u __attribute__((ext_vector_type(4)));
typedef unsigned v2u __attribute__((ext_vector_type(2)));
typedef float f32x4 __attribute__((ext_vector_type(4)));
typedef float f32x16 __attribute__((ext_vector_type(16)));
typedef short bf16x8 __attribute__((ext_vector_type(8)));
typedef short s16x4 __attribute__((ext_vector_type(4)));
#define LDS_WAIT() asm volatile("s_waitcnt lgkmcnt(0)" ::: "memory")
#define VM_WAIT() asm volatile("s_waitcnt vmcnt(0)" ::: "memory")
__device__ __forceinline__ unsigned f2bf(float f) { unsigned u = __builtin_bit_cast(unsigned, f); return (u + 0x7fffu + ((u >> 16) & 1u)) >> 16; }
__device__ __forceinline__ unsigned pk2(float lo, float hi) { return f2bf(lo) | (f2bf(hi) << 16); }
typedef float f32x2_t __attribute__((ext_vector_type(2))); typedef __bf16 bf16x2_t __attribute__((ext_vector_type(2)));
__device__ __forceinline__ unsigned cvtpk(float lo, float hi) { f32x2_t v = {lo, hi}; bf16x2_t b = __builtin_convertvector(v, bf16x2_t); return __builtin_bit_cast(unsigned, b); }
__device__ __forceinline__ float bf2f(unsigned short b) { return __builtin_bit_cast(float, (unsigned)b << 16); }
__device__ __forceinline__ float bflo(unsigned w) { return __builtin_bit_cast(float, w << 16); }
__device__ __forceinline__ float bfhi(unsigned w) { return __builtin_bit_cast(float, w & 0xffff0000u); }
__device__ __forceinline__ int opaque_i(int x) { asm volatile("" : "+v"(x)); return x; }
__device__ __forceinline__ float wave_sum(float v) {
#pragma unroll
    for (int o = 1; o < 64; o <<= 1) v += __shfl_xor(v, o);
    return v;
}
__device__ __forceinline__ float gelu_tanh_f(float x) {
    const float t = x * (-2.3022082062f - 0.1029432457f * x * x);
    return x * __builtin_amdgcn_rcpf(1.f + __builtin_amdgcn_exp2f(t));
}
namespace pg8 {
#define PG8_LAS __attribute__((address_space(3)))
typedef unsigned short bf16_t;
typedef short bf16x8 __attribute__((ext_vector_type(8)));
typedef float f32x4 __attribute__((ext_vector_type(4)));
typedef unsigned u32x4 __attribute__((ext_vector_type(4)));
constexpr int BM = 256, BK = 64, HALF = 128, HTB = HALF * BK * 2  , STAGE_BYTES = 8 * HTB, NXCD = 8, WGM = 8;

__host__ __device__ __forceinline__ int lds_byte(int r, int c) { const int st = (r >> 4) * 2 + (c >> 5), rr = r & 15, cc = c & 31, ob = rr * 64 + cc * 2; return st * 1024 + (ob ^ (((ob >> 9) & 1) << 5)); }
__host__ __device__ __forceinline__ void stage_rc(int b, int& R, int& C) { const int st = b / 1024, sb = b % 1024, swz = sb ^ (((sb >> 9) & 1) << 5); R = (st >> 1) * 16 + swz / 64; C = (st & 1) * 32 + (swz % 64) / 2; }
__host__ __device__ __forceinline__ int perm32(int rho) { const int n = rho >> 4, i = rho & 15; return 8 * (i >> 2) + 4 * n + (i & 3); }

struct Unit { int pm, pn; };
struct Gemm { const bf16_t* A; const bf16_t* Bt; int M, N, K; };

struct StaticOrder {
    int nM, nN, nwg, G, c;
    __host__ __device__ void init(int M, int N, int G_, int c_) { nM = M / BM; nN = N / BM; nwg = nM * nN; G = G_; c = c_; }
    __host__ __device__ bool next(int i, Unit& u) const {
        const long L = (long)i * G + c; if (L >= nwg) return false;
        int wgid = (int)L; { const int q = nwg / NXCD, r = nwg % NXCD, xcd = wgid % NXCD, off = wgid / NXCD; wgid = (xcd < r ? xcd * (q + 1) : r * (q + 1) + (xcd - r) * q) + off; }
        const int nig = WGM * nN, gid = wgid / nig, fm = gid * WGM, gsz = (nM - fm) < WGM ? (nM - fm) : WGM;
        u.pm = fm + ((wgid % nig) % gsz); u.pn = (wgid % nig) / gsz; return true;
    }
    __device__ __forceinline__ void a_ready(const Unit&) const {}
    __device__ __forceinline__ void done(const Unit&) const {}
};

__device__ __forceinline__ unsigned cvt_pk_bf16(float lo, float hi) { unsigned r; asm volatile("v_cvt_pk_bf16_f32 %0, %1, %2" : "=v"(r) : "v"(lo), "v"(hi)); return r; }
typedef float f32x2 __attribute__((ext_vector_type(2)));
struct EpiBf16 {
    static constexpr bool PERM = true, AFTER_DRAIN = false;
    bf16_t* O; int ldc; float scale;
    __device__ __forceinline__ void operator()(const f32x4 (&acc)[2][2][4][2], const Unit& u, int wr, int wc, int fr, int fq) const {
        const int row0 = u.pm * BM + wr * 64 + fr; const int col0 = u.pn * BM + wc * 32 + 8 * fq;
#pragma unroll
        for (int ai = 0; ai < 2; ++ai)
#pragma unroll
            for (int m = 0; m < 4; ++m) { bf16_t* rowp = O + (size_t)(row0 + ai * HALF + m * 16) * ldc + col0;
#pragma unroll
                for (int bj = 0; bj < 2; ++bj) { const f32x4 v0 = acc[ai][bj][m][0] * scale, v1 = acc[ai][bj][m][1] * scale;
                    u32x4 w; w.x = cvt_pk_bf16(v0[0], v0[1]); w.y = cvt_pk_bf16(v0[2], v0[3]); w.z = cvt_pk_bf16(v1[0], v1[1]); w.w = cvt_pk_bf16(v1[2], v1[3]);
                    *(u32x4*)(rowp + bj * HALF) = w; } }
    }
};
struct EpiResF32 {
    static constexpr bool PERM = false, AFTER_DRAIN = false;
    const float* res0; const float* res1; int split_pm; float* out; int ldc;
    __device__ __forceinline__ void operator()(const f32x4 (&acc)[2][2][4][2], const Unit& u, int wr, int wc, int fr, int fq) const {
        const int row0 = u.pm * BM + wr * 64 + fr; const int col0 = u.pn * BM + wc * 32 + 4 * fq;
        const float* rb = (u.pm < split_pm) ? res0 : res1 - (size_t)split_pm * BM * ldc;
#pragma unroll
        for (int ai = 0; ai < 2; ++ai)
#pragma unroll
            for (int m = 0; m < 4; ++m) { const size_t off = (size_t)(row0 + ai * HALF + m * 16) * ldc + col0;
#pragma unroll
                for (int bj = 0; bj < 2; ++bj)
#pragma unroll
                    for (int n = 0; n < 2; ++n) { const f32x4 r = *(const f32x4*)(rb + off + bj * HALF + n * 16); *(f32x4*)(out + off + bj * HALF + n * 16) = acc[ai][bj][m][n] + r; }
                if (m & 1) asm volatile("" ::: "memory"); }
    }
};
struct EpiResF32N {
    static constexpr bool PERM = false, AFTER_DRAIN = false;
    const float* res0; const float* res1; int split_pm; float* out; bf16_t* outb; float* ssq; int ldc;
    __device__ __forceinline__ void operator()(const f32x4 (&acc)[2][2][4][2], const Unit& u, int wr, int wc, int fr, int fq) const {
        const int row0 = u.pm * BM + wr * 64 + fr; const int col0 = u.pn * BM + wc * 32 + 4 * fq;
        const float* rb = (u.pm < split_pm) ? res0 : res1 - (size_t)split_pm * BM * ldc;
#pragma unroll
        for (int ai = 0; ai < 2; ++ai)
#pragma unroll
            for (int m = 0; m < 4; ++m) { const int row = row0 + ai * HALF + m * 16; const size_t off = (size_t)row * ldc + col0; float s = 0.f;
#pragma unroll
                for (int bj = 0; bj < 2; ++bj)
#pragma unroll
                    for (int n = 0; n < 2; ++n) { const f32x4 r = *(const f32x4*)(rb + off + bj * HALF + n * 16); const f32x4 v = acc[ai][bj][m][n] + r; *(f32x4*)(out + off + bj * HALF + n * 16) = v;
                        s += (v[0] * v[0] + v[1] * v[1]) + (v[2] * v[2] + v[3] * v[3]);
                        typedef unsigned u32x2_ __attribute__((ext_vector_type(2))); u32x2_ w; w.x = cvt_pk_bf16(v[0], v[1]); w.y = cvt_pk_bf16(v[2], v[3]); *(u32x2_*)(outb + off + bj * HALF + n * 16) = w; }
                s += __shfl_xor(s, 16); s += __shfl_xor(s, 32);
                if (fq == 0) ssq[(size_t)row * 16 + u.pn * 4 + wc] = s;
                if (m & 1) asm volatile("" ::: "memory"); }
    }
};
struct EpiBf16S {
    static constexpr bool PERM = true, AFTER_DRAIN = false;
    bf16_t* O; int ldc; const float* ssq; float eps;
    __device__ __forceinline__ void operator()(const f32x4 (&acc)[2][2][4][2], const Unit& u, int wr, int wc, int fr, int fq) const {
        const int row0 = u.pm * BM + wr * 64 + fr; const int col0 = u.pn * BM + wc * 32 + 8 * fq;
        f32x4 part[2][4];
#pragma unroll
        for (int ai = 0; ai < 2; ++ai)
#pragma unroll
            for (int m = 0; m < 4; ++m) part[ai][m] = *(const f32x4*)(ssq + (size_t)(row0 + ai * HALF + m * 16) * 16 + 4 * fq);
#pragma unroll
        for (int ai = 0; ai < 2; ++ai)
#pragma unroll
            for (int m = 0; m < 4; ++m) { const int row = row0 + ai * HALF + m * 16;
                float tot = (part[ai][m][0] + part[ai][m][1]) + (part[ai][m][2] + part[ai][m][3]);
                tot += __shfl_xor(tot, 16); tot += __shfl_xor(tot, 32);
                const float scale = __builtin_amdgcn_rsqf(tot * (1.0f / 1024.0f) + eps);
                bf16_t* rowp = O + (size_t)row * ldc + col0;
#pragma unroll
                for (int bj = 0; bj < 2; ++bj) { const f32x4 v0 = acc[ai][bj][m][0] * scale, v1 = acc[ai][bj][m][1] * scale;
                    u32x4 w; w.x = cvt_pk_bf16(v0[0], v0[1]); w.y = cvt_pk_bf16(v0[2], v0[3]); w.z = cvt_pk_bf16(v1[0], v1[1]); w.w = cvt_pk_bf16(v1[2], v1[3]);
                    *(u32x4*)(rowp + bj * HALF) = w; } }
    }
};
template <bool RES_BF16, bool OUT_BF16> struct EpiRes {
    static constexpr bool PERM = false, AFTER_DRAIN = false;
    const void* res0; const void* res1; int split_pm; void* out; int ldc;
    __device__ __forceinline__ void operator()(const f32x4 (&acc)[2][2][4][2], const Unit& u, int wr, int wc, int fr, int fq) const {
        typedef unsigned u32x2_ __attribute__((ext_vector_type(2)));
        const int row0 = u.pm * BM + wr * 64 + fr; const int col0 = u.pn * BM + wc * 32 + 4 * fq;
        const bool first = u.pm < split_pm;
#pragma unroll
        for (int ai = 0; ai < 2; ++ai)
#pragma unroll
            for (int m = 0; m < 4; ++m) { const int row = row0 + ai * HALF + m * 16; const size_t off = (size_t)row * ldc + col0; const size_t roff = first ? off : off - (size_t)split_pm * BM * ldc;
#pragma unroll
                for (int bj = 0; bj < 2; ++bj)
#pragma unroll
                    for (int n = 0; n < 2; ++n) { const size_t o2 = bj * HALF + n * 16; f32x4 r;
                        if (RES_BF16) { const u32x2_ rw = *(const u32x2_*)((const bf16_t*)(first ? res0 : res1) + roff + o2); r = (f32x4){__builtin_bit_cast(float, rw.x << 16), __builtin_bit_cast(float, rw.x & 0xffff0000u), __builtin_bit_cast(float, rw.y << 16), __builtin_bit_cast(float, rw.y & 0xffff0000u)}; }
                        else r = *(const f32x4*)((const float*)(first ? res0 : res1) + roff + o2);
                        const f32x4 v = acc[ai][bj][m][n] + r;
                        if (OUT_BF16) { u32x2_ w; w.x = cvt_pk_bf16(v[0], v[1]); w.y = cvt_pk_bf16(v[2], v[3]); *(u32x2_*)((bf16_t*)out + off + o2) = w; }
                        else *(f32x4*)((float*)out + off + o2) = v; }
                if (m & 1) asm volatile("" ::: "memory"); }
    }
};
template <bool RES_BF16> struct EpiResN {
    static constexpr bool PERM = false, AFTER_DRAIN = false;
    const void* res0; const void* res1; int split_pm; bf16_t* out; float* ssq; int ldc;
    __device__ __forceinline__ void operator()(const f32x4 (&acc)[2][2][4][2], const Unit& u, int wr, int wc, int fr, int fq) const {
        typedef unsigned u32x2_ __attribute__((ext_vector_type(2)));
        const int row0 = u.pm * BM + wr * 64 + fr; const int col0 = u.pn * BM + wc * 32 + 4 * fq;
        const bool first = u.pm < split_pm;
#pragma unroll
        for (int ai = 0; ai < 2; ++ai)
#pragma unroll
            for (int m = 0; m < 4; ++m) { const int row = row0 + ai * HALF + m * 16; const size_t off = (size_t)row * ldc + col0; const size_t roff = first ? off : off - (size_t)split_pm * BM * ldc; float s = 0.f;
#pragma unroll
                for (int bj = 0; bj < 2; ++bj)
#pragma unroll
                    for (int n = 0; n < 2; ++n) { const size_t o2 = bj * HALF + n * 16; f32x4 r;
                        if (RES_BF16) { const u32x2_ rw = *(const u32x2_*)((const bf16_t*)(first ? res0 : res1) + roff + o2); r = (f32x4){__builtin_bit_cast(float, rw.x << 16), __builtin_bit_cast(float, rw.x & 0xffff0000u), __builtin_bit_cast(float, rw.y << 16), __builtin_bit_cast(float, rw.y & 0xffff0000u)}; }
                        else r = *(const f32x4*)((const float*)(first ? res0 : res1) + roff + o2);
                        const f32x4 v = acc[ai][bj][m][n] + r;
                        s += (v[0] * v[0] + v[1] * v[1]) + (v[2] * v[2] + v[3] * v[3]);
                        u32x2_ w; w.x = cvt_pk_bf16(v[0], v[1]); w.y = cvt_pk_bf16(v[2], v[3]); *(u32x2_*)(out + off + o2) = w; }
                s += __shfl_xor(s, 16); s += __shfl_xor(s, 32);
                if (fq == 0) ssq[(size_t)row * 16 + u.pn * 4 + wc] = s;
                if (m & 1) asm volatile("" ::: "memory"); }
    }
};
__device__ __forceinline__ float dpp_ror1(float x) { return __builtin_bit_cast(float, __builtin_amdgcn_update_dpp(0, __builtin_bit_cast(int, x), 0x121, 0xf, 0xf, false)); }
__device__ __forceinline__ float dpp_ror2(float x) { return __builtin_bit_cast(float, __builtin_amdgcn_update_dpp(0, __builtin_bit_cast(int, x), 0x122, 0xf, 0xf, false)); }
struct EpiUpFused {
    static constexpr bool PERM = false, AFTER_DRAIN = false;
    bf16_t* HID; const float* wconv; const float* bconv; bf16_t* RAW01; float* RAWG; float* pconv; PG8_LAS float* halo; int dff; const PG8_LAS float* rstd;
    __device__ __forceinline__ void operator()(const f32x4 (&acc)[2][2][4][2], const Unit& u, int wr, int wc, int fr, int fq) const {
        typedef unsigned u32x2_ __attribute__((ext_vector_type(2)));
        const int lane = fq * 16 + fr;
        const int fb = u.pn * 128 + wc * 32 + 4 * fq;
        const int hc = wc * 32 + 4 * fq;
        float rs[2][4];
#pragma unroll
        for (int ai = 0; ai < 2; ++ai)
#pragma unroll
            for (int m = 0; m < 4; ++m) rs[ai][m] = rstd[(u.pm & 7) * BM + ai * HALF + wr * 64 + m * 16 + fr];
        if (fr >= 14) {
#pragma unroll
            for (int ai = 0; ai < 2; ++ai)
#pragma unroll
                for (int n = 0; n < 2; ++n) *(PG8_LAS f32x4*)(halo + ((ai * 2 + wr) * 2 + (fr - 14)) * 128 + hc + 16 * n) = acc[ai][0][3][n] * rs[ai][3];
        }
        asm volatile("s_waitcnt lgkmcnt(0)" ::: "memory"); __builtin_amdgcn_s_barrier(); asm volatile("" ::: "memory");
        const bool seq_tile = (u.pm & 7) == 0;
#pragma unroll
        for (int n = 0; n < 2; ++n) {
            const f32x4 w0 = *(const f32x4*)(wconv + fb + 16 * n), w1 = *(const f32x4*)(wconv + dff + fb + 16 * n), w2 = *(const f32x4*)(wconv + 2 * dff + fb + 16 * n), bb = *(const f32x4*)(bconv + fb + 16 * n);
#pragma unroll
            for (int ai = 0; ai < 2; ++ai) {
                f32x4 p14 = (f32x4){0.f, 0.f, 0.f, 0.f}, p15 = p14;
                const bool top = (ai == 0 && wr == 0);
                if (!top) { const int pg = (wr == 1) ? (ai * 2 + 0) : ((ai - 1) * 2 + 1); p14 = *(const PG8_LAS f32x4*)(halo + (pg * 2 + 0) * 128 + hc + 16 * n); p15 = *(const PG8_LAS f32x4*)(halo + (pg * 2 + 1) * 128 + hc + 16 * n); }
                f32x4 pr1, pr2;
#pragma unroll
                for (int e = 0; e < 4; ++e) { const float x0 = (fr == 14) ? p14[e] : p15[e]; pr1[e] = dpp_ror1(x0); pr2[e] = dpp_ror2(x0); }
#pragma unroll
                for (int m = 0; m < 4; ++m) {
                    const f32x4 cur = acc[ai][0][m][n] * rs[ai][m], val = acc[ai][1][m][n] * rs[ai][m];
                    f32x4 g1, g2, c1, c2;
#pragma unroll
                    for (int e = 0; e < 4; ++e) { c1[e] = dpp_ror1(cur[e]); c2[e] = dpp_ror2(cur[e]);
                        g1[e] = fr >= 1 ? c1[e] : pr1[e]; g2[e] = fr >= 2 ? c2[e] : pr2[e]; }
                    pr1 = c1; pr2 = c2;
                    const int row = u.pm * BM + ai * HALF + wr * 64 + m * 16 + fr;
                    const bool first2 = top && m == 0 && fr < 2;
                    if (first2 && seq_tile) { if (fr == 0) g1 = (f32x4){0.f, 0.f, 0.f, 0.f}; g2 = (f32x4){0.f, 0.f, 0.f, 0.f}; }
                    if (first2 && !seq_tile) {
                        u32x2_ wg_, wv_; wg_.x = cvt_pk_bf16(cur[0], cur[1]); wg_.y = cvt_pk_bf16(cur[2], cur[3]); wv_.x = cvt_pk_bf16(val[0], val[1]); wv_.y = cvt_pk_bf16(val[2], val[3]);
                        bf16_t* rp = RAW01 + ((size_t)u.pm * 2 + fr) * (2 * dff) + fb + 16 * n; *(u32x2_*)rp = wg_; *(u32x2_*)(rp + dff) = wv_;
                    } else {
                        f32x4 h;
#pragma unroll
                        for (int e = 0; e < 4; ++e) { const float c = bb[e] + g2[e] * w0[e] + g1[e] * w1[e] + cur[e] * w2[e]; h[e] = c * __builtin_amdgcn_rcpf(1.f + __expf(-c)) * val[e]; }
                        u32x2_ wh; wh.x = cvt_pk_bf16(h[0], h[1]); wh.y = cvt_pk_bf16(h[2], h[3]);
                        *(u32x2_*)(HID + (size_t)row * dff + fb + 16 * n) = wh;
                    }
                    if (ai == 1 && wr == 1 && m == 3 && fr >= 14) {
                        *(f32x4*)(RAWG + ((size_t)u.pm * 2 + (fr - 14)) * dff + fb + 16 * n) = cur;
                        if ((u.pm & 7) == 7) *(f32x4*)(pconv + ((size_t)(u.pm >> 3) * 2 + (fr - 14)) * dff + fb + 16 * n) = cur;
                    }
                }
            }
        }
        asm volatile("s_waitcnt lgkmcnt(0)" ::: "memory"); __builtin_amdgcn_s_barrier(); asm volatile("" ::: "memory");
    }
};
template <class Epi, class Sched, bool ALIGN_EPI = false, bool SP2 = false>
__device__ __forceinline__ void gemm_phase(PG8_LAS unsigned char* lds, const Gemm g, const Sched& S, const Epi& E) {
    const int tid = opaque_i(threadIdx.x), wid = __builtin_amdgcn_readfirstlane(tid >> 6), lane = tid & 63, wr = wid >> 2, wc = wid & 3, fr = lane & 15, fq = lane >> 4;
    const int K = g.K, nt = K / BK;
    unsigned voffA[2], voffB[2];
#pragma unroll
    for (int i = 0; i < 2; ++i) { int R, C; stage_rc(tid * 16 + i * 8192, R, C); const int Rb = Epi::PERM ? ((R & ~31) + perm32(R & 31)) : R;
        voffA[i] = (unsigned)(R * K + C) * 2u; voffB[i] = (unsigned)(Rb * K + C) * 2u; }
    const size_t kstep = (size_t)(BK * 2);
    const size_t hstep = (size_t)HALF * K * 2;
    const size_t tstep = 2 * hstep;
    const unsigned ldsw = (unsigned)wid * 1024u;
    const int aoff = lds_byte(wr * 64 + fr, fq * 8), boff = lds_byte(wc * 32 + fr, fq * 8);
#define PG8_SA(b, h) (((b) * 2 + (h)) * HTB)
#define PG8_SB(b, h) ((4 + (b) * 2 + (h)) * HTB)
#define PG8_STAGE(bufoff, gbase, voff) do { _Pragma("unroll") for (int _i = 0; _i < 2; ++_i) \
        __builtin_amdgcn_global_load_lds((const unsigned*)((const char*)(gbase) + (voff)[_i]), (PG8_LAS unsigned*)(lds + (bufoff) + ldsw + _i * 8192), 16, 0, 0); } while (0)
#define PG8_LDA(dst, b, h) do { _Pragma("unroll") for (int m = 0; m < 4; ++m) _Pragma("unroll") for (int k = 0; k < 2; ++k) dst[m][k] = *(const PG8_LAS bf16x8*)(lds + PG8_SA(b, h) + aoff + m * 2048 + k * 1024); } while (0)
#define PG8_LDB(dst, b, h) do { _Pragma("unroll") for (int n = 0; n < 2; ++n) _Pragma("unroll") for (int k = 0; k < 2; ++k) dst[n][k] = *(const PG8_LAS bf16x8*)(lds + PG8_SB(b, h) + boff + n * 2048 + k * 1024); } while (0)
#define PG8_MMA(ai, bj, At, Bt) do { __builtin_amdgcn_s_setprio(1); _Pragma("unroll") for (int m = 0; m < 4; ++m) _Pragma("unroll") for (int n = 0; n < 2; ++n) _Pragma("unroll") for (int k = 0; k < 2; ++k) \
        acc[ai][bj][m][n] = __builtin_amdgcn_mfma_f32_16x16x32_bf16(Bt[n][k], At[m][k], acc[ai][bj][m][n], 0, 0, 0); __builtin_amdgcn_s_setprio(0); } while (0)
#define PG8_WAIT_V(n) asm volatile("s_waitcnt vmcnt(" #n ")" ::: "memory")
#define PG8_WAIT_L(n) asm volatile("s_waitcnt lgkmcnt(" #n ")" ::: "memory")
#define PG8_BAR __builtin_amdgcn_s_barrier()
#define PG8_SCHED __builtin_amdgcn_sched_barrier(0)
    Unit cur, nxt; int ui = 0;
    if (!S.next(0, cur)) return;
    f32x4 acc[2][2][4][2];
#pragma unroll
    for (int a = 0; a < 2; ++a)
#pragma unroll
        for (int b = 0; b < 2; ++b)
#pragma unroll
            for (int m = 0; m < 4; ++m)
#pragma unroll
                for (int n = 0; n < 2; ++n) acc[a][b][m][n] = (f32x4){0.f, 0.f, 0.f, 0.f};
    bf16x8 At[4][2], B0[2][2], B1[2][2];
    const char* cA = (const char*)g.A + (size_t)cur.pm * tstep; const char* cB = (const char*)g.Bt + (size_t)cur.pn * tstep;
    S.a_ready(cur);
    if constexpr (SP2) {
        PG8_STAGE(PG8_SB(0, 0), cB, voffB); PG8_STAGE(PG8_SB(0, 1), cB + hstep, voffB); PG8_STAGE(PG8_SA(0, 0), cA, voffA); PG8_STAGE(PG8_SA(0, 1), cA + hstep, voffA);
        if (wr == 1) PG8_BAR;
        PG8_WAIT_V(2); PG8_BAR;
        PG8_STAGE(PG8_SB(1, 0), cB + kstep, voffB); PG8_STAGE(PG8_SA(1, 0), cA + kstep, voffA); PG8_STAGE(PG8_SB(1, 1), cB + hstep + kstep, voffB);
        PG8_WAIT_V(6); PG8_BAR;
    } else {
        PG8_STAGE(PG8_SB(0, 0), cB, voffB); PG8_STAGE(PG8_SA(0, 0), cA, voffA); PG8_STAGE(PG8_SB(0, 1), cB + hstep, voffB); PG8_STAGE(PG8_SA(0, 1), cA + hstep, voffA);
        if (wr == 1) PG8_BAR;
        PG8_WAIT_V(4); PG8_BAR;
        PG8_STAGE(PG8_SB(1, 0), cB + kstep, voffB); PG8_STAGE(PG8_SA(1, 0), cA + kstep, voffA); PG8_STAGE(PG8_SB(1, 1), cB + hstep + kstep, voffB);
        PG8_WAIT_V(6); PG8_BAR;
    }
    for (;;) {
        const bool has_next = S.next(ui + 1, nxt);
        const char* nA = has_next ? (const char*)g.A + (size_t)nxt.pm * tstep : cA; const char* nB = has_next ? (const char*)g.Bt + (size_t)nxt.pn * tstep : cB;
        for (int t = 0; t < nt; t += 2) {
            const bool last = (t == nt - 2);
            const char* a1 = cA + (size_t)(t + 1) * kstep;
            const char* a2 = last ? nA : cA + (size_t)(t + 2) * kstep; const char* b2 = last ? nB : cB + (size_t)(t + 2) * kstep;
            const char* a3 = a2 + kstep; const char* b3 = b2 + kstep;
            if (last && has_next) S.a_ready(nxt);
            if constexpr (SP2) {
            PG8_LDB(B0, 0, 0); PG8_LDB(B1, 0, 1); PG8_SCHED; PG8_LDA(At, 0, 0); PG8_STAGE(PG8_SA(1, 1), a1 + hstep, voffA);
            PG8_WAIT_V(8); PG8_WAIT_L(0); PG8_BAR; PG8_MMA(0, 0, At, B0); PG8_MMA(0, 1, At, B1); PG8_BAR; PG8_SCHED;
            PG8_LDA(At, 0, 1); PG8_STAGE(PG8_SB(0, 0), b2, voffB); PG8_STAGE(PG8_SB(0, 1), b2 + hstep, voffB); PG8_STAGE(PG8_SA(0, 0), a2, voffA);
            PG8_WAIT_V(8); PG8_WAIT_L(0); PG8_BAR; PG8_MMA(1, 0, At, B0); PG8_MMA(1, 1, At, B1); PG8_BAR; PG8_SCHED;
            PG8_LDB(B0, 1, 0); PG8_LDB(B1, 1, 1); PG8_SCHED; PG8_LDA(At, 1, 0); PG8_STAGE(PG8_SA(0, 1), a2 + hstep, voffA);
            PG8_WAIT_V(8); PG8_WAIT_L(0); PG8_BAR; PG8_MMA(0, 0, At, B0); PG8_MMA(0, 1, At, B1); PG8_BAR; PG8_SCHED;
            PG8_LDA(At, 1, 1); PG8_STAGE(PG8_SB(1, 0), b3, voffB); PG8_STAGE(PG8_SB(1, 1), b3 + hstep, voffB); PG8_STAGE(PG8_SA(1, 0), a3, voffA);
            PG8_WAIT_V(8); PG8_WAIT_L(0); PG8_BAR; PG8_MMA(1, 0, At, B0); PG8_MMA(1, 1, At, B1); PG8_BAR; PG8_SCHED;
            } else {
            PG8_LDB(B0, 0, 0); PG8_SCHED; PG8_LDA(At, 0, 0); PG8_STAGE(PG8_SA(1, 1), a1 + hstep, voffA);
            PG8_WAIT_L(8); PG8_BAR; PG8_WAIT_L(0); PG8_MMA(0, 0, At, B0); PG8_BAR; PG8_SCHED;
            PG8_LDB(B1, 0, 1); PG8_STAGE(PG8_SB(0, 0), b2, voffB);
            PG8_BAR; PG8_WAIT_L(0); PG8_MMA(0, 1, At, B1); PG8_BAR;
            PG8_LDA(At, 0, 1); PG8_STAGE(PG8_SA(0, 0), a2, voffA);
            PG8_BAR; PG8_WAIT_L(0); PG8_MMA(1, 0, At, B0); PG8_BAR; PG8_SCHED;
            PG8_STAGE(PG8_SB(0, 1), b2 + hstep, voffB);
            PG8_WAIT_V(6); PG8_BAR; PG8_MMA(1, 1, At, B1); PG8_BAR;
            PG8_LDB(B0, 1, 0); PG8_SCHED; PG8_LDA(At, 1, 0); PG8_STAGE(PG8_SA(0, 1), a2 + hstep, voffA);
            PG8_WAIT_L(8); PG8_BAR; PG8_WAIT_L(0); PG8_MMA(0, 0, At, B0); PG8_BAR; PG8_SCHED;
            PG8_LDB(B1, 1, 1); PG8_STAGE(PG8_SB(1, 0), b3, voffB);
            PG8_BAR; PG8_WAIT_L(0); PG8_MMA(0, 1, At, B1); PG8_BAR;
            PG8_LDA(At, 1, 1); PG8_STAGE(PG8_SA(1, 0), a3, voffA);
            PG8_BAR; PG8_WAIT_L(0); PG8_MMA(1, 0, At, B0); PG8_BAR; PG8_SCHED;
            PG8_STAGE(PG8_SB(1, 1), b3 + hstep, voffB);
            PG8_WAIT_V(6); PG8_BAR; PG8_MMA(1, 1, At, B1); PG8_BAR;
            }
        }
        if constexpr (ALIGN_EPI) { if (wr == 0) PG8_BAR; }
        if constexpr (!Epi::AFTER_DRAIN) { E(acc, cur, wr, wc, fr, fq); S.done(cur); }
        if (!has_next) break;
#pragma unroll
        for (int a = 0; a < 2; ++a)
#pragma unroll
            for (int b = 0; b < 2; ++b)
#pragma unroll
                for (int m = 0; m < 4; ++m)
#pragma unroll
                    for (int n = 0; n < 2; ++n) acc[a][b][m][n] = (f32x4){0.f, 0.f, 0.f, 0.f};
        cur = nxt; cA = nA; cB = nB; ++ui;
        if constexpr (ALIGN_EPI) { if (wr == 1) PG8_BAR; }
    }
    PG8_WAIT_V(0);
    if constexpr (!ALIGN_EPI) { if (wr == 0) PG8_BAR; }
    PG8_BAR;
    if constexpr (Epi::AFTER_DRAIN) { E.fused(acc, cur, wr, wc, fr, fq, lds, wid, lane); S.done(cur); }
#undef PG8_SA
#undef PG8_SB
#undef PG8_STAGE
#undef PG8_LDA
#undef PG8_LDB
#undef PG8_MMA
#undef PG8_WAIT_V
#undef PG8_WAIT_L
#undef PG8_BAR
#undef PG8_SCHED
}
}
#define XB_TMO      128
#define XB_XCNT(j)  (256  + 64 * (j))
#define XB_XSUB(j)  (1280 + 64 * (j))
#define XB_XGEN(j)  (2304 + 64 * (j))
#define XB_TOP      3328
#define XB_TOPGEN   3392
#define XCD_BAR_WORDS 3456
#define XB_SPIN_CAP (1u << 18)

__device__ __forceinline__ unsigned xb_ld(unsigned* p)              { return __hip_atomic_load(p, __ATOMIC_RELAXED, __HIP_MEMORY_SCOPE_AGENT); }
__device__ __forceinline__ unsigned xb_add(unsigned* p, unsigned v) { return __hip_atomic_fetch_add(p, v, __ATOMIC_RELAXED, __HIP_MEMORY_SCOPE_AGENT); }
__device__ __forceinline__ unsigned xb_xcc_id() { return (unsigned)__builtin_amdgcn_s_getreg((3 << 11) | 20) & 0xFu; }
#define XB_SPIN(cond, bar) do { unsigned _sp = 0; while (cond) { __builtin_amdgcn_s_sleep(1); \
    if ((++_sp & 255u) == 0u) { if (xb_ld(&(bar)[XB_TMO])) break; if (_sp > XB_SPIN_CAP) { atomicAdd(&(bar)[XB_TMO], 1u); break; } } } } while (0)

struct XcdBarrier {
    unsigned* bar; unsigned x;
    volatile LAS unsigned* st;
};

__device__ __forceinline__ XcdBarrier xcd_barrier_post(unsigned* bar, volatile LAS unsigned* st) {
    XcdBarrier b; b.bar = bar; b.x = xb_xcc_id(); b.st = st;
    if (threadIdx.x == 0) (void)xb_add(&bar[XB_XCNT(b.x)], 1u);
    return b;
}
__device__ __forceinline__ void xcd_barrier_complete(unsigned* bar, unsigned x, unsigned& nloc, unsigned& nx) {
    const unsigned G = gridDim.x * gridDim.y * gridDim.z;
    unsigned sum, cnt, mine, sp = 0u;
    for (;;) {
        sum = 0u; cnt = 0u; mine = 0u;
#pragma unroll
        for (unsigned j = 0; j < 16; ++j) { const unsigned c = xb_ld(&bar[XB_XCNT(j)]); sum += c; cnt += (c > 0u) ? 1u : 0u; mine = (j == x) ? c : mine; }
        if (sum == G) break;
        __builtin_amdgcn_s_sleep(1);
        if ((++sp & 255u) == 0u) { if (xb_ld(&bar[XB_TMO])) break; if (sp > XB_SPIN_CAP) { atomicAdd(&bar[XB_TMO], 1u); break; } }
    }
    nloc = mine > 0u ? mine : 1u; nx = cnt > 0u ? cnt : 1u;
}

__device__ __forceinline__ void xcd_barrier(const XcdBarrier& b) {
    asm volatile("s_waitcnt vmcnt(0)" ::: "memory");
    __syncthreads();
    if (threadIdx.x == 0) {
        unsigned* bar = b.bar;
        __builtin_amdgcn_s_waitcnt(0);
        unsigned nloc = b.st[0], nx = b.st[1];
        if (nloc == 0u) { xcd_barrier_complete(bar, b.x, nloc, nx); b.st[0] = nloc; b.st[1] = nx; }
        const unsigned old = xb_add(&bar[XB_XSUB(b.x)], 1u);
        const unsigned gen = old / nloc;
        if (old + 1u == (gen + 1u) * nloc) {
            __builtin_amdgcn_fence(__ATOMIC_RELEASE, "agent");
            asm volatile("s_waitcnt vmcnt(0)" ::: "memory");
            const unsigned og = xb_add(&bar[XB_TOP], 1u);
            const unsigned tg = og / nx;
            if (og + 1u == (tg + 1u) * nx) xb_add(&bar[XB_TOPGEN], 1u);
            else XB_SPIN(xb_ld(&bar[XB_TOPGEN]) == tg, bar);
            __builtin_amdgcn_fence(__ATOMIC_ACQUIRE, "agent");
            xb_add(&bar[XB_XGEN(b.x)], 1u);
            asm volatile("s_waitcnt vmcnt(0)" ::: "memory");
        } else {
            XB_SPIN(xb_ld(&bar[XB_XGEN(b.x)]) == gen, bar);
            __builtin_amdgcn_fence(__ATOMIC_ACQUIRE, "agent");
            asm volatile("s_waitcnt vmcnt(0)" ::: "memory");
        }
    }
    __syncthreads();
}
namespace mk {
constexpr int NWAVES = 8;
constexpr int D = 1024, TP = 16384, TSMP = 512, T = TP + TSMP, SEQ = 2048, NSEQ = 128, PAST = 8192;
constexpr int NIN = 1568, NINP = 1792, DFF = 2816;
constexpr float EPS = 1e-6f;
constexpr float LOG2E = 1.4426950408889634f;
constexpr float QSCALE = 0.10206207261596577f * LOG2E;
constexpr float MQSCALE = 0.08838834764831845f * LOG2E;

constexpr size_t O_YP = 0, O_YS = 16777216, O_PCKV = O_YS + 524288, O_PKPE = O_PCKV + 4194304, O_PMK = O_PKPE + 524288, O_PMV = O_PMK + 1048576,
                 O_PCONV = O_PMV + 1048576, O_SCKV = O_PCONV + 45056, O_SKPE = O_SCKV + 131072, O_SCV = O_SKPE + 16384, O_SCONV = O_SCV + 262144, O_END = O_SCONV + 720896;
static_assert(O_END == 25292800, "output size");

constexpr size_t al(size_t x) { return (x + 4095) & ~(size_t)4095; }
constexpr size_t WS_CTL = 0, CTL_ZERO_BYTES = 1u << 20;
constexpr size_t WS_W_IN = 1u << 20;
constexpr size_t WS_W_UQ = al(WS_W_IN + (size_t)NINP * D * 2);
constexpr size_t WS_W_UK = al(WS_W_UQ + (size_t)768 * 256 * 2);
constexpr size_t WS_W_UV = al(WS_W_UK + (size_t)512 * 256 * 2);
constexpr size_t WS_W_O = al(WS_W_UV + (size_t)512 * 256 * 2);
constexpr size_t WS_W_MQ = al(WS_W_O + (size_t)1024 * 1024 * 2);
constexpr size_t WS_W_MKV = al(WS_W_MQ + (size_t)512 * 1024 * 2);
constexpr size_t WS_W_MO = al(WS_W_MKV + (size_t)1024 * 1024 * 2);
constexpr size_t WS_W_UP = al(WS_W_MO + (size_t)1024 * 512 * 2);
constexpr size_t WS_W_DN = al(WS_W_UP + (size_t)2 * DFF * D * 2);
constexpr size_t WS_ROPE = al(WS_W_DN + (size_t)D * DFF * 2);
constexpr size_t ROPE_N = 8200;
constexpr size_t WS_XN = al(WS_ROPE + 2 * ROPE_N * 16 * 4);
constexpr size_t WS_MN = al(WS_XN + (size_t)T * D * 2);
constexpr size_t WS_Z = al(WS_MN + (size_t)2048 * D * 2);
constexpr size_t WS_MKV = al(WS_Z + (size_t)T * NINP * 2);
constexpr size_t WS_CQN = al(WS_MKV + (size_t)2048 * 1024 * 2);
constexpr size_t WS_CKVN = al(WS_CQN + (size_t)T * 256 * 2);
constexpr size_t WS_VG = al(WS_CKVN + (size_t)T * 256 * 2);
constexpr size_t WS_MK = al(WS_VG + (size_t)T * 512 * 2);
constexpr size_t WS_MVT = al(WS_MK + (size_t)2048 * 512 * 2);
constexpr size_t WS_QR = al(WS_MVT + (size_t)2048 * 512 * 2);
constexpr size_t WS_KNR = al(WS_QR + (size_t)T * 768 * 2);
constexpr size_t WS_VT = al(WS_KNR + (size_t)TP * 512 * 2);
constexpr size_t WS_QF = al(WS_VT + (size_t)512 * TP * 2);
constexpr size_t WS_KF = al(WS_QF + (size_t)T * 768 * 2);
constexpr size_t WS_BO = al(WS_KF + (size_t)TP * 768 * 2);
constexpr size_t WS_MRG = al(WS_BO + (size_t)T * 512 * 2);
constexpr size_t WS_X1 = al(WS_MRG + (size_t)T * 1024 * 2);
constexpr size_t WS_H2 = al(WS_X1 + (size_t)T * 1024 * 4);
constexpr size_t WS_MQ = al(WS_H2 + (size_t)T * 1024 * 2);
constexpr size_t WS_MO = al(WS_MQ + (size_t)T * 512 * 2);
constexpr size_t WS_X2 = al(WS_MO + (size_t)T * 512 * 2);
constexpr size_t WS_H3 = al(WS_X2 + (size_t)T * 1024 * 4);
constexpr size_t WS_UP = al(WS_H3 + (size_t)T * 1024 * 2);
constexpr size_t WS_HID = al(WS_UP + (size_t)T * 2 * DFF * 2);
constexpr size_t WS_SPART = al(WS_HID + (size_t)T * DFF * 2);
constexpr size_t SPART_STRIDE = (32 + 32 * 256) * 4;
constexpr size_t WS_QEXT = al(WS_SPART + (size_t)NSEQ * 2 * SPART_STRIDE);
constexpr size_t WS_W_SB = al(WS_QEXT + (size_t)NSEQ * 32 * 288 * 2);
constexpr size_t WS_SSQ1_PRE = al(WS_W_SB + (size_t)8 * 128 * 128 * 2);
constexpr size_t WS_RAW01 = WS_SSQ1_PRE;
constexpr size_t WS_RAWG = al(WS_RAW01 + (size_t)64 * 2 * 5632 * 2);
constexpr size_t WS_SSQ1 = al(WS_RAWG + (size_t)64 * 2 * 2816 * 4);
constexpr size_t WS_SSQ2 = al(WS_SSQ1 + (size_t)T * 16 * 4);
constexpr size_t WS_MK_END = al(WS_SSQ2 + (size_t)T * 16 * 4);
static_assert(WS_MK_END < (1000u << 20), "mk workspace under 1000 MiB");
constexpr int CW_BAR = 4096;
constexpr int CW_HIDS = 16384;

constexpr int RING_BYTES = 155648, MISC_OFF = RING_BYTES + 320, LDS_BYTES = 159744;

struct Args { const void* in[38]; float* out; unsigned char* ws; int ph_lo, ph_hi; };
static_assert(sizeof(Args) == 38 * 8 + 8 + 8 + 8, "Args has no padding");

struct Frame {
    LAS unsigned char* lds; unsigned char* lds_g;
    int tid, lane, wave, G, bid;
    unsigned char* ws; float* out;
    const float* const* in;
    template <class P> __device__ __forceinline__ P* w(size_t off) const { return (P*)(ws + off); }
    __device__ __forceinline__ const float* inf(int i) const { return (const float*)in[i]; }
};

enum { I_XP = 0, I_XS, I_CKV, I_KPE, I_CMK, I_CMV, I_CONVST, I_PT, I_MEMP, I_GMIX, I_WIN, I_LNG, I_LNB, I_WS, I_BS, I_GQA, I_WUQ, I_GKVA, I_WUK, I_WUV, I_GQKQ, I_GQKK,
       I_GOA, I_GOB, I_WO, I_GMEMX, I_GMEMIN, I_WMQ, I_WMK, I_WMV, I_GMQ, I_GMK, I_WMO, I_GFFN, I_WUP, I_WCONV, I_BCONV, I_WDOWN };

struct P0Item { float v[32]; float g; };
__device__ __forceinline__ void p0_item_load(P0Item& x, const float* W, int K, int N, int item, int lane, const float* gain) {
    const int nblk = N / 32, kb = item / nblk, nb = item % nblk, k0 = 64 * kb, n0 = 32 * nb;
#pragma unroll
    for (int i = 0; i < 32; ++i) { const int kk = 2 * i + (lane >> 5); x.v[i] = W[(size_t)(k0 + kk) * N + n0 + (lane & 31)]; }
    x.g = gain ? gain[k0 + lane] : 1.f;
}
__device__ __forceinline__ void p0_item_finish(const P0Item& x, int K, int N, bf16* WT, int row_off, LAS float* scr, int item, int lane, bool has_gain) {
    const int nblk = N / 32, kb = item / nblk, nb = item % nblk, k0 = 64 * kb, n0 = 32 * nb;
#pragma unroll
    for (int i = 0; i < 32; ++i) { const int kk = 2 * i + (lane >> 5); float wv_ = x.v[i]; if (has_gain) wv_ *= __shfl(x.g, kk); scr[kk * 33 + (lane & 31)] = wv_; }
    LDS_WAIT(); asm volatile("" ::: "memory");
    const int c = lane & 7;
#pragma unroll
    for (int j = 0; j < 4; ++j) { const int n = (lane >> 3) + 8 * j; const LAS float* s = scr + (8 * c) * 33 + n;
        v4u o; o.x = pk2(s[0 * 33], s[1 * 33]); o.y = pk2(s[2 * 33], s[3 * 33]); o.z = pk2(s[4 * 33], s[5 * 33]); o.w = pk2(s[6 * 33], s[7 * 33]);
        *(v4u*)(WT + (size_t)(row_off + n0 + n) * K + k0 + 8 * c) = o; }
    LDS_WAIT(); asm volatile("" ::: "memory");
}
__device__ __forceinline__ void rms_row_to_bf16(const float* xrow, const float* g, bf16* orow, int lane) {
    const f32x4* xr = (const f32x4*)xrow + lane; const f32x4* gr = (const f32x4*)g + lane;
    f32x4 v[4]; float s = 0.f;
#pragma unroll
    for (int j = 0; j < 4; ++j) { v[j] = xr[64 * j]; s += (v[j].x * v[j].x + v[j].y * v[j].y) + (v[j].z * v[j].z + v[j].w * v[j].w); }
    const float rstd = rsqrtf(wave_sum(s) * (1.f / 1024.f) + EPS);
    unsigned long long* o8 = (unsigned long long*)orow + lane;
#pragma unroll
    for (int j = 0; j < 4; ++j) { const f32x4 gg = gr[64 * j];
        o8[64 * j] = (unsigned long long)pk2(v[j].x * rstd * gg.x, v[j].y * rstd * gg.y) | ((unsigned long long)pk2(v[j].z * rstd * gg.z, v[j].w * rstd * gg.w) << 32); }
}
__device__ __forceinline__ const float* xrow_ptr(const Frame& F, int r) { return r < TP ? F.inf(I_XP) + (size_t)r * D : F.inf(I_XS) + (size_t)(r - TP) * D; }

template <int M_LO, int M_HI>
__device__ __forceinline__ void p0_transposes(Frame& F, int gw, int NGW) {
    LAS float* scr = (LAS float*)(F.lds + F.wave * 16384);
    constexpr int NI = 11;
    const int srcs[NI] = {I_WIN, I_WUQ, I_WUK, I_WUV, I_WO, I_WMQ, I_WMK, I_WMV, I_WMO, I_WUP, I_WDOWN};
    const int Ks[NI] = {1024, 256, 256, 256, 1024, 1024, 1024, 1024, 512, 1024, 2816};
    const int Ns[NI] = {1568, 768, 512, 512, 1024, 512, 512, 512, 1024, 5632, 1024};
    const size_t dsts[NI] = {WS_W_IN, WS_W_UQ, WS_W_UK, WS_W_UV, WS_W_O, WS_W_MQ, WS_W_MKV, WS_W_MKV, WS_W_MO, WS_W_UP, WS_W_DN};
    const int roffs[NI] = {0, 0, 0, 0, 0, 0, 0, 512, 0, 0, 0};
    const int gains[NI] = {-1, -1, -1, -1, -1, I_GMEMX, -1, -1, -1, I_GFFN, -1};
    int base = 0;
#pragma unroll
    for (int m = M_LO; m < M_HI; ++m) {
        const int cnt = (Ks[m] / 64) * (Ns[m] / 32);
        int first = gw - (base % NGW); if (first < 0) first += NGW;
        const float* gp = gains[m] >= 0 ? F.inf(gains[m]) : nullptr;
        P0Item cur_, nxt_;
        if (first < cnt) p0_item_load(cur_, F.inf(srcs[m]), Ks[m], Ns[m], first, F.lane, gp);
        for (int it = first; it < cnt; it += NGW) {
            const bool more = it + NGW < cnt;
            if (more) p0_item_load(nxt_, F.inf(srcs[m]), Ks[m], Ns[m], it + NGW, F.lane, gp);
            int roff = roffs[m];
            if (m == 9) {
                const int n0 = 32 * (it % (Ns[m] / 32)); const int f0 = n0 < DFF ? n0 : n0 - DFF; roff = 256 * (f0 >> 7) + (n0 < DFF ? 0 : 128) + (f0 & 127) - n0; }
            p0_item_finish(cur_, Ks[m], Ns[m], F.w<bf16>(dsts[m]), roff, scr, it, F.lane, gains[m] >= 0);
            if (more) cur_ = nxt_;
        }
        base += cnt;
    }
}
__device__ __forceinline__ void p0_prologue(Frame& F) {
    const int gw = F.bid * NWAVES + F.wave, NGW = F.G * NWAVES;
    p0_transposes<0, 9>(F, gw, NGW);
    for (int r = gw; r < NINP - NIN; r += NGW) { v4u* p = (v4u*)(F.w<bf16>(WS_W_IN) + (size_t)(NIN + r) * D) + F.lane; p[0] = (v4u){0, 0, 0, 0}; p[64] = (v4u){0, 0, 0, 0}; }
    for (int r = gw; r < T + 2048; r += 2 * NGW) {
        f32x4 v[2][4]; const float* gp[2]; bf16* op[2]; bool ok[2];
#pragma unroll
        for (int k = 0; k < 2; ++k) { const int rr = r + k * NGW; ok[k] = rr < T + 2048;
            const float* xr = !ok[k] ? F.inf(I_XP) : (rr < T ? xrow_ptr(F, rr) : F.inf(I_MEMP) + (size_t)(rr - T) * D);
            gp[k] = (rr < T) ? F.inf(I_GMIX) : F.inf(I_GMEMIN); op[k] = (rr < T) ? F.w<bf16>(WS_XN) + (size_t)rr * D : F.w<bf16>(WS_MN) + (size_t)(rr - T) * D;
#pragma unroll
            for (int j = 0; j < 4; ++j) v[k][j] = ((const f32x4*)xr)[F.lane + 64 * j]; }
#pragma unroll
        for (int k = 0; k < 2; ++k) if (ok[k]) {
            float sq = 0.f;
#pragma unroll
            for (int j = 0; j < 4; ++j) sq += (v[k][j].x * v[k][j].x + v[k][j].y * v[k][j].y) + (v[k][j].z * v[k][j].z + v[k][j].w * v[k][j].w);
            const float rstd = rsqrtf(wave_sum(sq) * (1.f / 1024.f) + EPS);
            unsigned long long* o8 = (unsigned long long*)op[k] + F.lane;
#pragma unroll
            for (int j = 0; j < 4; ++j) { const f32x4 gg = ((const f32x4*)gp[k])[F.lane + 64 * j];
                o8[64 * j] = (unsigned long long)pk2(v[k][j].x * rstd * gg.x, v[k][j].y * rstd * gg.y) | ((unsigned long long)pk2(v[k][j].z * rstd * gg.z, v[k][j].w * rstd * gg.w) << 32); }
        }
    }
    { const float* wsrc = F.inf(I_WS); bf16* wdst = F.w<bf16>(WS_W_SB);
      for (int i = F.bid * 512 + F.tid; i < 8 * 128 * 128 / 4; i += F.G * 512) { const f32x4 v = *(const f32x4*)(wsrc + 4 * i); v2u o; o.x = pk2(v[0], v[1]); o.y = pk2(v[2], v[3]); *(v2u*)(wdst + 4 * i) = o; } }
    { float* cs = F.w<float>(WS_ROPE); float* sn = cs + ROPE_N * 16;
      for (int i = F.bid * 512 + F.tid; i < (int)ROPE_N * 16; i += F.G * 512) { const int pos = i >> 4, f = i & 15;
          const double ang = (double)pos * pow(10000.0, -(double)f / 16.0); cs[i] = (float)cos(ang); sn[i] = (float)sin(ang); } }
}

__device__ __forceinline__ void p2_post_inproj(Frame& F) {
    const int gw = F.bid * NWAVES + F.wave, NGW = F.G * NWAVES, lane = F.lane;
    const bf16* Z = F.w<bf16>(WS_Z);
    const float* lg = F.inf(I_LNG); const float* lb = F.inf(I_LNB);
    const f32x4 lg0 = *(const f32x4*)(lg + 8 * lane), lg1 = *(const f32x4*)(lg + 8 * lane + 4), lb0 = *(const f32x4*)(lb + 8 * lane), lb1 = *(const f32x4*)(lb + 8 * lane + 4);
    const f32x4 gqa = *(const f32x4*)(F.inf(I_GQA) + 4 * lane), gkva = *(const f32x4*)(F.inf(I_GKVA) + 4 * lane);
    for (int r0 = gw; r0 < T; r0 += 4 * NGW) {
        v4u rawv[4]; v2u rawq[4], rawk[4]; bf16 rawp[4];
#pragma unroll
        for (int k = 0; k < 4; ++k) { const int r = r0 + k * NGW; if (r < T) { const bf16* zr = Z + (size_t)r * NINP;
            rawv[k] = *(const v4u*)(zr + 512 + 8 * lane); rawq[k] = *(const v2u*)(zr + 1024 + 4 * lane); rawk[k] = *(const v2u*)(zr + 1280 + 4 * lane); rawp[k] = zr[1536 + (lane & 31)]; } }
#pragma unroll
        for (int k = 0; k < 4; ++k) { const int r = r0 + k * NGW; if (r < T) {
        {
            const v4u raw = rawv[k];
            float x[8];
#pragma unroll
            for (int i = 0; i < 4; ++i) { x[2 * i] = gelu_tanh_f(bflo(raw[i])); x[2 * i + 1] = gelu_tanh_f(bfhi(raw[i])); }
            float s = 0.f;
#pragma unroll
            for (int i = 0; i < 8; ++i) s += x[i];
            s += __shfl_xor(s, 1); s += __shfl_xor(s, 2); s += __shfl_xor(s, 4);
            const float mean = s * (1.f / 64.f);
            float q = 0.f;
#pragma unroll
            for (int i = 0; i < 8; ++i) { x[i] -= mean; q += x[i] * x[i]; }
            q += __shfl_xor(q, 1); q += __shfl_xor(q, 2); q += __shfl_xor(q, 4);
            const float rstd = rsqrtf(q * (1.f / 64.f) + EPS);
            f32x4 y0, y1;
#pragma unroll
            for (int i = 0; i < 4; ++i) { y0[i] = x[i] * rstd * lg0[i] + lb0[i]; y1[i] = x[4 + i] * rstd * lg1[i] + lb1[i]; }
            v4u o; o.x = pk2(y0[0], y0[1]); o.y = pk2(y0[2], y0[3]); o.z = pk2(y1[0], y1[1]); o.w = pk2(y1[2], y1[3]);
            *(v4u*)(F.w<bf16>(WS_VG) + (size_t)r * 512 + 8 * lane) = o;
            if (r >= TP) { float* d = F.out + O_SCV + (size_t)(r - TP) * 512 + 8 * lane; *(f32x4*)d = y0; *(f32x4*)(d + 4) = y1; }
        }
#pragma unroll
        for (int which = 0; which < 2; ++which) {
            const v2u raw = which ? rawk[k] : rawq[k];
            f32x4 x; x[0] = bflo(raw[0]); x[1] = bfhi(raw[0]); x[2] = bflo(raw[1]); x[3] = bfhi(raw[1]);
            const float ss = wave_sum((x[0] * x[0] + x[1] * x[1]) + (x[2] * x[2] + x[3] * x[3]));
            const float rstd = rsqrtf(ss * (1.f / 256.f) + EPS);
            const f32x4 g = which ? gkva : gqa;
            f32x4 y;
#pragma unroll
            for (int i = 0; i < 4; ++i) y[i] = x[i] * rstd * g[i];
            v2u o; o.x = pk2(y[0], y[1]); o.y = pk2(y[2], y[3]);
            *(v2u*)(F.w<bf16>(which ? WS_CKVN : WS_CQN) + (size_t)r * 256 + 4 * lane) = o;
            if (which) { float* d = (r < TP) ? F.out + O_PCKV + (size_t)r * 256 : F.out + O_SCKV + (size_t)(r - TP) * 256; *(f32x4*)(d + 4 * lane) = y; }
        }
        if (lane < 32) { float* d = (r < TP) ? F.out + O_PKPE + (size_t)r * 32 : F.out + O_SKPE + (size_t)(r - TP) * 32; d[lane] = bf2f(rawp[k]); }
        } }
    }
    const bf16* MKV = F.w<bf16>(WS_MKV);
    for (int r = gw; r < 2048; r += NGW) {
        const bf16* mr = MKV + (size_t)r * 1024;
        {
            const v4u raw = *(const v4u*)(mr + 8 * lane);
            float x[8];
#pragma unroll
            for (int i = 0; i < 4; ++i) { x[2 * i] = bflo(raw[i]); x[2 * i + 1] = bfhi(raw[i]); }
            float ss = 0.f;
#pragma unroll
            for (int i = 0; i < 8; ++i) ss += x[i] * x[i];
            ss += __shfl_xor(ss, 1); ss += __shfl_xor(ss, 2); ss += __shfl_xor(ss, 4); ss += __shfl_xor(ss, 8);
            const float rstd = rsqrtf(ss * (1.f / 128.f) + EPS);
            const float* g = F.inf(I_GMK) + ((8 * lane) & 127);
            f32x4 y0, y1;
#pragma unroll
            for (int i = 0; i < 4; ++i) { y0[i] = x[i] * rstd * g[i]; y1[i] = x[4 + i] * rstd * g[4 + i]; }
            float* d = F.out + O_PMK + (size_t)r * 512 + 8 * lane; *(f32x4*)d = y0; *(f32x4*)(d + 4) = y1;
            v4u o; o.x = pk2(y0[0], y0[1]); o.y = pk2(y0[2], y0[3]); o.z = pk2(y1[0], y1[1]); o.w = pk2(y1[2], y1[3]);
            *(v4u*)(F.w<bf16>(WS_MK) + (size_t)r * 512 + 8 * lane) = o;
        }
        {
            const v4u raw = *(const v4u*)(mr + 512 + 8 * lane);
            float x[8];
#pragma unroll
            for (int i = 0; i < 4; ++i) { x[2 * i] = bflo(raw[i]); x[2 * i + 1] = bfhi(raw[i]); }
            float* d = F.out + O_PMV + (size_t)r * 512 + 8 * lane; *(f32x4*)d = (f32x4){x[0], x[1], x[2], x[3]}; *(f32x4*)(d + 4) = (f32x4){x[4], x[5], x[6], x[7]};
        }
    }
    for (int g8 = gw; g8 < 256; g8 += NGW) {
        v4u rw[8];
#pragma unroll
        for (int k = 0; k < 8; ++k) rw[k] = *(const v4u*)(MKV + (size_t)(8 * g8 + k) * 1024 + 512 + 8 * lane);
        const int b = (8 * g8) >> 8, key0 = (8 * g8) & 255;
        bf16* mvt = F.w<bf16>(WS_MVT);
#pragma unroll
        for (int i = 0; i < 8; ++i) { const int col = 8 * lane + i, h = col >> 7, dv = col & 127; v4u o;
#pragma unroll
            for (int j = 0; j < 4; ++j) { const unsigned lo = (i & 1) ? (rw[2 * j][i >> 1] >> 16) : (rw[2 * j][i >> 1] & 0xffffu), hi = (i & 1) ? (rw[2 * j + 1][i >> 1] >> 16) : (rw[2 * j + 1][i >> 1] & 0xffffu); o[j] = lo | (hi << 16); }
            *(v4u*)(mvt + ((size_t)(b * 4 + h) * 128 + dv) * 256 + key0) = o; }
    }
}
}
namespace mk {
struct P4Raw { v4u raw; unsigned r1, r2; };
__device__ __forceinline__ P4Raw p4_load_row(const bf16* nope, const bf16* pe, int lane) { const int sub = lane & 7; P4Raw x; x.raw = *(const v4u*)(nope + 8 * sub); x.r1 = *(const unsigned*)(pe + 2 * sub); x.r2 = *(const unsigned*)(pe + 16 + 2 * sub); return x; }
__device__ __forceinline__ void p4_norm_rope_row(const P4Raw in, const float* g, const float* cs, const float* sn, int pos, float oscale, bf16* dst, int lane, bf16* dst2 = nullptr) {
    const int sub = lane & 7;
    const v4u raw = in.raw;
    const unsigned r1 = in.r1, r2 = in.r2;
    float x[8];
#pragma unroll
    for (int i = 0; i < 4; ++i) { x[2 * i] = bflo(raw[i]); x[2 * i + 1] = bfhi(raw[i]); }
    float a0 = bflo(r1), a1 = bfhi(r1), b0 = bflo(r2), b1 = bfhi(r2);
    float ss = (a0 * a0 + a1 * a1) + (b0 * b0 + b1 * b1);
#pragma unroll
    for (int i = 0; i < 8; ++i) ss += x[i] * x[i];
    ss += __shfl_xor(ss, 1); ss += __shfl_xor(ss, 2); ss += __shfl_xor(ss, 4);
    const float rs = rsqrtf(ss * (1.f / 96.f) + EPS) * oscale;
    const f32x4 g0 = *(const f32x4*)(g + 8 * sub), g1 = *(const f32x4*)(g + 8 * sub + 4);
    v4u o; o.x = pk2(x[0] * rs * g0[0], x[1] * rs * g0[1]); o.y = pk2(x[2] * rs * g0[2], x[3] * rs * g0[3]); o.z = pk2(x[4] * rs * g1[0], x[5] * rs * g1[1]); o.w = pk2(x[6] * rs * g1[2], x[7] * rs * g1[3]);
    *(v4u*)(dst + 8 * sub) = o;
    const int f = 2 * sub;
    a0 *= rs * g[64 + f]; a1 *= rs * g[65 + f]; b0 *= rs * g[80 + f]; b1 *= rs * g[81 + f];
    const float c0 = cs[pos * 16 + f], c1 = cs[pos * 16 + f + 1], s0 = sn[pos * 16 + f], s1 = sn[pos * 16 + f + 1];
    const unsigned o1_ = pk2(a0 * c0 - b0 * s0, a1 * c1 - b1 * s1), o2_ = pk2(b0 * c0 + a0 * s0, b1 * c1 + a1 * s1);
    *(unsigned*)(dst + 64 + f) = o1_; *(unsigned*)(dst + 80 + f) = o2_;
    if (dst2) { *(unsigned*)(dst2 + f) = o1_; *(unsigned*)(dst2 + 16 + f) = o2_; }
}
__device__ __forceinline__ void p4_qk_norm_rope(Frame& F) {
    const int gw = F.bid * NWAVES + F.wave, NGW = F.G * NWAVES, lane = F.lane, h = lane >> 3;
    const float* cs = F.w<float>(WS_ROPE); const float* sn = cs + ROPE_N * 16;
    const bf16* QR = F.w<bf16>(WS_QR); const bf16* KNR = F.w<bf16>(WS_KNR); const bf16* Z = F.w<bf16>(WS_Z);
    for (int r0 = gw; r0 < T; r0 += 4 * NGW) {
        P4Raw qin[4], kin[4];
#pragma unroll
        for (int k = 0; k < 4; ++k) { const int r = r0 + k * NGW; if (r < T) { const bf16* q = QR + (size_t)r * 768 + 96 * h; qin[k] = p4_load_row(q, q + 64, lane);
            if (r < TP) kin[k] = p4_load_row(KNR + (size_t)r * 512 + 64 * h, Z + (size_t)r * NINP + 1536, lane); } }
#pragma unroll
        for (int k = 0; k < 4; ++k) { const int r = r0 + k * NGW; if (r < T) {
            const int pos = r < TP ? (r & 2047) : PAST + ((r - TP) & 3);
            bf16* qx = nullptr;
            if (r >= TP) { const int sq = (r - TP) >> 2, tq = (r - TP) & 3; qx = F.w<bf16>(WS_QEXT) + ((size_t)sq * 32 + tq * 8 + h) * 288 + 256; }
            p4_norm_rope_row(qin[k], F.inf(I_GQKQ), cs, sn, pos, QSCALE, F.w<bf16>(WS_QF) + (size_t)r * 768 + 96 * h, lane, qx);
            if (r < TP) p4_norm_rope_row(kin[k], F.inf(I_GQKK), cs, sn, pos, 1.f, F.w<bf16>(WS_KF) + (size_t)r * 768 + 96 * h, lane);
        } }
    }
}
__device__ __forceinline__ void p4_qext(Frame& F) {
    const int gw = F.bid * NWAVES + F.wave, NGW = F.G * NWAVES, lane = F.lane, l31 = lane & 31, hh = lane >> 5;
    const float* gq = F.inf(I_GQKQ); const float* gk = F.inf(I_GQKK);
    for (int u = gw; u < 1024; u += NGW) {
        const int h = u & 7, cbk = (u >> 3) & 7, rbk = u >> 6;
        const int row = TP + 32 * rbk + l31;
        const bf16* qp = F.w<bf16>(WS_QR) + (size_t)row * 768 + 96 * h;
        v4u raw[4]; float ss = 0.f;
#pragma unroll
        for (int ks = 0; ks < 4; ++ks) { raw[ks] = *(const v4u*)(qp + 16 * ks + 8 * hh);
#pragma unroll
            for (int i = 0; i < 4; ++i) { const float a = bflo(raw[ks][i]), c = bfhi(raw[ks][i]); ss += a * a + c * c; } }
        { const v4u r0 = *(const v4u*)(qp + 64 + 16 * hh), r1 = *(const v4u*)(qp + 64 + 16 * hh + 8);
#pragma unroll
          for (int i = 0; i < 4; ++i) { const float a = bflo(r0[i]), c = bfhi(r0[i]), d = bflo(r1[i]), e = bfhi(r1[i]); ss += (a * a + c * c) + (d * d + e * e); } }
        ss += __shfl_xor(ss, 32);
        const float rs = rsqrtf(ss * (1.f / 96.f) + EPS) * QSCALE;
        f32x16 acc = {};
        const float* wp = F.inf(I_WUK) + (size_t)(32 * cbk + l31) * 512 + h * 64 + 8 * hh;
#pragma unroll
        for (int ks = 0; ks < 4; ++ks) {
            const int d0 = 16 * ks + 8 * hh;
            const f32x4 w0 = *(const f32x4*)(wp + 16 * ks), w1 = *(const f32x4*)(wp + 16 * ks + 4);
            v4u wa; wa.x = cvtpk(w0[0], w0[1]); wa.y = cvtpk(w0[2], w0[3]); wa.z = cvtpk(w1[0], w1[1]); wa.w = cvtpk(w1[2], w1[3]);
            const f32x4 q0 = *(const f32x4*)(gq + d0), q1 = *(const f32x4*)(gq + d0 + 4), k0 = *(const f32x4*)(gk + d0), k1 = *(const f32x4*)(gk + d0 + 4);
            v4u qb; qb.x = cvtpk(bflo(raw[ks][0]) * rs * q0[0] * k0[0], bfhi(raw[ks][0]) * rs * q0[1] * k0[1]); qb.y = cvtpk(bflo(raw[ks][1]) * rs * q0[2] * k0[2], bfhi(raw[ks][1]) * rs * q0[3] * k0[3]);
            qb.z = cvtpk(bflo(raw[ks][2]) * rs * q1[0] * k1[0], bfhi(raw[ks][2]) * rs * q1[1] * k1[1]); qb.w = cvtpk(bflo(raw[ks][3]) * rs * q1[2] * k1[2], bfhi(raw[ks][3]) * rs * q1[3] * k1[3]);
            acc = __builtin_amdgcn_mfma_f32_32x32x16_bf16(__builtin_bit_cast(bf16x8, wa), __builtin_bit_cast(bf16x8, qb), acc, 0, 0, 0);
        }
        const int sq = (32 * rbk + l31) >> 2, tq = l31 & 3;
        bf16* dst = F.w<bf16>(WS_QEXT) + ((size_t)sq * 32 + tq * 8 + h) * 288 + 32 * cbk + 4 * hh;
#pragma unroll
        for (int g = 0; g < 4; ++g) { v2u o; o.x = cvtpk(acc[4 * g], acc[4 * g + 1]); o.y = cvtpk(acc[4 * g + 2], acc[4 * g + 3]); *(v2u*)(dst + 8 * g) = o; }
    }
}
}
namespace mk {
__device__ __forceinline__ float wave_max(float v) {
#pragma unroll
    for (int o = 1; o < 64; o <<= 1) v = fmaxf(v, __shfl_xor(v, o));
    return v;
}
__device__ __forceinline__ float gain_absmax(const float* g, int n, int lane) { float m = 0.f; for (int i = lane; i < n; i += 64) m = fmaxf(m, fabsf(g[i])); return wave_max(m); }

constexpr int PA_KROW = 208, PA_VROW = 144, PA_KBUF = 0, PA_VBUF = 2 * 64 * PA_KROW, PA_END = PA_VBUF + 2 * 64 * PA_VROW;
__device__ __forceinline__ void attn_prompt_unit(Frame& F, int b, int h, int qb, float negM) {
    const int tid = F.tid, lane = F.lane, wv = F.wave, l31 = lane & 31, hh = lane >> 5;
    LAS unsigned char* L = F.lds;
    const int q0w = 256 * qb + 32 * wv;
    const bf16* Qp = F.w<bf16>(WS_QF) + (size_t)(b * SEQ + q0w + l31) * 768 + h * 96 + 8 * hh;
    bf16x8 qf[6];
#pragma unroll
    for (int ks = 0; ks < 6; ++ks) qf[ks] = *(const bf16x8*)(Qp + 16 * ks);
    const bf16* Kg = F.w<bf16>(WS_KF) + (size_t)(b * SEQ) * 768 + h * 96;
    const bf16* Vg = F.w<bf16>(WS_VT) + (size_t)(h * 64) * TP + (size_t)b * SEQ;
    const int keyA = tid / 12, cA = tid % 12, keyB = (512 + tid) / 12, cB = (512 + tid) % 12, dvv = tid >> 3, cv = tid & 7;
    const int NT = 4 * qb + 4;
    v4u ka, kb2 = (v4u){0, 0, 0, 0}, vv_;
#define PA_LOAD(kt) do { ka = *(const v4u*)(Kg + (size_t)(64 * (kt) + keyA) * 768 + 8 * cA); if (tid < 256) kb2 = *(const v4u*)(Kg + (size_t)(64 * (kt) + keyB) * 768 + 8 * cB); \
        vv_ = *(const v4u*)(Vg + (size_t)dvv * TP + 64 * (kt) + 8 * cv); } while (0)
#define PA_STORE(buf) do { *(LAS v4u*)(L + PA_KBUF + (buf) * 64 * PA_KROW + keyA * PA_KROW + 16 * cA) = ka; if (tid < 256) *(LAS v4u*)(L + PA_KBUF + (buf) * 64 * PA_KROW + keyB * PA_KROW + 16 * cB) = kb2; \
        *(LAS v4u*)(L + PA_VBUF + (buf) * 64 * PA_VROW + dvv * PA_VROW + 16 * cv) = vv_; } while (0)
    PA_LOAD(0); PA_STORE(0);
    __syncthreads();
    if (NT > 1) PA_LOAD(1);
    f32x16 o0 = {}, o1 = {}; float l = 0.f;
#pragma unroll 1
    for (int kt = 0; kt < NT; ++kt) {
        const int buf = kt & 1;
        if (64 * kt <= q0w + 31) {
            const bool part = (64 * kt + 63 > q0w);
            const LAS unsigned char* kbp = L + PA_KBUF + buf * 64 * PA_KROW + l31 * PA_KROW + 16 * hh;
            const LAS unsigned char* vbp = L + PA_VBUF + buf * 64 * PA_VROW + l31 * PA_VROW + 8 * hh;
            bf16x8 kfa[6], kfb[6], vfa[2][2], vfb[2][2];
#define PA_VFRAG(dst, sub_) do { _Pragma("unroll") for (int s2 = 0; s2 < 2; ++s2) _Pragma("unroll") for (int dt = 0; dt < 2; ++dt) { const LAS unsigned char* vp = vbp + dt * 32 * PA_VROW + (32 * (sub_) + 16 * s2) * 2; \
                const s16x4 lo = *(const LAS s16x4*)vp, hi = *(const LAS s16x4*)(vp + 16); dst[s2][dt] = (bf16x8){lo[0], lo[1], lo[2], lo[3], hi[0], hi[1], hi[2], hi[3]}; } } while (0)
#define PA_EXP(s, sub_, pb, MASK) do { float p[16]; \
                _Pragma("unroll") for (int i = 0; i < 16; ++i) { float e = __builtin_amdgcn_exp2f(s[i] + negM); if (MASK && (64 * kt + 32 * (sub_) + (i & 3) + 8 * (i >> 2) + 4 * hh) > q0w + l31) e = 0.f; p[i] = e; l += e; } \
                _Pragma("unroll") for (int s2 = 0; s2 < 2; ++s2) { v4u w; w.x = cvtpk(p[8 * s2 + 0], p[8 * s2 + 1]); w.y = cvtpk(p[8 * s2 + 2], p[8 * s2 + 3]); w.z = cvtpk(p[8 * s2 + 4], p[8 * s2 + 5]); w.w = cvtpk(p[8 * s2 + 6], p[8 * s2 + 7]); pb[s2] = __builtin_bit_cast(bf16x8, w); } } while (0)
#pragma unroll
            for (int ks = 0; ks < 6; ++ks) kfa[ks] = *(const LAS bf16x8*)(kbp + 32 * ks);
            __builtin_amdgcn_sched_barrier(0);
            f32x16 sA = {}, sB = {};
#pragma unroll
            for (int ks = 0; ks < 6; ++ks) kfb[ks] = *(const LAS bf16x8*)(kbp + 32 * PA_KROW + 32 * ks);
#pragma unroll
            for (int ks = 0; ks < 6; ++ks) sA = __builtin_amdgcn_mfma_f32_32x32x16_bf16(kfa[ks], qf[ks], sA, 0, 0, 0);
            __builtin_amdgcn_sched_barrier(0);
            PA_VFRAG(vfa, 0);
#pragma unroll
            for (int ks = 0; ks < 6; ++ks) sB = __builtin_amdgcn_mfma_f32_32x32x16_bf16(kfb[ks], qf[ks], sB, 0, 0, 0);
            __builtin_amdgcn_sched_barrier(0);
            bf16x8 pbA[2], pbB[2];
            if (part) PA_EXP(sA, 0, pbA, true); else PA_EXP(sA, 0, pbA, false);
            __builtin_amdgcn_sched_barrier(0);
            PA_VFRAG(vfb, 1);
#pragma unroll
            for (int s2 = 0; s2 < 2; ++s2) { o0 = __builtin_amdgcn_mfma_f32_32x32x16_bf16(vfa[s2][0], pbA[s2], o0, 0, 0, 0); o1 = __builtin_amdgcn_mfma_f32_32x32x16_bf16(vfa[s2][1], pbA[s2], o1, 0, 0, 0); }
            __builtin_amdgcn_sched_barrier(0);
            if (part) PA_EXP(sB, 1, pbB, true); else PA_EXP(sB, 1, pbB, false);
            __builtin_amdgcn_sched_barrier(0);
#pragma unroll
            for (int s2 = 0; s2 < 2; ++s2) { o0 = __builtin_amdgcn_mfma_f32_32x32x16_bf16(vfb[s2][0], pbB[s2], o0, 0, 0, 0); o1 = __builtin_amdgcn_mfma_f32_32x32x16_bf16(vfb[s2][1], pbB[s2], o1, 0, 0, 0); }
            __builtin_amdgcn_sched_barrier(0);
#undef PA_VFRAG
#undef PA_EXP
        }
        if (kt + 1 < NT) PA_STORE(buf ^ 1);
        __syncthreads();
        if (kt + 2 < NT) PA_LOAD(kt + 2);
    }
#undef PA_LOAD
#undef PA_STORE
    l += __shfl_xor(l, 32);
    const float rl = 1.f / l;
    bf16* Op = F.w<bf16>(WS_BO) + (size_t)(b * SEQ + q0w + l31) * 512 + h * 64 + 4 * hh;
#pragma unroll
    for (int g = 0; g < 4; ++g) {
        v2u w0; w0.x = cvtpk(o0[4 * g] * rl, o0[4 * g + 1] * rl); w0.y = cvtpk(o0[4 * g + 2] * rl, o0[4 * g + 3] * rl);
        v2u w1; w1.x = cvtpk(o1[4 * g] * rl, o1[4 * g + 1] * rl); w1.y = cvtpk(o1[4 * g + 2] * rl, o1[4 * g + 3] * rl);
        *(v2u*)(Op + 8 * g) = w0; *(v2u*)(Op + 32 + 8 * g) = w1;
    }
}
__device__ __forceinline__ void p5_attn_prompt(Frame& F, float negM) {
    for (int u = F.bid; u < 256; u += F.G) {
        const int bh = u >> 2, p = u & 3, b = bh >> 3, h = bh & 7;
        attn_prompt_unit(F, b, h, p, negM);
        attn_prompt_unit(F, b, h, 7 - p, negM);
    }
}
}
namespace mk {
constexpr int SA_ROWB = 592;
constexpr int SA_TILE = 0, SA_T8 = 2 * 64 * SA_ROWB, SA_T8ROW = 272, SA_KP2 = SA_T8 + 64 * SA_T8ROW, SA_GPE = SA_KP2 + 256, SA_R = SA_GPE + 128, SA_PT = SA_R + 2048, SA_PTROW = 144,
              SA_QEXT = SA_PT + 32 * SA_PTROW, SA_RBASE = SA_QEXT + 32 * SA_ROWB  , SA_RDEL = SA_RBASE + 65 * 128  , SA_END = SA_RDEL + 64 * 128;
static_assert(SA_END <= RING_BYTES, "sample attention LDS");
typedef short v4i16_t __attribute__((ext_vector_type(4)));
#define SA_BAR() do { asm volatile("s_waitcnt lgkmcnt(0)" ::: "memory"); __builtin_amdgcn_s_barrier(); asm volatile("" ::: "memory"); } while (0)

__device__ __forceinline__ void attn_sample_unit(Frame& F, int s, int split, float negM) {
    const int tid = F.tid, lane = F.lane, w = F.wave, hh = lane >> 5, l31 = lane & 31;
    LAS unsigned char* L = F.lds;
    const float* pool_ckv = F.inf(I_CKV); const float* pool_kpe = F.inf(I_KPE); const int* pt = (const int*)F.in[I_PT] + s * 64;
    const float* cs = F.w<float>(WS_ROPE); const float* sn = cs + ROPE_N * 16;
    const float* gk = F.inf(I_GQKK);
    const int kbeg = split * 4096, NT = split ? 65 : 64;
    const int prow = tid >> 3, pc4 = tid & 7;
    const int mypage = pt[split * 32 + l31];
    f32x4 va[8], vb[8], pe;
#define SA_LOADC(n, V) do { const int key0_ = kbeg + 64 * (n); const int page_ = __builtin_amdgcn_readlane(mypage, (n) >> 1); const size_t rb_ = (size_t)page_ * 128 + (key0_ & 127); \
        const float* cp_ = pool_ckv + (rb_ + w) * 256 + 4 * lane; \
        _Pragma("unroll") for (int i = 0; i < 8; ++i) V[i] = __builtin_nontemporal_load((const f32x4*)(cp_ + (size_t)i * 2048)); } while (0)
#define SA_LOADPC(n) do { const int key0_ = kbeg + 64 * (n); const int page_ = __builtin_amdgcn_readlane(mypage, (n) >> 1); const size_t rb_ = (size_t)page_ * 128 + (key0_ & 127); \
        pe = __builtin_nontemporal_load((const f32x4*)(pool_kpe + (rb_ + prow) * 32 + 4 * pc4)); } while (0)
#define SA_LOADP(n) do { if (kbeg + 64 * (n) < PAST) SA_LOADPC(n); else { pe = (f32x4){0.f, 0.f, 0.f, 0.f}; \
            if (prow < 4) { const v2u r_ = *(const v2u*)(F.w<bf16>(WS_Z) + (size_t)(TP + 4 * s + prow) * NINP + 1536 + 4 * pc4); pe = (f32x4){bflo(r_.x), bfhi(r_.x), bflo(r_.y), bfhi(r_.y)}; } } } while (0)
#define SA_LOAD(n, V) do { \
        if (kbeg + 64 * (n) < PAST) SA_LOADC(n, V); else { \
            _Pragma("unroll") for (int i = 0; i < 8; ++i) V[i] = (f32x4){0.f, 0.f, 0.f, 0.f}; \
            if (w < 4) { const v2u o_ = *(const v2u*)(F.w<bf16>(WS_CKVN) + (size_t)(TP + 4 * s + w) * 256 + 4 * lane); V[0] = (f32x4){bflo(o_.x), bfhi(o_.x), bflo(o_.y), bfhi(o_.y)}; } \
        } } while (0)
#define SA_CONVERT(n, V) do { LAS unsigned char* tb_ = L + SA_TILE + ((n) & 1) * 64 * SA_ROWB; \
        _Pragma("unroll") for (int i = 0; i < 8; ++i) { v2u o_; o_.x = cvtpk(V[i][0], V[i][1]); o_.y = cvtpk(V[i][2], V[i][3]); \
            *(LAS v2u*)(tb_ + (w + 8 * i) * SA_ROWB + 8 * lane) = o_; \
            int f8_ = 0; f8_ = __builtin_amdgcn_cvt_pk_fp8_f32(V[i][0], V[i][1], f8_, false); f8_ = __builtin_amdgcn_cvt_pk_fp8_f32(V[i][2], V[i][3], f8_, true); \
            *(LAS int*)(L + SA_T8 + (w + 8 * i) * SA_T8ROW + 4 * lane) = f8_; } \
        { const f32x4 pv = pe; float ss_ = (pv[0] * pv[0] + pv[1] * pv[1]) + (pv[2] * pv[2] + pv[3] * pv[3]); ss_ += __shfl_xor(ss_, 1); ss_ += __shfl_xor(ss_, 2); ss_ += __shfl_xor(ss_, 4); \
          if (pc4 == 0) ((LAS float*)(L + SA_KP2))[prow] = ss_; \
          const LAS float* rb_ = (const LAS float*)(L + SA_RBASE) + (n) * 32 + 4 * (pc4 & 3); const LAS float* rd_ = (const LAS float*)(L + SA_RDEL) + prow * 32 + 4 * (pc4 & 3); \
          const f32x4 cb_ = *(const LAS f32x4*)rb_, sb_ = *(const LAS f32x4*)(rb_ + 16), cd_ = *(const LAS f32x4*)rd_, sd_ = *(const LAS f32x4*)(rd_ + 16); \
          const f32x4 c_ = cb_ * cd_ - sb_ * sd_, s_ = sb_ * cd_ + cb_ * sd_; \
          f32x4 x_ = pv * *(const LAS f32x4*)(L + SA_GPE + 16 * pc4), y_, o4_; y_[0] = __shfl_xor(x_[0], 4); y_[1] = __shfl_xor(x_[1], 4); y_[2] = __shfl_xor(x_[2], 4); y_[3] = __shfl_xor(x_[3], 4); \
          if (pc4 < 4) o4_ = x_ * c_ - y_ * s_; else o4_ = x_ * c_ + y_ * s_; \
          v2u o_; o_.x = cvtpk(o4_[0], o4_[1]); o_.y = cvtpk(o4_[2], o4_[3]); *(LAS v2u*)(tb_ + prow * SA_ROWB + 512 + pc4 * 8) = o_; } } while (0)
    SA_LOADPC(0); SA_LOADC(0, va);
    __builtin_amdgcn_sched_barrier(0);
    SA_LOADC(1, vb);
    __builtin_amdgcn_sched_barrier(0);
    { const bf16* qx = F.w<bf16>(WS_QEXT) + (size_t)s * 32 * 288;
      for (int ch = tid; ch < 32 * 36; ch += 512) { const int r_ = ch / 36, c_ = ch % 36; *(LAS v4u*)(L + SA_QEXT + r_ * SA_ROWB + 16 * c_) = *(const v4u*)(qx + r_ * 288 + 8 * c_); } }
    typedef int v8i_t __attribute__((ext_vector_type(8)));
    v8i_t Wf[2][4];
    { const bf16* Wp = F.w<bf16>(WS_W_UK) + (size_t)(w * 64 + l31) * 256 + 32 * hh;
#pragma unroll
      for (int dt = 0; dt < 2; ++dt)
#pragma unroll
          for (int ks = 0; ks < 4; ++ks) { v8i_t fr;
#pragma unroll
              for (int q = 0; q < 4; ++q) { const v4u raw = *(const v4u*)(Wp + (size_t)dt * 32 * 256 + 64 * ks + 8 * q);
                  int d0 = 0, d1 = 0;
                  d0 = __builtin_amdgcn_cvt_pk_fp8_f32(bflo(raw.x) * 16.f, bfhi(raw.x) * 16.f, d0, false); d0 = __builtin_amdgcn_cvt_pk_fp8_f32(bflo(raw.y) * 16.f, bfhi(raw.y) * 16.f, d0, true);
                  d1 = __builtin_amdgcn_cvt_pk_fp8_f32(bflo(raw.z) * 16.f, bfhi(raw.z) * 16.f, d1, false); d1 = __builtin_amdgcn_cvt_pk_fp8_f32(bflo(raw.w) * 16.f, bfhi(raw.w) * 16.f, d1, true);
                  fr[2 * q] = d0; fr[2 * q + 1] = d1; }
              Wf[dt][ks] = fr; } }
    if (tid < 32) ((LAS float*)(L + SA_GPE))[tid] = gk[64 + tid];
    for (int i = tid; i < 65 * 8; i += 512) { const int n_ = i >> 3, c_ = i & 7; *(LAS f32x4*)(L + SA_RBASE + n_ * 128 + 16 * c_) = *(const f32x4*)((c_ < 4 ? cs : sn - 16) + (size_t)(kbeg + 64 * n_) * 16 + 4 * c_); }
    { const int r_ = tid >> 3, c_ = tid & 7; *(LAS f32x4*)(L + SA_RDEL + r_ * 128 + 16 * c_) = *(const f32x4*)((c_ < 4 ? cs : sn - 16) + (size_t)r_ * 16 + 4 * c_); }
    SA_BAR();
    f32x16 oacc = {}; float lsum = 0.f;
    SA_CONVERT(0, va);
    __builtin_amdgcn_sched_barrier(0);
    SA_LOADPC(1);
    __builtin_amdgcn_sched_barrier(0);
    SA_LOADC(2, va);
    __builtin_amdgcn_sched_barrier(0);
    SA_BAR();
    const int lane_ = lane, tid_ = tid;
#define SA_STEP(n, V, DO_CONV, DO_LOADP, LOADPM, DO_LOAD, LOADM) do { \
        const int lane = opaque_i(lane_), tid = opaque_i(tid_), hh = lane >> 5, l31 = lane & 31, prow = tid >> 3, pc4 = tid & 7, l15 = lane & 15, l4 = lane >> 4;     \
        const LAS unsigned char* tb = L + SA_TILE + ((n) & 1) * 64 * SA_ROWB; \
          \
        _Pragma("unroll") for (int kt2 = 0; kt2 < 2; ++kt2) { \
            const LAS unsigned char* bp = L + SA_T8 + (32 * kt2 + l31) * SA_T8ROW + 32 * hh; \
            f32x16 a0 = {}, a1 = {}; \
            _Pragma("unroll") for (int ks = 0; ks < 4; ++ks) { const v4u lo = *(const LAS v4u*)(bp + 64 * ks), hi = *(const LAS v4u*)(bp + 64 * ks + 16); \
                const v8i_t fb = (v8i_t){(int)lo.x, (int)lo.y, (int)lo.z, (int)lo.w, (int)hi.x, (int)hi.y, (int)hi.z, (int)hi.w}; \
                a0 = __builtin_amdgcn_mfma_scale_f32_32x32x64_f8f6f4(Wf[0][ks], fb, a0, 0, 0, 0, 0x7B7B7B7B, 0, 0x7F7F7F7F); \
                a1 = __builtin_amdgcn_mfma_scale_f32_32x32x64_f8f6f4(Wf[1][ks], fb, a1, 0, 0, 0, 0x7B7B7B7B, 0, 0x7F7F7F7F); \
                if (ks & 1) __builtin_amdgcn_sched_barrier(0); } \
            float ss = 0.f; \
            _Pragma("unroll") for (int i = 0; i < 16; ++i) ss += a0[i] * a0[i] + a1[i] * a1[i]; \
            ss += __shfl_xor(ss, 32); \
            ss += ((const LAS float*)(L + SA_KP2))[32 * kt2 + l31]; \
            if (hh == 0) ((LAS float*)(L + SA_R))[w * 64 + 32 * kt2 + l31] = rsqrtf(ss * (1.f / 96.f) + EPS); \
        } \
        SA_BAR(); \
        if (DO_CONV) SA_CONVERT((n) + 1, V); \
        __builtin_amdgcn_sched_barrier(0); \
        if (DO_LOADP) LOADPM((n) + 2); \
        __builtin_amdgcn_sched_barrier(0); \
        if (DO_LOAD) LOADM((n) + 3, V); \
        __builtin_amdgcn_sched_barrier(0); \
          \
        if (w < 2) { \
            f32x16 sa0 = {}, sa1 = {}; \
            const LAS unsigned char* ap = tb + (32 * w + l31) * SA_ROWB + 16 * hh; \
            const LAS unsigned char* qp = L + SA_QEXT + l31 * SA_ROWB + 16 * hh; \
            _Pragma("unroll") for (int k0 = 0; k0 < 18; k0 += 3) { bf16x8 afr[3], qfr[3]; \
                _Pragma("unroll") for (int ks = 0; ks < 3; ++ks) { afr[ks] = *(const LAS bf16x8*)(ap + 32 * (k0 + ks)); qfr[ks] = *(const LAS bf16x8*)(qp + 32 * (k0 + ks)); } \
                __builtin_amdgcn_sched_barrier(0); \
                _Pragma("unroll") for (int ks = 0; ks < 3; ++ks) { if ((k0 + ks) & 1) sa1 = __builtin_amdgcn_mfma_f32_32x32x16_bf16(afr[ks], qfr[ks], sa1, 0, 0, 0); else sa0 = __builtin_amdgcn_mfma_f32_32x32x16_bf16(afr[ks], qfr[ks], sa0, 0, 0, 0); } \
                __builtin_amdgcn_sched_barrier(0); } \
            const int t_q = l31 >> 3, h_q = l31 & 7; \
            _Pragma("unroll") for (int g = 0; g < 4; ++g) { \
                const f32x4 r4 = *(const LAS f32x4*)(L + SA_R + (h_q * 64 + 32 * w + 8 * g + 4 * hh) * 4); \
                const int kg = kbeg + 64 * (n) + 32 * w + 8 * g + 4 * hh; \
                float p[4]; \
                _Pragma("unroll") for (int i = 0; i < 4; ++i) { float e = __builtin_amdgcn_exp2f((sa0[4 * g + i] + sa1[4 * g + i]) * r4[i] + negM); if (kg + i > PAST + t_q) e = 0.f; p[i] = e; lsum += e; } \
                v2u o; o.x = cvtpk(p[0], p[1]); o.y = cvtpk(p[2], p[3]); \
                *(LAS v2u*)(L + SA_PT + l31 * SA_PTROW + (32 * w + 8 * g + 4 * hh) * 2) = o; } \
        } \
        SA_BAR(); \
          \
        { \
            const LAS unsigned char* trp = tb + (8 * hh + (l15 >> 2)) * SA_ROWB + (32 * w + 16 * (l4 & 1) + 4 * (l15 & 3)) * 2; \
            const LAS unsigned char* pp = L + SA_PT + l31 * SA_PTROW + 16 * hh; \
            _Pragma("unroll") for (int s2 = 0; s2 < 4; ++s2) { \
                const s16x4 lo = __builtin_bit_cast(s16x4, __builtin_amdgcn_ds_read_tr16_b64_v4i16((LAS v4i16_t*)(trp + (16 * s2) * SA_ROWB))); \
                const s16x4 hi = __builtin_bit_cast(s16x4, __builtin_amdgcn_ds_read_tr16_b64_v4i16((LAS v4i16_t*)(trp + (16 * s2 + 4) * SA_ROWB))); \
                const bf16x8 af = (bf16x8){lo[0], lo[1], lo[2], lo[3], hi[0], hi[1], hi[2], hi[3]}; \
                const bf16x8 pf = *(const LAS bf16x8*)(pp + 32 * s2); \
                oacc = __builtin_amdgcn_mfma_f32_32x32x16_bf16(af, pf, oacc, 0, 0, 0); if (s2 & 1) __builtin_amdgcn_sched_barrier(0); \
            } \
        } } while (0)
#pragma unroll 1
    for (int n = 0; n < 60; n += 2) {
        SA_STEP(n, vb, true, true, SA_LOADPC, true, SA_LOADC);
        SA_STEP(n + 1, va, true, true, SA_LOADPC, true, SA_LOADC);
    }
#pragma unroll 1
    for (int n = 60; n < NT; n += 2) {
        SA_STEP(n, vb, n + 1 < NT, n + 2 < NT, SA_LOADP, n + 3 < NT, SA_LOAD);
        if (n + 1 < NT) SA_STEP(n + 1, va, n + 2 < NT, n + 3 < NT, SA_LOADP, n + 4 < NT, SA_LOAD);
    }
#undef SA_STEP
#undef SA_LOAD
#undef SA_LOADC
#undef SA_LOADP
#undef SA_LOADPC
#undef SA_CONVERT
    float* part = (float*)(F.ws + WS_SPART + (size_t)(s * 2 + split) * SPART_STRIDE);
    lsum += __shfl_xor(lsum, 32);
    __syncthreads();
    if (w < 2 && lane < 32) ((LAS float*)(L + SA_R))[w * 32 + lane] = lsum;
    __syncthreads();
    if (tid < 32) { const LAS float* lp = (const LAS float*)(L + SA_R); part[tid] = lp[tid] + lp[32 + tid]; }
#pragma unroll
    for (int g = 0; g < 4; ++g) *(f32x4*)(part + 32 + l31 * 256 + 32 * w + 8 * g + 4 * hh) = (f32x4){oacc[4 * g], oacc[4 * g + 1], oacc[4 * g + 2], oacc[4 * g + 3]};
    __syncthreads();
}
}
namespace mk {
__device__ __forceinline__ void p6_gmlp_chunk(Frame& F, int chunk) {
    const int lane = F.lane, g = F.wave, hh = lane >> 5, l31 = lane & 31;
    LAS float* SS = (LAS float*)(F.lds + 131072);
    LAS unsigned char* VT_ = F.lds + g * 16384;
    const int row0 = chunk * 128;
    const bf16* VG = F.w<bf16>(WS_VG) + (size_t)row0 * 512 + g * 64;
    const bf16* Z = F.w<bf16>(WS_Z) + (size_t)row0 * NINP + g * 64;
    const bf16* Wg = F.w<bf16>(WS_W_SB) + (size_t)g * 128 * 128;
    const float* bs = F.inf(I_BS) + g * 128;
    v4u wf[4][8];
#pragma unroll
    for (int tt = 0; tt < 4; ++tt)
#pragma unroll
        for (int ks = 0; ks < 2 * tt + 2; ++ks) wf[tt][ks] = *(const v4u*)(Wg + (size_t)(32 * tt + l31) * 128 + 16 * ks + 8 * hh);
#pragma unroll
    for (int i = 0; i < 16; ++i) { const int r = (lane >> 3) + 8 * i, ch = lane & 7; const v4u v = *(const v4u*)(VG + (size_t)r * 512 + 8 * ch); *(LAS v4u*)(VT_ + r * 128 + 16 * ch) = v;
        if ((i & 3) == 3) __builtin_amdgcn_sched_barrier(0); }
    LDS_WAIT(); asm volatile("" ::: "memory");
    const int l4 = lane >> 4, l15 = lane & 15;
    const LAS unsigned char* trb = VT_ + (8 * hh + (l15 >> 2)) * 128 + (16 * (l4 & 1) + 4 * (l15 & 3)) * 2;
    v2u pa[4][2][4];
    v2u ura[4][2][4]; float bta[4];
#pragma unroll
    for (int tt = 0; tt < 4; ++tt) { const int t = 32 * tt + l31; bta[tt] = bs[t];
#pragma unroll
        for (int dt = 0; dt < 2; ++dt)
#pragma unroll
            for (int gq = 0; gq < 4; ++gq) ura[tt][dt][gq] = *(const v2u*)(Z + (size_t)t * NINP + 32 * dt + 8 * gq + 4 * hh); }
#pragma unroll
    for (int tt = 0; tt < 4; ++tt) {
        const int t = 32 * tt + l31;
        const v2u (&ur)[2][4] = ura[tt];
        const float bt = bta[tt];
        f32x16 a0 = {}, a1 = {};
#pragma unroll
        for (int ks = 0; ks < 2 * tt + 2; ++ks) {
            v4u pk = wf[tt][ks];
            if (ks >= 2 * tt) {
                const int s0 = 16 * ks + 8 * hh;
#pragma unroll
                for (int i = 0; i < 4; ++i) { unsigned wv = pk[i]; if (s0 + 2 * i > t) wv = 0u; else if (s0 + 2 * i + 1 > t) wv &= 0xffffu; pk[i] = wv; }
            }
            const bf16x8 bfr = __builtin_bit_cast(bf16x8, pk);
            bf16x8 af[2];
#pragma unroll
            for (int dt = 0; dt < 2; ++dt) {
                const s16x4 lo = __builtin_bit_cast(s16x4, __builtin_amdgcn_ds_read_tr16_b64_v4i16((LAS v4i16_t*)(trb + (16 * ks) * 128 + 64 * dt)));
                const s16x4 hi = __builtin_bit_cast(s16x4, __builtin_amdgcn_ds_read_tr16_b64_v4i16((LAS v4i16_t*)(trb + (16 * ks + 4) * 128 + 64 * dt)));
                af[dt] = (bf16x8){lo[0], lo[1], lo[2], lo[3], hi[0], hi[1], hi[2], hi[3]};
            }
            a0 = __builtin_amdgcn_mfma_f32_32x32x16_bf16(af[0], bfr, a0, 0, 0, 0); a1 = __builtin_amdgcn_mfma_f32_32x32x16_bf16(af[1], bfr, a1, 0, 0, 0);
        }
        float ss = 0.f;
#pragma unroll
        for (int dt = 0; dt < 2; ++dt)
#pragma unroll
            for (int gq = 0; gq < 4; ++gq) {
                const v2u u2 = ur[dt][gq];
                const float u0 = gelu_tanh_f(bflo(u2.x)), u1 = gelu_tanh_f(bfhi(u2.x)), u2f = gelu_tanh_f(bflo(u2.y)), u3 = gelu_tanh_f(bfhi(u2.y));
                const f32x16& acc = dt ? a1 : a0;
                const float v0 = u0 * (acc[4 * gq] + bt), v1 = u1 * (acc[4 * gq + 1] + bt), v2 = u2f * (acc[4 * gq + 2] + bt), v3 = u3 * (acc[4 * gq + 3] + bt);
                ss += (v0 * v0 + v1 * v1) + (v2 * v2 + v3 * v3);
                v2u o; o.x = cvtpk(v0, v1); o.y = cvtpk(v2, v3); pa[tt][dt][gq] = o;
            }
        ss += __shfl_xor(ss, 32);
        if (hh == 0) SS[g * 128 + t] = ss;
    }
    __syncthreads();
    const float* goa = F.inf(I_GOA) + g * 64;
    bf16* MRG = F.w<bf16>(WS_MRG) + (size_t)row0 * 1024 + g * 64;
#pragma unroll
    for (int tt = 0; tt < 4; ++tt) {
        const int t = 32 * tt + l31;
        float tot = 0.f;
#pragma unroll
        for (int k = 0; k < 8; ++k) tot += SS[k * 128 + t];
        const float rstd = rsqrtf(tot * (1.f / 512.f) + EPS);
#pragma unroll
        for (int dt = 0; dt < 2; ++dt)
#pragma unroll
            for (int gq = 0; gq < 4; ++gq) {
                const int d0 = 32 * dt + 8 * gq + 4 * hh;
                const f32x4 gg = *(const f32x4*)(goa + d0);
                const v2u v = pa[tt][dt][gq];
                v2u o; o.x = cvtpk(bflo(v.x) * rstd * gg[0], bfhi(v.x) * rstd * gg[1]); o.y = cvtpk(bflo(v.y) * rstd * gg[2], bfhi(v.y) * rstd * gg[3]);
                *(v2u*)(MRG + (size_t)t * 1024 + d0) = o;
            }
    }
    __syncthreads();
}
__device__ __forceinline__ void p6_sample_seq(Frame& F, int s) {
    const int tid = F.tid, lane = F.lane, w = F.wave, l31 = lane & 31, hh = lane >> 5;
    LAS float* RED = (LAS float*)(F.lds + 32768);
    const float* p0 = (const float*)(F.ws + WS_SPART + (size_t)(s * 2) * SPART_STRIDE); const float* p1 = (const float*)((const unsigned char*)p0 + SPART_STRIDE);
    f32x16 a0 = {}, a1 = {};
    {
        const int th = (l31 & 3) * 8 + w;
        const float inv_l = 1.f / (p0[th] + p1[th]);
        const float* o0 = p0 + 32 + th * 256 + 8 * hh; const float* o1 = p1 + 32 + th * 256 + 8 * hh;
        const bf16* Wp = F.w<bf16>(WS_W_UV) + (size_t)(w * 64 + l31) * 256 + 8 * hh;
#pragma unroll
        for (int k0 = 0; k0 < 16; k0 += 4) {
            f32x4 x0[4], x1[4], y0[4], y1[4]; bf16x8 b0[4], b1[4];
#pragma unroll
            for (int i = 0; i < 4; ++i) { const int ks = k0 + i; x0[i] = *(const f32x4*)(o0 + 16 * ks); x1[i] = *(const f32x4*)(o0 + 16 * ks + 4); y0[i] = *(const f32x4*)(o1 + 16 * ks); y1[i] = *(const f32x4*)(o1 + 16 * ks + 4);
                b0[i] = *(const bf16x8*)(Wp + 16 * ks); b1[i] = *(const bf16x8*)(Wp + (size_t)32 * 256 + 16 * ks); }
#pragma unroll
            for (int i = 0; i < 4; ++i) { const f32x4 u0 = (x0[i] + y0[i]) * inv_l, u1 = (x1[i] + y1[i]) * inv_l;
                v4u pk; pk.x = cvtpk(u0[0], u0[1]); pk.y = cvtpk(u0[2], u0[3]); pk.z = cvtpk(u1[0], u1[1]); pk.w = cvtpk(u1[2], u1[3]);
                if (l31 >= 4) pk = (v4u){0u, 0u, 0u, 0u};
                const bf16x8 af = __builtin_bit_cast(bf16x8, pk);
                a0 = __builtin_amdgcn_mfma_f32_32x32x16_bf16(af, b0[i], a0, 0, 0, 0); a1 = __builtin_amdgcn_mfma_f32_32x32x16_bf16(af, b1[i], a1, 0, 0, 0); }
        }
    }
    const int col = tid;
    float ao[4];
    { const int g = col >> 6; const bf16* VG = F.w<bf16>(WS_VG) + (size_t)(TP + 4 * s) * 512 + col; const bf16* Z = F.w<bf16>(WS_Z) + (size_t)(TP + 4 * s) * NINP + col;
      const float* Wg = F.inf(I_WS) + (size_t)g * 128 * 128; const float* bs = F.inf(I_BS) + g * 128;
      float vg[4];
#pragma unroll
      for (int t = 0; t < 4; ++t) vg[t] = bf2f(VG[(size_t)t * 512]);
#pragma unroll
      for (int t = 0; t < 4; ++t) { float m = bs[t];
#pragma unroll
          for (int s2 = 0; s2 <= t; ++s2) m += Wg[t * 128 + s2] * vg[s2];
          ao[t] = gelu_tanh_f(bf2f(Z[(size_t)t * NINP])) * m; } }
    float red[8];
#pragma unroll
    for (int t = 0; t < 4; ++t) { red[t] = wave_sum(ao[t] * ao[t]); const float bq = (hh == 0) ? (a0[t] * a0[t] + a1[t] * a1[t]) : 0.f; red[4 + t] = wave_sum(bq); }
    if (lane < 8) { float v = red[0];
#pragma unroll
        for (int k = 1; k < 8; ++k) v = (lane == k) ? red[k] : v;
        RED[w * 8 + lane] = v; }
    __syncthreads();
    const float ga = F.inf(I_GOA)[col];
    bf16* MRG = F.w<bf16>(WS_MRG) + (size_t)(TP + 4 * s) * 1024; bf16* BO = F.w<bf16>(WS_BO) + (size_t)(TP + 4 * s) * 512;
    const float gb0 = F.inf(I_GOB)[w * 64 + l31], gb1 = F.inf(I_GOB)[w * 64 + 32 + l31];
#pragma unroll
    for (int t = 0; t < 4; ++t) {
        float sa = 0.f, sb = 0.f;
#pragma unroll
        for (int k = 0; k < 8; ++k) { sa += RED[k * 8 + t]; sb += RED[k * 8 + 4 + t]; }
        MRG[(size_t)t * 1024 + col] = (bf16)f2bf(ao[t] * rsqrtf(sa * (1.f / 512.f) + EPS) * ga);
        if (hh == 0) { const float rb = rsqrtf(sb * (1.f / 512.f) + EPS);
            MRG[(size_t)t * 1024 + 512 + w * 64 + l31] = (bf16)f2bf(a0[t] * rb * gb0); MRG[(size_t)t * 1024 + 512 + w * 64 + 32 + l31] = (bf16)f2bf(a1[t] * rb * gb1);
            BO[(size_t)t * 512 + w * 64 + l31] = (bf16)f2bf(a0[t]); BO[(size_t)t * 512 + w * 64 + 32 + l31] = (bf16)f2bf(a1[t]); }
    }
    __syncthreads();
}
static_assert(TP % (4 * 256 * NWAVES) == 0, "b_out norm loop: four rows per wave iteration");
__device__ __forceinline__ void p6_merge(Frame& F) {
#ifdef MK_TIMING
    unsigned long long* st_ = (unsigned long long*)(F.ws + WS_CTL + (768 << 10)) + F.bid * 32;
#define P6ST(k) do { if (F.tid == 0) st_[k] = __builtin_amdgcn_s_memrealtime(); } while (0)
#else
#define P6ST(k) do {} while (0)
#endif
    { const int u = F.bid; if (u < 128) { P6ST(24); p6_gmlp_chunk(F, u); P6ST(25); } else { P6ST(26); p6_sample_seq(F, u - 128); P6ST(27); } }
    P6ST(28);
    const int gw = F.bid * NWAVES + F.wave, NGW = F.G * NWAVES, lane = F.lane;
    const f32x4 g0 = *(const f32x4*)(F.inf(I_GOB) + 8 * lane), g1 = *(const f32x4*)(F.inf(I_GOB) + 8 * lane + 4);
    for (int r0 = gw; r0 < TP; r0 += 4 * NGW) {
        v4u raws[4];
#pragma unroll
        for (int k = 0; k < 4; ++k) raws[k] = *(const v4u*)(F.w<bf16>(WS_BO) + (size_t)(r0 + k * NGW) * 512 + 8 * lane);
#pragma unroll
        for (int k = 0; k < 4; ++k) { const int r = r0 + k * NGW; const v4u raw = raws[k];
        float x[8];
#pragma unroll
        for (int i = 0; i < 4; ++i) { x[2 * i] = bflo(raw[i]); x[2 * i + 1] = bfhi(raw[i]); }
        float ss = 0.f;
#pragma unroll
        for (int i = 0; i < 8; ++i) ss += x[i] * x[i];
        const float rstd = rsqrtf(wave_sum(ss) * (1.f / 512.f) + EPS);
        v4u o; o.x = pk2(x[0] * rstd * g0[0], x[1] * rstd * g0[1]); o.y = pk2(x[2] * rstd * g0[2], x[3] * rstd * g0[3]); o.z = pk2(x[4] * rstd * g1[0], x[5] * rstd * g1[1]); o.w = pk2(x[6] * rstd * g1[2], x[7] * rstd * g1[3]);
        *(v4u*)(F.w<bf16>(WS_MRG) + (size_t)r * 1024 + 512 + 8 * lane) = o;
        }
    }
    P6ST(29);
}
}
namespace mk {
__device__ __forceinline__ void rms_rowb_finish(const v4u a, const v4u b, const f32x4 g0, const f32x4 g1, const f32x4 g2, const f32x4 g3, bf16* orow, int lane) {
    float x[16];
#pragma unroll
    for (int i = 0; i < 4; ++i) { x[2 * i] = bflo(a[i]); x[2 * i + 1] = bfhi(a[i]); x[8 + 2 * i] = bflo(b[i]); x[8 + 2 * i + 1] = bfhi(b[i]); }
    float s = 0.f;
#pragma unroll
    for (int i = 0; i < 16; ++i) s += x[i] * x[i];
    const float rstd = rsqrtf(wave_sum(s) * (1.f / 1024.f) + EPS);
    v4u o0, o1;
    o0.x = pk2(x[0] * rstd * g0[0], x[1] * rstd * g0[1]); o0.y = pk2(x[2] * rstd * g0[2], x[3] * rstd * g0[3]); o0.z = pk2(x[4] * rstd * g1[0], x[5] * rstd * g1[1]); o0.w = pk2(x[6] * rstd * g1[2], x[7] * rstd * g1[3]);
    o1.x = pk2(x[8] * rstd * g2[0], x[9] * rstd * g2[1]); o1.y = pk2(x[10] * rstd * g2[2], x[11] * rstd * g2[3]); o1.z = pk2(x[12] * rstd * g3[0], x[13] * rstd * g3[1]); o1.w = pk2(x[14] * rstd * g3[2], x[15] * rstd * g3[3]);
    *(v4u*)(orow + 8 * lane) = o0; *(v4u*)(orow + 512 + 8 * lane) = o1;
}
__device__ __forceinline__ void p_rms_rows(Frame& F, size_t src_off, int gain_idx, size_t dst_off) {
    const int gw = F.bid * NWAVES + F.wave, NGW = F.G * NWAVES, lane = F.lane;
    const float* g = F.inf(gain_idx);
    const f32x4 g0 = *(const f32x4*)(g + 8 * lane), g1 = *(const f32x4*)(g + 8 * lane + 4), g2 = *(const f32x4*)(g + 512 + 8 * lane), g3 = *(const f32x4*)(g + 512 + 8 * lane + 4);
    const bf16* src = F.w<bf16>(src_off); bf16* dst = F.w<bf16>(dst_off);
    for (int r = gw; r < T; r += 4 * NGW) {
        v4u a[4], b[4];
#pragma unroll
        for (int k = 0; k < 4; ++k) { const int rr = r + k * NGW; if (rr < T) { a[k] = *(const v4u*)(src + (size_t)rr * D + 8 * lane); b[k] = *(const v4u*)(src + (size_t)rr * D + 512 + 8 * lane); } }
#pragma unroll
        for (int k = 0; k < 4; ++k) { const int rr = r + k * NGW; if (rr < T) rms_rowb_finish(a[k], b[k], g0, g1, g2, g3, dst + (size_t)rr * D, lane); }
    }
}

constexpr int MA_KROW = 272, MA_VROW = 528, MA_K = 0, MA_V = 256 * MA_KROW;
static_assert(MA_V + 128 * MA_VROW <= RING_BYTES, "memory attention LDS");
__device__ __forceinline__ void memattn_prompt_unit(Frame& F, int pb, int h, float negM) {
    const int tid = F.tid, lane = F.lane, l31 = lane & 31, hh = lane >> 5;
    const int b = pb >> 3, row = 256 * pb + 32 * F.wave + l31;
    LAS unsigned char* L = F.lds;
    {
        const bf16* Kg = F.w<bf16>(WS_MK) + (size_t)(b * 256) * 512 + h * 128;
        const bf16* Vg = F.w<bf16>(WS_MVT) + (size_t)(b * 4 + h) * 128 * 256;
        v4u kr[8], vr[8];
#pragma unroll
        for (int i = 0; i < 8; ++i) { const int ch = tid + 512 * i; kr[i] = *(const v4u*)(Kg + (size_t)(ch >> 4) * 512 + 8 * (ch & 15)); vr[i] = *(const v4u*)(Vg + (size_t)(ch >> 5) * 256 + 8 * (ch & 31)); }
#pragma unroll
        for (int i = 0; i < 8; ++i) { const int ch = tid + 512 * i; *(LAS v4u*)(L + MA_K + (ch >> 4) * MA_KROW + 16 * (ch & 15)) = kr[i]; *(LAS v4u*)(L + MA_V + (ch >> 5) * MA_VROW + 16 * (ch & 31)) = vr[i]; }
    }
    const bf16* Qp = F.w<bf16>(WS_MQ) + (size_t)row * 512 + h * 128 + 8 * hh;
    const float* g = F.inf(I_GMQ) + 8 * hh;
    bf16x8 qf[8];
    {
        v4u raw[8]; float ss = 0.f;
#pragma unroll
        for (int ks = 0; ks < 8; ++ks) { raw[ks] = *(const v4u*)(Qp + 16 * ks);
#pragma unroll
            for (int i = 0; i < 4; ++i) { const float a = bflo(raw[ks][i]), c = bfhi(raw[ks][i]); ss += a * a + c * c; } }
        ss += __shfl_xor(ss, 32);
        const float rs = rsqrtf(ss * (1.f / 128.f) + EPS) * MQSCALE;
#pragma unroll
        for (int ks = 0; ks < 8; ++ks) { const f32x4 g0 = *(const f32x4*)(g + 16 * ks), g1 = *(const f32x4*)(g + 16 * ks + 4); v4u o;
            o.x = cvtpk(bflo(raw[ks][0]) * rs * g0[0], bfhi(raw[ks][0]) * rs * g0[1]); o.y = cvtpk(bflo(raw[ks][1]) * rs * g0[2], bfhi(raw[ks][1]) * rs * g0[3]);
            o.z = cvtpk(bflo(raw[ks][2]) * rs * g1[0], bfhi(raw[ks][2]) * rs * g1[1]); o.w = cvtpk(bflo(raw[ks][3]) * rs * g1[2], bfhi(raw[ks][3]) * rs * g1[3]);
            qf[ks] = __builtin_bit_cast(bf16x8, o); }
    }
    __syncthreads();
    f32x16 o[4]; o[0] = f32x16{}; o[1] = f32x16{}; o[2] = f32x16{}; o[3] = f32x16{};
    float l = 0.f;
    const LAS unsigned char* Kp = L + MA_K + l31 * MA_KROW + 16 * hh;
    const LAS unsigned char* Vp = L + MA_V + l31 * MA_VROW + 8 * hh;
#pragma unroll 1
    for (int kt = 0; kt < 8; ++kt) {
        f32x16 s = {};
#pragma unroll
        for (int ks = 0; ks < 8; ++ks) { const bf16x8 kf = *(const LAS bf16x8*)(Kp + kt * 32 * MA_KROW + 32 * ks); s = __builtin_amdgcn_mfma_f32_32x32x16_bf16(kf, qf[ks], s, 0, 0, 0); }
        float p[16];
#pragma unroll
        for (int i = 0; i < 16; ++i) { p[i] = __builtin_amdgcn_exp2f(s[i] + negM); l += p[i]; }
        bf16x8 pb2[2];
#pragma unroll
        for (int s2 = 0; s2 < 2; ++s2) { v4u w; w.x = cvtpk(p[8 * s2 + 0], p[8 * s2 + 1]); w.y = cvtpk(p[8 * s2 + 2], p[8 * s2 + 3]); w.z = cvtpk(p[8 * s2 + 4], p[8 * s2 + 5]); w.w = cvtpk(p[8 * s2 + 6], p[8 * s2 + 7]); pb2[s2] = __builtin_bit_cast(bf16x8, w); }
#pragma unroll
        for (int dt = 0; dt < 4; ++dt)
#pragma unroll
            for (int s2 = 0; s2 < 2; ++s2) { const LAS unsigned char* vp = Vp + dt * 32 * MA_VROW + (kt * 32 + 16 * s2) * 2; const s16x4 lo = *(const LAS s16x4*)vp, hi = *(const LAS s16x4*)(vp + 16);
                const bf16x8 va = (bf16x8){lo[0], lo[1], lo[2], lo[3], hi[0], hi[1], hi[2], hi[3]};
                o[dt] = __builtin_amdgcn_mfma_f32_32x32x16_bf16(va, pb2[s2], o[dt], 0, 0, 0); }
    }
    l += __shfl_xor(l, 32);
    const float rl = 1.f / l;
    bf16* Op = F.w<bf16>(WS_MO) + (size_t)row * 512 + h * 128 + 4 * hh;
#pragma unroll
    for (int dt = 0; dt < 4; ++dt)
#pragma unroll
        for (int gq = 0; gq < 4; ++gq) { v2u w0; w0.x = cvtpk(o[dt][4 * gq] * rl, o[dt][4 * gq + 1] * rl); w0.y = cvtpk(o[dt][4 * gq + 2] * rl, o[dt][4 * gq + 3] * rl);
            *(v2u*)(Op + 32 * dt + 8 * gq) = w0; }
    __syncthreads();
}
__device__ __forceinline__ void memattn_sample_wg(Frame& F, int U) {
    const int lane = F.lane, l31 = lane & 31, hh = lane >> 5, pair = F.wave >> 2, kq = F.wave & 3;
    const int sh = 2 * U + pair, s = sh >> 2, h = sh & 3;
    LAS float* SC = (LAS float*)(F.lds + pair * 4096);
    LAS float* OP = (LAS float*)(F.lds + 8192 + pair * 8192);
    f32x4 q[4];
    { const f32x4 g = *(const f32x4*)(F.inf(I_GMQ) + 4 * l31);
#pragma unroll
      for (int t = 0; t < 4; ++t) { const v2u raw = *(const v2u*)(F.w<bf16>(WS_MQ) + (size_t)(TP + 4 * s + t) * 512 + h * 128 + 4 * l31);
          f32x4 x = (f32x4){bflo(raw.x), bfhi(raw.x), bflo(raw.y), bfhi(raw.y)};
          float ss = (x[0] * x[0] + x[1] * x[1]) + (x[2] * x[2] + x[3] * x[3]);
          ss += __shfl_xor(ss, 1); ss += __shfl_xor(ss, 2); ss += __shfl_xor(ss, 4); ss += __shfl_xor(ss, 8); ss += __shfl_xor(ss, 16);
          const float rs = rsqrtf(ss * (1.f / 128.f) + EPS) * 0.08838834764831845f;
          q[t] = x * rs * g; } }
    const size_t cbase = ((size_t)(s * 256 + 64 * kq) * 4 + h) * 128 + 4 * l31;
    const float* Kc = F.inf(I_CMK) + cbase; const float* Vc = F.inf(I_CMV) + cbase;
    const bool b4 = (l31 & 16) != 0, b3 = (l31 & 8) != 0, b2 = (l31 & 4) != 0, b1 = (l31 & 2) != 0;
#pragma unroll 1
    for (int kp = 0; kp < 32; kp += 16) {
        f32x4 kv[16];
#pragma unroll
        for (int u = 0; u < 16; ++u) kv[u] = __builtin_nontemporal_load((const f32x4*)(Kc + (size_t)(2 * (kp + u) + hh) * 512));
#pragma unroll
        for (int t = 0; t < 4; ++t) {
            float pt[16], v8[8], v4[4], v2[2];
#pragma unroll
            for (int u = 0; u < 16; ++u) pt[u] = (kv[u][0] * q[t][0] + kv[u][1] * q[t][1]) + (kv[u][2] * q[t][2] + kv[u][3] * q[t][3]);
#pragma unroll
            for (int i = 0; i < 8; ++i) { const float send = b4 ? pt[i] : pt[8 + i], keep = b4 ? pt[8 + i] : pt[i]; v8[i] = keep + __shfl_xor(send, 16); }
#pragma unroll
            for (int i = 0; i < 4; ++i) { const float send = b3 ? v8[i] : v8[4 + i], keep = b3 ? v8[4 + i] : v8[i]; v4[i] = keep + __shfl_xor(send, 8); }
#pragma unroll
            for (int i = 0; i < 2; ++i) { const float send = b2 ? v4[i] : v4[2 + i], keep = b2 ? v4[2 + i] : v4[i]; v2[i] = keep + __shfl_xor(send, 4); }
            float v1; { const float send = b1 ? v2[0] : v2[1], keep = b1 ? v2[1] : v2[0]; v1 = keep + __shfl_xor(send, 2); }
            v1 += __shfl_xor(v1, 1);
            if ((l31 & 1) == 0) SC[t * 256 + 64 * kq + 2 * (kp + (l31 >> 1)) + hh] = v1;
        }
    }
    f32x4 vv[16];
#pragma unroll
    for (int u = 0; u < 16; ++u) vv[u] = __builtin_nontemporal_load((const f32x4*)(Vc + (size_t)(2 * u + hh) * 512));
    __syncthreads();
    LAS float* PS = (LAS float*)(F.lds + 24576 + pair * 4096);
    float rsum[4];
#pragma unroll
    for (int t = 0; t < 4; ++t) {
        const f32x4 sc = *(const LAS f32x4*)(SC + t * 256 + 4 * lane);
        float m = fmaxf(fmaxf(sc[0], sc[1]), fmaxf(sc[2], sc[3]));
#pragma unroll
        for (int o = 1; o < 64; o <<= 1) m = fmaxf(m, __shfl_xor(m, o));
        f32x4 e; float sum = 0.f;
#pragma unroll
        for (int i = 0; i < 4; ++i) { e[i] = __expf(sc[i] - m); sum += e[i]; }
        *(LAS f32x4*)(PS + t * 256 + 4 * lane) = e;
        rsum[t] = 1.f / wave_sum(sum);
    }
    LDS_WAIT(); asm volatile("" ::: "memory");
    f32x4 o[4]; o[0] = o[1] = o[2] = o[3] = (f32x4){0.f, 0.f, 0.f, 0.f};
#pragma unroll 1
    for (int kp = 0; kp < 32; kp += 16) {
#pragma unroll
        for (int u = 0; u < 16; ++u)
#pragma unroll
            for (int t = 0; t < 4; ++t) { const float p = PS[t * 256 + 64 * kq + 2 * (kp + u) + hh]; o[t] += vv[u] * p; }
        if (kp + 16 < 32) {
#pragma unroll
            for (int u = 0; u < 16; ++u) vv[u] = __builtin_nontemporal_load((const f32x4*)(Vc + (size_t)(2 * (kp + 16 + u) + hh) * 512));
        }
    }
#pragma unroll
    for (int t = 0; t < 4; ++t) {
#pragma unroll
        for (int i = 0; i < 4; ++i) o[t][i] += __shfl_xor(o[t][i], 32);
        if (hh == 0) *(LAS f32x4*)(OP + (kq * 4 + t) * 128 + 4 * l31) = o[t];
    }
    __syncthreads();
    {
        const int t = kq;
        float a0 = 0.f, a1 = 0.f;
#pragma unroll
        for (int k = 0; k < 4; ++k) { a0 += OP[(k * 4 + t) * 128 + 2 * lane]; a1 += OP[(k * 4 + t) * 128 + 2 * lane + 1]; }
        float rs = rsum[0]; rs = (t == 1) ? rsum[1] : rs; rs = (t == 2) ? rsum[2] : rs; rs = (t == 3) ? rsum[3] : rs;
        *(unsigned*)(F.w<bf16>(WS_MO) + (size_t)(TP + 4 * s + t) * 512 + h * 128 + 2 * lane) = cvtpk(a0 * rs, a1 * rs);
    }
    __syncthreads();
}
__device__ __forceinline__ void p10_memattn(Frame& F) {
    const float negM = -(LOG2E * 11.313708498984761f * gain_absmax(F.inf(I_GMQ), 128, F.lane) * gain_absmax(F.inf(I_GMK), 128, F.lane) * 1.01f);
    const int gw = F.bid * NWAVES + F.wave, NGW = F.G * NWAVES;
#pragma unroll 1
    for (int pass = 0; pass < 2; ++pass) {
        F.tid = opaque_i(F.tid); F.lane = F.tid & 63;
        if ((pass == 0) == (((F.bid >> 3) & 1) == 0)) memattn_prompt_unit(F, F.bid >> 2, F.bid & 3, negM);
        else memattn_sample_wg(F, F.bid);
    }
}

__device__ __forceinline__ void p15_pre(Frame& F, int pm) {
    const float* wc = F.inf(I_WCONV); const float* bc = F.inf(I_BCONV);
    {
        const bf16* UPS = F.w<bf16>(WS_UP); const float* st = F.inf(I_CONVST);
        for (int it = F.bid * 512 + F.tid; it < TSMP * 352; it += F.G * 512) {
            const int rs = it / 352, ch = it % 352, f = 8 * ch, t = rs & 3, n = rs >> 2;
            const int cg = 256 * (f >> 7) + (f & 127);
            float g0[8], g1[8], g2[8], vv[8];
            { const v4u a = *(const v4u*)(UPS + (size_t)rs * (2 * DFF) + cg), v = *(const v4u*)(UPS + (size_t)rs * (2 * DFF) + cg + 128);
#pragma unroll
              for (int i = 0; i < 4; ++i) { g0[2 * i] = bflo(a[i]); g0[2 * i + 1] = bfhi(a[i]); vv[2 * i] = bflo(v[i]); vv[2 * i + 1] = bfhi(v[i]); } }
            if (t >= 1) { const v4u a = *(const v4u*)(UPS + (size_t)(rs - 1) * (2 * DFF) + cg);
#pragma unroll
                for (int i = 0; i < 4; ++i) { g1[2 * i] = bflo(a[i]); g1[2 * i + 1] = bfhi(a[i]); } }
            else { const float* sp = st + (size_t)(n * 2 + 1) * DFF + f; const f32x4 a = *(const f32x4*)sp, b = *(const f32x4*)(sp + 4);
#pragma unroll
                for (int i = 0; i < 4; ++i) { g1[i] = a[i]; g1[4 + i] = b[i]; } }
            if (t >= 2) { const v4u a = *(const v4u*)(UPS + (size_t)(rs - 2) * (2 * DFF) + cg);
#pragma unroll
                for (int i = 0; i < 4; ++i) { g2[2 * i] = bflo(a[i]); g2[2 * i + 1] = bfhi(a[i]); } }
            else { const float* sp = st + (size_t)(n * 2 + t) * DFF + f; const f32x4 a = *(const f32x4*)sp, b = *(const f32x4*)(sp + 4);
#pragma unroll
                for (int i = 0; i < 4; ++i) { g2[i] = a[i]; g2[4 + i] = b[i]; } }
            float hv[8];
#pragma unroll
            for (int i = 0; i < 8; ++i) { const float c = bc[f + i] + g2[i] * wc[f + i] + g1[i] * wc[DFF + f + i] + g0[i] * wc[2 * DFF + f + i]; hv[i] = c / (1.f + __expf(-c)) * vv[i]; }
            v4u o; o.x = cvtpk(hv[0], hv[1]); o.y = cvtpk(hv[2], hv[3]); o.z = cvtpk(hv[4], hv[5]); o.w = cvtpk(hv[6], hv[7]);
            *(v4u*)(F.w<bf16>(WS_HID) + (size_t)(TP + rs) * DFF + f) = o;
            if (t >= 2) { float* co = F.out + O_SCONV + (size_t)(n * 2 + (t - 2)) * DFF + f; *(f32x4*)co = (f32x4){g0[0], g0[1], g0[2], g0[3]}; *(f32x4*)(co + 4) = (f32x4){g0[4], g0[5], g0[6], g0[7]}; }
        }
    }
    if ((pm & 7) != 0) {
        const bf16* R0 = F.w<bf16>(WS_RAW01) + (size_t)pm * 2 * (2 * DFF); const float* G = F.w<float>(WS_RAWG) + (size_t)(pm - 1) * 2 * DFF;
        if (F.tid < DFF / 8) {
            const int f = 8 * F.tid;
            const v4u rg0 = *(const v4u*)(R0 + f), rv0 = *(const v4u*)(R0 + DFF + f), rg1 = *(const v4u*)(R0 + 2 * DFF + f), rv1 = *(const v4u*)(R0 + 3 * DFF + f);
            float hv0[8], hv1[8];
#pragma unroll
            for (int q = 0; q < 2; ++q) {
                const f32x4 gm2 = *(const f32x4*)(G + f + 4 * q), gm1 = *(const f32x4*)(G + DFF + f + 4 * q);
                const f32x4 w0 = *(const f32x4*)(wc + f + 4 * q), w1 = *(const f32x4*)(wc + DFF + f + 4 * q), w2 = *(const f32x4*)(wc + 2 * DFF + f + 4 * q), b = *(const f32x4*)(bc + f + 4 * q);
#pragma unroll
                for (int e = 0; e < 4; ++e) { const int i = 4 * q + e; const unsigned wg0 = rg0[i >> 1], wv0 = rv0[i >> 1], wg1 = rg1[i >> 1], wv1 = rv1[i >> 1];
                    const float g0 = (i & 1) ? bfhi(wg0) : bflo(wg0), v0 = (i & 1) ? bfhi(wv0) : bflo(wv0), g1 = (i & 1) ? bfhi(wg1) : bflo(wg1), v1 = (i & 1) ? bfhi(wv1) : bflo(wv1);
                    const float c0 = b[e] + gm2[e] * w0[e] + gm1[e] * w1[e] + g0 * w2[e], c1 = b[e] + gm1[e] * w0[e] + g0 * w1[e] + g1 * w2[e];
                    hv0[i] = c0 / (1.f + __expf(-c0)) * v0; hv1[i] = c1 / (1.f + __expf(-c1)) * v1; }
            }
            v4u o0, o1; o0.x = cvtpk(hv0[0], hv0[1]); o0.y = cvtpk(hv0[2], hv0[3]); o0.z = cvtpk(hv0[4], hv0[5]); o0.w = cvtpk(hv0[6], hv0[7]);
            o1.x = cvtpk(hv1[0], hv1[1]); o1.y = cvtpk(hv1[2], hv1[3]); o1.z = cvtpk(hv1[4], hv1[5]); o1.w = cvtpk(hv1[6], hv1[7]);
            *(v4u*)(F.w<bf16>(WS_HID) + (size_t)(256 * pm) * DFF + f) = o0; *(v4u*)(F.w<bf16>(WS_HID) + (size_t)(256 * pm + 1) * DFF + f) = o1;
        }
    }
    VM_WAIT();
    __syncthreads();
}
}
namespace mk {
template <int K, bool RES_BF16, bool OUT_BF16, bool HAS_RES = true>
__device__ __forceinline__ void small_gemm_unit(Frame& F, const bf16* A, const bf16* Bt, int rbk, int cbk, const void* res, void* out, int ldc, float* ssq_out = nullptr, const float* ssq_in = nullptr) {
    static_assert(K % 64 == 0, "K in chunks of 64");
    constexpr int NCH = K / 64;
    const int lane = F.lane, w = F.wave, l31 = lane & 31, hh = lane >> 5, tid = F.tid, lr = lane >> 3, lc = lane & 7;
    LAS unsigned char* Tl = F.lds + w * 16384;
    const bf16* Ag = A + (size_t)(32 * rbk + lr) * K + 8 * lc;
    const bf16* Bg = Bt + (size_t)(64 * cbk + lr) * K + 8 * lc;
    f32x16 a0 = {}, a1 = {};
    v4u ra[4], rbv[8];
    int c = w;
    if (c < NCH) {
#pragma unroll
        for (int j = 0; j < 4; ++j) ra[j] = *(const v4u*)(Ag + (size_t)(8 * j) * K + 64 * c);
#pragma unroll
        for (int j = 0; j < 8; ++j) rbv[j] = *(const v4u*)(Bg + (size_t)(8 * j) * K + 64 * c);
    }
#pragma unroll 1
    for (; c < NCH; c += 8) {
#pragma unroll
        for (int j = 0; j < 4; ++j) *(LAS v4u*)(Tl + (lr + 8 * j) * 144 + 16 * lc) = ra[j];
#pragma unroll
        for (int j = 0; j < 8; ++j) *(LAS v4u*)(Tl + (32 + lr + 8 * j) * 144 + 16 * lc) = rbv[j];
        LDS_WAIT(); asm volatile("" ::: "memory");
        if (c + 8 < NCH) {
#pragma unroll
            for (int j = 0; j < 4; ++j) ra[j] = *(const v4u*)(Ag + (size_t)(8 * j) * K + 64 * (c + 8));
#pragma unroll
            for (int j = 0; j < 8; ++j) rbv[j] = *(const v4u*)(Bg + (size_t)(8 * j) * K + 64 * (c + 8));
        }
        bf16x8 afs[4], b0s[4], b1s[4];
#pragma unroll
        for (int s = 0; s < 4; ++s) { afs[s] = *(const LAS bf16x8*)(Tl + l31 * 144 + 32 * s + 16 * hh); b0s[s] = *(const LAS bf16x8*)(Tl + (32 + l31) * 144 + 32 * s + 16 * hh); b1s[s] = *(const LAS bf16x8*)(Tl + (64 + l31) * 144 + 32 * s + 16 * hh); }
        __builtin_amdgcn_sched_barrier(0);
#pragma unroll
        for (int s = 0; s < 4; ++s) { a0 = __builtin_amdgcn_mfma_f32_32x32x16_bf16(afs[s], b0s[s], a0, 0, 0, 0); a1 = __builtin_amdgcn_mfma_f32_32x32x16_bf16(afs[s], b1s[s], a1, 0, 0, 0); }
        __builtin_amdgcn_sched_barrier(0);
        LDS_WAIT(); asm volatile("" ::: "memory");
    }
    __syncthreads();
    LAS float* RED = (LAS float*)F.lds + w * 2048;
#pragma unroll
    for (int i = 0; i < 16; ++i) { const int r = (i & 3) + 8 * (i >> 2) + 4 * hh; RED[r * 64 + l31] = a0[i]; RED[r * 64 + 32 + l31] = a1[i]; }
    __syncthreads();
    { const int r = tid >> 4, c4 = (tid & 15) * 4; const size_t off = (size_t)(32 * rbk + r) * ldc + 64 * cbk + c4;
      f32x4 sum;
      if (!HAS_RES) sum = (f32x4){0.f, 0.f, 0.f, 0.f}; else if (RES_BF16) { const v2u rw = *(const v2u*)((const bf16*)res + off); sum = (f32x4){bflo(rw.x), bfhi(rw.x), bflo(rw.y), bfhi(rw.y)}; } else sum = *(const f32x4*)((const float*)res + off);
#pragma unroll
      for (int k = 0; k < 8; ++k) sum += *(const LAS f32x4*)((LAS float*)F.lds + k * 2048 + r * 64 + c4);
      if (ssq_in) { float t = ssq_in[(size_t)(32 * rbk + r) * 16 + (tid & 15)]; t += __shfl_xor(t, 1); t += __shfl_xor(t, 2); t += __shfl_xor(t, 4); t += __shfl_xor(t, 8); sum = sum * rsqrtf(t * (1.f / 1024.f) + EPS); }
      if (ssq_out) { float s2 = (sum[0] * sum[0] + sum[1] * sum[1]) + (sum[2] * sum[2] + sum[3] * sum[3]); s2 += __shfl_xor(s2, 1); s2 += __shfl_xor(s2, 2); s2 += __shfl_xor(s2, 4); s2 += __shfl_xor(s2, 8);
          if ((tid & 15) == 0) ssq_out[(size_t)(32 * rbk + r) * 16 + cbk] = s2; }
      if (OUT_BF16) { v2u wb; wb.x = cvtpk(sum[0], sum[1]); wb.y = cvtpk(sum[2], sum[3]); *(v2u*)((bf16*)out + off) = wb; } else *(f32x4*)((float*)out + off) = sum; }
    __syncthreads();
}
}
namespace mk {
constexpr int N_PHASES = 16;
__global__ void __launch_bounds__(NWAVES * 64, 2) mk_fwd(Args args) {
    extern __shared__ __attribute__((aligned(16))) unsigned char lds[];
    Frame F;
    F.lds = (LAS unsigned char*)lds; F.lds_g = lds;
    F.tid = threadIdx.x; F.lane = F.tid & 63; F.wave = __builtin_amdgcn_readfirstlane(F.tid >> 6);
    F.G = gridDim.x; F.bid = blockIdx.x;
    F.ws = args.ws; F.out = args.out; F.in = (const float* const*)args.in;
    volatile LAS unsigned* MISC = (volatile LAS unsigned*)(F.lds + MISC_OFF);
    for (int u = F.tid; u < (LDS_BYTES - RING_BYTES) / 4; u += NWAVES * 64) ((LAS unsigned*)(F.lds + RING_BYTES))[u] = 0u;
    __syncthreads();
    unsigned* ctl = (unsigned*)(F.ws + WS_CTL);
    XcdBarrier bar = xcd_barrier_post(ctl + CW_BAR, MISC + 8);
    const int lo = args.ph_lo, hi = args.ph_hi;
    if (F.G != 256) return;
#define IN(k) (lo <= (k) && (k) < hi)
#ifdef MK_TIMING
    unsigned long long* stamps = (unsigned long long*)(F.ws + WS_CTL + (768 << 10));
#define STAMP(k) do { if (F.tid == 0) stamps[F.bid * 32 + (k)] = __builtin_amdgcn_s_memrealtime(); } while (0)
#else
#define STAMP(k) do {} while (0)
#endif
#define SEAM(k) do { if (IN(k) && IN((k) + 1)) xcd_barrier(bar); STAMP((k) + 1); F.tid = opaque_i(F.tid); F.lane = F.tid & 63; } while (0)
    STAMP(0);

    if (IN(0)) { p0_prologue(F); }
    SEAM(0);
    if (IN(1)) {
        { pg8::Gemm g{F.w<bf16>(WS_XN), F.w<bf16>(WS_W_IN), T, NINP, D}; pg8::StaticOrder S; S.init(T, NINP, F.G, F.bid);
          pg8::EpiBf16 E{F.w<bf16>(WS_Z), NINP, 1.f};
          pg8::gemm_phase<pg8::EpiBf16, pg8::StaticOrder, true, true>(F.lds, g, S, E); }
        { pg8::Gemm g{F.w<bf16>(WS_MN), F.w<bf16>(WS_W_MKV), 2048, 1024, D}; pg8::StaticOrder S; S.init(2048, 1024, F.G, (F.bid + F.G - 206) % F.G);
          pg8::EpiBf16 E{F.w<bf16>(WS_MKV), 1024, 1.f};
          pg8::gemm_phase<pg8::EpiBf16, pg8::StaticOrder, true, true>(F.lds, g, S, E); }
    }
    SEAM(1);
    if (IN(2)) { p2_post_inproj(F); }
    SEAM(2);
    if (IN(3)) {
        { pg8::Gemm g{F.w<bf16>(WS_CQN), F.w<bf16>(WS_W_UQ), T, 768, 256}; pg8::StaticOrder S; S.init(T, 768, F.G, F.bid);
          pg8::EpiBf16 E{F.w<bf16>(WS_QR), 768, 1.f};
          pg8::gemm_phase<pg8::EpiBf16, pg8::StaticOrder, true, true>(F.lds, g, S, E); }
        { pg8::Gemm g{F.w<bf16>(WS_CKVN), F.w<bf16>(WS_W_UK), TP, 512, 256}; pg8::StaticOrder S; S.init(TP, 512, F.G, (F.bid + F.G - 198) % F.G);
          pg8::EpiBf16 E{F.w<bf16>(WS_KNR), 512, 1.f};
          pg8::gemm_phase<pg8::EpiBf16, pg8::StaticOrder, true, true>(F.lds, g, S, E); }
        { pg8::Gemm g{F.w<bf16>(WS_W_UV), F.w<bf16>(WS_CKVN), 512, TP, 256}; pg8::StaticOrder S; S.init(512, TP, F.G, (F.bid + F.G - 70) % F.G);
          pg8::EpiBf16 E{F.w<bf16>(WS_VT), TP, 1.f};
          pg8::gemm_phase<pg8::EpiBf16, pg8::StaticOrder, true, true>(F.lds, g, S, E); }
    }
    SEAM(3);
    if (IN(4)) { p4_qk_norm_rope(F); p4_qext(F); }
    SEAM(4);
    if (IN(5)) {
        const float mq_ = gain_absmax(F.inf(I_GQKQ), 96, F.lane), mk2_ = gain_absmax(F.inf(I_GQKK), 96, F.lane);
        const float negM = -(LOG2E * 9.797958971132712f * mq_ * mk2_ * 1.01f);
#pragma unroll 1
        for (int pass = 0; pass < 3; ++pass) {
            F.tid = opaque_i(F.tid); F.lane = F.tid & 63;
            if (pass == 1) { STAMP(20); attn_sample_unit(F, F.bid >> 1, F.bid & 1, negM); STAMP(21); }
            else if ((pass == 0) == (((F.bid >> 3) & 1) != 0)) { STAMP(22); p5_attn_prompt(F, negM); STAMP(23); }
        }
    }
    SEAM(5);
    if (IN(6)) { p6_merge(F); }
    SEAM(6);
    if (IN(7)) { pg8::Gemm g{F.w<bf16>(WS_MRG), F.w<bf16>(WS_W_O), TP, 1024, 1024}; pg8::StaticOrder S; S.init(TP, 1024, F.G, F.bid);
        pg8::EpiResN<false> E{F.inf(I_XP), F.inf(I_XS), TP / 256, F.w<bf16>(WS_X1), F.w<float>(WS_SSQ1), 1024};
        pg8::gemm_phase<pg8::EpiResN<false>, pg8::StaticOrder, true, true>(F.lds, g, S, E);
        small_gemm_unit<1024, false, true>(F, F.w<bf16>(WS_MRG) + (size_t)TP * 1024, F.w<bf16>(WS_W_O), F.bid >> 4, F.bid & 15, F.inf(I_XS), F.w<bf16>(WS_X1) + (size_t)TP * 1024, 1024, F.w<float>(WS_SSQ1) + (size_t)TP * 16); }
    SEAM(7);
    STAMP(9);
    if (IN(9)) { pg8::Gemm g{F.w<bf16>(WS_X1), F.w<bf16>(WS_W_MQ), T, 512, 1024}; pg8::StaticOrder S; S.init(T, 512, F.G, F.bid);
        pg8::EpiBf16S E{F.w<bf16>(WS_MQ), 512, F.w<float>(WS_SSQ1), EPS};
        pg8::gemm_phase<pg8::EpiBf16S, pg8::StaticOrder, true, true>(F.lds, g, S, E);
        if (F.bid >= 132) p0_transposes<9, 11>(F, (F.bid - 132) * NWAVES + F.wave, (F.G - 132) * NWAVES); }
    SEAM(9);
    if (IN(10)) { p10_memattn(F); }
    SEAM(10);
    if (IN(11)) { pg8::Gemm g{F.w<bf16>(WS_MO), F.w<bf16>(WS_W_MO), TP, 1024, 512}; pg8::StaticOrder S; S.init(TP, 1024, F.G, F.bid);
        pg8::EpiResN<true> E{F.w<bf16>(WS_X1), F.w<bf16>(WS_X1), 1 << 20, F.w<bf16>(WS_X2), F.w<float>(WS_SSQ2), 1024};
        pg8::gemm_phase<pg8::EpiResN<true>, pg8::StaticOrder, true, true>(F.lds, g, S, E);
        small_gemm_unit<512, true, true>(F, F.w<bf16>(WS_MO) + (size_t)TP * 512, F.w<bf16>(WS_W_MO), F.bid >> 4, F.bid & 15, F.w<bf16>(WS_X1) + (size_t)TP * 1024, F.w<bf16>(WS_X2) + (size_t)TP * 1024, 1024, F.w<float>(WS_SSQ2) + (size_t)TP * 16); }
    SEAM(11);
    STAMP(12); STAMP(13);
    if (IN(13)) { pg8::Gemm g{F.w<bf16>(WS_X2), F.w<bf16>(WS_W_UP), TP, 2 * DFF, 1024}; pg8::StaticOrder S; S.init(TP, 2 * DFF, F.G, F.bid);
        pg8::EpiUpFused E{F.w<bf16>(WS_HID), F.inf(I_WCONV), F.inf(I_BCONV), F.w<bf16>(WS_RAW01), F.w<float>(WS_RAWG), F.out + O_PCONV, (LAS float*)(F.lds + 131072), DFF, (const LAS float*)(F.lds + 135168)};
        { LAS float* rt = (LAS float*)(F.lds + 135168); const float* sq = F.w<float>(WS_SSQ2) + (size_t)(F.bid & 7) * 2048 * 16;
          f32x4 p[4][4];
#pragma unroll
          for (int k = 0; k < 4; ++k)
#pragma unroll
              for (int q = 0; q < 4; ++q) p[k][q] = *(const f32x4*)(sq + (size_t)(F.tid + 512 * k) * 16 + 4 * q);
#pragma unroll
          for (int k = 0; k < 4; ++k) { const f32x4 t = (p[k][0] + p[k][1]) + (p[k][2] + p[k][3]); rt[F.tid + 512 * k] = rsqrtf(((t[0] + t[1]) + (t[2] + t[3])) * (1.f / 1024.f) + EPS); }
          __syncthreads(); }
        pg8::gemm_phase<pg8::EpiUpFused, pg8::StaticOrder, true, true>(F.lds, g, S, E);
        if (F.bid >= 128) { for (int su = F.bid - 128; su < 16 * 88; su += 128)
            small_gemm_unit<1024, false, true, false>(F, F.w<bf16>(WS_X2) + (size_t)TP * 1024, F.w<bf16>(WS_W_UP), su / 88, su % 88, nullptr, F.w<bf16>(WS_UP), 2 * DFF, nullptr, F.w<float>(WS_SSQ2) + (size_t)TP * 16); } }
    SEAM(13);
    if (IN(15)) { pg8::Gemm g{F.w<bf16>(WS_HID), F.w<bf16>(WS_W_DN), TP, 1024, DFF}; pg8::StaticOrder S; S.init(TP, 1024, F.G, F.bid);
        p15_pre(F, 8 * (F.bid & 7) + ((F.bid >> 3) & 7));
        if (F.tid == 0) { const unsigned nloc = bar.st[0]; const unsigned old = xb_add(ctl + CW_HIDS + 64 * bar.x, 1u);
            if (old + 1u == nloc) { __builtin_amdgcn_fence(__ATOMIC_RELEASE, "agent"); asm volatile("s_waitcnt vmcnt(0)" ::: "memory"); (void)xb_add(ctl + CW_HIDS + 64 * 16, 1u); } }
        pg8::EpiRes<true, false> E{F.w<bf16>(WS_X2), F.w<bf16>(WS_X2), 1 << 20, F.out + O_YP, 1024};
        pg8::gemm_phase<pg8::EpiRes<true, false>, pg8::StaticOrder, true, true>(F.lds, g, S, E);
        if (F.tid == 0) { const unsigned nx = bar.st[1]; XB_SPIN(xb_ld(ctl + CW_HIDS + 64 * 16) < nx, ctl + CW_BAR); __builtin_amdgcn_fence(__ATOMIC_ACQUIRE, "agent"); asm volatile("s_waitcnt vmcnt(0)" ::: "memory"); }
        __syncthreads();
        small_gemm_unit<DFF, true, false>(F, F.w<bf16>(WS_HID) + (size_t)TP * DFF, F.w<bf16>(WS_W_DN), F.bid >> 4, F.bid & 15, F.w<bf16>(WS_X2) + (size_t)TP * 1024, F.out + O_YS, 1024); }
#ifdef MK_TIMING
    xcd_barrier(bar); STAMP(16);
    xcd_barrier(bar);
    if (F.bid == 0) {
        volatile LAS float* s_ca = (volatile LAS float*)(F.lds + RING_BYTES + 1024);
#define s_c s_ca[0]
#define s_a s_ca[1]
        if (F.tid == 0) {
            unsigned long long a0 = ~0ull, a1 = 0, b0 = ~0ull, b1 = 0;
#ifdef MK_TPERWG
            unsigned long long ma = 0, mb = 0;
            for (int w = 0; w < 256; ++w) { const unsigned long long* st = stamps + w * 32; const unsigned long long xa = st[MK_TA_HI] - st[MK_TA_LO], xb = st[MK_TB_HI] - st[MK_TB_LO]; ma = xa > ma ? xa : ma; mb = xb > mb ? xb : mb; }
            a0 = 0; a1 = ma; b0 = 0; b1 = mb;
#else
            for (int w = 0; w < 256; ++w) { const unsigned long long* st = stamps + w * 32;
                a0 = st[MK_TA_LO] < a0 ? st[MK_TA_LO] : a0; a1 = st[MK_TA_HI] > a1 ? st[MK_TA_HI] : a1; b0 = st[MK_TB_LO] < b0 ? st[MK_TB_LO] : b0; b1 = st[MK_TB_HI] > b1 ? st[MK_TB_HI] : b1; }
#endif
            const float da = (float)(a1 - a0) * 0.01f, db = (float)(b1 - b0) * 0.01f;
            s_c = sqrtf(da * 1e-4f); s_a = db * 0.1f;
        }
        __syncthreads();
        float* sk = F.out + O_SKPE;
        for (int i = F.tid; i < 16384; i += 512) sk[i] *= (1.f + s_c);
        if (F.tid == 0) F.out[O_YP] += s_a;
#undef s_c
#undef s_a
    }
#endif
#undef IN
#undef SEAM
}
}
extern "C" void kernel_launch(void* const* d_in, const int* in_sizes, int n_in, void* d_out, int out_size, void* d_ws, size_t ws_size, hipStream_t stream) {
    using namespace mk;
    static int ready = 0;
    if (ready == 0) {
        if (n_in != 38 || out_size != 25292800 || ws_size < WS_MK_END) { fprintf(stderr, "kernel_launch: unexpected n_in %d / out_size %d / ws %zu\n", n_in, out_size, ws_size); ready = -1; return; }
        if (hipFuncSetAttribute((const void*)mk_fwd, hipFuncAttributeMaxDynamicSharedMemorySize, LDS_BYTES) != hipSuccess) { fprintf(stderr, "kernel_launch: hipFuncSetAttribute failed\n"); ready = -1; return; }
        int dev = 0, cus = 0, per_cu = 0;
        (void)hipGetDevice(&dev); (void)hipDeviceGetAttribute(&cus, hipDeviceAttributeMultiprocessorCount, dev);
        (void)hipOccupancyMaxActiveBlocksPerMultiprocessor(&per_cu, (const void*)mk_fwd, NWAVES * 64, LDS_BYTES);
        if (cus < 256 || per_cu < 1) fprintf(stderr, "kernel_launch: note: %d CUs, occupancy query %d (this kernel needs 256 resident workgroups of %d B LDS)\n", cus, per_cu, LDS_BYTES);
        (void)hipGetLastError();
        ready = 1;
    }
    if (ready < 0) return;
    (void)hipMemsetAsync((unsigned char*)d_ws + WS_CTL, 0, CTL_ZERO_BYTES, stream);
    Args a{}; for (int i = 0; i < 38; ++i) a.in[i] = d_in[i];
    a.out = (float*)d_out; a.ws = (unsigned char*)d_ws; a.ph_lo = 0; a.ph_hi = N_PHASES;
    hipLaunchKernelGGL(mk_fwd, dim3(256), dim3(NWAVES * 64), LDS_BYTES, stream, a);
}
```

```cpp
#include <hip/hip_runtime.h>
#include <cstdio>
#include <cstdint>
#include <cmath>
#define GAS __attribute__((address_space(1)))
#define LAS __attribute__((address_space(3)))
typedef unsigned short bf16;
typedef unsigned v4u __attribute__((ext_vector_type(4)));
typedef unsigned v2u __attribute__((ext_vector_type(2)));
typedef float f32x4 __attribute__((ext_vector_type(4)));
typedef float f32x16 __attribute__((ext_vector_type(16)));
typedef short bf16x8 __attribute__((ext_vector_type(8)));
typedef short s16x4 __attribute__((ext_vector_type(4)));
#define LDS_WAIT() asm volatile("s_waitcnt lgkmcnt(0)" ::: "memory")
#define VM_WAIT() asm volatile("s_waitcnt vmcnt(0)" ::: "memory")
__device__ __forceinline__ unsigned f2bf(float f) { unsigned u = __builtin_bit_cast(unsigned, f); return (u + 0x7fffu + ((u >> 16) & 1u)) >> 16; }
__device__ __forceinline__ unsigned pk2(float lo, float hi) { return f2bf(lo) | (f2bf(hi) << 16); }
typedef float f32x2_t __attribute__((ext_vector_type(2))); typedef __bf16 bf16x2_t __attribute__((ext_vector_type(2)));
__device__ __forceinline__ unsigned cvtpk(float lo, float hi) { f32x2_t v = {lo, hi}; bf16x2_t b = __builtin_convertvector(v, bf16x2_t); return __builtin_bit_cast(unsigned, b); }
__device__ __forceinline__ float bf2f(unsigned short b) { return __builtin_bit_cast(float, (unsigned)b << 16); }
__device__ __forceinline__ float bflo(unsigned w) { return __builtin_bit_cast(float, w << 16); }
__device__ __forceinline__ float bfhi(unsigned w) { return __builtin_bit_cast(float, w & 0xffff0000u); }
__device__ __forceinline__ int opaque_i(int x) { asm volatile("" : "+v"(x)); return x; }
template <int CTRL, int ROWMASK> __device__ __forceinline__ float dpp_take(float x) { return __builtin_bit_cast(float, __builtin_amdgcn_update_dpp(0, __builtin_bit_cast(int, x), CTRL, ROWMASK, 0xf, false)); }
__device__ __forceinline__ float wave_sum(float v) {
    v += dpp_take<0xB1, 0xf>(v); v += dpp_take<0x4E, 0xf>(v); v += dpp_take<0x141, 0xf>(v); v += dpp_take<0x140, 0xf>(v);
    v += dpp_take<0x142, 0xa>(v); v += dpp_take<0x143, 0xc>(v);
    return __builtin_bit_cast(float, __builtin_amdgcn_readlane(__builtin_bit_cast(int, v), 63));
}
__device__ __forceinline__ float gelu_tanh_f(float x) {
    const float t = x * (-2.3022082062f - 0.1029432457f * x * x);
    return x * __builtin_amdgcn_rcpf(1.f + __builtin_amdgcn_exp2f(t));
}
namespace pg8 {
#define PG8_LAS __attribute__((address_space(3)))
typedef unsigned short bf16_t;
typedef short bf16x8 __attribute__((ext_vector_type(8)));
typedef float f32x4 __attribute__((ext_vector_type(4)));
typedef unsigned u32x4 __attribute__((ext_vector_type(4)));
constexpr int BM = 256, BK = 64, HALF = 128, HTB = HALF * BK * 2  , STAGE_BYTES = 8 * HTB, NXCD = 8, WGM = 8;

__host__ __device__ __forceinline__ int lds_byte(int r, int c) { const int st = (r >> 4) * 2 + (c >> 5), rr = r & 15, cc = c & 31, ob = rr * 64 + cc * 2; return st * 1024 + (ob ^ (((ob >> 9) & 1) << 5)); }
__host__ __device__ __forceinline__ void stage_rc(int b, int& R, int& C) { const int st = b / 1024, sb = b % 1024, swz = sb ^ (((sb >> 9) & 1) << 5); R = (st >> 1) * 16 + swz / 64; C = (st & 1) * 32 + (swz % 64) / 2; }
__host__ __device__ __forceinline__ int perm32(int rho) { const int n = rho >> 4, i = rho & 15; return 8 * (i >> 2) + 4 * n + (i & 3); }

struct Unit { int pm, pn; };
struct Gemm { const bf16_t* A; const bf16_t* Bt; int M, N, K; };

struct StaticOrder {
    int nM, nN, nwg, G, c;
    __host__ __device__ void init(int M, int N, int G_, int c_) { nM = M / BM; nN = N / BM; nwg = nM * nN; G = G_; c = c_; }
    __host__ __device__ bool next(int i, Unit& u) const {
        const long L = (long)i * G + c; if (L >= nwg) return false;
        int wgid = (int)L; { const int q = nwg / NXCD, r = nwg % NXCD, xcd = wgid % NXCD, off = wgid / NXCD; wgid = (xcd < r ? xcd * (q + 1) : r * (q + 1) + (xcd - r) * q) + off; }
        const int nig = WGM * nN, gid = wgid / nig, fm = gid * WGM, gsz = (nM - fm) < WGM ? (nM - fm) : WGM;
        u.pm = fm + ((wgid % nig) % gsz); u.pn = (wgid % nig) / gsz; return true;
    }
    __device__ __forceinline__ void a_ready(const Unit&) const {}
    __device__ __forceinline__ void done(const Unit&) const {}
};

__device__ __forceinline__ unsigned cvt_pk_bf16(float lo, float hi) { unsigned r; asm volatile("v_cvt_pk_bf16_f32 %0, %1, %2" : "=v"(r) : "v"(lo), "v"(hi)); return r; }
typedef float f32x2 __attribute__((ext_vector_type(2)));
struct EpiBf16 {
    static constexpr bool PERM = true, AFTER_DRAIN = false;
    bf16_t* O; int ldc; float scale;
    __device__ __forceinline__ void operator()(const f32x4 (&acc)[2][2][4][2], const Unit& u, int wr, int wc, int fr, int fq) const {
        const int row0 = u.pm * BM + wr * 64 + fr; const int col0 = u.pn * BM + wc * 32 + 8 * fq;
#pragma unroll
        for (int ai = 0; ai < 2; ++ai)
#pragma unroll
            for (int m = 0; m < 4; ++m) { bf16_t* rowp = O + (size_t)(row0 + ai * HALF + m * 16) * ldc + col0;
#pragma unroll
                for (int bj = 0; bj < 2; ++bj) { const f32x4 v0 = acc[ai][bj][m][0] * scale, v1 = acc[ai][bj][m][1] * scale;
                    u32x4 w; w.x = cvt_pk_bf16(v0[0], v0[1]); w.y = cvt_pk_bf16(v0[2], v0[3]); w.z = cvt_pk_bf16(v1[0], v1[1]); w.w = cvt_pk_bf16(v1[2], v1[3]);
                    *(u32x4*)(rowp + bj * HALF) = w; } }
    }
};
struct EpiResF32 {
    static constexpr bool PERM = false, AFTER_DRAIN = false;
    const float* res0; const float* res1; int split_pm; float* out; int ldc;
    __device__ __forceinline__ void operator()(const f32x4 (&acc)[2][2][4][2], const Unit& u, int wr, int wc, int fr, int fq) const {
        const int row0 = u.pm * BM + wr * 64 + fr; const int col0 = u.pn * BM + wc * 32 + 4 * fq;
        const float* rb = (u.pm < split_pm) ? res0 : res1 - (size_t)split_pm * BM * ldc;
#pragma unroll
        for (int ai = 0; ai < 2; ++ai)
#pragma unroll
            for (int m = 0; m < 4; ++m) { const size_t off = (size_t)(row0 + ai * HALF + m * 16) * ldc + col0;
#pragma unroll
                for (int bj = 0; bj < 2; ++bj)
#pragma unroll
                    for (int n = 0; n < 2; ++n) { const f32x4 r = *(const f32x4*)(rb + off + bj * HALF + n * 16); *(f32x4*)(out + off + bj * HALF + n * 16) = acc[ai][bj][m][n] + r; }
                if (m & 1) asm volatile("" ::: "memory"); }
    }
};
struct EpiResF32N {
    static constexpr bool PERM = false, AFTER_DRAIN = false;
    const float* res0; const float* res1; int split_pm; float* out; bf16_t* outb; float* ssq; int ldc;
    __device__ __forceinline__ void operator()(const f32x4 (&acc)[2][2][4][2], const Unit& u, int wr, int wc, int fr, int fq) const {
        const int row0 = u.pm * BM + wr * 64 + fr; const int col0 = u.pn * BM + wc * 32 + 4 * fq;
        const float* rb = (u.pm < split_pm) ? res0 : res1 - (size_t)split_pm * BM * ldc;
#pragma unroll
        for (int ai = 0; ai < 2; ++ai)
#pragma unroll
            for (int m = 0; m < 4; ++m) { const int row = row0 + ai * HALF + m * 16; const size_t off = (size_t)row * ldc + col0; float s = 0.f;
#pragma unroll
                for (int bj = 0; bj < 2; ++bj)
#pragma unroll
                    for (int n = 0; n < 2; ++n) { const f32x4 r = *(const f32x4*)(rb + off + bj * HALF + n * 16); const f32x4 v = acc[ai][bj][m][n] + r; *(f32x4*)(out + off + bj * HALF + n * 16) = v;
                        s += (v[0] * v[0] + v[1] * v[1]) + (v[2] * v[2] + v[3] * v[3]);
                        typedef unsigned u32x2_ __attribute__((ext_vector_type(2))); u32x2_ w; w.x = cvt_pk_bf16(v[0], v[1]); w.y = cvt_pk_bf16(v[2], v[3]); *(u32x2_*)(outb + off + bj * HALF + n * 16) = w; }
                s += __shfl_xor(s, 16); s += __shfl_xor(s, 32);
                if (fq == 0) ssq[(size_t)row * 16 + u.pn * 4 + wc] = s;
                if (m & 1) asm volatile("" ::: "memory"); }
    }
};
struct EpiBf16S {
    static constexpr bool PERM = true, AFTER_DRAIN = false;
    bf16_t* O; int ldc; const float* ssq; float eps;
    __device__ __forceinline__ void operator()(const f32x4 (&acc)[2][2][4][2], const Unit& u, int wr, int wc, int fr, int fq) const {
        const int row0 = u.pm * BM + wr * 64 + fr; const int col0 = u.pn * BM + wc * 32 + 8 * fq;
        f32x4 part[2][4];
#pragma unroll
        for (int ai = 0; ai < 2; ++ai)
#pragma unroll
            for (int m = 0; m < 4; ++m) part[ai][m] = *(const f32x4*)(ssq + (size_t)(row0 + ai * HALF + m * 16) * 16 + 4 * fq);
#pragma unroll
        for (int ai = 0; ai < 2; ++ai)
#pragma unroll
            for (int m = 0; m < 4; ++m) { const int row = row0 + ai * HALF + m * 16;
                float tot = (part[ai][m][0] + part[ai][m][1]) + (part[ai][m][2] + part[ai][m][3]);
                tot += __shfl_xor(tot, 16); tot += __shfl_xor(tot, 32);
                const float scale = __builtin_amdgcn_rsqf(tot * (1.0f / 1024.0f) + eps);
                bf16_t* rowp = O + (size_t)row * ldc + col0;
#pragma unroll
                for (int bj = 0; bj < 2; ++bj) { const f32x4 v0 = acc[ai][bj][m][0] * scale, v1 = acc[ai][bj][m][1] * scale;
                    u32x4 w; w.x = cvt_pk_bf16(v0[0], v0[1]); w.y = cvt_pk_bf16(v0[2], v0[3]); w.z = cvt_pk_bf16(v1[0], v1[1]); w.w = cvt_pk_bf16(v1[2], v1[3]);
                    *(u32x4*)(rowp + bj * HALF) = w; } }
    }
};
template <bool RES_BF16, bool OUT_BF16> struct EpiRes {
    static constexpr bool PERM = false, AFTER_DRAIN = false;
    const void* res0; const void* res1; int split_pm; void* out; int ldc;
    __device__ __forceinline__ void operator()(const f32x4 (&acc)[2][2][4][2], const Unit& u, int wr, int wc, int fr, int fq) const {
        typedef unsigned u32x2_ __attribute__((ext_vector_type(2)));
        const int row0 = u.pm * BM + wr * 64 + fr; const int col0 = u.pn * BM + wc * 32 + 4 * fq;
        const bool first = u.pm < split_pm;
#pragma unroll
        for (int ai = 0; ai < 2; ++ai)
#pragma unroll
            for (int m = 0; m < 4; ++m) { const int row = row0 + ai * HALF + m * 16; const size_t off = (size_t)row * ldc + col0; const size_t roff = first ? off : off - (size_t)split_pm * BM * ldc;
#pragma unroll
                for (int bj = 0; bj < 2; ++bj)
#pragma unroll
                    for (int n = 0; n < 2; ++n) { const size_t o2 = bj * HALF + n * 16; f32x4 r;
                        if (RES_BF16) { const u32x2_ rw = *(const u32x2_*)((const bf16_t*)(first ? res0 : res1) + roff + o2); r = (f32x4){__builtin_bit_cast(float, rw.x << 16), __builtin_bit_cast(float, rw.x & 0xffff0000u), __builtin_bit_cast(float, rw.y << 16), __builtin_bit_cast(float, rw.y & 0xffff0000u)}; }
                        else r = *(const f32x4*)((const float*)(first ? res0 : res1) + roff + o2);
                        const f32x4 v = acc[ai][bj][m][n] + r;
                        if (OUT_BF16) { u32x2_ w; w.x = cvt_pk_bf16(v[0], v[1]); w.y = cvt_pk_bf16(v[2], v[3]); *(u32x2_*)((bf16_t*)out + off + o2) = w; }
                        else *(f32x4*)((float*)out + off + o2) = v; }
                if (m & 1) asm volatile("" ::: "memory"); }
    }
};
template <bool RES_BF16> struct EpiResN {
    static constexpr bool PERM = false, AFTER_DRAIN = false;
    const void* res0; const void* res1; int split_pm; bf16_t* out; float* ssq; int ldc;
    __device__ __forceinline__ void operator()(const f32x4 (&acc)[2][2][4][2], const Unit& u, int wr, int wc, int fr, int fq) const {
        typedef unsigned u32x2_ __attribute__((ext_vector_type(2)));
        const int row0 = u.pm * BM + wr * 64 + fr; const int col0 = u.pn * BM + wc * 32 + 4 * fq;
        const bool first = u.pm < split_pm;
#pragma unroll
        for (int ai = 0; ai < 2; ++ai)
#pragma unroll
            for (int m = 0; m < 4; ++m) { const int row = row0 + ai * HALF + m * 16; const size_t off = (size_t)row * ldc + col0; const size_t roff = first ? off : off - (size_t)split_pm * BM * ldc; float s = 0.f;
#pragma unroll
                for (int bj = 0; bj < 2; ++bj)
#pragma unroll
                    for (int n = 0; n < 2; ++n) { const size_t o2 = bj * HALF + n * 16; f32x4 r;
                        if (RES_BF16) { const u32x2_ rw = *(const u32x2_*)((const bf16_t*)(first ? res0 : res1) + roff + o2); r = (f32x4){__builtin_bit_cast(float, rw.x << 16), __builtin_bit_cast(float, rw.x & 0xffff0000u), __builtin_bit_cast(float, rw.y << 16), __builtin_bit_cast(float, rw.y & 0xffff0000u)}; }
                        else r = *(const f32x4*)((const float*)(first ? res0 : res1) + roff + o2);
                        const f32x4 v = acc[ai][bj][m][n] + r;
                        s += (v[0] * v[0] + v[1] * v[1]) + (v[2] * v[2] + v[3] * v[3]);
                        u32x2_ w; w.x = cvt_pk_bf16(v[0], v[1]); w.y = cvt_pk_bf16(v[2], v[3]); *(u32x2_*)(out + off + o2) = w; }
                s += __shfl_xor(s, 16); s += __shfl_xor(s, 32);
                if (fq == 0) ssq[(size_t)row * 16 + u.pn * 4 + wc] = s;
                if (m & 1) asm volatile("" ::: "memory"); }
    }
};
__device__ __forceinline__ float dpp_ror1(float x) { return __builtin_bit_cast(float, __builtin_amdgcn_update_dpp(0, __builtin_bit_cast(int, x), 0x121, 0xf, 0xf, false)); }
__device__ __forceinline__ float dpp_ror2(float x) { return __builtin_bit_cast(float, __builtin_amdgcn_update_dpp(0, __builtin_bit_cast(int, x), 0x122, 0xf, 0xf, false)); }
struct EpiUpFused {
    static constexpr bool PERM = false, AFTER_DRAIN = false;
    bf16_t* HID; const float* wconv; const float* bconv; bf16_t* RAW01; float* RAWG; float* pconv; PG8_LAS float* halo; int dff; const PG8_LAS float* rstd;
    __device__ __forceinline__ void operator()(const f32x4 (&acc)[2][2][4][2], const Unit& u, int wr, int wc, int fr, int fq) const {
        typedef unsigned u32x2_ __attribute__((ext_vector_type(2)));
        const int lane = fq * 16 + fr;
        const int fb = u.pn * 128 + wc * 32 + 4 * fq;
        const int hc = wc * 32 + 4 * fq;
        float rs[2][4];
#pragma unroll
        for (int ai = 0; ai < 2; ++ai)
#pragma unroll
            for (int m = 0; m < 4; ++m) rs[ai][m] = rstd[(u.pm & 7) * BM + ai * HALF + wr * 64 + m * 16 + fr];
        if (fr >= 14) {
#pragma unroll
            for (int ai = 0; ai < 2; ++ai)
#pragma unroll
                for (int n = 0; n < 2; ++n) *(PG8_LAS f32x4*)(halo + ((ai * 2 + wr) * 2 + (fr - 14)) * 128 + hc + 16 * n) = acc[ai][0][3][n] * rs[ai][3];
        }
        asm volatile("s_waitcnt lgkmcnt(0)" ::: "memory"); __builtin_amdgcn_s_barrier(); asm volatile("" ::: "memory");
        const bool seq_tile = (u.pm & 7) == 0;
#pragma unroll
        for (int n = 0; n < 2; ++n) {
            const f32x4 w0 = *(const f32x4*)(wconv + fb + 16 * n), w1 = *(const f32x4*)(wconv + dff + fb + 16 * n), w2 = *(const f32x4*)(wconv + 2 * dff + fb + 16 * n), bb = *(const f32x4*)(bconv + fb + 16 * n);
#pragma unroll
            for (int ai = 0; ai < 2; ++ai) {
                f32x4 p14 = (f32x4){0.f, 0.f, 0.f, 0.f}, p15 = p14;
                const bool top = (ai == 0 && wr == 0);
                if (!top) { const int pg = (wr == 1) ? (ai * 2 + 0) : ((ai - 1) * 2 + 1); p14 = *(const PG8_LAS f32x4*)(halo + (pg * 2 + 0) * 128 + hc + 16 * n); p15 = *(const PG8_LAS f32x4*)(halo + (pg * 2 + 1) * 128 + hc + 16 * n); }
                f32x4 pr1, pr2;
#pragma unroll
                for (int e = 0; e < 4; ++e) { const float x0 = (fr == 14) ? p14[e] : p15[e]; pr1[e] = dpp_ror1(x0); pr2[e] = dpp_ror2(x0); }
#pragma unroll
                for (int m = 0; m < 4; ++m) {
                    const f32x4 cur = acc[ai][0][m][n] * rs[ai][m], val = acc[ai][1][m][n] * rs[ai][m];
                    f32x4 g1, g2, c1, c2;
#pragma unroll
                    for (int e = 0; e < 4; ++e) { c1[e] = dpp_ror1(cur[e]); c2[e] = dpp_ror2(cur[e]);
                        g1[e] = fr >= 1 ? c1[e] : pr1[e]; g2[e] = fr >= 2 ? c2[e] : pr2[e]; }
                    pr1 = c1; pr2 = c2;
                    const int row = u.pm * BM + ai * HALF + wr * 64 + m * 16 + fr;
                    const bool first2 = top && m == 0 && fr < 2;
                    if (first2 && seq_tile) { if (fr == 0) g1 = (f32x4){0.f, 0.f, 0.f, 0.f}; g2 = (f32x4){0.f, 0.f, 0.f, 0.f}; }
                    if (first2 && !seq_tile) {
                        u32x2_ wg_, wv_; wg_.x = cvt_pk_bf16(cur[0], cur[1]); wg_.y = cvt_pk_bf16(cur[2], cur[3]); wv_.x = cvt_pk_bf16(val[0], val[1]); wv_.y = cvt_pk_bf16(val[2], val[3]);
                        bf16_t* rp = RAW01 + ((size_t)u.pm * 2 + fr) * (2 * dff) + fb + 16 * n; *(u32x2_*)rp = wg_; *(u32x2_*)(rp + dff) = wv_;
                    } else {
                        f32x4 h;
#pragma unroll
                        for (int e = 0; e < 4; ++e) { const float c = bb[e] + g2[e] * w0[e] + g1[e] * w1[e] + cur[e] * w2[e]; h[e] = c * __builtin_amdgcn_rcpf(1.f + __expf(-c)) * val[e]; }
                        u32x2_ wh; wh.x = cvt_pk_bf16(h[0], h[1]); wh.y = cvt_pk_bf16(h[2], h[3]);
                        *(u32x2_*)(HID + (size_t)row * dff + fb + 16 * n) = wh;
                    }
                    if (ai == 1 && wr == 1 && m == 3 && fr >= 14) {
                        *(f32x4*)(RAWG + ((size_t)u.pm * 2 + (fr - 14)) * dff + fb + 16 * n) = cur;
                        if ((u.pm & 7) == 7) *(f32x4*)(pconv + ((size_t)(u.pm >> 3) * 2 + (fr - 14)) * dff + fb + 16 * n) = cur;
                    }
                }
            }
        }
        asm volatile("s_waitcnt lgkmcnt(0)" ::: "memory"); __builtin_amdgcn_s_barrier(); asm volatile("" ::: "memory");
    }
};
template <class Epi, class Sched, bool ALIGN_EPI = false, bool SP2 = false>
__device__ __forceinline__ void gemm_phase(PG8_LAS unsigned char* lds, const Gemm g, const Sched& S, const Epi& E) {
    const int tid = opaque_i(threadIdx.x), wid = __builtin_amdgcn_readfirstlane(tid >> 6), lane = tid & 63, wr = wid >> 2, wc = wid & 3, fr = lane & 15, fq = lane >> 4;
    const int K = g.K, nt = K / BK;
    unsigned voffA[2], voffB[2];
#pragma unroll
    for (int i = 0; i < 2; ++i) { int R, C; stage_rc(tid * 16 + i * 8192, R, C); const int Rb = Epi::PERM ? ((R & ~31) + perm32(R & 31)) : R;
        voffA[i] = (unsigned)(R * K + C) * 2u; voffB[i] = (unsigned)(Rb * K + C) * 2u; }
    const size_t kstep = (size_t)(BK * 2);
    const size_t hstep = (size_t)HALF * K * 2;
    const size_t tstep = 2 * hstep;
    const unsigned ldsw = (unsigned)wid * 1024u;
    const int aoff = lds_byte(wr * 64 + fr, fq * 8), boff = lds_byte(wc * 32 + fr, fq * 8);
#define PG8_SA(b, h) (((b) * 2 + (h)) * HTB)
#define PG8_SB(b, h) ((4 + (b) * 2 + (h)) * HTB)
#define PG8_STAGE(bufoff, gbase, voff) do { _Pragma("unroll") for (int _i = 0; _i < 2; ++_i) \
        __builtin_amdgcn_global_load_lds((const unsigned*)((const char*)(gbase) + (voff)[_i]), (PG8_LAS unsigned*)(lds + (bufoff) + ldsw + _i * 8192), 16, 0, 0); } while (0)
#define PG8_LDA(dst, b, h) do { _Pragma("unroll") for (int m = 0; m < 4; ++m) _Pragma("unroll") for (int k = 0; k < 2; ++k) dst[m][k] = *(const PG8_LAS bf16x8*)(lds + PG8_SA(b, h) + aoff + m * 2048 + k * 1024); } while (0)
#define PG8_LDB(dst, b, h) do { _Pragma("unroll") for (int n = 0; n < 2; ++n) _Pragma("unroll") for (int k = 0; k < 2; ++k) dst[n][k] = *(const PG8_LAS bf16x8*)(lds + PG8_SB(b, h) + boff + n * 2048 + k * 1024); } while (0)
#define PG8_MMA(ai, bj, At, Bt) do { __builtin_amdgcn_s_setprio(1); _Pragma("unroll") for (int m = 0; m < 4; ++m) _Pragma("unroll") for (int n = 0; n < 2; ++n) _Pragma("unroll") for (int k = 0; k < 2; ++k) \
        acc[ai][bj][m][n] = __builtin_amdgcn_mfma_f32_16x16x32_bf16(Bt[n][k], At[m][k], acc[ai][bj][m][n], 0, 0, 0); __builtin_amdgcn_s_setprio(0); } while (0)
#define PG8_WAIT_V(n) asm volatile("s_waitcnt vmcnt(" #n ")" ::: "memory")
#define PG8_WAIT_L(n) asm volatile("s_waitcnt lgkmcnt(" #n ")" ::: "memory")
#define PG8_BAR __builtin_amdgcn_s_barrier()
#define PG8_SCHED __builtin_amdgcn_sched_barrier(0)
    Unit cur, nxt; int ui = 0;
    if (!S.next(0, cur)) return;
    f32x4 acc[2][2][4][2];
#pragma unroll
    for (int a = 0; a < 2; ++a)
#pragma unroll
        for (int b = 0; b < 2; ++b)
#pragma unroll
            for (int m = 0; m < 4; ++m)
#pragma unroll
                for (int n = 0; n < 2; ++n) acc[a][b][m][n] = (f32x4){0.f, 0.f, 0.f, 0.f};
    bf16x8 At[4][2], B0[2][2], B1[2][2];
    const char* cA = (const char*)g.A + (size_t)cur.pm * tstep; const char* cB = (const char*)g.Bt + (size_t)cur.pn * tstep;
    S.a_ready(cur);
    if constexpr (SP2) {
        PG8_STAGE(PG8_SB(0, 0), cB, voffB); PG8_STAGE(PG8_SB(0, 1), cB + hstep, voffB); PG8_STAGE(PG8_SA(0, 0), cA, voffA); PG8_STAGE(PG8_SA(0, 1), cA + hstep, voffA);
        if (wr == 1) PG8_BAR;
        PG8_WAIT_V(2); PG8_BAR;
        PG8_STAGE(PG8_SB(1, 0), cB + kstep, voffB); PG8_STAGE(PG8_SA(1, 0), cA + kstep, voffA); PG8_STAGE(PG8_SB(1, 1), cB + hstep + kstep, voffB);
        PG8_WAIT_V(6); PG8_BAR;
    } else {
        PG8_STAGE(PG8_SB(0, 0), cB, voffB); PG8_STAGE(PG8_SA(0, 0), cA, voffA); PG8_STAGE(PG8_SB(0, 1), cB + hstep, voffB); PG8_STAGE(PG8_SA(0, 1), cA + hstep, voffA);
        if (wr == 1) PG8_BAR;
        PG8_WAIT_V(4); PG8_BAR;
        PG8_STAGE(PG8_SB(1, 0), cB + kstep, voffB); PG8_STAGE(PG8_SA(1, 0), cA + kstep, voffA); PG8_STAGE(PG8_SB(1, 1), cB + hstep + kstep, voffB);
        PG8_WAIT_V(6); PG8_BAR;
    }
    for (;;) {
        const bool has_next = S.next(ui + 1, nxt);
        const char* nA = has_next ? (const char*)g.A + (size_t)nxt.pm * tstep : cA; const char* nB = has_next ? (const char*)g.Bt + (size_t)nxt.pn * tstep : cB;
        for (int t = 0; t < nt; t += 2) {
            const bool last = (t == nt - 2);
            const char* a1 = cA + (size_t)(t + 1) * kstep;
            const char* a2 = last ? nA : cA + (size_t)(t + 2) * kstep; const char* b2 = last ? nB : cB + (size_t)(t + 2) * kstep;
            const char* a3 = a2 + kstep; const char* b3 = b2 + kstep;
            if (last && has_next) S.a_ready(nxt);
            if constexpr (SP2) {
            PG8_LDB(B0, 0, 0); PG8_LDB(B1, 0, 1); PG8_SCHED; PG8_LDA(At, 0, 0); PG8_STAGE(PG8_SA(1, 1), a1 + hstep, voffA);
            PG8_WAIT_V(8); PG8_WAIT_L(0); PG8_BAR; PG8_MMA(0, 0, At, B0); PG8_MMA(0, 1, At, B1); PG8_BAR; PG8_SCHED;
            PG8_LDA(At, 0, 1); PG8_STAGE(PG8_SB(0, 0), b2, voffB); PG8_STAGE(PG8_SB(0, 1), b2 + hstep, voffB); PG8_STAGE(PG8_SA(0, 0), a2, voffA);
            PG8_WAIT_V(8); PG8_WAIT_L(0); PG8_BAR; PG8_MMA(1, 0, At, B0); PG8_MMA(1, 1, At, B1); PG8_BAR; PG8_SCHED;
            PG8_LDB(B0, 1, 0); PG8_LDB(B1, 1, 1); PG8_SCHED; PG8_LDA(At, 1, 0); PG8_STAGE(PG8_SA(0, 1), a2 + hstep, voffA);
            PG8_WAIT_V(8); PG8_WAIT_L(0); PG8_BAR; PG8_MMA(0, 0, At, B0); PG8_MMA(0, 1, At, B1); PG8_BAR; PG8_SCHED;
            PG8_LDA(At, 1, 1); PG8_STAGE(PG8_SB(1, 0), b3, voffB); PG8_STAGE(PG8_SB(1, 1), b3 + hstep, voffB); PG8_STAGE(PG8_SA(1, 0), a3, voffA);
            PG8_WAIT_V(8); PG8_WAIT_L(0); PG8_BAR; PG8_MMA(1, 0, At, B0); PG8_MMA(1, 1, At, B1); PG8_BAR; PG8_SCHED;
            } else {
            PG8_LDB(B0, 0, 0); PG8_SCHED; PG8_LDA(At, 0, 0); PG8_STAGE(PG8_SA(1, 1), a1 + hstep, voffA);
            PG8_WAIT_L(8); PG8_BAR; PG8_WAIT_L(0); PG8_MMA(0, 0, At, B0); PG8_BAR; PG8_SCHED;
            PG8_LDB(B1, 0, 1); PG8_STAGE(PG8_SB(0, 0), b2, voffB);
            PG8_BAR; PG8_WAIT_L(0); PG8_MMA(0, 1, At, B1); PG8_BAR;
            PG8_LDA(At, 0, 1); PG8_STAGE(PG8_SA(0, 0), a2, voffA);
            PG8_BAR; PG8_WAIT_L(0); PG8_MMA(1, 0, At, B0); PG8_BAR; PG8_SCHED;
            PG8_STAGE(PG8_SB(0, 1), b2 + hstep, voffB);
            PG8_WAIT_V(6); PG8_BAR; PG8_MMA(1, 1, At, B1); PG8_BAR;
            PG8_LDB(B0, 1, 0); PG8_SCHED; PG8_LDA(At, 1, 0); PG8_STAGE(PG8_SA(0, 1), a2 + hstep, voffA);
            PG8_WAIT_L(8); PG8_BAR; PG8_WAIT_L(0); PG8_MMA(0, 0, At, B0); PG8_BAR; PG8_SCHED;
            PG8_LDB(B1, 1, 1); PG8_STAGE(PG8_SB(1, 0), b3, voffB);
            PG8_BAR; PG8_WAIT_L(0); PG8_MMA(0, 1, At, B1); PG8_BAR;
            PG8_LDA(At, 1, 1); PG8_STAGE(PG8_SA(1, 0), a3, voffA);
            PG8_BAR; PG8_WAIT_L(0); PG8_MMA(1, 0, At, B0); PG8_BAR; PG8_SCHED;
            PG8_STAGE(PG8_SB(1, 1), b3 + hstep, voffB);
            PG8_WAIT_V(6); PG8_BAR; PG8_MMA(1, 1, At, B1); PG8_BAR;
            }
        }
        if constexpr (ALIGN_EPI) { if (wr == 0) PG8_BAR; }
        if constexpr (!Epi::AFTER_DRAIN) { E(acc, cur, wr, wc, fr, fq); S.done(cur); }
        if (!has_next) break;
#pragma unroll
        for (int a = 0; a < 2; ++a)
#pragma unroll
            for (int b = 0; b < 2; ++b)
#pragma unroll
                for (int m = 0; m < 4; ++m)
#pragma unroll
                    for (int n = 0; n < 2; ++n) acc[a][b][m][n] = (f32x4){0.f, 0.f, 0.f, 0.f};
        cur = nxt; cA = nA; cB = nB; ++ui;
        if constexpr (ALIGN_EPI) { if (wr == 1) PG8_BAR; }
    }
    PG8_WAIT_V(0);
    if constexpr (!ALIGN_EPI) { if (wr == 0) PG8_BAR; }
    PG8_BAR;
    if constexpr (Epi::AFTER_DRAIN) { E.fused(acc, cur, wr, wc, fr, fq, lds, wid, lane); S.done(cur); }
#undef PG8_SA
#undef PG8_SB
#undef PG8_STAGE
#undef PG8_LDA
#undef PG8_LDB
#undef PG8_MMA
#undef PG8_WAIT_V
#undef PG8_WAIT_L
#undef PG8_BAR
#undef PG8_SCHED
}
}
#define XB_TMO      128
#define XB_XCNT(j)  (256  + 64 * (j))
#define XB_XSUB(j)  (1280 + 64 * (j))
#define XB_XGEN(j)  (2304 + 64 * (j))
#define XB_TOP      3328
#define XB_TOPGEN   3392
#define XCD_BAR_WORDS 3456
#define XB_SPIN_CAP (1u << 18)

__device__ __forceinline__ unsigned xb_ld(unsigned* p)              { return __hip_atomic_load(p, __ATOMIC_RELAXED, __HIP_MEMORY_SCOPE_AGENT); }
__device__ __forceinline__ unsigned xb_add(unsigned* p, unsigned v) { return __hip_atomic_fetch_add(p, v, __ATOMIC_RELAXED, __HIP_MEMORY_SCOPE_AGENT); }
__device__ __forceinline__ unsigned xb_xcc_id() { return (unsigned)__builtin_amdgcn_s_getreg((3 << 11) | 20) & 0xFu; }
#define XB_SPIN(cond, bar) do { unsigned _sp = 0; while (cond) { __builtin_amdgcn_s_sleep(1); \
    if ((++_sp & 255u) == 0u) { if (xb_ld(&(bar)[XB_TMO])) break; if (_sp > XB_SPIN_CAP) { atomicAdd(&(bar)[XB_TMO], 1u); break; } } } } while (0)

struct XcdBarrier {
    unsigned* bar; unsigned x;
    volatile LAS unsigned* st;
};

__device__ __forceinline__ XcdBarrier xcd_barrier_post(unsigned* bar, volatile LAS unsigned* st) {
    XcdBarrier b; b.bar = bar; b.x = xb_xcc_id(); b.st = st;
    if (threadIdx.x == 0) (void)xb_add(&bar[XB_XCNT(b.x)], 1u);
    return b;
}
__device__ __forceinline__ void xcd_barrier_complete(unsigned* bar, unsigned x, unsigned& nloc, unsigned& nx) {
    const unsigned G = gridDim.x * gridDim.y * gridDim.z;
    unsigned sum, cnt, mine, sp = 0u;
    for (;;) {
        sum = 0u; cnt = 0u; mine = 0u;
#pragma unroll
        for (unsigned j = 0; j < 16; ++j) { const unsigned c = xb_ld(&bar[XB_XCNT(j)]); sum += c; cnt += (c > 0u) ? 1u : 0u; mine = (j == x) ? c : mine; }
        if (sum == G) break;
        __builtin_amdgcn_s_sleep(1);
        if ((++sp & 255u) == 0u) { if (xb_ld(&bar[XB_TMO])) break; if (sp > XB_SPIN_CAP) { atomicAdd(&bar[XB_TMO], 1u); break; } }
    }
    nloc = mine > 0u ? mine : 1u; nx = cnt > 0u ? cnt : 1u;
}

__device__ __forceinline__ void xcd_barrier(const XcdBarrier& b) {
    asm volatile("s_waitcnt vmcnt(0)" ::: "memory");
    __syncthreads();
    if (threadIdx.x == 0) {
        unsigned* bar = b.bar;
        __builtin_amdgcn_s_waitcnt(0);
        unsigned nloc = b.st[0], nx = b.st[1];
        if (nloc == 0u) { xcd_barrier_complete(bar, b.x, nloc, nx); b.st[0] = nloc; b.st[1] = nx; }
        const unsigned old = xb_add(&bar[XB_XSUB(b.x)], 1u);
        const unsigned gen = old / nloc;
        if (old + 1u == (gen + 1u) * nloc) {
            __builtin_amdgcn_fence(__ATOMIC_RELEASE, "agent");
            asm volatile("s_waitcnt vmcnt(0)" ::: "memory");
            const unsigned og = xb_add(&bar[XB_TOP], 1u);
            const unsigned tg = og / nx;
            if (og + 1u == (tg + 1u) * nx) xb_add(&bar[XB_TOPGEN], 1u);
            else XB_SPIN(xb_ld(&bar[XB_TOPGEN]) == tg, bar);
            __builtin_amdgcn_fence(__ATOMIC_ACQUIRE, "agent");
            xb_add(&bar[XB_XGEN(b.x)], 1u);
            asm volatile("s_waitcnt vmcnt(0)" ::: "memory");
        } else {
            XB_SPIN(xb_ld(&bar[XB_XGEN(b.x)]) == gen, bar);
            __builtin_amdgcn_fence(__ATOMIC_ACQUIRE, "agent");
            asm volatile("s_waitcnt vmcnt(0)" ::: "memory");
        }
    }
    __syncthreads();
}
namespace mk {
constexpr int NWAVES = 8;
constexpr int D = 1024, TP = 16384, TSMP = 512, T = TP + TSMP, SEQ = 2048, NSEQ = 128, PAST = 8192;
constexpr int NIN = 1568, NINP = 1792, DFF = 2816;
constexpr float EPS = 1e-6f;
constexpr float LOG2E = 1.4426950408889634f;
constexpr float QSCALE = 0.10206207261596577f * LOG2E;
constexpr float MQSCALE = 0.08838834764831845f * LOG2E;

constexpr size_t O_YP = 0, O_YS = 16777216, O_PCKV = O_YS + 524288, O_PKPE = O_PCKV + 4194304, O_PMK = O_PKPE + 524288, O_PMV = O_PMK + 1048576,
                 O_PCONV = O_PMV + 1048576, O_SCKV = O_PCONV + 45056, O_SKPE = O_SCKV + 131072, O_SCV = O_SKPE + 16384, O_SCONV = O_SCV + 262144, O_END = O_SCONV + 720896;
static_assert(O_END == 25292800, "output size");

constexpr size_t al(size_t x) { return (x + 4095) & ~(size_t)4095; }
constexpr size_t WS_CTL = 0, CTL_ZERO_BYTES = 1u << 20;
constexpr size_t WS_W_IN = 1u << 20;
constexpr size_t WS_W_UQ = al(WS_W_IN + (size_t)NINP * D * 2);
constexpr size_t WS_W_UK = al(WS_W_UQ + (size_t)768 * 256 * 2);
constexpr size_t WS_W_UV = al(WS_W_UK + (size_t)512 * 256 * 2);
constexpr size_t WS_W_O = al(WS_W_UV + (size_t)512 * 256 * 2);
constexpr size_t WS_W_MQ = al(WS_W_O + (size_t)1024 * 1024 * 2);
constexpr size_t WS_W_MKV = al(WS_W_MQ + (size_t)512 * 1024 * 2);
constexpr size_t WS_W_MO = al(WS_W_MKV + (size_t)1024 * 1024 * 2);
constexpr size_t WS_W_UP = al(WS_W_MO + (size_t)1024 * 512 * 2);
constexpr size_t WS_W_DN = al(WS_W_UP + (size_t)2 * DFF * D * 2);
constexpr size_t WS_ROPE = al(WS_W_DN + (size_t)D * DFF * 2);
constexpr size_t ROPE_N = 8200;
constexpr size_t WS_XN = al(WS_ROPE + 2 * ROPE_N * 16 * 4);
constexpr size_t WS_MN = al(WS_XN + (size_t)T * D * 2);
constexpr size_t WS_Z = al(WS_MN + (size_t)2048 * D * 2);
constexpr size_t WS_MKV = al(WS_Z + (size_t)T * NINP * 2);
constexpr size_t WS_CQN = al(WS_MKV + (size_t)2048 * 1024 * 2);
constexpr size_t WS_CKVN = al(WS_CQN + (size_t)T * 256 * 2);
constexpr size_t WS_VG = al(WS_CKVN + (size_t)T * 256 * 2);
constexpr size_t WS_MK = al(WS_VG + (size_t)T * 512 * 2);
constexpr size_t WS_MVT = al(WS_MK + (size_t)2048 * 512 * 2);
constexpr size_t WS_QR = al(WS_MVT + (size_t)2048 * 512 * 2);
constexpr size_t WS_KNR = al(WS_QR + (size_t)T * 768 * 2);
constexpr size_t WS_VT = al(WS_KNR + (size_t)TP * 512 * 2);
constexpr size_t WS_QF = al(WS_VT + (size_t)512 * TP * 2);
constexpr size_t WS_KF = al(WS_QF + (size_t)T * 768 * 2);
constexpr size_t WS_BO = al(WS_KF + (size_t)TP * 768 * 2);
constexpr size_t WS_MRG = al(WS_BO + (size_t)T * 512 * 2);
constexpr size_t WS_X1 = al(WS_MRG + (size_t)T * 1024 * 2);
constexpr size_t WS_H2 = al(WS_X1 + (size_t)T * 1024 * 4);
constexpr size_t WS_MQ = al(WS_H2 + (size_t)T * 1024 * 2);
constexpr size_t WS_MO = al(WS_MQ + (size_t)T * 512 * 2);
constexpr size_t WS_X2 = al(WS_MO + (size_t)T * 512 * 2);
constexpr size_t WS_H3 = al(WS_X2 + (size_t)T * 1024 * 4);
constexpr size_t WS_UP = al(WS_H3 + (size_t)T * 1024 * 2);
constexpr size_t WS_HID = al(WS_UP + (size_t)T * 2 * DFF * 2);
constexpr size_t WS_SPART = al(WS_HID + (size_t)T * DFF * 2);
constexpr size_t SPART_STRIDE = (32 + 32 * 256) * 4;
constexpr size_t WS_QEXT = al(WS_SPART + (size_t)NSEQ * 2 * SPART_STRIDE);
constexpr size_t WS_W_SB = al(WS_QEXT + (size_t)NSEQ * 32 * 288 * 2);
constexpr size_t WS_SSQ1_PRE = al(WS_W_SB + (size_t)8 * 128 * 128 * 2);
constexpr size_t WS_RAW01 = WS_SSQ1_PRE;
constexpr size_t WS_RAWG = al(WS_RAW01 + (size_t)64 * 2 * 5632 * 2);
constexpr size_t WS_SSQ1 = al(WS_RAWG + (size_t)64 * 2 * 2816 * 4);
constexpr size_t WS_SSQ2 = al(WS_SSQ1 + (size_t)T * 16 * 4);
constexpr size_t WS_MK_END = al(WS_SSQ2 + (size_t)T * 16 * 4);
static_assert(WS_MK_END < (1000u << 20), "mk workspace under 1000 MiB");
constexpr int CW_BAR = 4096;
constexpr int CW_HIDS = 16384;

constexpr int RING_BYTES = 155648, MISC_OFF = RING_BYTES + 320, LDS_BYTES = 159744;

struct Args { const void* in[38]; float* out; unsigned char* ws; int ph_lo, ph_hi; };
static_assert(sizeof(Args) == 38 * 8 + 8 + 8 + 8, "Args has no padding");

struct Frame {
    LAS unsigned char* lds; unsigned char* lds_g;
    int tid, lane, wave, G, bid;
    unsigned char* ws; float* out;
    const float* const* in;
    template <class P> __device__ __forceinline__ P* w(size_t off) const { return (P*)(ws + off); }
    __device__ __forceinline__ const float* inf(int i) const { return (const float*)in[i]; }
};

enum { I_XP = 0, I_XS, I_CKV, I_KPE, I_CMK, I_CMV, I_CONVST, I_PT, I_MEMP, I_GMIX, I_WIN, I_LNG, I_LNB, I_WS, I_BS, I_GQA, I_WUQ, I_GKVA, I_WUK, I_WUV, I_GQKQ, I_GQKK,
       I_GOA, I_GOB, I_WO, I_GMEMX, I_GMEMIN, I_WMQ, I_WMK, I_WMV, I_GMQ, I_GMK, I_WMO, I_GFFN, I_WUP, I_WCONV, I_BCONV, I_WDOWN };

struct P0Item { float v[32]; float g; };
__device__ __forceinline__ void p0_item_load(P0Item& x, const float* W, int K, int N, int item, int lane, const float* gain) {
    const int nblk = N / 32, kb = item / nblk, nb = item % nblk, k0 = 64 * kb, n0 = 32 * nb;
#pragma unroll
    for (int i = 0; i < 32; ++i) { const int kk = 2 * i + (lane >> 5); x.v[i] = W[(size_t)(k0 + kk) * N + n0 + (lane & 31)]; }
    x.g = gain ? gain[k0 + lane] : 1.f;
}
__device__ __forceinline__ void p0_item_finish(const P0Item& x, int K, int N, bf16* WT, int row_off, LAS float* scr, int item, int lane, bool has_gain) {
    const int nblk = N / 32, kb = item / nblk, nb = item % nblk, k0 = 64 * kb, n0 = 32 * nb;
#pragma unroll
    for (int i = 0; i < 32; ++i) { const int kk = 2 * i + (lane >> 5); float wv_ = x.v[i]; if (has_gain) wv_ *= __shfl(x.g, kk); scr[kk * 33 + (lane & 31)] = wv_; }
    LDS_WAIT(); asm volatile("" ::: "memory");
    const int c = lane & 7;
#pragma unroll
    for (int j = 0; j < 4; ++j) { const int n = (lane >> 3) + 8 * j; const LAS float* s = scr + (8 * c) * 33 + n;
        v4u o; o.x = pk2(s[0 * 33], s[1 * 33]); o.y = pk2(s[2 * 33], s[3 * 33]); o.z = pk2(s[4 * 33], s[5 * 33]); o.w = pk2(s[6 * 33], s[7 * 33]);
        *(v4u*)(WT + (size_t)(row_off + n0 + n) * K + k0 + 8 * c) = o; }
    LDS_WAIT(); asm volatile("" ::: "memory");
}
__device__ __forceinline__ void rms_row_to_bf16(const float* xrow, const float* g, bf16* orow, int lane) {
    const f32x4* xr = (const f32x4*)xrow + lane; const f32x4* gr = (const f32x4*)g + lane;
    f32x4 v[4]; float s = 0.f;
#pragma unroll
    for (int j = 0; j < 4; ++j) { v[j] = xr[64 * j]; s += (v[j].x * v[j].x + v[j].y * v[j].y) + (v[j].z * v[j].z + v[j].w * v[j].w); }
    const float rstd = rsqrtf(wave_sum(s) * (1.f / 1024.f) + EPS);
    unsigned long long* o8 = (unsigned long long*)orow + lane;
#pragma unroll
    for (int j = 0; j < 4; ++j) { const f32x4 gg = gr[64 * j];
        o8[64 * j] = (unsigned long long)pk2(v[j].x * rstd * gg.x, v[j].y * rstd * gg.y) | ((unsigned long long)pk2(v[j].z * rstd * gg.z, v[j].w * rstd * gg.w) << 32); }
}
__device__ __forceinline__ const float* xrow_ptr(const Frame& F, int r) { return r < TP ? F.inf(I_XP) + (size_t)r * D : F.inf(I_XS) + (size_t)(r - TP) * D; }

template <int M_LO, int M_HI>
__device__ __forceinline__ void p0_transposes(Frame& F, int gw, int NGW) {
    LAS float* scr = (LAS float*)(F.lds + F.wave * 16384);
    constexpr int NI = 11;
    const int srcs[NI] = {I_WIN, I_WUQ, I_WUK, I_WUV, I_WO, I_WMQ, I_WMK, I_WMV, I_WMO, I_WUP, I_WDOWN};
    const int Ks[NI] = {1024, 256, 256, 256, 1024, 1024, 1024, 1024, 512, 1024, 2816};
    const int Ns[NI] = {1568, 768, 512, 512, 1024, 512, 512, 512, 1024, 5632, 1024};
    const size_t dsts[NI] = {WS_W_IN, WS_W_UQ, WS_W_UK, WS_W_UV, WS_W_O, WS_W_MQ, WS_W_MKV, WS_W_MKV, WS_W_MO, WS_W_UP, WS_W_DN};
    const int roffs[NI] = {0, 0, 0, 0, 0, 0, 0, 512, 0, 0, 0};
    const int gains[NI] = {-1, -1, -1, -1, -1, I_GMEMX, -1, -1, -1, I_GFFN, -1};
    int base = 0;
#pragma unroll
    for (int m = M_LO; m < M_HI; ++m) {
        const int cnt = (Ks[m] / 64) * (Ns[m] / 32);
        int first = gw - (base % NGW); if (first < 0) first += NGW;
        const float* gp = gains[m] >= 0 ? F.inf(gains[m]) : nullptr;
        P0Item cur_, nxt_;
        if (first < cnt) p0_item_load(cur_, F.inf(srcs[m]), Ks[m], Ns[m], first, F.lane, gp);
        for (int it = first; it < cnt; it += NGW) {
            const bool more = it + NGW < cnt;
            if (more) p0_item_load(nxt_, F.inf(srcs[m]), Ks[m], Ns[m], it + NGW, F.lane, gp);
            int roff = roffs[m];
            if (m == 9) {
                const int n0 = 32 * (it % (Ns[m] / 32)); const int f0 = n0 < DFF ? n0 : n0 - DFF; roff = 256 * (f0 >> 7) + (n0 < DFF ? 0 : 128) + (f0 & 127) - n0; }
            p0_item_finish(cur_, Ks[m], Ns[m], F.w<bf16>(dsts[m]), roff, scr, it, F.lane, gains[m] >= 0);
            if (more) cur_ = nxt_;
        }
        base += cnt;
    }
}
__device__ __forceinline__ void p0_prologue(Frame& F) {
    const int gw = F.bid * NWAVES + F.wave, NGW = F.G * NWAVES;
    p0_transposes<0, 9>(F, gw, NGW);
    for (int r = gw; r < NINP - NIN; r += NGW) { v4u* p = (v4u*)(F.w<bf16>(WS_W_IN) + (size_t)(NIN + r) * D) + F.lane; p[0] = (v4u){0, 0, 0, 0}; p[64] = (v4u){0, 0, 0, 0}; }
    for (int r = gw; r < T + 2048; r += 2 * NGW) {
        f32x4 v[2][4]; const float* gp[2]; bf16* op[2]; bool ok[2];
#pragma unroll
        for (int k = 0; k < 2; ++k) { const int rr = r + k * NGW; ok[k] = rr < T + 2048;
            const float* xr = !ok[k] ? F.inf(I_XP) : (rr < T ? xrow_ptr(F, rr) : F.inf(I_MEMP) + (size_t)(rr - T) * D);
            gp[k] = (rr < T) ? F.inf(I_GMIX) : F.inf(I_GMEMIN); op[k] = (rr < T) ? F.w<bf16>(WS_XN) + (size_t)rr * D : F.w<bf16>(WS_MN) + (size_t)(rr - T) * D;
#pragma unroll
            for (int j = 0; j < 4; ++j) v[k][j] = ((const f32x4*)xr)[F.lane + 64 * j]; }
#pragma unroll
        for (int k = 0; k < 2; ++k) if (ok[k]) {
            float sq = 0.f;
#pragma unroll
            for (int j = 0; j < 4; ++j) sq += (v[k][j].x * v[k][j].x + v[k][j].y * v[k][j].y) + (v[k][j].z * v[k][j].z + v[k][j].w * v[k][j].w);
            const float rstd = rsqrtf(wave_sum(sq) * (1.f / 1024.f) + EPS);
            unsigned long long* o8 = (unsigned long long*)op[k] + F.lane;
#pragma unroll
            for (int j = 0; j < 4; ++j) { const f32x4 gg = ((const f32x4*)gp[k])[F.lane + 64 * j];
                o8[64 * j] = (unsigned long long)pk2(v[k][j].x * rstd * gg.x, v[k][j].y * rstd * gg.y) | ((unsigned long long)pk2(v[k][j].z * rstd * gg.z, v[k][j].w * rstd * gg.w) << 32); }
        }
    }
    { const float* wsrc = F.inf(I_WS); bf16* wdst = F.w<bf16>(WS_W_SB);
      for (int i = F.bid * 512 + F.tid; i < 8 * 128 * 128 / 4; i += F.G * 512) { const f32x4 v = *(const f32x4*)(wsrc + 4 * i); v2u o; o.x = pk2(v[0], v[1]); o.y = pk2(v[2], v[3]); *(v2u*)(wdst + 4 * i) = o; } }
    { float* cs = F.w<float>(WS_ROPE); float* sn = cs + ROPE_N * 16;
      for (int i = F.bid * 512 + F.tid; i < (int)ROPE_N * 16; i += F.G * 512) { const int pos = i >> 4, f = i & 15;
          const double ang = (double)pos * pow(10000.0, -(double)f / 16.0); cs[i] = (float)cos(ang); sn[i] = (float)sin(ang); } }
}

__device__ __forceinline__ void p2_post_inproj(Frame& F) {
    const int gw = F.bid * NWAVES + F.wave, NGW = F.G * NWAVES, lane = F.lane;
    const bf16* Z = F.w<bf16>(WS_Z);
    const float* lg = F.inf(I_LNG); const float* lb = F.inf(I_LNB);
    const f32x4 lg0 = *(const f32x4*)(lg + 8 * lane), lg1 = *(const f32x4*)(lg + 8 * lane + 4), lb0 = *(const f32x4*)(lb + 8 * lane), lb1 = *(const f32x4*)(lb + 8 * lane + 4);
    const f32x4 gqa = *(const f32x4*)(F.inf(I_GQA) + 4 * lane), gkva = *(const f32x4*)(F.inf(I_GKVA) + 4 * lane);
    for (int r0 = gw; r0 < T; r0 += 4 * NGW) {
        v4u rawv[4]; v2u rawq[4], rawk[4]; bf16 rawp[4];
#pragma unroll
        for (int k = 0; k < 4; ++k) { const int r = r0 + k * NGW; if (r < T) { const bf16* zr = Z + (size_t)r * NINP;
            rawv[k] = *(const v4u*)(zr + 512 + 8 * lane); rawq[k] = *(const v2u*)(zr + 1024 + 4 * lane); rawk[k] = *(const v2u*)(zr + 1280 + 4 * lane); rawp[k] = zr[1536 + (lane & 31)]; } }
#pragma unroll
        for (int k = 0; k < 4; ++k) { const int r = r0 + k * NGW; if (r < T) {
        {
            const v4u raw = rawv[k];
            float x[8];
#pragma unroll
            for (int i = 0; i < 4; ++i) { x[2 * i] = gelu_tanh_f(bflo(raw[i])); x[2 * i + 1] = gelu_tanh_f(bfhi(raw[i])); }
            float s = 0.f;
#pragma unroll
            for (int i = 0; i < 8; ++i) s += x[i];
            s += __shfl_xor(s, 1); s += __shfl_xor(s, 2); s += __shfl_xor(s, 4);
            const float mean = s * (1.f / 64.f);
            float q = 0.f;
#pragma unroll
            for (int i = 0; i < 8; ++i) { x[i] -= mean; q += x[i] * x[i]; }
            q += __shfl_xor(q, 1); q += __shfl_xor(q, 2); q += __shfl_xor(q, 4);
            const float rstd = rsqrtf(q * (1.f / 64.f) + EPS);
            f32x4 y0, y1;
#pragma unroll
            for (int i = 0; i < 4; ++i) { y0[i] = x[i] * rstd * lg0[i] + lb0[i]; y1[i] = x[4 + i] * rstd * lg1[i] + lb1[i]; }
            v4u o; o.x = pk2(y0[0], y0[1]); o.y = pk2(y0[2], y0[3]); o.z = pk2(y1[0], y1[1]); o.w = pk2(y1[2], y1[3]);
            *(v4u*)(F.w<bf16>(WS_VG) + (size_t)r * 512 + 8 * lane) = o;
            if (r >= TP) { float* d = F.out + O_SCV + (size_t)(r - TP) * 512 + 8 * lane; *(f32x4*)d = y0; *(f32x4*)(d + 4) = y1; }
        }
#pragma unroll
        for (int which = 0; which < 2; ++which) {
            const v2u raw = which ? rawk[k] : rawq[k];
            f32x4 x; x[0] = bflo(raw[0]); x[1] = bfhi(raw[0]); x[2] = bflo(raw[1]); x[3] = bfhi(raw[1]);
            const float ss = wave_sum((x[0] * x[0] + x[1] * x[1]) + (x[2] * x[2] + x[3] * x[3]));
            const float rstd = rsqrtf(ss * (1.f / 256.f) + EPS);
            const f32x4 g = which ? gkva : gqa;
            f32x4 y;
#pragma unroll
            for (int i = 0; i < 4; ++i) y[i] = x[i] * rstd * g[i];
            v2u o; o.x = pk2(y[0], y[1]); o.y = pk2(y[2], y[3]);
            *(v2u*)(F.w<bf16>(which ? WS_CKVN : WS_CQN) + (size_t)r * 256 + 4 * lane) = o;
            if (which) { float* d = (r < TP) ? F.out + O_PCKV + (size_t)r * 256 : F.out + O_SCKV + (size_t)(r - TP) * 256; *(f32x4*)(d + 4 * lane) = y; }
        }
        if (lane < 32) { float* d = (r < TP) ? F.out + O_PKPE + (size_t)r * 32 : F.out + O_SKPE + (size_t)(r - TP) * 32; d[lane] = bf2f(rawp[k]); }
        } }
    }
    const bf16* MKV = F.w<bf16>(WS_MKV);
    for (int r = gw; r < 2048; r += NGW) {
        const bf16* mr = MKV + (size_t)r * 1024;
        {
            const v4u raw = *(const v4u*)(mr + 8 * lane);
            float x[8];
#pragma unroll
            for (int i = 0; i < 4; ++i) { x[2 * i] = bflo(raw[i]); x[2 * i + 1] = bfhi(raw[i]); }
            float ss = 0.f;
#pragma unroll
            for (int i = 0; i < 8; ++i) ss += x[i] * x[i];
            ss += __shfl_xor(ss, 1); ss += __shfl_xor(ss, 2); ss += __shfl_xor(ss, 4); ss += __shfl_xor(ss, 8);
            const float rstd = rsqrtf(ss * (1.f / 128.f) + EPS);
            const float* g = F.inf(I_GMK) + ((8 * lane) & 127);
            f32x4 y0, y1;
#pragma unroll
            for (int i = 0; i < 4; ++i) { y0[i] = x[i] * rstd * g[i]; y1[i] = x[4 + i] * rstd * g[4 + i]; }
            float* d = F.out + O_PMK + (size_t)r * 512 + 8 * lane; *(f32x4*)d = y0; *(f32x4*)(d + 4) = y1;
            v4u o; o.x = pk2(y0[0], y0[1]); o.y = pk2(y0[2], y0[3]); o.z = pk2(y1[0], y1[1]); o.w = pk2(y1[2], y1[3]);
            *(v4u*)(F.w<bf16>(WS_MK) + (size_t)r * 512 + 8 * lane) = o;
        }
        {
            const v4u raw = *(const v4u*)(mr + 512 + 8 * lane);
            float x[8];
#pragma unroll
            for (int i = 0; i < 4; ++i) { x[2 * i] = bflo(raw[i]); x[2 * i + 1] = bfhi(raw[i]); }
            float* d = F.out + O_PMV + (size_t)r * 512 + 8 * lane; *(f32x4*)d = (f32x4){x[0], x[1], x[2], x[3]}; *(f32x4*)(d + 4) = (f32x4){x[4], x[5], x[6], x[7]};
        }
    }
    for (int g8 = gw; g8 < 256; g8 += NGW) {
        v4u rw[8];
#pragma unroll
        for (int k = 0; k < 8; ++k) rw[k] = *(const v4u*)(MKV + (size_t)(8 * g8 + k) * 1024 + 512 + 8 * lane);
        const int b = (8 * g8) >> 8, key0 = (8 * g8) & 255;
        bf16* mvt = F.w<bf16>(WS_MVT);
#pragma unroll
        for (int i = 0; i < 8; ++i) { const int col = 8 * lane + i, h = col >> 7, dv = col & 127; v4u o;
#pragma unroll
            for (int j = 0; j < 4; ++j) { const unsigned lo = (i & 1) ? (rw[2 * j][i >> 1] >> 16) : (rw[2 * j][i >> 1] & 0xffffu), hi = (i & 1) ? (rw[2 * j + 1][i >> 1] >> 16) : (rw[2 * j + 1][i >> 1] & 0xffffu); o[j] = lo | (hi << 16); }
            *(v4u*)(mvt + ((size_t)(b * 4 + h) * 128 + dv) * 256 + key0) = o; }
    }
}
}
namespace mk {
struct P4Raw { v4u raw; unsigned r1, r2; };
__device__ __forceinline__ P4Raw p4_load_row(const bf16* nope, const bf16* pe, int lane) { const int sub = lane & 7; P4Raw x; x.raw = *(const v4u*)(nope + 8 * sub); x.r1 = *(const unsigned*)(pe + 2 * sub); x.r2 = *(const unsigned*)(pe + 16 + 2 * sub); return x; }
__device__ __forceinline__ void p4_norm_rope_row(const P4Raw in, const float* g, const float* cs, const float* sn, int pos, float oscale, bf16* dst, int lane, bf16* dst2 = nullptr) {
    const int sub = lane & 7;
    const v4u raw = in.raw;
    const unsigned r1 = in.r1, r2 = in.r2;
    float x[8];
#pragma unroll
    for (int i = 0; i < 4; ++i) { x[2 * i] = bflo(raw[i]); x[2 * i + 1] = bfhi(raw[i]); }
    float a0 = bflo(r1), a1 = bfhi(r1), b0 = bflo(r2), b1 = bfhi(r2);
    float ss = (a0 * a0 + a1 * a1) + (b0 * b0 + b1 * b1);
#pragma unroll
    for (int i = 0; i < 8; ++i) ss += x[i] * x[i];
    ss += __shfl_xor(ss, 1); ss += __shfl_xor(ss, 2); ss += __shfl_xor(ss, 4);
    const float rs = rsqrtf(ss * (1.f / 96.f) + EPS) * oscale;
    const f32x4 g0 = *(const f32x4*)(g + 8 * sub), g1 = *(const f32x4*)(g + 8 * sub + 4);
    v4u o; o.x = pk2(x[0] * rs * g0[0], x[1] * rs * g0[1]); o.y = pk2(x[2] * rs * g0[2], x[3] * rs * g0[3]); o.z = pk2(x[4] * rs * g1[0], x[5] * rs * g1[1]); o.w = pk2(x[6] * rs * g1[2], x[7] * rs * g1[3]);
    *(v4u*)(dst + 8 * sub) = o;
    const int f = 2 * sub;
    a0 *= rs * g[64 + f]; a1 *= rs * g[65 + f]; b0 *= rs * g[80 + f]; b1 *= rs * g[81 + f];
    const float c0 = cs[pos * 16 + f], c1 = cs[pos * 16 + f + 1], s0 = sn[pos * 16 + f], s1 = sn[pos * 16 + f + 1];
    const unsigned o1_ = pk2(a0 * c0 - b0 * s0, a1 * c1 - b1 * s1), o2_ = pk2(b0 * c0 + a0 * s0, b1 * c1 + a1 * s1);
    *(unsigned*)(dst + 64 + f) = o1_; *(unsigned*)(dst + 80 + f) = o2_;
    if (dst2) { *(unsigned*)(dst2 + f) = o1_; *(unsigned*)(dst2 + 16 + f) = o2_; }
}
__device__ __forceinline__ void p4_qk_norm_rope(Frame& F) {
    const int gw = F.bid * NWAVES + F.wave, NGW = F.G * NWAVES, lane = F.lane, h = lane >> 3;
    const float* cs = F.w<float>(WS_ROPE); const float* sn = cs + ROPE_N * 16;
    const bf16* QR = F.w<bf16>(WS_QR); const bf16* KNR = F.w<bf16>(WS_KNR); const bf16* Z = F.w<bf16>(WS_Z);
    for (int r0 = gw; r0 < T; r0 += 4 * NGW) {
        P4Raw qin[4], kin[4];
#pragma unroll
        for (int k = 0; k < 4; ++k) { const int r = r0 + k * NGW; if (r < T) { const bf16* q = QR + (size_t)r * 768 + 96 * h; qin[k] = p4_load_row(q, q + 64, lane);
            if (r < TP) kin[k] = p4_load_row(KNR + (size_t)r * 512 + 64 * h, Z + (size_t)r * NINP + 1536, lane); } }
#pragma unroll
        for (int k = 0; k < 4; ++k) { const int r = r0 + k * NGW; if (r < T) {
            const int pos = r < TP ? (r & 2047) : PAST + ((r - TP) & 3);
            bf16* qx = nullptr;
            if (r >= TP) { const int sq = (r - TP) >> 2, tq = (r - TP) & 3; qx = F.w<bf16>(WS_QEXT) + ((size_t)sq * 32 + tq * 8 + h) * 288 + 256; }
            p4_norm_rope_row(qin[k], F.inf(I_GQKQ), cs, sn, pos, QSCALE, F.w<bf16>(WS_QF) + (size_t)r * 768 + 96 * h, lane, qx);
            if (r < TP) p4_norm_rope_row(kin[k], F.inf(I_GQKK), cs, sn, pos, 1.f, F.w<bf16>(WS_KF) + (size_t)r * 768 + 96 * h, lane);
        } }
    }
}
__device__ __forceinline__ void p4_qext(Frame& F) {
    const int gw = F.bid * NWAVES + F.wave, NGW = F.G * NWAVES, lane = F.lane, l31 = lane & 31, hh = lane >> 5;
    const float* gq = F.inf(I_GQKQ); const float* gk = F.inf(I_GQKK);
    for (int u = gw; u < 1024; u += NGW) {
        const int h = u & 7, cbk = (u >> 3) & 7, rbk = u >> 6;
        const int row = TP + 32 * rbk + l31;
        const bf16* qp = F.w<bf16>(WS_QR) + (size_t)row * 768 + 96 * h;
        v4u raw[4]; float ss = 0.f;
#pragma unroll
        for (int ks = 0; ks < 4; ++ks) { raw[ks] = *(const v4u*)(qp + 16 * ks + 8 * hh);
#pragma unroll
            for (int i = 0; i < 4; ++i) { const float a = bflo(raw[ks][i]), c = bfhi(raw[ks][i]); ss += a * a + c * c; } }
        { const v4u r0 = *(const v4u*)(qp + 64 + 16 * hh), r1 = *(const v4u*)(qp + 64 + 16 * hh + 8);
#pragma unroll
          for (int i = 0; i < 4; ++i) { const float a = bflo(r0[i]), c = bfhi(r0[i]), d = bflo(r1[i]), e = bfhi(r1[i]); ss += (a * a + c * c) + (d * d + e * e); } }
        ss += __shfl_xor(ss, 32);
        const float rs = rsqrtf(ss * (1.f / 96.f) + EPS) * QSCALE;
        f32x16 acc = {};
        const float* wp = F.inf(I_WUK) + (size_t)(32 * cbk + l31) * 512 + h * 64 + 8 * hh;
#pragma unroll
        for (int ks = 0; ks < 4; ++ks) {
            const int d0 = 16 * ks + 8 * hh;
            const f32x4 w0 = *(const f32x4*)(wp + 16 * ks), w1 = *(const f32x4*)(wp + 16 * ks + 4);
            v4u wa; wa.x = cvtpk(w0[0], w0[1]); wa.y = cvtpk(w0[2], w0[3]); wa.z = cvtpk(w1[0], w1[1]); wa.w = cvtpk(w1[2], w1[3]);
            const f32x4 q0 = *(const f32x4*)(gq + d0), q1 = *(const f32x4*)(gq + d0 + 4), k0 = *(const f32x4*)(gk + d0), k1 = *(const f32x4*)(gk + d0 + 4);
            v4u qb; qb.x = cvtpk(bflo(raw[ks][0]) * rs * q0[0] * k0[0], bfhi(raw[ks][0]) * rs * q0[1] * k0[1]); qb.y = cvtpk(bflo(raw[ks][1]) * rs * q0[2] * k0[2], bfhi(raw[ks][1]) * rs * q0[3] * k0[3]);
            qb.z = cvtpk(bflo(raw[ks][2]) * rs * q1[0] * k1[0], bfhi(raw[ks][2]) * rs * q1[1] * k1[1]); qb.w = cvtpk(bflo(raw[ks][3]) * rs * q1[2] * k1[2], bfhi(raw[ks][3]) * rs * q1[3] * k1[3]);
            acc = __builtin_amdgcn_mfma_f32_32x32x16_bf16(__builtin_bit_cast(bf16x8, wa), __builtin_bit_cast(bf16x8, qb), acc, 0, 0, 0);
        }
        const int sq = (32 * rbk + l31) >> 2, tq = l31 & 3;
        bf16* dst = F.w<bf16>(WS_QEXT) + ((size_t)sq * 32 + tq * 8 + h) * 288 + 32 * cbk + 4 * hh;
#pragma unroll
        for (int g = 0; g < 4; ++g) { v2u o; o.x = cvtpk(acc[4 * g], acc[4 * g + 1]); o.y = cvtpk(acc[4 * g + 2], acc[4 * g + 3]); *(v2u*)(dst + 8 * g) = o; }
    }
}
}
namespace mk {
__device__ __forceinline__ float wave_max(float v) {
#pragma unroll
    for (int o = 1; o < 64; o <<= 1) v = fmaxf(v, __shfl_xor(v, o));
    return v;
}
__device__ __forceinline__ float gain_absmax(const float* g, int n, int lane) { float m = 0.f; for (int i = lane; i < n; i += 64) m = fmaxf(m, fabsf(g[i])); return wave_max(m); }

constexpr int PA_KROW = 208, PA_VROW = 144, PA_KBUF = 0, PA_VBUF = 2 * 64 * PA_KROW, PA_END = PA_VBUF + 2 * 64 * PA_VROW;
__device__ __forceinline__ void attn_prompt_unit(Frame& F, int b, int h, int qb, float negM) {
    const int tid = F.tid, lane = F.lane, wv = F.wave, l31 = lane & 31, hh = lane >> 5;
    LAS unsigned char* L = F.lds;
    const int q0w = 256 * qb + 32 * wv;
    const bf16* Qp = F.w<bf16>(WS_QF) + (size_t)(b * SEQ + q0w + l31) * 768 + h * 96 + 8 * hh;
    bf16x8 qf[6];
#pragma unroll
    for (int ks = 0; ks < 6; ++ks) qf[ks] = *(const bf16x8*)(Qp + 16 * ks);
    const bf16* Kg = F.w<bf16>(WS_KF) + (size_t)(b * SEQ) * 768 + h * 96;
    const bf16* Vg = F.w<bf16>(WS_VT) + (size_t)(h * 64) * TP + (size_t)b * SEQ;
    const int keyA = tid / 12, cA = tid % 12, keyB = (512 + tid) / 12, cB = (512 + tid) % 12, dvv = tid >> 3, cv = tid & 7;
    const int NT = 4 * qb + 4;
    v4u ka, kb2 = (v4u){0, 0, 0, 0}, vv_;
#define PA_LOAD(kt) do { ka = *(const v4u*)(Kg + (size_t)(64 * (kt) + keyA) * 768 + 8 * cA); if (tid < 256) kb2 = *(const v4u*)(Kg + (size_t)(64 * (kt) + keyB) * 768 + 8 * cB); \
        vv_ = *(const v4u*)(Vg + (size_t)dvv * TP + 64 * (kt) + 8 * cv); } while (0)
#define PA_STORE(buf) do { *(LAS v4u*)(L + PA_KBUF + (buf) * 64 * PA_KROW + keyA * PA_KROW + 16 * cA) = ka; if (tid < 256) *(LAS v4u*)(L + PA_KBUF + (buf) * 64 * PA_KROW + keyB * PA_KROW + 16 * cB) = kb2; \
        *(LAS v4u*)(L + PA_VBUF + (buf) * 64 * PA_VROW + dvv * PA_VROW + 16 * cv) = vv_; } while (0)
    PA_LOAD(0); PA_STORE(0);
    __syncthreads();
    if (NT > 1) PA_LOAD(1);
    f32x16 o0 = {}, o1 = {}; float l = 0.f;
#pragma unroll 1
    for (int kt = 0; kt < NT; ++kt) {
        const int buf = kt & 1;
        if (64 * kt <= q0w + 31) {
            const bool part = (64 * kt + 63 > q0w);
            const LAS unsigned char* kbp = L + PA_KBUF + buf * 64 * PA_KROW + l31 * PA_KROW + 16 * hh;
            const LAS unsigned char* vbp = L + PA_VBUF + buf * 64 * PA_VROW + l31 * PA_VROW + 8 * hh;
            bf16x8 kfa[6], kfb[6], vfa[2][2], vfb[2][2];
#define PA_VFRAG(dst, sub_) do { _Pragma("unroll") for (int s2 = 0; s2 < 2; ++s2) _Pragma("unroll") for (int dt = 0; dt < 2; ++dt) { const LAS unsigned char* vp = vbp + dt * 32 * PA_VROW + (32 * (sub_) + 16 * s2) * 2; \
                const s16x4 lo = *(const LAS s16x4*)vp, hi = *(const LAS s16x4*)(vp + 16); dst[s2][dt] = (bf16x8){lo[0], lo[1], lo[2], lo[3], hi[0], hi[1], hi[2], hi[3]}; } } while (0)
#define PA_EXP(s, sub_, pb, MASK) do { float p[16]; \
                _Pragma("unroll") for (int i = 0; i < 16; ++i) { float e = __builtin_amdgcn_exp2f(s[i] + negM); if (MASK && (64 * kt + 32 * (sub_) + (i & 3) + 8 * (i >> 2) + 4 * hh) > q0w + l31) e = 0.f; p[i] = e; l += e; } \
                _Pragma("unroll") for (int s2 = 0; s2 < 2; ++s2) { v4u w; w.x = cvtpk(p[8 * s2 + 0], p[8 * s2 + 1]); w.y = cvtpk(p[8 * s2 + 2], p[8 * s2 + 3]); w.z = cvtpk(p[8 * s2 + 4], p[8 * s2 + 5]); w.w = cvtpk(p[8 * s2 + 6], p[8 * s2 + 7]); pb[s2] = __builtin_bit_cast(bf16x8, w); } } while (0)
#pragma unroll
            for (int ks = 0; ks < 6; ++ks) kfa[ks] = *(const LAS bf16x8*)(kbp + 32 * ks);
            __builtin_amdgcn_sched_barrier(0);
            f32x16 sA = {}, sB = {};
#pragma unroll
            for (int ks = 0; ks < 6; ++ks) kfb[ks] = *(const LAS bf16x8*)(kbp + 32 * PA_KROW + 32 * ks);
#pragma unroll
            for (int ks = 0; ks < 6; ++ks) sA = __builtin_amdgcn_mfma_f32_32x32x16_bf16(kfa[ks], qf[ks], sA, 0, 0, 0);
            __builtin_amdgcn_sched_barrier(0);
            PA_VFRAG(vfa, 0);
#pragma unroll
            for (int ks = 0; ks < 6; ++ks) sB = __builtin_amdgcn_mfma_f32_32x32x16_bf16(kfb[ks], qf[ks], sB, 0, 0, 0);
            __builtin_amdgcn_sched_barrier(0);
            bf16x8 pbA[2], pbB[2];
            if (part) PA_EXP(sA, 0, pbA, true); else PA_EXP(sA, 0, pbA, false);
            __builtin_amdgcn_sched_barrier(0);
            PA_VFRAG(vfb, 1);
#pragma unroll
            for (int s2 = 0; s2 < 2; ++s2) { o0 = __builtin_amdgcn_mfma_f32_32x32x16_bf16(vfa[s2][0], pbA[s2], o0, 0, 0, 0); o1 = __builtin_amdgcn_mfma_f32_32x32x16_bf16(vfa[s2][1], pbA[s2], o1, 0, 0, 0); }
            __builtin_amdgcn_sched_barrier(0);
            if (part) PA_EXP(sB, 1, pbB, true); else PA_EXP(sB, 1, pbB, false);
            __builtin_amdgcn_sched_barrier(0);
#pragma unroll
            for (int s2 = 0; s2 < 2; ++s2) { o0 = __builtin_amdgcn_mfma_f32_32x32x16_bf16(vfb[s2][0], pbB[s2], o0, 0, 0, 0); o1 = __builtin_amdgcn_mfma_f32_32x32x16_bf16(vfb[s2][1], pbB[s2], o1, 0, 0, 0); }
            __builtin_amdgcn_sched_barrier(0);
#undef PA_VFRAG
#undef PA_EXP
        }
        if (kt + 1 < NT) PA_STORE(buf ^ 1);
        __syncthreads();
        if (kt + 2 < NT) PA_LOAD(kt + 2);
    }
#undef PA_LOAD
#undef PA_STORE
    l += __shfl_xor(l, 32);
    const float rl = 1.f / l;
    bf16* Op = F.w<bf16>(WS_BO) + (size_t)(b * SEQ + q0w + l31) * 512 + h * 64 + 4 * hh;
#pragma unroll
    for (int g = 0; g < 4; ++g) {
        v2u w0; w0.x = cvtpk(o0[4 * g] * rl, o0[4 * g + 1] * rl); w0.y = cvtpk(o0[4 * g + 2] * rl, o0[4 * g + 3] * rl);
        v2u w1; w1.x = cvtpk(o1[4 * g] * rl, o1[4 * g + 1] * rl); w1.y = cvtpk(o1[4 * g + 2] * rl, o1[4 * g + 3] * rl);
        *(v2u*)(Op + 8 * g) = w0; *(v2u*)(Op + 32 + 8 * g) = w1;
    }
}
__device__ __forceinline__ void p5_attn_prompt(Frame& F, float negM) {
    for (int u = F.bid; u < 256; u += F.G) {
        const int bh = u >> 2, p = u & 3, b = bh >> 3, h = bh & 7;
        attn_prompt_unit(F, b, h, p, negM);
        attn_prompt_unit(F, b, h, 7 - p, negM);
    }
}
}
namespace mk {
constexpr int SA_ROWB = 592;
constexpr int SA_TILE = 0, SA_T8 = 2 * 64 * SA_ROWB, SA_T8ROW = 272, SA_KP2 = SA_T8 + 64 * SA_T8ROW, SA_GPE = SA_KP2 + 256, SA_R = SA_GPE + 128, SA_PT = SA_R + 2048, SA_PTROW = 144,
              SA_QEXT = SA_PT + 32 * SA_PTROW, SA_RBASE = SA_QEXT + 32 * SA_ROWB  , SA_RDEL = SA_RBASE + 65 * 128  , SA_END = SA_RDEL + 64 * 128;
static_assert(SA_END <= RING_BYTES, "sample attention LDS");
typedef short v4i16_t __attribute__((ext_vector_type(4)));
#define SA_BAR() do { asm volatile("s_waitcnt lgkmcnt(0)" ::: "memory"); __builtin_amdgcn_s_barrier(); asm volatile("" ::: "memory"); } while (0)

__device__ __forceinline__ void attn_sample_unit(Frame& F, int s, int split, float negM) {
    const int tid = F.tid, lane = F.lane, w = F.wave, hh = lane >> 5, l31 = lane & 31;
    LAS unsigned char* L = F.lds;
    const float* pool_ckv = F.inf(I_CKV); const float* pool_kpe = F.inf(I_KPE); const int* pt = (const int*)F.in[I_PT] + s * 64;
    const float* cs = F.w<float>(WS_ROPE); const float* sn = cs + ROPE_N * 16;
    const float* gk = F.inf(I_GQKK);
    const int kbeg = split * 4096, NT = split ? 65 : 64;
    const int prow = tid >> 3, pc4 = tid & 7;
    const int mypage = pt[split * 32 + l31];
    f32x4 va[8], vb[8], pe;
#define SA_LOADC(n, V) do { const int key0_ = kbeg + 64 * (n); const int page_ = __builtin_amdgcn_readlane(mypage, (n) >> 1); const size_t rb_ = (size_t)page_ * 128 + (key0_ & 127); \
        const float* cp_ = pool_ckv + (rb_ + w) * 256 + 4 * lane; \
        _Pragma("unroll") for (int i = 0; i < 8; ++i) V[i] = __builtin_nontemporal_load((const f32x4*)(cp_ + (size_t)i * 2048)); } while (0)
#define SA_LOADPC(n) do { const int key0_ = kbeg + 64 * (n); const int page_ = __builtin_amdgcn_readlane(mypage, (n) >> 1); const size_t rb_ = (size_t)page_ * 128 + (key0_ & 127); \
        pe = __builtin_nontemporal_load((const f32x4*)(pool_kpe + (rb_ + prow) * 32 + 4 * pc4)); } while (0)
#define SA_LOADP(n) do { if (kbeg + 64 * (n) < PAST) SA_LOADPC(n); else { pe = (f32x4){0.f, 0.f, 0.f, 0.f}; \
            if (prow < 4) { const v2u r_ = *(const v2u*)(F.w<bf16>(WS_Z) + (size_t)(TP + 4 * s + prow) * NINP + 1536 + 4 * pc4); pe = (f32x4){bflo(r_.x), bfhi(r_.x), bflo(r_.y), bfhi(r_.y)}; } } } while (0)
#define SA_LOAD(n, V) do { \
        if (kbeg + 64 * (n) < PAST) SA_LOADC(n, V); else { \
            _Pragma("unroll") for (int i = 0; i < 8; ++i) V[i] = (f32x4){0.f, 0.f, 0.f, 0.f}; \
            if (w < 4) { const v2u o_ = *(const v2u*)(F.w<bf16>(WS_CKVN) + (size_t)(TP + 4 * s + w) * 256 + 4 * lane); V[0] = (f32x4){bflo(o_.x), bfhi(o_.x), bflo(o_.y), bfhi(o_.y)}; } \
        } } while (0)
#define SA_CONVERT(n, V) do { LAS unsigned char* tb_ = L + SA_TILE + ((n) & 1) * 64 * SA_ROWB; \
        _Pragma("unroll") for (int i = 0; i < 8; ++i) { v2u o_; o_.x = cvtpk(V[i][0], V[i][1]); o_.y = cvtpk(V[i][2], V[i][3]); \
            *(LAS v2u*)(tb_ + (w + 8 * i) * SA_ROWB + 8 * lane) = o_; \
            int f8_ = 0; f8_ = __builtin_amdgcn_cvt_pk_fp8_f32(V[i][0], V[i][1], f8_, false); f8_ = __builtin_amdgcn_cvt_pk_fp8_f32(V[i][2], V[i][3], f8_, true); \
            *(LAS int*)(L + SA_T8 + (w + 8 * i) * SA_T8ROW + 4 * lane) = f8_; } \
        { const f32x4 pv = pe; float ss_ = (pv[0] * pv[0] + pv[1] * pv[1]) + (pv[2] * pv[2] + pv[3] * pv[3]); ss_ += __shfl_xor(ss_, 1); ss_ += __shfl_xor(ss_, 2); ss_ += __shfl_xor(ss_, 4); \
          if (pc4 == 0) ((LAS float*)(L + SA_KP2))[prow] = ss_; \
          const LAS float* rb_ = (const LAS float*)(L + SA_RBASE) + (n) * 32 + 4 * (pc4 & 3); const LAS float* rd_ = (const LAS float*)(L + SA_RDEL) + prow * 32 + 4 * (pc4 & 3); \
          const f32x4 cb_ = *(const LAS f32x4*)rb_, sb_ = *(const LAS f32x4*)(rb_ + 16), cd_ = *(const LAS f32x4*)rd_, sd_ = *(const LAS f32x4*)(rd_ + 16); \
          const f32x4 c_ = cb_ * cd_ - sb_ * sd_, s_ = sb_ * cd_ + cb_ * sd_; \
          f32x4 x_ = pv * *(const LAS f32x4*)(L + SA_GPE + 16 * pc4), y_, o4_; y_[0] = __shfl_xor(x_[0], 4); y_[1] = __shfl_xor(x_[1], 4); y_[2] = __shfl_xor(x_[2], 4); y_[3] = __shfl_xor(x_[3], 4); \
          if (pc4 < 4) o4_ = x_ * c_ - y_ * s_; else o4_ = x_ * c_ + y_ * s_; \
          v2u o_; o_.x = cvtpk(o4_[0], o4_[1]); o_.y = cvtpk(o4_[2], o4_[3]); *(LAS v2u*)(tb_ + prow * SA_ROWB + 512 + pc4 * 8) = o_; } } while (0)
    SA_LOADPC(0); SA_LOADC(0, va);
    __builtin_amdgcn_sched_barrier(0);
    SA_LOADC(1, vb);
    __builtin_amdgcn_sched_barrier(0);
    { const bf16* qx = F.w<bf16>(WS_QEXT) + (size_t)s * 32 * 288;
      for (int ch = tid; ch < 32 * 36; ch += 512) { const int r_ = ch / 36, c_ = ch % 36; *(LAS v4u*)(L + SA_QEXT + r_ * SA_ROWB + 16 * c_) = *(const v4u*)(qx + r_ * 288 + 8 * c_); } }
    typedef int v8i_t __attribute__((ext_vector_type(8)));
    v8i_t Wf[2][4];
    { const bf16* Wp = F.w<bf16>(WS_W_UK) + (size_t)(w * 64 + l31) * 256 + 32 * hh;
#pragma unroll
      for (int dt = 0; dt < 2; ++dt)
#pragma unroll
          for (int ks = 0; ks < 4; ++ks) { v8i_t fr;
#pragma unroll
              for (int q = 0; q < 4; ++q) { const v4u raw = *(const v4u*)(Wp + (size_t)dt * 32 * 256 + 64 * ks + 8 * q);
                  int d0 = 0, d1 = 0;
                  d0 = __builtin_amdgcn_cvt_pk_fp8_f32(bflo(raw.x) * 16.f, bfhi(raw.x) * 16.f, d0, false); d0 = __builtin_amdgcn_cvt_pk_fp8_f32(bflo(raw.y) * 16.f, bfhi(raw.y) * 16.f, d0, true);
                  d1 = __builtin_amdgcn_cvt_pk_fp8_f32(bflo(raw.z) * 16.f, bfhi(raw.z) * 16.f, d1, false); d1 = __builtin_amdgcn_cvt_pk_fp8_f32(bflo(raw.w) * 16.f, bfhi(raw.w) * 16.f, d1, true);
                  fr[2 * q] = d0; fr[2 * q + 1] = d1; }
              Wf[dt][ks] = fr; } }
    if (tid < 32) ((LAS float*)(L + SA_GPE))[tid] = gk[64 + tid];
    for (int i = tid; i < 65 * 8; i += 512) { const int n_ = i >> 3, c_ = i & 7; *(LAS f32x4*)(L + SA_RBASE + n_ * 128 + 16 * c_) = *(const f32x4*)((c_ < 4 ? cs : sn - 16) + (size_t)(kbeg + 64 * n_) * 16 + 4 * c_); }
    { const int r_ = tid >> 3, c_ = tid & 7; *(LAS f32x4*)(L + SA_RDEL + r_ * 128 + 16 * c_) = *(const f32x4*)((c_ < 4 ? cs : sn - 16) + (size_t)r_ * 16 + 4 * c_); }
    SA_BAR();
    f32x16 oacc = {}; float lsum = 0.f;
    SA_CONVERT(0, va);
    __builtin_amdgcn_sched_barrier(0);
    SA_LOADPC(1);
    __builtin_amdgcn_sched_barrier(0);
    SA_LOADC(2, va);
    __builtin_amdgcn_sched_barrier(0);
    SA_BAR();
    const int lane_ = lane, tid_ = tid;
#define SA_STEP(n, V, DO_CONV, DO_LOADP, LOADPM, DO_LOAD, LOADM) do { \
        const int lane = opaque_i(lane_), tid = opaque_i(tid_), hh = lane >> 5, l31 = lane & 31, prow = tid >> 3, pc4 = tid & 7, l15 = lane & 15, l4 = lane >> 4;     \
        const LAS unsigned char* tb = L + SA_TILE + ((n) & 1) * 64 * SA_ROWB; \
          \
        _Pragma("unroll") for (int kt2 = 0; kt2 < 2; ++kt2) { \
            const LAS unsigned char* bp = L + SA_T8 + (32 * kt2 + l31) * SA_T8ROW + 32 * hh; \
            f32x16 a0 = {}, a1 = {}; \
            _Pragma("unroll") for (int ks = 0; ks < 4; ++ks) { const v4u lo = *(const LAS v4u*)(bp + 64 * ks), hi = *(const LAS v4u*)(bp + 64 * ks + 16); \
                const v8i_t fb = (v8i_t){(int)lo.x, (int)lo.y, (int)lo.z, (int)lo.w, (int)hi.x, (int)hi.y, (int)hi.z, (int)hi.w}; \
                a0 = __builtin_amdgcn_mfma_scale_f32_32x32x64_f8f6f4(Wf[0][ks], fb, a0, 0, 0, 0, 0x7B7B7B7B, 0, 0x7F7F7F7F); \
                a1 = __builtin_amdgcn_mfma_scale_f32_32x32x64_f8f6f4(Wf[1][ks], fb, a1, 0, 0, 0, 0x7B7B7B7B, 0, 0x7F7F7F7F); \
                if (ks & 1) __builtin_amdgcn_sched_barrier(0); } \
            float ss = 0.f; \
            _Pragma("unroll") for (int i = 0; i < 16; ++i) ss += a0[i] * a0[i] + a1[i] * a1[i]; \
            ss += __shfl_xor(ss, 32); \
            ss += ((const LAS float*)(L + SA_KP2))[32 * kt2 + l31]; \
            if (hh == 0) ((LAS float*)(L + SA_R))[w * 64 + 32 * kt2 + l31] = rsqrtf(ss * (1.f / 96.f) + EPS); \
        } \
        SA_BAR(); \
        if (DO_CONV) SA_CONVERT((n) + 1, V); \
        __builtin_amdgcn_sched_barrier(0); \
        if (DO_LOADP) LOADPM((n) + 2); \
        __builtin_amdgcn_sched_barrier(0); \
        if (DO_LOAD) LOADM((n) + 3, V); \
        __builtin_amdgcn_sched_barrier(0); \
          \
        if (w < 2) { \
            f32x16 sa0 = {}, sa1 = {}; \
            const LAS unsigned char* ap = tb + (32 * w + l31) * SA_ROWB + 16 * hh; \
            const LAS unsigned char* qp = L + SA_QEXT + l31 * SA_ROWB + 16 * hh; \
            _Pragma("unroll") for (int k0 = 0; k0 < 18; k0 += 3) { bf16x8 afr[3], qfr[3]; \
                _Pragma("unroll") for (int ks = 0; ks < 3; ++ks) { afr[ks] = *(const LAS bf16x8*)(ap + 32 * (k0 + ks)); qfr[ks] = *(const LAS bf16x8*)(qp + 32 * (k0 + ks)); } \
                __builtin_amdgcn_sched_barrier(0); \
                _Pragma("unroll") for (int ks = 0; ks < 3; ++ks) { if ((k0 + ks) & 1) sa1 = __builtin_amdgcn_mfma_f32_32x32x16_bf16(afr[ks], qfr[ks], sa1, 0, 0, 0); else sa0 = __builtin_amdgcn_mfma_f32_32x32x16_bf16(afr[ks], qfr[ks], sa0, 0, 0, 0); } \
                __builtin_amdgcn_sched_barrier(0); } \
            const int t_q = l31 >> 3, h_q = l31 & 7; \
            _Pragma("unroll") for (int g = 0; g < 4; ++g) { \
                const f32x4 r4 = *(const LAS f32x4*)(L + SA_R + (h_q * 64 + 32 * w + 8 * g + 4 * hh) * 4); \
                const int kg = kbeg + 64 * (n) + 32 * w + 8 * g + 4 * hh; \
                float p[4]; \
                _Pragma("unroll") for (int i = 0; i < 4; ++i) { float e = __builtin_amdgcn_exp2f((sa0[4 * g + i] + sa1[4 * g + i]) * r4[i] + negM); if (kg + i > PAST + t_q) e = 0.f; p[i] = e; lsum += e; } \
                v2u o; o.x = cvtpk(p[0], p[1]); o.y = cvtpk(p[2], p[3]); \
                *(LAS v2u*)(L + SA_PT + l31 * SA_PTROW + (32 * w + 8 * g + 4 * hh) * 2) = o; } \
        } \
        SA_BAR(); \
          \
        { \
            const LAS unsigned char* trp = tb + (8 * hh + (l15 >> 2)) * SA_ROWB + (32 * w + 16 * (l4 & 1) + 4 * (l15 & 3)) * 2; \
            const LAS unsigned char* pp = L + SA_PT + l31 * SA_PTROW + 16 * hh; \
            _Pragma("unroll") for (int s2 = 0; s2 < 4; ++s2) { \
                const s16x4 lo = __builtin_bit_cast(s16x4, __builtin_amdgcn_ds_read_tr16_b64_v4i16((LAS v4i16_t*)(trp + (16 * s2) * SA_ROWB))); \
                const s16x4 hi = __builtin_bit_cast(s16x4, __builtin_amdgcn_ds_read_tr16_b64_v4i16((LAS v4i16_t*)(trp + (16 * s2 + 4) * SA_ROWB))); \
                const bf16x8 af = (bf16x8){lo[0], lo[1], lo[2], lo[3], hi[0], hi[1], hi[2], hi[3]}; \
                const bf16x8 pf = *(const LAS bf16x8*)(pp + 32 * s2); \
                oacc = __builtin_amdgcn_mfma_f32_32x32x16_bf16(af, pf, oacc, 0, 0, 0); if (s2 & 1) __builtin_amdgcn_sched_barrier(0); \
            } \
        } } while (0)
#pragma unroll 1
    for (int n = 0; n < 60; n += 2) {
        SA_STEP(n, vb, true, true, SA_LOADPC, true, SA_LOADC);
        SA_STEP(n + 1, va, true, true, SA_LOADPC, true, SA_LOADC);
    }
#pragma unroll 1
    for (int n = 60; n < NT; n += 2) {
        SA_STEP(n, vb, n + 1 < NT, n + 2 < NT, SA_LOADP, n + 3 < NT, SA_LOAD);
        if (n + 1 < NT) SA_STEP(n + 1, va, n + 2 < NT, n + 3 < NT, SA_LOADP, n + 4 < NT, SA_LOAD);
    }
#undef SA_STEP
#undef SA_LOAD
#undef SA_LOADC
#undef SA_LOADP
#undef SA_LOADPC
#undef SA_CONVERT
    float* part = (float*)(F.ws + WS_SPART + (size_t)(s * 2 + split) * SPART_STRIDE);
    lsum += __shfl_xor(lsum, 32);
    __syncthreads();
    if (w < 2 && lane < 32) ((LAS float*)(L + SA_R))[w * 32 + lane] = lsum;
    __syncthreads();
    if (tid < 32) { const LAS float* lp = (const LAS float*)(L + SA_R); part[tid] = lp[tid] + lp[32 + tid]; }
#pragma unroll
    for (int g = 0; g < 4; ++g) *(f32x4*)(part + 32 + l31 * 256 + 32 * w + 8 * g + 4 * hh) = (f32x4){oacc[4 * g], oacc[4 * g + 1], oacc[4 * g + 2], oacc[4 * g + 3]};
    __syncthreads();
}
}
namespace mk {
__device__ __forceinline__ void p6_gmlp_chunk(Frame& F, int chunk) {
    const int lane = F.lane, g = F.wave, hh = lane >> 5, l31 = lane & 31;
    LAS float* SS = (LAS float*)(F.lds + 131072);
    LAS unsigned char* VT_ = F.lds + g * 16384;
    const int row0 = chunk * 128;
    const bf16* VG = F.w<bf16>(WS_VG) + (size_t)row0 * 512 + g * 64;
    const bf16* Z = F.w<bf16>(WS_Z) + (size_t)row0 * NINP + g * 64;
    const bf16* Wg = F.w<bf16>(WS_W_SB) + (size_t)g * 128 * 128;
    const float* bs = F.inf(I_BS) + g * 128;
    v4u wf[4][8];
#pragma unroll
    for (int tt = 0; tt < 4; ++tt)
#pragma unroll
        for (int ks = 0; ks < 2 * tt + 2; ++ks) wf[tt][ks] = *(const v4u*)(Wg + (size_t)(32 * tt + l31) * 128 + 16 * ks + 8 * hh);
#pragma unroll
    for (int i = 0; i < 16; ++i) { const int r = (lane >> 3) + 8 * i, ch = lane & 7; const v4u v = *(const v4u*)(VG + (size_t)r * 512 + 8 * ch); *(LAS v4u*)(VT_ + r * 128 + 16 * ch) = v;
        if ((i & 3) == 3) __builtin_amdgcn_sched_barrier(0); }
    LDS_WAIT(); asm volatile("" ::: "memory");
    const int l4 = lane >> 4, l15 = lane & 15;
    const LAS unsigned char* trb = VT_ + (8 * hh + (l15 >> 2)) * 128 + (16 * (l4 & 1) + 4 * (l15 & 3)) * 2;
    v2u pa[4][2][4];
    v2u ura[4][2][4]; float bta[4];
#pragma unroll
    for (int tt = 0; tt < 4; ++tt) { const int t = 32 * tt + l31; bta[tt] = bs[t];
#pragma unroll
        for (int dt = 0; dt < 2; ++dt)
#pragma unroll
            for (int gq = 0; gq < 4; ++gq) ura[tt][dt][gq] = *(const v2u*)(Z + (size_t)t * NINP + 32 * dt + 8 * gq + 4 * hh); }
#pragma unroll
    for (int tt = 0; tt < 4; ++tt) {
        const int t = 32 * tt + l31;
        const v2u (&ur)[2][4] = ura[tt];
        const float bt = bta[tt];
        f32x16 a0 = {}, a1 = {};
#pragma unroll
        for (int ks = 0; ks < 2 * tt + 2; ++ks) {
            v4u pk = wf[tt][ks];
            if (ks >= 2 * tt) {
                const int s0 = 16 * ks + 8 * hh;
#pragma unroll
                for (int i = 0; i < 4; ++i) { unsigned wv = pk[i]; if (s0 + 2 * i > t) wv = 0u; else if (s0 + 2 * i + 1 > t) wv &= 0xffffu; pk[i] = wv; }
            }
            const bf16x8 bfr = __builtin_bit_cast(bf16x8, pk);
            bf16x8 af[2];
#pragma unroll
            for (int dt = 0; dt < 2; ++dt) {
                const s16x4 lo = __builtin_bit_cast(s16x4, __builtin_amdgcn_ds_read_tr16_b64_v4i16((LAS v4i16_t*)(trb + (16 * ks) * 128 + 64 * dt)));
                const s16x4 hi = __builtin_bit_cast(s16x4, __builtin_amdgcn_ds_read_tr16_b64_v4i16((LAS v4i16_t*)(trb + (16 * ks + 4) * 128 + 64 * dt)));
                af[dt] = (bf16x8){lo[0], lo[1], lo[2], lo[3], hi[0], hi[1], hi[2], hi[3]};
            }
            a0 = __builtin_amdgcn_mfma_f32_32x32x16_bf16(af[0], bfr, a0, 0, 0, 0); a1 = __builtin_amdgcn_mfma_f32_32x32x16_bf16(af[1], bfr, a1, 0, 0, 0);
        }
        float ss = 0.f;
#pragma unroll
        for (int dt = 0; dt < 2; ++dt)
#pragma unroll
            for (int gq = 0; gq < 4; ++gq) {
                const v2u u2 = ur[dt][gq];
                const float u0 = gelu_tanh_f(bflo(u2.x)), u1 = gelu_tanh_f(bfhi(u2.x)), u2f = gelu_tanh_f(bflo(u2.y)), u3 = gelu_tanh_f(bfhi(u2.y));
                const f32x16& acc = dt ? a1 : a0;
                const float v0 = u0 * (acc[4 * gq] + bt), v1 = u1 * (acc[4 * gq + 1] + bt), v2 = u2f * (acc[4 * gq + 2] + bt), v3 = u3 * (acc[4 * gq + 3] + bt);
                ss += (v0 * v0 + v1 * v1) + (v2 * v2 + v3 * v3);
                v2u o; o.x = cvtpk(v0, v1); o.y = cvtpk(v2, v3); pa[tt][dt][gq] = o;
            }
        ss += __shfl_xor(ss, 32);
        if (hh == 0) SS[g * 128 + t] = ss;
    }
    __syncthreads();
    const float* goa = F.inf(I_GOA) + g * 64;
    bf16* MRG = F.w<bf16>(WS_MRG) + (size_t)row0 * 1024 + g * 64;
#pragma unroll
    for (int tt = 0; tt < 4; ++tt) {
        const int t = 32 * tt + l31;
        float tot = 0.f;
#pragma unroll
        for (int k = 0; k < 8; ++k) tot += SS[k * 128 + t];
        const float rstd = rsqrtf(tot * (1.f / 512.f) + EPS);
#pragma unroll
        for (int dt = 0; dt < 2; ++dt)
#pragma unroll
            for (int gq = 0; gq < 4; ++gq) {
                const int d0 = 32 * dt + 8 * gq + 4 * hh;
                const f32x4 gg = *(const f32x4*)(goa + d0);
                const v2u v = pa[tt][dt][gq];
                v2u o; o.x = cvtpk(bflo(v.x) * rstd * gg[0], bfhi(v.x) * rstd * gg[1]); o.y = cvtpk(bflo(v.y) * rstd * gg[2], bfhi(v.y) * rstd * gg[3]);
                *(v2u*)(MRG + (size_t)t * 1024 + d0) = o;
            }
    }
    __syncthreads();
}
__device__ __forceinline__ void p6_sample_seq(Frame& F, int s) {
    const int tid = F.tid, lane = F.lane, w = F.wave, l31 = lane & 31, hh = lane >> 5;
    LAS float* RED = (LAS float*)(F.lds + 32768);
    const float* p0 = (const float*)(F.ws + WS_SPART + (size_t)(s * 2) * SPART_STRIDE); const float* p1 = (const float*)((const unsigned char*)p0 + SPART_STRIDE);
    f32x16 a0 = {}, a1 = {};
    {
        const int th = (l31 & 3) * 8 + w;
        const float inv_l = 1.f / (p0[th] + p1[th]);
        const float* o0 = p0 + 32 + th * 256 + 8 * hh; const float* o1 = p1 + 32 + th * 256 + 8 * hh;
        const bf16* Wp = F.w<bf16>(WS_W_UV) + (size_t)(w * 64 + l31) * 256 + 8 * hh;
#pragma unroll
        for (int k0 = 0; k0 < 16; k0 += 4) {
            f32x4 x0[4], x1[4], y0[4], y1[4]; bf16x8 b0[4], b1[4];
#pragma unroll
            for (int i = 0; i < 4; ++i) { const int ks = k0 + i; x0[i] = *(const f32x4*)(o0 + 16 * ks); x1[i] = *(const f32x4*)(o0 + 16 * ks + 4); y0[i] = *(const f32x4*)(o1 + 16 * ks); y1[i] = *(const f32x4*)(o1 + 16 * ks + 4);
                b0[i] = *(const bf16x8*)(Wp + 16 * ks); b1[i] = *(const bf16x8*)(Wp + (size_t)32 * 256 + 16 * ks); }
#pragma unroll
            for (int i = 0; i < 4; ++i) { const f32x4 u0 = (x0[i] + y0[i]) * inv_l, u1 = (x1[i] + y1[i]) * inv_l;
                v4u pk; pk.x = cvtpk(u0[0], u0[1]); pk.y = cvtpk(u0[2], u0[3]); pk.z = cvtpk(u1[0], u1[1]); pk.w = cvtpk(u1[2], u1[3]);
                if (l31 >= 4) pk = (v4u){0u, 0u, 0u, 0u};
                const bf16x8 af = __builtin_bit_cast(bf16x8, pk);
                a0 = __builtin_amdgcn_mfma_f32_32x32x16_bf16(af, b0[i], a0, 0, 0, 0); a1 = __builtin_amdgcn_mfma_f32_32x32x16_bf16(af, b1[i], a1, 0, 0, 0); }
        }
    }
    const int col = tid;
    float ao[4];
    { const int g = col >> 6; const bf16* VG = F.w<bf16>(WS_VG) + (size_t)(TP + 4 * s) * 512 + col; const bf16* Z = F.w<bf16>(WS_Z) + (size_t)(TP + 4 * s) * NINP + col;
      const float* Wg = F.inf(I_WS) + (size_t)g * 128 * 128; const float* bs = F.inf(I_BS) + g * 128;
      float vg[4];
#pragma unroll
      for (int t = 0; t < 4; ++t) vg[t] = bf2f(VG[(size_t)t * 512]);
#pragma unroll
      for (int t = 0; t < 4; ++t) { float m = bs[t];
#pragma unroll
          for (int s2 = 0; s2 <= t; ++s2) m += Wg[t * 128 + s2] * vg[s2];
          ao[t] = gelu_tanh_f(bf2f(Z[(size_t)t * NINP])) * m; } }
    float red[8];
#pragma unroll
    for (int t = 0; t < 4; ++t) { red[t] = wave_sum(ao[t] * ao[t]); const float bq = (hh == 0) ? (a0[t] * a0[t] + a1[t] * a1[t]) : 0.f; red[4 + t] = wave_sum(bq); }
    if (lane < 8) { float v = red[0];
#pragma unroll
        for (int k = 1; k < 8; ++k) v = (lane == k) ? red[k] : v;
        RED[w * 8 + lane] = v; }
    __syncthreads();
    const float ga = F.inf(I_GOA)[col];
    bf16* MRG = F.w<bf16>(WS_MRG) + (size_t)(TP + 4 * s) * 1024; bf16* BO = F.w<bf16>(WS_BO) + (size_t)(TP + 4 * s) * 512;
    const float gb0 = F.inf(I_GOB)[w * 64 + l31], gb1 = F.inf(I_GOB)[w * 64 + 32 + l31];
#pragma unroll
    for (int t = 0; t < 4; ++t) {
        float sa = 0.f, sb = 0.f;
#pragma unroll
        for (int k = 0; k < 8; ++k) { sa += RED[k * 8 + t]; sb += RED[k * 8 + 4 + t]; }
        MRG[(size_t)t * 1024 + col] = (bf16)f2bf(ao[t] * rsqrtf(sa * (1.f / 512.f) + EPS) * ga);
        if (hh == 0) { const float rb = rsqrtf(sb * (1.f / 512.f) + EPS);
            MRG[(size_t)t * 1024 + 512 + w * 64 + l31] = (bf16)f2bf(a0[t] * rb * gb0); MRG[(size_t)t * 1024 + 512 + w * 64 + 32 + l31] = (bf16)f2bf(a1[t] * rb * gb1);
            BO[(size_t)t * 512 + w * 64 + l31] = (bf16)f2bf(a0[t]); BO[(size_t)t * 512 + w * 64 + 32 + l31] = (bf16)f2bf(a1[t]); }
    }
    __syncthreads();
}
static_assert(TP % (4 * 256 * NWAVES) == 0, "b_out norm loop: four rows per wave iteration");
__device__ __forceinline__ void p6_merge(Frame& F) {
#ifdef MK_TIMING
    unsigned long long* st_ = (unsigned long long*)(F.ws + WS_CTL + (768 << 10)) + F.bid * 32;
#define P6ST(k) do { if (F.tid == 0) st_[k] = __builtin_amdgcn_s_memrealtime(); } while (0)
#else
#define P6ST(k) do {} while (0)
#endif
    { const int u = F.bid; if (u < 128) { P6ST(24); p6_gmlp_chunk(F, u); P6ST(25); } else { P6ST(26); p6_sample_seq(F, u - 128); P6ST(27); } }
    P6ST(28);
    const int gw = F.bid * NWAVES + F.wave, NGW = F.G * NWAVES, lane = F.lane;
    const f32x4 g0 = *(const f32x4*)(F.inf(I_GOB) + 8 * lane), g1 = *(const f32x4*)(F.inf(I_GOB) + 8 * lane + 4);
    for (int r0 = gw; r0 < TP; r0 += 4 * NGW) {
        v4u raws[4];
#pragma unroll
        for (int k = 0; k < 4; ++k) raws[k] = *(const v4u*)(F.w<bf16>(WS_BO) + (size_t)(r0 + k * NGW) * 512 + 8 * lane);
#pragma unroll
        for (int k = 0; k < 4; ++k) { const int r = r0 + k * NGW; const v4u raw = raws[k];
        float x[8];
#pragma unroll
        for (int i = 0; i < 4; ++i) { x[2 * i] = bflo(raw[i]); x[2 * i + 1] = bfhi(raw[i]); }
        float ss = 0.f;
#pragma unroll
        for (int i = 0; i < 8; ++i) ss += x[i] * x[i];
        const float rstd = rsqrtf(wave_sum(ss) * (1.f / 512.f) + EPS);
        v4u o; o.x = pk2(x[0] * rstd * g0[0], x[1] * rstd * g0[1]); o.y = pk2(x[2] * rstd * g0[2], x[3] * rstd * g0[3]); o.z = pk2(x[4] * rstd * g1[0], x[5] * rstd * g1[1]); o.w = pk2(x[6] * rstd * g1[2], x[7] * rstd * g1[3]);
        *(v4u*)(F.w<bf16>(WS_MRG) + (size_t)r * 1024 + 512 + 8 * lane) = o;
        }
    }
    P6ST(29);
}
}
namespace mk {
__device__ __forceinline__ void rms_rowb_finish(const v4u a, const v4u b, const f32x4 g0, const f32x4 g1, const f32x4 g2, const f32x4 g3, bf16* orow, int lane) {
    float x[16];
#pragma unroll
    for (int i = 0; i < 4; ++i) { x[2 * i] = bflo(a[i]); x[2 * i + 1] = bfhi(a[i]); x[8 + 2 * i] = bflo(b[i]); x[8 + 2 * i + 1] = bfhi(b[i]); }
    float s = 0.f;
#pragma unroll
    for (int i = 0; i < 16; ++i) s += x[i] * x[i];
    const float rstd = rsqrtf(wave_sum(s) * (1.f / 1024.f) + EPS);
    v4u o0, o1;
    o0.x = pk2(x[0] * rstd * g0[0], x[1] * rstd * g0[1]); o0.y = pk2(x[2] * rstd * g0[2], x[3] * rstd * g0[3]); o0.z = pk2(x[4] * rstd * g1[0], x[5] * rstd * g1[1]); o0.w = pk2(x[6] * rstd * g1[2], x[7] * rstd * g1[3]);
    o1.x = pk2(x[8] * rstd * g2[0], x[9] * rstd * g2[1]); o1.y = pk2(x[10] * rstd * g2[2], x[11] * rstd * g2[3]); o1.z = pk2(x[12] * rstd * g3[0], x[13] * rstd * g3[1]); o1.w = pk2(x[14] * rstd * g3[2], x[15] * rstd * g3[3]);
    *(v4u*)(orow + 8 * lane) = o0; *(v4u*)(orow + 512 + 8 * lane) = o1;
}
__device__ __forceinline__ void p_rms_rows(Frame& F, size_t src_off, int gain_idx, size_t dst_off) {
    const int gw = F.bid * NWAVES + F.wave, NGW = F.G * NWAVES, lane = F.lane;
    const float* g = F.inf(gain_idx);
    const f32x4 g0 = *(const f32x4*)(g + 8 * lane), g1 = *(const f32x4*)(g + 8 * lane + 4), g2 = *(const f32x4*)(g + 512 + 8 * lane), g3 = *(const f32x4*)(g + 512 + 8 * lane + 4);
    const bf16* src = F.w<bf16>(src_off); bf16* dst = F.w<bf16>(dst_off);
    for (int r = gw; r < T; r += 4 * NGW) {
        v4u a[4], b[4];
#pragma unroll
        for (int k = 0; k < 4; ++k) { const int rr = r + k * NGW; if (rr < T) { a[k] = *(const v4u*)(src + (size_t)rr * D + 8 * lane); b[k] = *(const v4u*)(src + (size_t)rr * D + 512 + 8 * lane); } }
#pragma unroll
        for (int k = 0; k < 4; ++k) { const int rr = r + k * NGW; if (rr < T) rms_rowb_finish(a[k], b[k], g0, g1, g2, g3, dst + (size_t)rr * D, lane); }
    }
}

constexpr int MA_KROW = 272, MA_VROW = 528, MA_K = 0, MA_V = 256 * MA_KROW;
static_assert(MA_V + 128 * MA_VROW <= RING_BYTES, "memory attention LDS");
__device__ __forceinline__ void memattn_prompt_unit(Frame& F, int pb, int h, float negM) {
    const int tid = F.tid, lane = F.lane, l31 = lane & 31, hh = lane >> 5;
    const int b = pb >> 3, row = 256 * pb + 32 * F.wave + l31;
    LAS unsigned char* L = F.lds;
    {
        const bf16* Kg = F.w<bf16>(WS_MK) + (size_t)(b * 256) * 512 + h * 128;
        const bf16* Vg = F.w<bf16>(WS_MVT) + (size_t)(b * 4 + h) * 128 * 256;
        v4u kr[8], vr[8];
#pragma unroll
        for (int i = 0; i < 8; ++i) { const int ch = tid + 512 * i; kr[i] = *(const v4u*)(Kg + (size_t)(ch >> 4) * 512 + 8 * (ch & 15)); vr[i] = *(const v4u*)(Vg + (size_t)(ch >> 5) * 256 + 8 * (ch & 31)); }
#pragma unroll
        for (int i = 0; i < 8; ++i) { const int ch = tid + 512 * i; *(LAS v4u*)(L + MA_K + (ch >> 4) * MA_KROW + 16 * (ch & 15)) = kr[i]; *(LAS v4u*)(L + MA_V + (ch >> 5) * MA_VROW + 16 * (ch & 31)) = vr[i]; }
    }
    const bf16* Qp = F.w<bf16>(WS_MQ) + (size_t)row * 512 + h * 128 + 8 * hh;
    const float* g = F.inf(I_GMQ) + 8 * hh;
    bf16x8 qf[8];
    {
        v4u raw[8]; float ss = 0.f;
#pragma unroll
        for (int ks = 0; ks < 8; ++ks) { raw[ks] = *(const v4u*)(Qp + 16 * ks);
#pragma unroll
            for (int i = 0; i < 4; ++i) { const float a = bflo(raw[ks][i]), c = bfhi(raw[ks][i]); ss += a * a + c * c; } }
        ss += __shfl_xor(ss, 32);
        const float rs = rsqrtf(ss * (1.f / 128.f) + EPS) * MQSCALE;
#pragma unroll
        for (int ks = 0; ks < 8; ++ks) { const f32x4 g0 = *(const f32x4*)(g + 16 * ks), g1 = *(const f32x4*)(g + 16 * ks + 4); v4u o;
            o.x = cvtpk(bflo(raw[ks][0]) * rs * g0[0], bfhi(raw[ks][0]) * rs * g0[1]); o.y = cvtpk(bflo(raw[ks][1]) * rs * g0[2], bfhi(raw[ks][1]) * rs * g0[3]);
            o.z = cvtpk(bflo(raw[ks][2]) * rs * g1[0], bfhi(raw[ks][2]) * rs * g1[1]); o.w = cvtpk(bflo(raw[ks][3]) * rs * g1[2], bfhi(raw[ks][3]) * rs * g1[3]);
            qf[ks] = __builtin_bit_cast(bf16x8, o); }
    }
    __syncthreads();
    f32x16 o[4]; o[0] = f32x16{}; o[1] = f32x16{}; o[2] = f32x16{}; o[3] = f32x16{};
    float l = 0.f;
    const LAS unsigned char* Kp = L + MA_K + l31 * MA_KROW + 16 * hh;
    const LAS unsigned char* Vp = L + MA_V + l31 * MA_VROW + 8 * hh;
#pragma unroll 1
    for (int kt = 0; kt < 8; ++kt) {
        f32x16 s = {};
#pragma unroll
        for (int ks = 0; ks < 8; ++ks) { const bf16x8 kf = *(const LAS bf16x8*)(Kp + kt * 32 * MA_KROW + 32 * ks); s = __builtin_amdgcn_mfma_f32_32x32x16_bf16(kf, qf[ks], s, 0, 0, 0); }
        float p[16];
#pragma unroll
        for (int i = 0; i < 16; ++i) { p[i] = __builtin_amdgcn_exp2f(s[i] + negM); l += p[i]; }
        bf16x8 pb2[2];
#pragma unroll
        for (int s2 = 0; s2 < 2; ++s2) { v4u w; w.x = cvtpk(p[8 * s2 + 0], p[8 * s2 + 1]); w.y = cvtpk(p[8 * s2 + 2], p[8 * s2 + 3]); w.z = cvtpk(p[8 * s2 + 4], p[8 * s2 + 5]); w.w = cvtpk(p[8 * s2 + 6], p[8 * s2 + 7]); pb2[s2] = __builtin_bit_cast(bf16x8, w); }
#pragma unroll
        for (int dt = 0; dt < 4; ++dt)
#pragma unroll
            for (int s2 = 0; s2 < 2; ++s2) { const LAS unsigned char* vp = Vp + dt * 32 * MA_VROW + (kt * 32 + 16 * s2) * 2; const s16x4 lo = *(const LAS s16x4*)vp, hi = *(const LAS s16x4*)(vp + 16);
                const bf16x8 va = (bf16x8){lo[0], lo[1], lo[2], lo[3], hi[0], hi[1], hi[2], hi[3]};
                o[dt] = __builtin_amdgcn_mfma_f32_32x32x16_bf16(va, pb2[s2], o[dt], 0, 0, 0); }
    }
    l += __shfl_xor(l, 32);
    const float rl = 1.f / l;
    bf16* Op = F.w<bf16>(WS_MO) + (size_t)row * 512 + h * 128 + 4 * hh;
#pragma unroll
    for (int dt = 0; dt < 4; ++dt)
#pragma unroll
        for (int gq = 0; gq < 4; ++gq) { v2u w0; w0.x = cvtpk(o[dt][4 * gq] * rl, o[dt][4 * gq + 1] * rl); w0.y = cvtpk(o[dt][4 * gq + 2] * rl, o[dt][4 * gq + 3] * rl);
            *(v2u*)(Op + 32 * dt + 8 * gq) = w0; }
    __syncthreads();
}
__device__ __forceinline__ void memattn_sample_wg(Frame& F, int U) {
    const int lane = F.lane, l31 = lane & 31, hh = lane >> 5, pair = F.wave >> 2, kq = F.wave & 3;
    const int sh = 2 * U + pair, s = sh >> 2, h = sh & 3;
    LAS float* SC = (LAS float*)(F.lds + pair * 4096);
    LAS float* OP = (LAS float*)(F.lds + 8192 + pair * 8192);
    f32x4 q[4];
    { const f32x4 g = *(const f32x4*)(F.inf(I_GMQ) + 4 * l31);
#pragma unroll
      for (int t = 0; t < 4; ++t) { const v2u raw = *(const v2u*)(F.w<bf16>(WS_MQ) + (size_t)(TP + 4 * s + t) * 512 + h * 128 + 4 * l31);
          f32x4 x = (f32x4){bflo(raw.x), bfhi(raw.x), bflo(raw.y), bfhi(raw.y)};
          float ss = (x[0] * x[0] + x[1] * x[1]) + (x[2] * x[2] + x[3] * x[3]);
          ss += __shfl_xor(ss, 1); ss += __shfl_xor(ss, 2); ss += __shfl_xor(ss, 4); ss += __shfl_xor(ss, 8); ss += __shfl_xor(ss, 16);
          const float rs = rsqrtf(ss * (1.f / 128.f) + EPS) * 0.08838834764831845f;
          q[t] = x * rs * g; } }
    const size_t cbase = ((size_t)(s * 256 + 64 * kq) * 4 + h) * 128 + 4 * l31;
    const float* Kc = F.inf(I_CMK) + cbase; const float* Vc = F.inf(I_CMV) + cbase;
    const bool b4 = (l31 & 16) != 0, b3 = (l31 & 8) != 0, b2 = (l31 & 4) != 0, b1 = (l31 & 2) != 0;
#pragma unroll 1
    for (int kp = 0; kp < 32; kp += 16) {
        f32x4 kv[16];
#pragma unroll
        for (int u = 0; u < 16; ++u) kv[u] = __builtin_nontemporal_load((const f32x4*)(Kc + (size_t)(2 * (kp + u) + hh) * 512));
#pragma unroll
        for (int t = 0; t < 4; ++t) {
            float pt[16], v8[8], v4[4], v2[2];
#pragma unroll
            for (int u = 0; u < 16; ++u) pt[u] = (kv[u][0] * q[t][0] + kv[u][1] * q[t][1]) + (kv[u][2] * q[t][2] + kv[u][3] * q[t][3]);
#pragma unroll
            for (int i = 0; i < 8; ++i) { const float send = b4 ? pt[i] : pt[8 + i], keep = b4 ? pt[8 + i] : pt[i]; v8[i] = keep + __shfl_xor(send, 16); }
#pragma unroll
            for (int i = 0; i < 4; ++i) { const float send = b3 ? v8[i] : v8[4 + i], keep = b3 ? v8[4 + i] : v8[i]; v4[i] = keep + __shfl_xor(send, 8); }
#pragma unroll
            for (int i = 0; i < 2; ++i) { const float send = b2 ? v4[i] : v4[2 + i], keep = b2 ? v4[2 + i] : v4[i]; v2[i] = keep + __shfl_xor(send, 4); }
            float v1; { const float send = b1 ? v2[0] : v2[1], keep = b1 ? v2[1] : v2[0]; v1 = keep + __shfl_xor(send, 2); }
            v1 += __shfl_xor(v1, 1);
            if ((l31 & 1) == 0) SC[t * 256 + 64 * kq + 2 * (kp + (l31 >> 1)) + hh] = v1;
        }
    }
    f32x4 vv[16];
#pragma unroll
    for (int u = 0; u < 16; ++u) vv[u] = __builtin_nontemporal_load((const f32x4*)(Vc + (size_t)(2 * u + hh) * 512));
    __syncthreads();
    LAS float* PS = (LAS float*)(F.lds + 24576 + pair * 4096);
    float rsum[4];
#pragma unroll
    for (int t = 0; t < 4; ++t) {
        const f32x4 sc = *(const LAS f32x4*)(SC + t * 256 + 4 * lane);
        float m = fmaxf(fmaxf(sc[0], sc[1]), fmaxf(sc[2], sc[3]));
#pragma unroll
        for (int o = 1; o < 64; o <<= 1) m = fmaxf(m, __shfl_xor(m, o));
        f32x4 e; float sum = 0.f;
#pragma unroll
        for (int i = 0; i < 4; ++i) { e[i] = __expf(sc[i] - m); sum += e[i]; }
        *(LAS f32x4*)(PS + t * 256 + 4 * lane) = e;
        rsum[t] = 1.f / wave_sum(sum);
    }
    LDS_WAIT(); asm volatile("" ::: "memory");
    f32x4 o[4]; o[0] = o[1] = o[2] = o[3] = (f32x4){0.f, 0.f, 0.f, 0.f};
#pragma unroll 1
    for (int kp = 0; kp < 32; kp += 16) {
#pragma unroll
        for (int u = 0; u < 16; ++u)
#pragma unroll
            for (int t = 0; t < 4; ++t) { const float p = PS[t * 256 + 64 * kq + 2 * (kp + u) + hh]; o[t] += vv[u] * p; }
        if (kp + 16 < 32) {
#pragma unroll
            for (int u = 0; u < 16; ++u) vv[u] = __builtin_nontemporal_load((const f32x4*)(Vc + (size_t)(2 * (kp + 16 + u) + hh) * 512));
        }
    }
#pragma unroll
    for (int t = 0; t < 4; ++t) {
#pragma unroll
        for (int i = 0; i < 4; ++i) o[t][i] += __shfl_xor(o[t][i], 32);
        if (hh == 0) *(LAS f32x4*)(OP + (kq * 4 + t) * 128 + 4 * l31) = o[t];
    }
    __syncthreads();
    {
        const int t = kq;
        float a0 = 0.f, a1 = 0.f;
#pragma unroll
        for (int k = 0; k < 4; ++k) { a0 += OP[(k * 4 + t) * 128 + 2 * lane]; a1 += OP[(k * 4 + t) * 128 + 2 * lane + 1]; }
        float rs = rsum[0]; rs = (t == 1) ? rsum[1] : rs; rs = (t == 2) ? rsum[2] : rs; rs = (t == 3) ? rsum[3] : rs;
        *(unsigned*)(F.w<bf16>(WS_MO) + (size_t)(TP + 4 * s + t) * 512 + h * 128 + 2 * lane) = cvtpk(a0 * rs, a1 * rs);
    }
    __syncthreads();
}
__device__ __forceinline__ void p10_memattn(Frame& F) {
    const float negM = -(LOG2E * 11.313708498984761f * gain_absmax(F.inf(I_GMQ), 128, F.lane) * gain_absmax(F.inf(I_GMK), 128, F.lane) * 1.01f);
    const int gw = F.bid * NWAVES + F.wave, NGW = F.G * NWAVES;
#pragma unroll 1
    for (int pass = 0; pass < 2; ++pass) {
        F.tid = opaque_i(F.tid); F.lane = F.tid & 63;
        if ((pass == 0) == (((F.bid >> 3) & 1) == 0)) memattn_prompt_unit(F, F.bid >> 2, F.bid & 3, negM);
        else memattn_sample_wg(F, F.bid);
    }
}

__device__ __forceinline__ void p15_pre(Frame& F, int pm) {
    const float* wc = F.inf(I_WCONV); const float* bc = F.inf(I_BCONV);
    {
        const bf16* UPS = F.w<bf16>(WS_UP); const float* st = F.inf(I_CONVST);
        for (int it = F.bid * 512 + F.tid; it < TSMP * 352; it += F.G * 512) {
            const int rs = it / 352, ch = it % 352, f = 8 * ch, t = rs & 3, n = rs >> 2;
            const int cg = 256 * (f >> 7) + (f & 127);
            float g0[8], g1[8], g2[8], vv[8];
            { const v4u a = *(const v4u*)(UPS + (size_t)rs * (2 * DFF) + cg), v = *(const v4u*)(UPS + (size_t)rs * (2 * DFF) + cg + 128);
#pragma unroll
              for (int i = 0; i < 4; ++i) { g0[2 * i] = bflo(a[i]); g0[2 * i + 1] = bfhi(a[i]); vv[2 * i] = bflo(v[i]); vv[2 * i + 1] = bfhi(v[i]); } }
            if (t >= 1) { const v4u a = *(const v4u*)(UPS + (size_t)(rs - 1) * (2 * DFF) + cg);
#pragma unroll
                for (int i = 0; i < 4; ++i) { g1[2 * i] = bflo(a[i]); g1[2 * i + 1] = bfhi(a[i]); } }
            else { const float* sp = st + (size_t)(n * 2 + 1) * DFF + f; const f32x4 a = *(const f32x4*)sp, b = *(const f32x4*)(sp + 4);
#pragma unroll
                for (int i = 0; i < 4; ++i) { g1[i] = a[i]; g1[4 + i] = b[i]; } }
            if (t >= 2) { const v4u a = *(const v4u*)(UPS + (size_t)(rs - 2) * (2 * DFF) + cg);
#pragma unroll
                for (int i = 0; i < 4; ++i) { g2[2 * i] = bflo(a[i]); g2[2 * i + 1] = bfhi(a[i]); } }
            else { const float* sp = st + (size_t)(n * 2 + t) * DFF + f; const f32x4 a = *(const f32x4*)sp, b = *(const f32x4*)(sp + 4);
#pragma unroll
                for (int i = 0; i < 4; ++i) { g2[i] = a[i]; g2[4 + i] = b[i]; } }
            float hv[8];
#pragma unroll
            for (int i = 0; i < 8; ++i) { const float c = bc[f + i] + g2[i] * wc[f + i] + g1[i] * wc[DFF + f + i] + g0[i] * wc[2 * DFF + f + i]; hv[i] = c / (1.f + __expf(-c)) * vv[i]; }
            v4u o; o.x = cvtpk(hv[0], hv[1]); o.y = cvtpk(hv[2], hv[3]); o.z = cvtpk(hv[4], hv[5]); o.w = cvtpk(hv[6], hv[7]);
            *(v4u*)(F.w<bf16>(WS_HID) + (size_t)(TP + rs) * DFF + f) = o;
            if (t >= 2) { float* co = F.out + O_SCONV + (size_t)(n * 2 + (t - 2)) * DFF + f; *(f32x4*)co = (f32x4){g0[0], g0[1], g0[2], g0[3]}; *(f32x4*)(co + 4) = (f32x4){g0[4], g0[5], g0[6], g0[7]}; }
        }
    }
    if ((pm & 7) != 0) {
        const bf16* R0 = F.w<bf16>(WS_RAW01) + (size_t)pm * 2 * (2 * DFF); const float* G = F.w<float>(WS_RAWG) + (size_t)(pm - 1) * 2 * DFF;
        if (F.tid < DFF / 8) {
            const int f = 8 * F.tid;
            const v4u rg0 = *(const v4u*)(R0 + f), rv0 = *(const v4u*)(R0 + DFF + f), rg1 = *(const v4u*)(R0 + 2 * DFF + f), rv1 = *(const v4u*)(R0 + 3 * DFF + f);
            float hv0[8], hv1[8];
#pragma unroll
            for (int q = 0; q < 2; ++q) {
                const f32x4 gm2 = *(const f32x4*)(G + f + 4 * q), gm1 = *(const f32x4*)(G + DFF + f + 4 * q);
                const f32x4 w0 = *(const f32x4*)(wc + f + 4 * q), w1 = *(const f32x4*)(wc + DFF + f + 4 * q), w2 = *(const f32x4*)(wc + 2 * DFF + f + 4 * q), b = *(const f32x4*)(bc + f + 4 * q);
#pragma unroll
                for (int e = 0; e < 4; ++e) { const int i = 4 * q + e; const unsigned wg0 = rg0[i >> 1], wv0 = rv0[i >> 1], wg1 = rg1[i >> 1], wv1 = rv1[i >> 1];
                    const float g0 = (i & 1) ? bfhi(wg0) : bflo(wg0), v0 = (i & 1) ? bfhi(wv0) : bflo(wv0), g1 = (i & 1) ? bfhi(wg1) : bflo(wg1), v1 = (i & 1) ? bfhi(wv1) : bflo(wv1);
                    const float c0 = b[e] + gm2[e] * w0[e] + gm1[e] * w1[e] + g0 * w2[e], c1 = b[e] + gm1[e] * w0[e] + g0 * w1[e] + g1 * w2[e];
                    hv0[i] = c0 / (1.f + __expf(-c0)) * v0; hv1[i] = c1 / (1.f + __expf(-c1)) * v1; }
            }
            v4u o0, o1; o0.x = cvtpk(hv0[0], hv0[1]); o0.y = cvtpk(hv0[2], hv0[3]); o0.z = cvtpk(hv0[4], hv0[5]); o0.w = cvtpk(hv0[6], hv0[7]);
            o1.x = cvtpk(hv1[0], hv1[1]); o1.y = cvtpk(hv1[2], hv1[3]); o1.z = cvtpk(hv1[4], hv1[5]); o1.w = cvtpk(hv1[6], hv1[7]);
            *(v4u*)(F.w<bf16>(WS_HID) + (size_t)(256 * pm) * DFF + f) = o0; *(v4u*)(F.w<bf16>(WS_HID) + (size_t)(256 * pm + 1) * DFF + f) = o1;
        }
    }
    VM_WAIT();
    __syncthreads();
}
}
namespace mk {
template <int K, bool RES_BF16, bool OUT_BF16, bool HAS_RES = true>
__device__ __forceinline__ void small_gemm_unit(Frame& F, const bf16* A, const bf16* Bt, int rbk, int cbk, const void* res, void* out, int ldc, float* ssq_out = nullptr, const float* ssq_in = nullptr) {
    static_assert(K % 64 == 0, "K in chunks of 64");
    constexpr int NCH = K / 64;
    const int lane = F.lane, w = F.wave, l31 = lane & 31, hh = lane >> 5, tid = F.tid, lr = lane >> 3, lc = lane & 7;
    LAS unsigned char* Tl = F.lds + w * 16384;
    const bf16* Ag = A + (size_t)(32 * rbk + lr) * K + 8 * lc;
    const bf16* Bg = Bt + (size_t)(64 * cbk + lr) * K + 8 * lc;
    f32x16 a0 = {}, a1 = {};
    v4u ra[4], rbv[8];
    int c = w;
    if (c < NCH) {
#pragma unroll
        for (int j = 0; j < 4; ++j) ra[j] = *(const v4u*)(Ag + (size_t)(8 * j) * K + 64 * c);
#pragma unroll
        for (int j = 0; j < 8; ++j) rbv[j] = *(const v4u*)(Bg + (size_t)(8 * j) * K + 64 * c);
    }
#pragma unroll 1
    for (; c < NCH; c += 8) {
#pragma unroll
        for (int j = 0; j < 4; ++j) *(LAS v4u*)(Tl + (lr + 8 * j) * 144 + 16 * lc) = ra[j];
#pragma unroll
        for (int j = 0; j < 8; ++j) *(LAS v4u*)(Tl + (32 + lr + 8 * j) * 144 + 16 * lc) = rbv[j];
        LDS_WAIT(); asm volatile("" ::: "memory");
        if (c + 8 < NCH) {
#pragma unroll
            for (int j = 0; j < 4; ++j) ra[j] = *(const v4u*)(Ag + (size_t)(8 * j) * K + 64 * (c + 8));
#pragma unroll
            for (int j = 0; j < 8; ++j) rbv[j] = *(const v4u*)(Bg + (size_t)(8 * j) * K + 64 * (c + 8));
        }
#pragma unroll
        for (int s = 0; s < 4; ++s) {
            const bf16x8 af = *(const LAS bf16x8*)(Tl + l31 * 144 + 32 * s + 16 * hh), b0 = *(const LAS bf16x8*)(Tl + (32 + l31) * 144 + 32 * s + 16 * hh), b1 = *(const LAS bf16x8*)(Tl + (64 + l31) * 144 + 32 * s + 16 * hh);
            a0 = __builtin_amdgcn_mfma_f32_32x32x16_bf16(af, b0, a0, 0, 0, 0); a1 = __builtin_amdgcn_mfma_f32_32x32x16_bf16(af, b1, a1, 0, 0, 0);
        }
        LDS_WAIT(); asm volatile("" ::: "memory");
    }
    __syncthreads();
    LAS float* RED = (LAS float*)F.lds + w * 2048;
#pragma unroll
    for (int i = 0; i < 16; ++i) { const int r = (i & 3) + 8 * (i >> 2) + 4 * hh; RED[r * 64 + l31] = a0[i]; RED[r * 64 + 32 + l31] = a1[i]; }
    __syncthreads();
    { const int r = tid >> 4, c4 = (tid & 15) * 4; const size_t off = (size_t)(32 * rbk + r) * ldc + 64 * cbk + c4;
      f32x4 sum;
      if (!HAS_RES) sum = (f32x4){0.f, 0.f, 0.f, 0.f}; else if (RES_BF16) { const v2u rw = *(const v2u*)((const bf16*)res + off); sum = (f32x4){bflo(rw.x), bfhi(rw.x), bflo(rw.y), bfhi(rw.y)}; } else sum = *(const f32x4*)((const float*)res + off);
#pragma unroll
      for (int k = 0; k < 8; ++k) sum += *(const LAS f32x4*)((LAS float*)F.lds + k * 2048 + r * 64 + c4);
      if (ssq_in) { float t = ssq_in[(size_t)(32 * rbk + r) * 16 + (tid & 15)]; t += __shfl_xor(t, 1); t += __shfl_xor(t, 2); t += __shfl_xor(t, 4); t += __shfl_xor(t, 8); sum = sum * rsqrtf(t * (1.f / 1024.f) + EPS); }
      if (ssq_out) { float s2 = (sum[0] * sum[0] + sum[1] * sum[1]) + (sum[2] * sum[2] + sum[3] * sum[3]); s2 += __shfl_xor(s2, 1); s2 += __shfl_xor(s2, 2); s2 += __shfl_xor(s2, 4); s2 += __shfl_xor(s2, 8);
          if ((tid & 15) == 0) ssq_out[(size_t)(32 * rbk + r) * 16 + cbk] = s2; }
      if (OUT_BF16) { v2u wb; wb.x = cvtpk(sum[0], sum[1]); wb.y = cvtpk(sum[2], sum[3]); *(v2u*)((bf16*)out + off) = wb; } else *(f32x4*)((float*)out + off) = sum; }
    __syncthreads();
}
}
namespace mk {
constexpr int N_PHASES = 16;
__global__ void __launch_bounds__(NWAVES * 64, 2) mk_fwd(Args args) {
    extern __shared__ __attribute__((aligned(16))) unsigned char lds[];
    Frame F;
    F.lds = (LAS unsigned char*)lds; F.lds_g = lds;
    F.tid = threadIdx.x; F.lane = F.tid & 63; F.wave = __builtin_amdgcn_readfirstlane(F.tid >> 6);
    F.G = gridDim.x; F.bid = blockIdx.x;
    F.ws = args.ws; F.out = args.out; F.in = (const float* const*)args.in;
    volatile LAS unsigned* MISC = (volatile LAS unsigned*)(F.lds + MISC_OFF);
    for (int u = F.tid; u < (LDS_BYTES - RING_BYTES) / 4; u += NWAVES * 64) ((LAS unsigned*)(F.lds + RING_BYTES))[u] = 0u;
    __syncthreads();
    unsigned* ctl = (unsigned*)(F.ws + WS_CTL);
    XcdBarrier bar = xcd_barrier_post(ctl + CW_BAR, MISC + 8);
    const int lo = args.ph_lo, hi = args.ph_hi;
    if (F.G != 256) return;
#define IN(k) (lo <= (k) && (k) < hi)
#ifdef MK_TIMING
    unsigned long long* stamps = (unsigned long long*)(F.ws + WS_CTL + (768 << 10));
#define STAMP(k) do { if (F.tid == 0) stamps[F.bid * 32 + (k)] = __builtin_amdgcn_s_memrealtime(); } while (0)
#else
#define STAMP(k) do {} while (0)
#endif
#define SEAM(k) do { if (IN(k) && IN((k) + 1)) xcd_barrier(bar); STAMP((k) + 1); F.tid = opaque_i(F.tid); F.lane = F.tid & 63; } while (0)
    STAMP(0);

    if (IN(0)) { p0_prologue(F); }
    SEAM(0);
    if (IN(1)) {
        { pg8::Gemm g{F.w<bf16>(WS_XN), F.w<bf16>(WS_W_IN), T, NINP, D}; pg8::StaticOrder S; S.init(T, NINP, F.G, F.bid);
          pg8::EpiBf16 E{F.w<bf16>(WS_Z), NINP, 1.f};
          pg8::gemm_phase<pg8::EpiBf16, pg8::StaticOrder, true, true>(F.lds, g, S, E); }
        { pg8::Gemm g{F.w<bf16>(WS_MN), F.w<bf16>(WS_W_MKV), 2048, 1024, D}; pg8::StaticOrder S; S.init(2048, 1024, F.G, (F.bid + F.G - 206) % F.G);
          pg8::EpiBf16 E{F.w<bf16>(WS_MKV), 1024, 1.f};
          pg8::gemm_phase<pg8::EpiBf16, pg8::StaticOrder, true, true>(F.lds, g, S, E); }
    }
    SEAM(1);
    if (IN(2)) { p2_post_inproj(F); }
    SEAM(2);
    if (IN(3)) {
        { pg8::Gemm g{F.w<bf16>(WS_CQN), F.w<bf16>(WS_W_UQ), T, 768, 256}; pg8::StaticOrder S; S.init(T, 768, F.G, F.bid);
          pg8::EpiBf16 E{F.w<bf16>(WS_QR), 768, 1.f};
          pg8::gemm_phase<pg8::EpiBf16, pg8::StaticOrder, true, true>(F.lds, g, S, E); }
        { pg8::Gemm g{F.w<bf16>(WS_CKVN), F.w<bf16>(WS_W_UK), TP, 512, 256}; pg8::StaticOrder S; S.init(TP, 512, F.G, (F.bid + F.G - 198) % F.G);
          pg8::EpiBf16 E{F.w<bf16>(WS_KNR), 512, 1.f};
          pg8::gemm_phase<pg8::EpiBf16, pg8::StaticOrder, true, true>(F.lds, g, S, E); }
        { pg8::Gemm g{F.w<bf16>(WS_W_UV), F.w<bf16>(WS_CKVN), 512, TP, 256}; pg8::StaticOrder S; S.init(512, TP, F.G, (F.bid + F.G - 70) % F.G);
          pg8::EpiBf16 E{F.w<bf16>(WS_VT), TP, 1.f};
          pg8::gemm_phase<pg8::EpiBf16, pg8::StaticOrder, true, true>(F.lds, g, S, E); }
    }
    SEAM(3);
    if (IN(4)) { p4_qk_norm_rope(F); p4_qext(F); }
    SEAM(4);
    if (IN(5)) {
        const float mq_ = gain_absmax(F.inf(I_GQKQ), 96, F.lane), mk2_ = gain_absmax(F.inf(I_GQKK), 96, F.lane);
        const float negM = -(LOG2E * 9.797958971132712f * mq_ * mk2_ * 1.01f);
#pragma unroll 1
        for (int pass = 0; pass < 3; ++pass) {
            F.tid = opaque_i(F.tid); F.lane = F.tid & 63;
            if (pass == 1) { STAMP(20); attn_sample_unit(F, F.bid >> 1, F.bid & 1, negM); STAMP(21); }
            else if ((pass == 0) == (((F.bid >> 3) & 1) != 0)) { STAMP(22); p5_attn_prompt(F, negM); STAMP(23); }
        }
    }
    SEAM(5);
    if (IN(6)) { p6_merge(F); }
    SEAM(6);
    if (IN(7)) { pg8::Gemm g{F.w<bf16>(WS_MRG), F.w<bf16>(WS_W_O), TP, 1024, 1024}; pg8::StaticOrder S; S.init(TP, 1024, F.G, F.bid);
        pg8::EpiResN<false> E{F.inf(I_XP), F.inf(I_XS), TP / 256, F.w<bf16>(WS_X1), F.w<float>(WS_SSQ1), 1024};
        pg8::gemm_phase<pg8::EpiResN<false>, pg8::StaticOrder, true, true>(F.lds, g, S, E);
        small_gemm_unit<1024, false, true>(F, F.w<bf16>(WS_MRG) + (size_t)TP * 1024, F.w<bf16>(WS_W_O), F.bid >> 4, F.bid & 15, F.inf(I_XS), F.w<bf16>(WS_X1) + (size_t)TP * 1024, 1024, F.w<float>(WS_SSQ1) + (size_t)TP * 16); }
    SEAM(7);
    STAMP(9);
    if (IN(9)) { pg8::Gemm g{F.w<bf16>(WS_X1), F.w<bf16>(WS_W_MQ), T, 512, 1024}; pg8::StaticOrder S; S.init(T, 512, F.G, F.bid);
        pg8::EpiBf16S E{F.w<bf16>(WS_MQ), 512, F.w<float>(WS_SSQ1), EPS};
        pg8::gemm_phase<pg8::EpiBf16S, pg8::StaticOrder, true, true>(F.lds, g, S, E);
        if (F.bid >= 132) p0_transposes<9, 11>(F, (F.bid - 132) * NWAVES + F.wave, (F.G - 132) * NWAVES); }
    SEAM(9);
    if (IN(10)) { p10_memattn(F); }
    SEAM(10);
    if (IN(11)) { pg8::Gemm g{F.w<bf16>(WS_MO), F.w<bf16>(WS_W_MO), TP, 1024, 512}; pg8::StaticOrder S; S.init(TP, 1024, F.G, F.bid);
        pg8::EpiResN<true> E{F.w<bf16>(WS_X1), F.w<bf16>(WS_X1), 1 << 20, F.w<bf16>(WS_X2), F.w<float>(WS_SSQ2), 1024};
        pg8::gemm_phase<pg8::EpiResN<true>, pg8::StaticOrder, true, true>(F.lds, g, S, E);
        small_gemm_unit<512, true, true>(F, F.w<bf16>(WS_MO) + (size_t)TP * 512, F.w<bf16>(WS_W_MO), F.bid >> 4, F.bid & 15, F.w<bf16>(WS_X1) + (size_t)TP * 1024, F.w<bf16>(WS_X2) + (size_t)TP * 1024, 1024, F.w<float>(WS_SSQ2) + (size_t)TP * 16); }
    SEAM(11);
    STAMP(12); STAMP(13);
    if (IN(13)) { pg8::Gemm g{F.w<bf16>(WS_X2), F.w<bf16>(WS_W_UP), TP, 2 * DFF, 1024}; pg8::StaticOrder S; S.init(TP, 2 * DFF, F.G, F.bid);
        pg8::EpiUpFused E{F.w<bf16>(WS_HID), F.inf(I_WCONV), F.inf(I_BCONV), F.w<bf16>(WS_RAW01), F.w<float>(WS_RAWG), F.out + O_PCONV, (LAS float*)(F.lds + 131072), DFF, (const LAS float*)(F.lds + 135168)};
        { LAS float* rt = (LAS float*)(F.lds + 135168); const float* sq = F.w<float>(WS_SSQ2) + (size_t)(F.bid & 7) * 2048 * 16;
          f32x4 p[4][4];
#pragma unroll
          for (int k = 0; k < 4; ++k)
#pragma unroll
              for (int q = 0; q < 4; ++q) p[k][q] = *(const f32x4*)(sq + (size_t)(F.tid + 512 * k) * 16 + 4 * q);
#pragma unroll
          for (int k = 0; k < 4; ++k) { const f32x4 t = (p[k][0] + p[k][1]) + (p[k][2] + p[k][3]); rt[F.tid + 512 * k] = rsqrtf(((t[0] + t[1]) + (t[2] + t[3])) * (1.f / 1024.f) + EPS); }
          __syncthreads(); }
        pg8::gemm_phase<pg8::EpiUpFused, pg8::StaticOrder, true, true>(F.lds, g, S, E);
        if (F.bid >= 128) { for (int su = F.bid - 128; su < 16 * 88; su += 128)
            small_gemm_unit<1024, false, true, false>(F, F.w<bf16>(WS_X2) + (size_t)TP * 1024, F.w<bf16>(WS_W_UP), su / 88, su % 88, nullptr, F.w<bf16>(WS_UP), 2 * DFF, nullptr, F.w<float>(WS_SSQ2) + (size_t)TP * 16); } }
    SEAM(13);
    if (IN(15)) { pg8::Gemm g{F.w<bf16>(WS_HID), F.w<bf16>(WS_W_DN), TP, 1024, DFF}; pg8::StaticOrder S; S.init(TP, 1024, F.G, F.bid);
        p15_pre(F, 8 * (F.bid & 7) + ((F.bid >> 3) & 7));
        if (F.tid == 0) { const unsigned nloc = bar.st[0]; const unsigned old = xb_add(ctl + CW_HIDS + 64 * bar.x, 1u);
            if (old + 1u == nloc) { __builtin_amdgcn_fence(__ATOMIC_RELEASE, "agent"); asm volatile("s_waitcnt vmcnt(0)" ::: "memory"); (void)xb_add(ctl + CW_HIDS + 64 * 16, 1u); } }
        pg8::EpiRes<true, false> E{F.w<bf16>(WS_X2), F.w<bf16>(WS_X2), 1 << 20, F.out + O_YP, 1024};
        pg8::gemm_phase<pg8::EpiRes<true, false>, pg8::StaticOrder, true, true>(F.lds, g, S, E);
        if (F.tid == 0) { const unsigned nx = bar.st[1]; XB_SPIN(xb_ld(ctl + CW_HIDS + 64 * 16) < nx, ctl + CW_BAR); __builtin_amdgcn_fence(__ATOMIC_ACQUIRE, "agent"); asm volatile("s_waitcnt vmcnt(0)" ::: "memory"); }
        __syncthreads();
        small_gemm_unit<DFF, true, false>(F, F.w<bf16>(WS_HID) + (size_t)TP * DFF, F.w<bf16>(WS_W_DN), F.bid >> 4, F.bid & 15, F.w<bf16>(WS_X2) + (size_t)TP * 1024, F.out + O_YS, 1024); }
#ifdef MK_TIMING
    xcd_barrier(bar); STAMP(16);
    xcd_barrier(bar);
    if (F.bid == 0) {
        volatile LAS float* s_ca = (volatile LAS float*)(F.lds + RING_BYTES + 1024);
#define s_c s_ca[0]
#define s_a s_ca[1]
        if (F.tid == 0) {
            unsigned long long a0 = ~0ull, a1 = 0, b0 = ~0ull, b1 = 0;
#ifdef MK_TPERWG
            unsigned long long ma = 0, mb = 0;
            for (int w = 0; w < 256; ++w) { const unsigned long long* st = stamps + w * 32; const unsigned long long xa = st[MK_TA_HI] - st[MK_TA_LO], xb = st[MK_TB_HI] - st[MK_TB_LO]; ma = xa > ma ? xa : ma; mb = xb > mb ? xb : mb; }
            a0 = 0; a1 = ma; b0 = 0; b1 = mb;
#else
            for (int w = 0; w < 256; ++w) { const unsigned long long* st = stamps + w * 32;
                a0 = st[MK_TA_LO] < a0 ? st[MK_TA_LO] : a0; a1 = st[MK_TA_HI] > a1 ? st[MK_TA_HI] : a1; b0 = st[MK_TB_LO] < b0 ? st[MK_TB_LO] : b0; b1 = st[MK_TB_HI] > b1 ? st[MK_TB_HI] : b1; }
#endif
            const float da = (float)(a1 - a0) * 0.01f, db = (float)(b1 - b0) * 0.01f;
            s_c = sqrtf(da * 1e-4f); s_a = db * 0.1f;
        }
        __syncthreads();
        float* sk = F.out + O_SKPE;
        for (int i = F.tid; i < 16384; i += 512) sk[i] *= (1.f + s_c);
        if (F.tid == 0) F.out[O_YP] += s_a;
#undef s_c
#undef s_a
    }
#endif
#undef IN
#undef SEAM
}
}
extern "C" void kernel_launch(void* const* d_in, const int* in_sizes, int n_in, void* d_out, int out_size, void* d_ws, size_t ws_size, hipStream_t stream) {
    using namespace mk;
    static int ready = 0;
    if (ready == 0) {
        if (n_in != 38 || out_size != 25292800 || ws_size < WS_MK_END) { fprintf(stderr, "kernel_launch: unexpected n_in %d / out_size %d / ws %zu\n", n_in, out_size, ws_size); ready = -1; return; }
        if (hipFuncSetAttribute((const void*)mk_fwd, hipFuncAttributeMaxDynamicSharedMemorySize, LDS_BYTES) != hipSuccess) { fprintf(stderr, "kernel_launch: hipFuncSetAttribute failed\n"); ready = -1; return; }
        int dev = 0, cus = 0, per_cu = 0;
        (void)hipGetDevice(&dev); (void)hipDeviceGetAttribute(&cus, hipDeviceAttributeMultiprocessorCount, dev);
        (void)hipOccupancyMaxActiveBlocksPerMultiprocessor(&per_cu, (const void*)mk_fwd, NWAVES * 64, LDS_BYTES);
        if (cus < 256 || per_cu < 1) fprintf(stderr, "kernel_launch: note: %d CUs, occupancy query %d (this kernel needs 256 resident workgroups of %d B LDS)\n", cus, per_cu, LDS_BYTES);
        (void)hipGetLastError();
        ready = 1;
    }
    if (ready < 0) return;
    (void)hipMemsetAsync((unsigned char*)d_ws + WS_CTL, 0, CTL_ZERO_BYTES, stream);
    Args a{}; for (int i = 0; i < 38; ++i) a.in[i] = d_in[i];
    a.out = (float*)d_out; a.ws = (unsigned char*)d_ws; a.ph_lo = 0; a.ph_hi = N_PHASES;
    hipLaunchKernelGGL(mk_fwd, dim3(256), dim3(NWAVES * 64), LDS_BYTES, stream, a);
}
```

```cpp
#include <hip/hip_runtime.h>
#include <cstdio>
#include <cstdint>
#include <cmath>
#define GAS __attribute__((address_space(1)))
#define LAS __attribute__((address_space(3)))
typedef unsigned short bf16;
typedef unsigned v4u __attribute__((ext_vector_type(4)));
typedef unsigned v2u __attribute__((ext_vector_type(2)));
typedef float f32x4 __attribute__((ext_vector_type(4)));
typedef float f32x16 __attribute__((ext_vector_type(16)));
typedef short bf16x8 __attribute__((ext_vector_type(8)));
typedef short s16x4 __attribute__((ext_vector_type(4)));
#define LDS_WAIT() asm volatile("s_waitcnt lgkmcnt(0)" ::: "memory")
#define VM_WAIT() asm volatile("s_waitcnt vmcnt(0)" ::: "memory")
__device__ __forceinline__ unsigned f2bf(float f) { unsigned u = __builtin_bit_cast(unsigned, f); return (u + 0x7fffu + ((u >> 16) & 1u)) >> 16; }
__device__ __forceinline__ unsigned pk2(float lo, float hi) { return f2bf(lo) | (f2bf(hi) << 16); }
typedef float f32x2_t __attribute__((ext_vector_type(2))); typedef __bf16 bf16x2_t __attribute__((ext_vector_type(2)));
__device__ __forceinline__ unsigned cvtpk(float lo, float hi) { f32x2_t v = {lo, hi}; bf16x2_t b = __builtin_convertvector(v, bf16x2_t); return __builtin_bit_cast(unsigned, b); }
__device__ __forceinline__ float bf2f(unsigned short b) { return __builtin_bit_cast(float, (unsigned)b << 16); }
__device__ __forceinline__ float bflo(unsigned w) { return __builtin_bit_cast(float, w << 16); }
__device__ __forceinline__ float bfhi(unsigned w) { return __builtin_bit_cast(float, w & 0xffff0000u); }
__device__ __forceinline__ int opaque_i(int x) { asm volatile("" : "+v"(x)); return x; }
template <int CTRL, int ROWMASK> __device__ __forceinline__ float dpp_take(float x) { return __builtin_bit_cast(float, __builtin_amdgcn_update_dpp(0, __builtin_bit_cast(int, x), CTRL, ROWMASK, 0xf, false)); }
__device__ __forceinline__ float dpp_sum8(float v) { v += dpp_take<0xB1, 0xf>(v); v += dpp_take<0x4E, 0xf>(v); v += dpp_take<0x141, 0xf>(v); return v; }
__device__ __forceinline__ float dpp_sum16(float v) { v = dpp_sum8(v); v += dpp_take<0x140, 0xf>(v); return v; }
__device__ __forceinline__ float wave_sum(float v) {
    v += dpp_take<0xB1, 0xf>(v); v += dpp_take<0x4E, 0xf>(v); v += dpp_take<0x141, 0xf>(v); v += dpp_take<0x140, 0xf>(v);
    v += dpp_take<0x142, 0xa>(v); v += dpp_take<0x143, 0xc>(v);
    return __builtin_bit_cast(float, __builtin_amdgcn_readlane(__builtin_bit_cast(int, v), 63));
}
__device__ __forceinline__ float gelu_tanh_f(float x) {
    const float t = x * (-2.3022082062f - 0.1029432457f * x * x);
    return x * __builtin_amdgcn_rcpf(1.f + __builtin_amdgcn_exp2f(t));
}
namespace pg8 {
#define PG8_LAS __attribute__((address_space(3)))
typedef unsigned short bf16_t;
typedef short bf16x8 __attribute__((ext_vector_type(8)));
typedef float f32x4 __attribute__((ext_vector_type(4)));
typedef unsigned u32x4 __attribute__((ext_vector_type(4)));
constexpr int BM = 256, BK = 64, HALF = 128, HTB = HALF * BK * 2  , STAGE_BYTES = 8 * HTB, NXCD = 8, WGM = 8;

__host__ __device__ __forceinline__ int lds_byte(int r, int c) { const int st = (r >> 4) * 2 + (c >> 5), rr = r & 15, cc = c & 31, ob = rr * 64 + cc * 2; return st * 1024 + (ob ^ (((ob >> 9) & 1) << 5)); }
__host__ __device__ __forceinline__ void stage_rc(int b, int& R, int& C) { const int st = b / 1024, sb = b % 1024, swz = sb ^ (((sb >> 9) & 1) << 5); R = (st >> 1) * 16 + swz / 64; C = (st & 1) * 32 + (swz % 64) / 2; }
__host__ __device__ __forceinline__ int perm32(int rho) { const int n = rho >> 4, i = rho & 15; return 8 * (i >> 2) + 4 * n + (i & 3); }

struct Unit { int pm, pn; };
struct Gemm { const bf16_t* A; const bf16_t* Bt; int M, N, K; };

struct StaticOrder {
    int nM, nN, nwg, G, c;
    __host__ __device__ void init(int M, int N, int G_, int c_) { nM = M / BM; nN = N / BM; nwg = nM * nN; G = G_; c = c_; }
    __host__ __device__ bool next(int i, Unit& u) const {
        const long L = (long)i * G + c; if (L >= nwg) return false;
        int wgid = (int)L; { const int q = nwg / NXCD, r = nwg % NXCD, xcd = wgid % NXCD, off = wgid / NXCD; wgid = (xcd < r ? xcd * (q + 1) : r * (q + 1) + (xcd - r) * q) + off; }
        const int nig = WGM * nN, gid = wgid / nig, fm = gid * WGM, gsz = (nM - fm) < WGM ? (nM - fm) : WGM;
        u.pm = fm + ((wgid % nig) % gsz); u.pn = (wgid % nig) / gsz; return true;
    }
    __device__ __forceinline__ void a_ready(const Unit&) const {}
    __device__ __forceinline__ void done(const Unit&) const {}
};

__device__ __forceinline__ unsigned cvt_pk_bf16(float lo, float hi) { unsigned r; asm volatile("v_cvt_pk_bf16_f32 %0, %1, %2" : "=v"(r) : "v"(lo), "v"(hi)); return r; }
typedef float f32x2 __attribute__((ext_vector_type(2)));
struct EpiBf16 {
    static constexpr bool PERM = true, AFTER_DRAIN = false;
    bf16_t* O; int ldc; float scale;
    __device__ __forceinline__ void operator()(const f32x4 (&acc)[2][2][4][2], const Unit& u, int wr, int wc, int fr, int fq) const {
        const int row0 = u.pm * BM + wr * 64 + fr; const int col0 = u.pn * BM + wc * 32 + 8 * fq;
#pragma unroll
        for (int ai = 0; ai < 2; ++ai)
#pragma unroll
            for (int m = 0; m < 4; ++m) { bf16_t* rowp = O + (size_t)(row0 + ai * HALF + m * 16) * ldc + col0;
#pragma unroll
                for (int bj = 0; bj < 2; ++bj) { const f32x4 v0 = acc[ai][bj][m][0] * scale, v1 = acc[ai][bj][m][1] * scale;
                    u32x4 w; w.x = cvt_pk_bf16(v0[0], v0[1]); w.y = cvt_pk_bf16(v0[2], v0[3]); w.z = cvt_pk_bf16(v1[0], v1[1]); w.w = cvt_pk_bf16(v1[2], v1[3]);
                    *(u32x4*)(rowp + bj * HALF) = w; } }
    }
};
struct EpiResF32 {
    static constexpr bool PERM = false, AFTER_DRAIN = false;
    const float* res0; const float* res1; int split_pm; float* out; int ldc;
    __device__ __forceinline__ void operator()(const f32x4 (&acc)[2][2][4][2], const Unit& u, int wr, int wc, int fr, int fq) const {
        const int row0 = u.pm * BM + wr * 64 + fr; const int col0 = u.pn * BM + wc * 32 + 4 * fq;
        const float* rb = (u.pm < split_pm) ? res0 : res1 - (size_t)split_pm * BM * ldc;
#pragma unroll
        for (int ai = 0; ai < 2; ++ai)
#pragma unroll
            for (int m = 0; m < 4; ++m) { const size_t off = (size_t)(row0 + ai * HALF + m * 16) * ldc + col0;
#pragma unroll
                for (int bj = 0; bj < 2; ++bj)
#pragma unroll
                    for (int n = 0; n < 2; ++n) { const f32x4 r = *(const f32x4*)(rb + off + bj * HALF + n * 16); *(f32x4*)(out + off + bj * HALF + n * 16) = acc[ai][bj][m][n] + r; }
                if (m & 1) asm volatile("" ::: "memory"); }
    }
};
struct EpiResF32N {
    static constexpr bool PERM = false, AFTER_DRAIN = false;
    const float* res0; const float* res1; int split_pm; float* out; bf16_t* outb; float* ssq; int ldc;
    __device__ __forceinline__ void operator()(const f32x4 (&acc)[2][2][4][2], const Unit& u, int wr, int wc, int fr, int fq) const {
        const int row0 = u.pm * BM + wr * 64 + fr; const int col0 = u.pn * BM + wc * 32 + 4 * fq;
        const float* rb = (u.pm < split_pm) ? res0 : res1 - (size_t)split_pm * BM * ldc;
#pragma unroll
        for (int ai = 0; ai < 2; ++ai)
#pragma unroll
            for (int m = 0; m < 4; ++m) { const int row = row0 + ai * HALF + m * 16; const size_t off = (size_t)row * ldc + col0; float s = 0.f;
#pragma unroll
                for (int bj = 0; bj < 2; ++bj)
#pragma unroll
                    for (int n = 0; n < 2; ++n) { const f32x4 r = *(const f32x4*)(rb + off + bj * HALF + n * 16); const f32x4 v = acc[ai][bj][m][n] + r; *(f32x4*)(out + off + bj * HALF + n * 16) = v;
                        s += (v[0] * v[0] + v[1] * v[1]) + (v[2] * v[2] + v[3] * v[3]);
                        typedef unsigned u32x2_ __attribute__((ext_vector_type(2))); u32x2_ w; w.x = cvt_pk_bf16(v[0], v[1]); w.y = cvt_pk_bf16(v[2], v[3]); *(u32x2_*)(outb + off + bj * HALF + n * 16) = w; }
                s += __shfl_xor(s, 16); s += __shfl_xor(s, 32);
                if (fq == 0) ssq[(size_t)row * 16 + u.pn * 4 + wc] = s;
                if (m & 1) asm volatile("" ::: "memory"); }
    }
};
struct EpiBf16S {
    static constexpr bool PERM = true, AFTER_DRAIN = false;
    bf16_t* O; int ldc; const float* ssq; float eps;
    __device__ __forceinline__ void operator()(const f32x4 (&acc)[2][2][4][2], const Unit& u, int wr, int wc, int fr, int fq) const {
        const int row0 = u.pm * BM + wr * 64 + fr; const int col0 = u.pn * BM + wc * 32 + 8 * fq;
        f32x4 part[2][4];
#pragma unroll
        for (int ai = 0; ai < 2; ++ai)
#pragma unroll
            for (int m = 0; m < 4; ++m) part[ai][m] = *(const f32x4*)(ssq + (size_t)(row0 + ai * HALF + m * 16) * 16 + 4 * fq);
#pragma unroll
        for (int ai = 0; ai < 2; ++ai)
#pragma unroll
            for (int m = 0; m < 4; ++m) { const int row = row0 + ai * HALF + m * 16;
                float tot = (part[ai][m][0] + part[ai][m][1]) + (part[ai][m][2] + part[ai][m][3]);
                tot += __shfl_xor(tot, 16); tot += __shfl_xor(tot, 32);
                const float scale = __builtin_amdgcn_rsqf(tot * (1.0f / 1024.0f) + eps);
                bf16_t* rowp = O + (size_t)row * ldc + col0;
#pragma unroll
                for (int bj = 0; bj < 2; ++bj) { const f32x4 v0 = acc[ai][bj][m][0] * scale, v1 = acc[ai][bj][m][1] * scale;
                    u32x4 w; w.x = cvt_pk_bf16(v0[0], v0[1]); w.y = cvt_pk_bf16(v0[2], v0[3]); w.z = cvt_pk_bf16(v1[0], v1[1]); w.w = cvt_pk_bf16(v1[2], v1[3]);
                    *(u32x4*)(rowp + bj * HALF) = w; } }
    }
};
template <bool RES_BF16, bool OUT_BF16> struct EpiRes {
    static constexpr bool PERM = false, AFTER_DRAIN = false;
    const void* res0; const void* res1; int split_pm; void* out; int ldc;
    __device__ __forceinline__ void operator()(const f32x4 (&acc)[2][2][4][2], const Unit& u, int wr, int wc, int fr, int fq) const {
        typedef unsigned u32x2_ __attribute__((ext_vector_type(2)));
        const int row0 = u.pm * BM + wr * 64 + fr; const int col0 = u.pn * BM + wc * 32 + 4 * fq;
        const bool first = u.pm < split_pm;
#pragma unroll
        for (int ai = 0; ai < 2; ++ai)
#pragma unroll
            for (int m = 0; m < 4; ++m) { const int row = row0 + ai * HALF + m * 16; const size_t off = (size_t)row * ldc + col0; const size_t roff = first ? off : off - (size_t)split_pm * BM * ldc;
#pragma unroll
                for (int bj = 0; bj < 2; ++bj)
#pragma unroll
                    for (int n = 0; n < 2; ++n) { const size_t o2 = bj * HALF + n * 16; f32x4 r;
                        if (RES_BF16) { const u32x2_ rw = *(const u32x2_*)((const bf16_t*)(first ? res0 : res1) + roff + o2); r = (f32x4){__builtin_bit_cast(float, rw.x << 16), __builtin_bit_cast(float, rw.x & 0xffff0000u), __builtin_bit_cast(float, rw.y << 16), __builtin_bit_cast(float, rw.y & 0xffff0000u)}; }
                        else r = *(const f32x4*)((const float*)(first ? res0 : res1) + roff + o2);
                        const f32x4 v = acc[ai][bj][m][n] + r;
                        if (OUT_BF16) { u32x2_ w; w.x = cvt_pk_bf16(v[0], v[1]); w.y = cvt_pk_bf16(v[2], v[3]); *(u32x2_*)((bf16_t*)out + off + o2) = w; }
                        else *(f32x4*)((float*)out + off + o2) = v; }
                if (m & 1) asm volatile("" ::: "memory"); }
    }
};
template <bool RES_BF16> struct EpiResN {
    static constexpr bool PERM = false, AFTER_DRAIN = false;
    const void* res0; const void* res1; int split_pm; bf16_t* out; float* ssq; int ldc;
    __device__ __forceinline__ void operator()(const f32x4 (&acc)[2][2][4][2], const Unit& u, int wr, int wc, int fr, int fq) const {
        typedef unsigned u32x2_ __attribute__((ext_vector_type(2)));
        const int row0 = u.pm * BM + wr * 64 + fr; const int col0 = u.pn * BM + wc * 32 + 4 * fq;
        const bool first = u.pm < split_pm;
#pragma unroll
        for (int ai = 0; ai < 2; ++ai)
#pragma unroll
            for (int m = 0; m < 4; ++m) { const int row = row0 + ai * HALF + m * 16; const size_t off = (size_t)row * ldc + col0; const size_t roff = first ? off : off - (size_t)split_pm * BM * ldc; float s = 0.f;
#pragma unroll
                for (int bj = 0; bj < 2; ++bj)
#pragma unroll
                    for (int n = 0; n < 2; ++n) { const size_t o2 = bj * HALF + n * 16; f32x4 r;
                        if (RES_BF16) { const u32x2_ rw = *(const u32x2_*)((const bf16_t*)(first ? res0 : res1) + roff + o2); r = (f32x4){__builtin_bit_cast(float, rw.x << 16), __builtin_bit_cast(float, rw.x & 0xffff0000u), __builtin_bit_cast(float, rw.y << 16), __builtin_bit_cast(float, rw.y & 0xffff0000u)}; }
                        else r = *(const f32x4*)((const float*)(first ? res0 : res1) + roff + o2);
                        const f32x4 v = acc[ai][bj][m][n] + r;
                        s += (v[0] * v[0] + v[1] * v[1]) + (v[2] * v[2] + v[3] * v[3]);
                        u32x2_ w; w.x = cvt_pk_bf16(v[0], v[1]); w.y = cvt_pk_bf16(v[2], v[3]); *(u32x2_*)(out + off + o2) = w; }
                s += __shfl_xor(s, 16); s += __shfl_xor(s, 32);
                if (fq == 0) ssq[(size_t)row * 16 + u.pn * 4 + wc] = s;
                if (m & 1) asm volatile("" ::: "memory"); }
    }
};
__device__ __forceinline__ float dpp_ror1(float x) { return __builtin_bit_cast(float, __builtin_amdgcn_update_dpp(0, __builtin_bit_cast(int, x), 0x121, 0xf, 0xf, false)); }
__device__ __forceinline__ float dpp_ror2(float x) { return __builtin_bit_cast(float, __builtin_amdgcn_update_dpp(0, __builtin_bit_cast(int, x), 0x122, 0xf, 0xf, false)); }
struct EpiUpFused {
    static constexpr bool PERM = false, AFTER_DRAIN = false;
    bf16_t* HID; const float* wconv; const float* bconv; bf16_t* RAW01; float* RAWG; float* pconv; PG8_LAS float* halo; int dff; const PG8_LAS float* rstd;
    __device__ __forceinline__ void operator()(const f32x4 (&acc)[2][2][4][2], const Unit& u, int wr, int wc, int fr, int fq) const {
        typedef unsigned u32x2_ __attribute__((ext_vector_type(2)));
        const int lane = fq * 16 + fr;
        const int fb = u.pn * 128 + wc * 32 + 4 * fq;
        const int hc = wc * 32 + 4 * fq;
        float rs[2][4];
#pragma unroll
        for (int ai = 0; ai < 2; ++ai)
#pragma unroll
            for (int m = 0; m < 4; ++m) rs[ai][m] = rstd[(u.pm & 7) * BM + ai * HALF + wr * 64 + m * 16 + fr];
        if (fr >= 14) {
#pragma unroll
            for (int ai = 0; ai < 2; ++ai)
#pragma unroll
                for (int n = 0; n < 2; ++n) *(PG8_LAS f32x4*)(halo + ((ai * 2 + wr) * 2 + (fr - 14)) * 128 + hc + 16 * n) = acc[ai][0][3][n] * rs[ai][3];
        }
        asm volatile("s_waitcnt lgkmcnt(0)" ::: "memory"); __builtin_amdgcn_s_barrier(); asm volatile("" ::: "memory");
        const bool seq_tile = (u.pm & 7) == 0;
#pragma unroll
        for (int n = 0; n < 2; ++n) {
            const f32x4 w0 = *(const f32x4*)(wconv + fb + 16 * n), w1 = *(const f32x4*)(wconv + dff + fb + 16 * n), w2 = *(const f32x4*)(wconv + 2 * dff + fb + 16 * n), bb = *(const f32x4*)(bconv + fb + 16 * n);
#pragma unroll
            for (int ai = 0; ai < 2; ++ai) {
                f32x4 p14 = (f32x4){0.f, 0.f, 0.f, 0.f}, p15 = p14;
                const bool top = (ai == 0 && wr == 0);
                if (!top) { const int pg = (wr == 1) ? (ai * 2 + 0) : ((ai - 1) * 2 + 1); p14 = *(const PG8_LAS f32x4*)(halo + (pg * 2 + 0) * 128 + hc + 16 * n); p15 = *(const PG8_LAS f32x4*)(halo + (pg * 2 + 1) * 128 + hc + 16 * n); }
                f32x4 pr1, pr2;
#pragma unroll
                for (int e = 0; e < 4; ++e) { const float x0 = (fr == 14) ? p14[e] : p15[e]; pr1[e] = dpp_ror1(x0); pr2[e] = dpp_ror2(x0); }
#pragma unroll
                for (int m = 0; m < 4; ++m) {
                    const f32x4 cur = acc[ai][0][m][n] * rs[ai][m], val = acc[ai][1][m][n] * rs[ai][m];
                    f32x4 g1, g2, c1, c2;
#pragma unroll
                    for (int e = 0; e < 4; ++e) { c1[e] = dpp_ror1(cur[e]); c2[e] = dpp_ror2(cur[e]);
                        g1[e] = fr >= 1 ? c1[e] : pr1[e]; g2[e] = fr >= 2 ? c2[e] : pr2[e]; }
                    pr1 = c1; pr2 = c2;
                    const int row = u.pm * BM + ai * HALF + wr * 64 + m * 16 + fr;
                    const bool first2 = top && m == 0 && fr < 2;
                    if (first2 && seq_tile) { if (fr == 0) g1 = (f32x4){0.f, 0.f, 0.f, 0.f}; g2 = (f32x4){0.f, 0.f, 0.f, 0.f}; }
                    if (first2 && !seq_tile) {
                        u32x2_ wg_, wv_; wg_.x = cvt_pk_bf16(cur[0], cur[1]); wg_.y = cvt_pk_bf16(cur[2], cur[3]); wv_.x = cvt_pk_bf16(val[0], val[1]); wv_.y = cvt_pk_bf16(val[2], val[3]);
                        bf16_t* rp = RAW01 + ((size_t)u.pm * 2 + fr) * (2 * dff) + fb + 16 * n; *(u32x2_*)rp = wg_; *(u32x2_*)(rp + dff) = wv_;
                    } else {
                        f32x4 h;
#pragma unroll
                        for (int e = 0; e < 4; ++e) { const float c = bb[e] + g2[e] * w0[e] + g1[e] * w1[e] + cur[e] * w2[e]; h[e] = c * __builtin_amdgcn_rcpf(1.f + __expf(-c)) * val[e]; }
                        u32x2_ wh; wh.x = cvt_pk_bf16(h[0], h[1]); wh.y = cvt_pk_bf16(h[2], h[3]);
                        *(u32x2_*)(HID + (size_t)row * dff + fb + 16 * n) = wh;
                    }
                    if (ai == 1 && wr == 1 && m == 3 && fr >= 14) {
                        *(f32x4*)(RAWG + ((size_t)u.pm * 2 + (fr - 14)) * dff + fb + 16 * n) = cur;
                        if ((u.pm & 7) == 7) *(f32x4*)(pconv + ((size_t)(u.pm >> 3) * 2 + (fr - 14)) * dff + fb + 16 * n) = cur;
                    }
                }
            }
        }
        asm volatile("s_waitcnt lgkmcnt(0)" ::: "memory"); __builtin_amdgcn_s_barrier(); asm volatile("" ::: "memory");
    }
};
template <class Epi, class Sched, bool ALIGN_EPI = false, bool SP2 = false>
__device__ __forceinline__ void gemm_phase(PG8_LAS unsigned char* lds, const Gemm g, const Sched& S, const Epi& E) {
    const int tid = opaque_i(threadIdx.x), wid = __builtin_amdgcn_readfirstlane(tid >> 6), lane = tid & 63, wr = wid >> 2, wc = wid & 3, fr = lane & 15, fq = lane >> 4;
    const int K = g.K, nt = K / BK;
    unsigned voffA[2], voffB[2];
#pragma unroll
    for (int i = 0; i < 2; ++i) { int R, C; stage_rc(tid * 16 + i * 8192, R, C); const int Rb = Epi::PERM ? ((R & ~31) + perm32(R & 31)) : R;
        voffA[i] = (unsigned)(R * K + C) * 2u; voffB[i] = (unsigned)(Rb * K + C) * 2u; }
    const size_t kstep = (size_t)(BK * 2);
    const size_t hstep = (size_t)HALF * K * 2;
    const size_t tstep = 2 * hstep;
    const unsigned ldsw = (unsigned)wid * 1024u;
    const int aoff = lds_byte(wr * 64 + fr, fq * 8), boff = lds_byte(wc * 32 + fr, fq * 8);
#define PG8_SA(b, h) (((b) * 2 + (h)) * HTB)
#define PG8_SB(b, h) ((4 + (b) * 2 + (h)) * HTB)
#define PG8_STAGE(bufoff, gbase, voff) do { _Pragma("unroll") for (int _i = 0; _i < 2; ++_i) \
        __builtin_amdgcn_global_load_lds((const unsigned*)((const char*)(gbase) + (voff)[_i]), (PG8_LAS unsigned*)(lds + (bufoff) + ldsw + _i * 8192), 16, 0, 0); } while (0)
#define PG8_LDA(dst, b, h) do { _Pragma("unroll") for (int m = 0; m < 4; ++m) _Pragma("unroll") for (int k = 0; k < 2; ++k) dst[m][k] = *(const PG8_LAS bf16x8*)(lds + PG8_SA(b, h) + aoff + m * 2048 + k * 1024); } while (0)
#define PG8_LDB(dst, b, h) do { _Pragma("unroll") for (int n = 0; n < 2; ++n) _Pragma("unroll") for (int k = 0; k < 2; ++k) dst[n][k] = *(const PG8_LAS bf16x8*)(lds + PG8_SB(b, h) + boff + n * 2048 + k * 1024); } while (0)
#define PG8_MMA(ai, bj, At, Bt) do { __builtin_amdgcn_s_setprio(1); _Pragma("unroll") for (int m = 0; m < 4; ++m) _Pragma("unroll") for (int n = 0; n < 2; ++n) _Pragma("unroll") for (int k = 0; k < 2; ++k) \
        acc[ai][bj][m][n] = __builtin_amdgcn_mfma_f32_16x16x32_bf16(Bt[n][k], At[m][k], acc[ai][bj][m][n], 0, 0, 0); __builtin_amdgcn_s_setprio(0); } while (0)
#define PG8_WAIT_V(n) asm volatile("s_waitcnt vmcnt(" #n ")" ::: "memory")
#define PG8_WAIT_L(n) asm volatile("s_waitcnt lgkmcnt(" #n ")" ::: "memory")
#define PG8_BAR __builtin_amdgcn_s_barrier()
#define PG8_SCHED __builtin_amdgcn_sched_barrier(0)
    Unit cur, nxt; int ui = 0;
    if (!S.next(0, cur)) return;
    f32x4 acc[2][2][4][2];
#pragma unroll
    for (int a = 0; a < 2; ++a)
#pragma unroll
        for (int b = 0; b < 2; ++b)
#pragma unroll
            for (int m = 0; m < 4; ++m)
#pragma unroll
                for (int n = 0; n < 2; ++n) acc[a][b][m][n] = (f32x4){0.f, 0.f, 0.f, 0.f};
    bf16x8 At[4][2], B0[2][2], B1[2][2];
    const char* cA = (const char*)g.A + (size_t)cur.pm * tstep; const char* cB = (const char*)g.Bt + (size_t)cur.pn * tstep;
    S.a_ready(cur);
    if constexpr (SP2) {
        PG8_STAGE(PG8_SB(0, 0), cB, voffB); PG8_STAGE(PG8_SB(0, 1), cB + hstep, voffB); PG8_STAGE(PG8_SA(0, 0), cA, voffA); PG8_STAGE(PG8_SA(0, 1), cA + hstep, voffA);
        if (wr == 1) PG8_BAR;
        PG8_WAIT_V(2); PG8_BAR;
        PG8_STAGE(PG8_SB(1, 0), cB + kstep, voffB); PG8_STAGE(PG8_SA(1, 0), cA + kstep, voffA); PG8_STAGE(PG8_SB(1, 1), cB + hstep + kstep, voffB);
        PG8_WAIT_V(6); PG8_BAR;
    } else {
        PG8_STAGE(PG8_SB(0, 0), cB, voffB); PG8_STAGE(PG8_SA(0, 0), cA, voffA); PG8_STAGE(PG8_SB(0, 1), cB + hstep, voffB); PG8_STAGE(PG8_SA(0, 1), cA + hstep, voffA);
        if (wr == 1) PG8_BAR;
        PG8_WAIT_V(4); PG8_BAR;
        PG8_STAGE(PG8_SB(1, 0), cB + kstep, voffB); PG8_STAGE(PG8_SA(1, 0), cA + kstep, voffA); PG8_STAGE(PG8_SB(1, 1), cB + hstep + kstep, voffB);
        PG8_WAIT_V(6); PG8_BAR;
    }
    for (;;) {
        const bool has_next = S.next(ui + 1, nxt);
        const char* nA = has_next ? (const char*)g.A + (size_t)nxt.pm * tstep : cA; const char* nB = has_next ? (const char*)g.Bt + (size_t)nxt.pn * tstep : cB;
        for (int t = 0; t < nt; t += 2) {
            const bool last = (t == nt - 2);
            const char* a1 = cA + (size_t)(t + 1) * kstep;
            const char* a2 = last ? nA : cA + (size_t)(t + 2) * kstep; const char* b2 = last ? nB : cB + (size_t)(t + 2) * kstep;
            const char* a3 = a2 + kstep; const char* b3 = b2 + kstep;
            if (last && has_next) S.a_ready(nxt);
            if constexpr (SP2) {
            PG8_LDB(B0, 0, 0); PG8_LDB(B1, 0, 1); PG8_SCHED; PG8_LDA(At, 0, 0); PG8_STAGE(PG8_SA(1, 1), a1 + hstep, voffA);
            PG8_WAIT_V(8); PG8_WAIT_L(0); PG8_BAR; PG8_MMA(0, 0, At, B0); PG8_MMA(0, 1, At, B1); PG8_BAR; PG8_SCHED;
            PG8_LDA(At, 0, 1); PG8_STAGE(PG8_SB(0, 0), b2, voffB); PG8_STAGE(PG8_SB(0, 1), b2 + hstep, voffB); PG8_STAGE(PG8_SA(0, 0), a2, voffA);
            PG8_WAIT_V(8); PG8_WAIT_L(0); PG8_BAR; PG8_MMA(1, 0, At, B0); PG8_MMA(1, 1, At, B1); PG8_BAR; PG8_SCHED;
            PG8_LDB(B0, 1, 0); PG8_LDB(B1, 1, 1); PG8_SCHED; PG8_LDA(At, 1, 0); PG8_STAGE(PG8_SA(0, 1), a2 + hstep, voffA);
            PG8_WAIT_V(8); PG8_WAIT_L(0); PG8_BAR; PG8_MMA(0, 0, At, B0); PG8_MMA(0, 1, At, B1); PG8_BAR; PG8_SCHED;
            PG8_LDA(At, 1, 1); PG8_STAGE(PG8_SB(1, 0), b3, voffB); PG8_STAGE(PG8_SB(1, 1), b3 + hstep, voffB); PG8_STAGE(PG8_SA(1, 0), a3, voffA);
            PG8_WAIT_V(8); PG8_WAIT_L(0); PG8_BAR; PG8_MMA(1, 0, At, B0); PG8_MMA(1, 1, At, B1); PG8_BAR; PG8_SCHED;
            } else {
            PG8_LDB(B0, 0, 0); PG8_SCHED; PG8_LDA(At, 0, 0); PG8_STAGE(PG8_SA(1, 1), a1 + hstep, voffA);
            PG8_WAIT_L(8); PG8_BAR; PG8_WAIT_L(0); PG8_MMA(0, 0, At, B0); PG8_BAR; PG8_SCHED;
            PG8_LDB(B1, 0, 1); PG8_STAGE(PG8_SB(0, 0), b2, voffB);
            PG8_BAR; PG8_WAIT_L(0); PG8_MMA(0, 1, At, B1); PG8_BAR;
            PG8_LDA(At, 0, 1); PG8_STAGE(PG8_SA(0, 0), a2, voffA);
            PG8_BAR; PG8_WAIT_L(0); PG8_MMA(1, 0, At, B0); PG8_BAR; PG8_SCHED;
            PG8_STAGE(PG8_SB(0, 1), b2 + hstep, voffB);
            PG8_WAIT_V(6); PG8_BAR; PG8_MMA(1, 1, At, B1); PG8_BAR;
            PG8_LDB(B0, 1, 0); PG8_SCHED; PG8_LDA(At, 1, 0); PG8_STAGE(PG8_SA(0, 1), a2 + hstep, voffA);
            PG8_WAIT_L(8); PG8_BAR; PG8_WAIT_L(0); PG8_MMA(0, 0, At, B0); PG8_BAR; PG8_SCHED;
            PG8_LDB(B1, 1, 1); PG8_STAGE(PG8_SB(1, 0), b3, voffB);
            PG8_BAR; PG8_WAIT_L(0); PG8_MMA(0, 1, At, B1); PG8_BAR;
            PG8_LDA(At, 1, 1); PG8_STAGE(PG8_SA(1, 0), a3, voffA);
            PG8_BAR; PG8_WAIT_L(0); PG8_MMA(1, 0, At, B0); PG8_BAR; PG8_SCHED;
            PG8_STAGE(PG8_SB(1, 1), b3 + hstep, voffB);
            PG8_WAIT_V(6); PG8_BAR; PG8_MMA(1, 1, At, B1); PG8_BAR;
            }
        }
        if constexpr (ALIGN_EPI) { if (wr == 0) PG8_BAR; }
        if constexpr (!Epi::AFTER_DRAIN) { E(acc, cur, wr, wc, fr, fq); S.done(cur); }
        if (!has_next) break;
#pragma unroll
        for (int a = 0; a < 2; ++a)
#pragma unroll
            for (int b = 0; b < 2; ++b)
#pragma unroll
                for (int m = 0; m < 4; ++m)
#pragma unroll
                    for (int n = 0; n < 2; ++n) acc[a][b][m][n] = (f32x4){0.f, 0.f, 0.f, 0.f};
        cur = nxt; cA = nA; cB = nB; ++ui;
        if constexpr (ALIGN_EPI) { if (wr == 1) PG8_BAR; }
    }
    PG8_WAIT_V(0);
    if constexpr (!ALIGN_EPI) { if (wr == 0) PG8_BAR; }
    PG8_BAR;
    if constexpr (Epi::AFTER_DRAIN) { E.fused(acc, cur, wr, wc, fr, fq, lds, wid, lane); S.done(cur); }
#undef PG8_SA
#undef PG8_SB
#undef PG8_STAGE
#undef PG8_LDA
#undef PG8_LDB
#undef PG8_MMA
#undef PG8_WAIT_V
#undef PG8_WAIT_L
#undef PG8_BAR
#undef PG8_SCHED
}
}
#define XB_TMO      128
#define XB_XCNT(j)  (256  + 64 * (j))
#define XB_XSUB(j)  (1280 + 64 * (j))
#define XB_XGEN(j)  (2304 + 64 * (j))
#define XB_TOP      3328
#define XB_TOPGEN   3392
#define XCD_BAR_WORDS 3456
#define XB_SPIN_CAP (1u << 18)

__device__ __forceinline__ unsigned xb_ld(unsigned* p)              { return __hip_atomic_load(p, __ATOMIC_RELAXED, __HIP_MEMORY_SCOPE_AGENT); }
__device__ __forceinline__ unsigned xb_add(unsigned* p, unsigned v) { return __hip_atomic_fetch_add(p, v, __ATOMIC_RELAXED, __HIP_MEMORY_SCOPE_AGENT); }
__device__ __forceinline__ unsigned xb_xcc_id() { return (unsigned)__builtin_amdgcn_s_getreg((3 << 11) | 20) & 0xFu; }
#define XB_SPIN(cond, bar) do { unsigned _sp = 0; while (cond) { __builtin_amdgcn_s_sleep(1); \
    if ((++_sp & 255u) == 0u) { if (xb_ld(&(bar)[XB_TMO])) break; if (_sp > XB_SPIN_CAP) { atomicAdd(&(bar)[XB_TMO], 1u); break; } } } } while (0)

struct XcdBarrier {
    unsigned* bar; unsigned x;
    volatile LAS unsigned* st;
};

__device__ __forceinline__ XcdBarrier xcd_barrier_post(unsigned* bar, volatile LAS unsigned* st) {
    XcdBarrier b; b.bar = bar; b.x = xb_xcc_id(); b.st = st;
    if (threadIdx.x == 0) (void)xb_add(&bar[XB_XCNT(b.x)], 1u);
    return b;
}
__device__ __forceinline__ void xcd_barrier_complete(unsigned* bar, unsigned x, unsigned& nloc, unsigned& nx) {
    const unsigned G = gridDim.x * gridDim.y * gridDim.z;
    unsigned sum, cnt, mine, sp = 0u;
    for (;;) {
        sum = 0u; cnt = 0u; mine = 0u;
#pragma unroll
        for (unsigned j = 0; j < 16; ++j) { const unsigned c = xb_ld(&bar[XB_XCNT(j)]); sum += c; cnt += (c > 0u) ? 1u : 0u; mine = (j == x) ? c : mine; }
        if (sum == G) break;
        __builtin_amdgcn_s_sleep(1);
        if ((++sp & 255u) == 0u) { if (xb_ld(&bar[XB_TMO])) break; if (sp > XB_SPIN_CAP) { atomicAdd(&bar[XB_TMO], 1u); break; } }
    }
    nloc = mine > 0u ? mine : 1u; nx = cnt > 0u ? cnt : 1u;
}

__device__ __forceinline__ void xcd_barrier(const XcdBarrier& b) {
    asm volatile("s_waitcnt vmcnt(0)" ::: "memory");
    __syncthreads();
    if (threadIdx.x == 0) {
        unsigned* bar = b.bar;
        __builtin_amdgcn_s_waitcnt(0);
        unsigned nloc = b.st[0], nx = b.st[1];
        if (nloc == 0u) { xcd_barrier_complete(bar, b.x, nloc, nx); b.st[0] = nloc; b.st[1] = nx; }
        const unsigned old = xb_add(&bar[XB_XSUB(b.x)], 1u);
        const unsigned gen = old / nloc;
        if (old + 1u == (gen + 1u) * nloc) {
            __builtin_amdgcn_fence(__ATOMIC_RELEASE, "agent");
            asm volatile("s_waitcnt vmcnt(0)" ::: "memory");
            const unsigned og = xb_add(&bar[XB_TOP], 1u);
            const unsigned tg = og / nx;
            if (og + 1u == (tg + 1u) * nx) xb_add(&bar[XB_TOPGEN], 1u);
            else XB_SPIN(xb_ld(&bar[XB_TOPGEN]) == tg, bar);
            __builtin_amdgcn_fence(__ATOMIC_ACQUIRE, "agent");
            xb_add(&bar[XB_XGEN(b.x)], 1u);
            asm volatile("s_waitcnt vmcnt(0)" ::: "memory");
        } else {
            XB_SPIN(xb_ld(&bar[XB_XGEN(b.x)]) == gen, bar);
            __builtin_amdgcn_fence(__ATOMIC_ACQUIRE, "agent");
            asm volatile("s_waitcnt vmcnt(0)" ::: "memory");
        }
    }
    __syncthreads();
}
namespace mk {
constexpr int NWAVES = 8;
constexpr int D = 1024, TP = 16384, TSMP = 512, T = TP + TSMP, SEQ = 2048, NSEQ = 128, PAST = 8192;
constexpr int NIN = 1568, NINP = 1792, DFF = 2816;
constexpr float EPS = 1e-6f;
constexpr float LOG2E = 1.4426950408889634f;
constexpr float QSCALE = 0.10206207261596577f * LOG2E;
constexpr float MQSCALE = 0.08838834764831845f * LOG2E;

constexpr size_t O_YP = 0, O_YS = 16777216, O_PCKV = O_YS + 524288, O_PKPE = O_PCKV + 4194304, O_PMK = O_PKPE + 524288, O_PMV = O_PMK + 1048576,
                 O_PCONV = O_PMV + 1048576, O_SCKV = O_PCONV + 45056, O_SKPE = O_SCKV + 131072, O_SCV = O_SKPE + 16384, O_SCONV = O_SCV + 262144, O_END = O_SCONV + 720896;
static_assert(O_END == 25292800, "output size");

constexpr size_t al(size_t x) { return (x + 4095) & ~(size_t)4095; }
constexpr size_t WS_CTL = 0, CTL_ZERO_BYTES = 1u << 20;
constexpr size_t WS_W_IN = 1u << 20;
constexpr size_t WS_W_UQ = al(WS_W_IN + (size_t)NINP * D * 2);
constexpr size_t WS_W_UK = al(WS_W_UQ + (size_t)768 * 256 * 2);
constexpr size_t WS_W_UV = al(WS_W_UK + (size_t)512 * 256 * 2);
constexpr size_t WS_W_O = al(WS_W_UV + (size_t)512 * 256 * 2);
constexpr size_t WS_W_MQ = al(WS_W_O + (size_t)1024 * 1024 * 2);
constexpr size_t WS_W_MKV = al(WS_W_MQ + (size_t)512 * 1024 * 2);
constexpr size_t WS_W_MO = al(WS_W_MKV + (size_t)1024 * 1024 * 2);
constexpr size_t WS_W_UP = al(WS_W_MO + (size_t)1024 * 512 * 2);
constexpr size_t WS_W_DN = al(WS_W_UP + (size_t)2 * DFF * D * 2);
constexpr size_t WS_ROPE = al(WS_W_DN + (size_t)D * DFF * 2);
constexpr size_t ROPE_N = 8200;
constexpr size_t WS_XN = al(WS_ROPE + 2 * ROPE_N * 16 * 4);
constexpr size_t WS_MN = al(WS_XN + (size_t)T * D * 2);
constexpr size_t WS_Z = al(WS_MN + (size_t)2048 * D * 2);
constexpr size_t WS_MKV = al(WS_Z + (size_t)T * NINP * 2);
constexpr size_t WS_CQN = al(WS_MKV + (size_t)2048 * 1024 * 2);
constexpr size_t WS_CKVN = al(WS_CQN + (size_t)T * 256 * 2);
constexpr size_t WS_VG = al(WS_CKVN + (size_t)T * 256 * 2);
constexpr size_t WS_MK = al(WS_VG + (size_t)T * 512 * 2);
constexpr size_t WS_MVT = al(WS_MK + (size_t)2048 * 512 * 2);
constexpr size_t WS_QR = al(WS_MVT + (size_t)2048 * 512 * 2);
constexpr size_t WS_KNR = al(WS_QR + (size_t)T * 768 * 2);
constexpr size_t WS_VT = al(WS_KNR + (size_t)TP * 512 * 2);
constexpr size_t WS_QF = al(WS_VT + (size_t)512 * TP * 2);
constexpr size_t WS_KF = al(WS_QF + (size_t)T * 768 * 2);
constexpr size_t WS_BO = al(WS_KF + (size_t)TP * 768 * 2);
constexpr size_t WS_MRG = al(WS_BO + (size_t)T * 512 * 2);
constexpr size_t WS_X1 = al(WS_MRG + (size_t)T * 1024 * 2);
constexpr size_t WS_H2 = al(WS_X1 + (size_t)T * 1024 * 4);
constexpr size_t WS_MQ = al(WS_H2 + (size_t)T * 1024 * 2);
constexpr size_t WS_MO = al(WS_MQ + (size_t)T * 512 * 2);
constexpr size_t WS_X2 = al(WS_MO + (size_t)T * 512 * 2);
constexpr size_t WS_H3 = al(WS_X2 + (size_t)T * 1024 * 4);
constexpr size_t WS_UP = al(WS_H3 + (size_t)T * 1024 * 2);
constexpr size_t WS_HID = al(WS_UP + (size_t)T * 2 * DFF * 2);
constexpr size_t WS_SPART = al(WS_HID + (size_t)T * DFF * 2);
constexpr size_t SPART_STRIDE = (32 + 32 * 256) * 4;
constexpr size_t WS_QEXT = al(WS_SPART + (size_t)NSEQ * 2 * SPART_STRIDE);
constexpr size_t WS_W_SB = al(WS_QEXT + (size_t)NSEQ * 32 * 288 * 2);
constexpr size_t WS_SSQ1_PRE = al(WS_W_SB + (size_t)8 * 128 * 128 * 2);
constexpr size_t WS_RAW01 = WS_SSQ1_PRE;
constexpr size_t WS_RAWG = al(WS_RAW01 + (size_t)64 * 2 * 5632 * 2);
constexpr size_t WS_SSQ1 = al(WS_RAWG + (size_t)64 * 2 * 2816 * 4);
constexpr size_t WS_SSQ2 = al(WS_SSQ1 + (size_t)T * 16 * 4);
constexpr size_t WS_MK_END = al(WS_SSQ2 + (size_t)T * 16 * 4);
static_assert(WS_MK_END < (1000u << 20), "mk workspace under 1000 MiB");
constexpr int CW_BAR = 4096;
constexpr int CW_HIDS = 16384;

constexpr int RING_BYTES = 155648, MISC_OFF = RING_BYTES + 320, LDS_BYTES = 159744;

struct Args { const void* in[38]; float* out; unsigned char* ws; int ph_lo, ph_hi; };
static_assert(sizeof(Args) == 38 * 8 + 8 + 8 + 8, "Args has no padding");

struct Frame {
    LAS unsigned char* lds; unsigned char* lds_g;
    int tid, lane, wave, G, bid;
    unsigned char* ws; float* out;
    const float* const* in;
    template <class P> __device__ __forceinline__ P* w(size_t off) const { return (P*)(ws + off); }
    __device__ __forceinline__ const float* inf(int i) const { return (const float*)in[i]; }
};

enum { I_XP = 0, I_XS, I_CKV, I_KPE, I_CMK, I_CMV, I_CONVST, I_PT, I_MEMP, I_GMIX, I_WIN, I_LNG, I_LNB, I_WS, I_BS, I_GQA, I_WUQ, I_GKVA, I_WUK, I_WUV, I_GQKQ, I_GQKK,
       I_GOA, I_GOB, I_WO, I_GMEMX, I_GMEMIN, I_WMQ, I_WMK, I_WMV, I_GMQ, I_GMK, I_WMO, I_GFFN, I_WUP, I_WCONV, I_BCONV, I_WDOWN };

struct P0Item { float v[32]; float g; };
__device__ __forceinline__ void p0_item_load(P0Item& x, const float* W, int K, int N, int item, int lane, const float* gain) {
    const int nblk = N / 32, kb = item / nblk, nb = item % nblk, k0 = 64 * kb, n0 = 32 * nb;
#pragma unroll
    for (int i = 0; i < 32; ++i) { const int kk = 2 * i + (lane >> 5); x.v[i] = W[(size_t)(k0 + kk) * N + n0 + (lane & 31)]; }
    x.g = gain ? gain[k0 + lane] : 1.f;
}
__device__ __forceinline__ void p0_item_finish(const P0Item& x, int K, int N, bf16* WT, int row_off, LAS float* scr, int item, int lane, bool has_gain) {
    const int nblk = N / 32, kb = item / nblk, nb = item % nblk, k0 = 64 * kb, n0 = 32 * nb;
#pragma unroll
    for (int i = 0; i < 32; ++i) { const int kk = 2 * i + (lane >> 5); float wv_ = x.v[i]; if (has_gain) wv_ *= __shfl(x.g, kk); scr[kk * 33 + (lane & 31)] = wv_; }
    LDS_WAIT(); asm volatile("" ::: "memory");
    const int c = lane & 7;
#pragma unroll
    for (int j = 0; j < 4; ++j) { const int n = (lane >> 3) + 8 * j; const LAS float* s = scr + (8 * c) * 33 + n;
        v4u o; o.x = pk2(s[0 * 33], s[1 * 33]); o.y = pk2(s[2 * 33], s[3 * 33]); o.z = pk2(s[4 * 33], s[5 * 33]); o.w = pk2(s[6 * 33], s[7 * 33]);
        *(v4u*)(WT + (size_t)(row_off + n0 + n) * K + k0 + 8 * c) = o; }
    LDS_WAIT(); asm volatile("" ::: "memory");
}
__device__ __forceinline__ void rms_row_to_bf16(const float* xrow, const float* g, bf16* orow, int lane) {
    const f32x4* xr = (const f32x4*)xrow + lane; const f32x4* gr = (const f32x4*)g + lane;
    f32x4 v[4]; float s = 0.f;
#pragma unroll
    for (int j = 0; j < 4; ++j) { v[j] = xr[64 * j]; s += (v[j].x * v[j].x + v[j].y * v[j].y) + (v[j].z * v[j].z + v[j].w * v[j].w); }
    const float rstd = rsqrtf(wave_sum(s) * (1.f / 1024.f) + EPS);
    unsigned long long* o8 = (unsigned long long*)orow + lane;
#pragma unroll
    for (int j = 0; j < 4; ++j) { const f32x4 gg = gr[64 * j];
        o8[64 * j] = (unsigned long long)pk2(v[j].x * rstd * gg.x, v[j].y * rstd * gg.y) | ((unsigned long long)pk2(v[j].z * rstd * gg.z, v[j].w * rstd * gg.w) << 32); }
}
__device__ __forceinline__ const float* xrow_ptr(const Frame& F, int r) { return r < TP ? F.inf(I_XP) + (size_t)r * D : F.inf(I_XS) + (size_t)(r - TP) * D; }

template <int M_LO, int M_HI>
__device__ __forceinline__ void p0_transposes(Frame& F, int gw, int NGW) {
    LAS float* scr = (LAS float*)(F.lds + F.wave * 16384);
    constexpr int NI = 11;
    const int srcs[NI] = {I_WIN, I_WUQ, I_WUK, I_WUV, I_WO, I_WMQ, I_WMK, I_WMV, I_WMO, I_WUP, I_WDOWN};
    const int Ks[NI] = {1024, 256, 256, 256, 1024, 1024, 1024, 1024, 512, 1024, 2816};
    const int Ns[NI] = {1568, 768, 512, 512, 1024, 512, 512, 512, 1024, 5632, 1024};
    const size_t dsts[NI] = {WS_W_IN, WS_W_UQ, WS_W_UK, WS_W_UV, WS_W_O, WS_W_MQ, WS_W_MKV, WS_W_MKV, WS_W_MO, WS_W_UP, WS_W_DN};
    const int roffs[NI] = {0, 0, 0, 0, 0, 0, 0, 512, 0, 0, 0};
    const int gains[NI] = {-1, -1, -1, -1, -1, I_GMEMX, -1, -1, -1, I_GFFN, -1};
    int base = 0;
#pragma unroll
    for (int m = M_LO; m < M_HI; ++m) {
        const int cnt = (Ks[m] / 64) * (Ns[m] / 32);
        int first = gw - (base % NGW); if (first < 0) first += NGW;
        const float* gp = gains[m] >= 0 ? F.inf(gains[m]) : nullptr;
        P0Item cur_, nxt_;
        if (first < cnt) p0_item_load(cur_, F.inf(srcs[m]), Ks[m], Ns[m], first, F.lane, gp);
        for (int it = first; it < cnt; it += NGW) {
            const bool more = it + NGW < cnt;
            if (more) p0_item_load(nxt_, F.inf(srcs[m]), Ks[m], Ns[m], it + NGW, F.lane, gp);
            int roff = roffs[m];
            if (m == 9) {
                const int n0 = 32 * (it % (Ns[m] / 32)); const int f0 = n0 < DFF ? n0 : n0 - DFF; roff = 256 * (f0 >> 7) + (n0 < DFF ? 0 : 128) + (f0 & 127) - n0; }
            p0_item_finish(cur_, Ks[m], Ns[m], F.w<bf16>(dsts[m]), roff, scr, it, F.lane, gains[m] >= 0);
            if (more) cur_ = nxt_;
        }
        base += cnt;
    }
}
__device__ __forceinline__ void p0_prologue(Frame& F) {
    const int gw = F.bid * NWAVES + F.wave, NGW = F.G * NWAVES;
    p0_transposes<0, 9>(F, gw, NGW);
    for (int r = gw; r < NINP - NIN; r += NGW) { v4u* p = (v4u*)(F.w<bf16>(WS_W_IN) + (size_t)(NIN + r) * D) + F.lane; p[0] = (v4u){0, 0, 0, 0}; p[64] = (v4u){0, 0, 0, 0}; }
    for (int r = gw; r < T + 2048; r += 2 * NGW) {
        f32x4 v[2][4]; const float* gp[2]; bf16* op[2]; bool ok[2];
#pragma unroll
        for (int k = 0; k < 2; ++k) { const int rr = r + k * NGW; ok[k] = rr < T + 2048;
            const float* xr = !ok[k] ? F.inf(I_XP) : (rr < T ? xrow_ptr(F, rr) : F.inf(I_MEMP) + (size_t)(rr - T) * D);
            gp[k] = (rr < T) ? F.inf(I_GMIX) : F.inf(I_GMEMIN); op[k] = (rr < T) ? F.w<bf16>(WS_XN) + (size_t)rr * D : F.w<bf16>(WS_MN) + (size_t)(rr - T) * D;
#pragma unroll
            for (int j = 0; j < 4; ++j) v[k][j] = ((const f32x4*)xr)[F.lane + 64 * j]; }
#pragma unroll
        for (int k = 0; k < 2; ++k) if (ok[k]) {
            float sq = 0.f;
#pragma unroll
            for (int j = 0; j < 4; ++j) sq += (v[k][j].x * v[k][j].x + v[k][j].y * v[k][j].y) + (v[k][j].z * v[k][j].z + v[k][j].w * v[k][j].w);
            const float rstd = rsqrtf(wave_sum(sq) * (1.f / 1024.f) + EPS);
            unsigned long long* o8 = (unsigned long long*)op[k] + F.lane;
#pragma unroll
            for (int j = 0; j < 4; ++j) { const f32x4 gg = ((const f32x4*)gp[k])[F.lane + 64 * j];
                o8[64 * j] = (unsigned long long)pk2(v[k][j].x * rstd * gg.x, v[k][j].y * rstd * gg.y) | ((unsigned long long)pk2(v[k][j].z * rstd * gg.z, v[k][j].w * rstd * gg.w) << 32); }
        }
    }
    { const float* wsrc = F.inf(I_WS); bf16* wdst = F.w<bf16>(WS_W_SB);
      for (int i = F.bid * 512 + F.tid; i < 8 * 128 * 128 / 4; i += F.G * 512) { const f32x4 v = *(const f32x4*)(wsrc + 4 * i); v2u o; o.x = pk2(v[0], v[1]); o.y = pk2(v[2], v[3]); *(v2u*)(wdst + 4 * i) = o; } }
    { float* cs = F.w<float>(WS_ROPE); float* sn = cs + ROPE_N * 16;
      for (int i = F.bid * 512 + F.tid; i < (int)ROPE_N * 16; i += F.G * 512) { const int pos = i >> 4, f = i & 15;
          const double ang = (double)pos * pow(10000.0, -(double)f / 16.0); cs[i] = (float)cos(ang); sn[i] = (float)sin(ang); } }
}

__device__ __forceinline__ void p2_post_inproj(Frame& F) {
    const int gw = F.bid * NWAVES + F.wave, NGW = F.G * NWAVES, lane = F.lane;
    const bf16* Z = F.w<bf16>(WS_Z);
    const float* lg = F.inf(I_LNG); const float* lb = F.inf(I_LNB);
    const f32x4 lg0 = *(const f32x4*)(lg + 8 * lane), lg1 = *(const f32x4*)(lg + 8 * lane + 4), lb0 = *(const f32x4*)(lb + 8 * lane), lb1 = *(const f32x4*)(lb + 8 * lane + 4);
    const f32x4 gqa = *(const f32x4*)(F.inf(I_GQA) + 4 * lane), gkva = *(const f32x4*)(F.inf(I_GKVA) + 4 * lane);
    for (int r0 = gw; r0 < T; r0 += 4 * NGW) {
        v4u rawv[4]; v2u rawq[4], rawk[4]; bf16 rawp[4];
#pragma unroll
        for (int k = 0; k < 4; ++k) { const int r = r0 + k * NGW; if (r < T) { const bf16* zr = Z + (size_t)r * NINP;
            rawv[k] = *(const v4u*)(zr + 512 + 8 * lane); rawq[k] = *(const v2u*)(zr + 1024 + 4 * lane); rawk[k] = *(const v2u*)(zr + 1280 + 4 * lane); rawp[k] = zr[1536 + (lane & 31)]; } }
#pragma unroll
        for (int k = 0; k < 4; ++k) { const int r = r0 + k * NGW; if (r < T) {
        {
            const v4u raw = rawv[k];
            float x[8];
#pragma unroll
            for (int i = 0; i < 4; ++i) { x[2 * i] = gelu_tanh_f(bflo(raw[i])); x[2 * i + 1] = gelu_tanh_f(bfhi(raw[i])); }
            float s = 0.f;
#pragma unroll
            for (int i = 0; i < 8; ++i) s += x[i];
            s = dpp_sum8(s);
            const float mean = s * (1.f / 64.f);
            float q = 0.f;
#pragma unroll
            for (int i = 0; i < 8; ++i) { x[i] -= mean; q += x[i] * x[i]; }
            q = dpp_sum8(q);
            const float rstd = rsqrtf(q * (1.f / 64.f) + EPS);
            f32x4 y0, y1;
#pragma unroll
            for (int i = 0; i < 4; ++i) { y0[i] = x[i] * rstd * lg0[i] + lb0[i]; y1[i] = x[4 + i] * rstd * lg1[i] + lb1[i]; }
            v4u o; o.x = pk2(y0[0], y0[1]); o.y = pk2(y0[2], y0[3]); o.z = pk2(y1[0], y1[1]); o.w = pk2(y1[2], y1[3]);
            *(v4u*)(F.w<bf16>(WS_VG) + (size_t)r * 512 + 8 * lane) = o;
            if (r >= TP) { float* d = F.out + O_SCV + (size_t)(r - TP) * 512 + 8 * lane; *(f32x4*)d = y0; *(f32x4*)(d + 4) = y1; }
        }
#pragma unroll
        for (int which = 0; which < 2; ++which) {
            const v2u raw = which ? rawk[k] : rawq[k];
            f32x4 x; x[0] = bflo(raw[0]); x[1] = bfhi(raw[0]); x[2] = bflo(raw[1]); x[3] = bfhi(raw[1]);
            const float ss = wave_sum((x[0] * x[0] + x[1] * x[1]) + (x[2] * x[2] + x[3] * x[3]));
            const float rstd = rsqrtf(ss * (1.f / 256.f) + EPS);
            const f32x4 g = which ? gkva : gqa;
            f32x4 y;
#pragma unroll
            for (int i = 0; i < 4; ++i) y[i] = x[i] * rstd * g[i];
            v2u o; o.x = pk2(y[0], y[1]); o.y = pk2(y[2], y[3]);
            *(v2u*)(F.w<bf16>(which ? WS_CKVN : WS_CQN) + (size_t)r * 256 + 4 * lane) = o;
            if (which) { float* d = (r < TP) ? F.out + O_PCKV + (size_t)r * 256 : F.out + O_SCKV + (size_t)(r - TP) * 256; *(f32x4*)(d + 4 * lane) = y; }
        }
        if (lane < 32) { float* d = (r < TP) ? F.out + O_PKPE + (size_t)r * 32 : F.out + O_SKPE + (size_t)(r - TP) * 32; d[lane] = bf2f(rawp[k]); }
        } }
    }
    const bf16* MKV = F.w<bf16>(WS_MKV);
    for (int r = gw; r < 2048; r += NGW) {
        const bf16* mr = MKV + (size_t)r * 1024;
        {
            const v4u raw = *(const v4u*)(mr + 8 * lane);
            float x[8];
#pragma unroll
            for (int i = 0; i < 4; ++i) { x[2 * i] = bflo(raw[i]); x[2 * i + 1] = bfhi(raw[i]); }
            float ss = 0.f;
#pragma unroll
            for (int i = 0; i < 8; ++i) ss += x[i] * x[i];
            ss = dpp_sum16(ss);
            const float rstd = rsqrtf(ss * (1.f / 128.f) + EPS);
            const float* g = F.inf(I_GMK) + ((8 * lane) & 127);
            f32x4 y0, y1;
#pragma unroll
            for (int i = 0; i < 4; ++i) { y0[i] = x[i] * rstd * g[i]; y1[i] = x[4 + i] * rstd * g[4 + i]; }
            float* d = F.out + O_PMK + (size_t)r * 512 + 8 * lane; *(f32x4*)d = y0; *(f32x4*)(d + 4) = y1;
            v4u o; o.x = pk2(y0[0], y0[1]); o.y = pk2(y0[2], y0[3]); o.z = pk2(y1[0], y1[1]); o.w = pk2(y1[2], y1[3]);
            *(v4u*)(F.w<bf16>(WS_MK) + (size_t)r * 512 + 8 * lane) = o;
        }
        {
            const v4u raw = *(const v4u*)(mr + 512 + 8 * lane);
            float x[8];
#pragma unroll
            for (int i = 0; i < 4; ++i) { x[2 * i] = bflo(raw[i]); x[2 * i + 1] = bfhi(raw[i]); }
            float* d = F.out + O_PMV + (size_t)r * 512 + 8 * lane; *(f32x4*)d = (f32x4){x[0], x[1], x[2], x[3]}; *(f32x4*)(d + 4) = (f32x4){x[4], x[5], x[6], x[7]};
        }
    }
    for (int g8 = gw; g8 < 256; g8 += NGW) {
        v4u rw[8];
#pragma unroll
        for (int k = 0; k < 8; ++k) rw[k] = *(const v4u*)(MKV + (size_t)(8 * g8 + k) * 1024 + 512 + 8 * lane);
        const int b = (8 * g8) >> 8, key0 = (8 * g8) & 255;
        bf16* mvt = F.w<bf16>(WS_MVT);
#pragma unroll
        for (int i = 0; i < 8; ++i) { const int col = 8 * lane + i, h = col >> 7, dv = col & 127; v4u o;
#pragma unroll
            for (int j = 0; j < 4; ++j) { const unsigned lo = (i & 1) ? (rw[2 * j][i >> 1] >> 16) : (rw[2 * j][i >> 1] & 0xffffu), hi = (i & 1) ? (rw[2 * j + 1][i >> 1] >> 16) : (rw[2 * j + 1][i >> 1] & 0xffffu); o[j] = lo | (hi << 16); }
            *(v4u*)(mvt + ((size_t)(b * 4 + h) * 128 + dv) * 256 + key0) = o; }
    }
}
}
namespace mk {
struct P4Raw { v4u raw; unsigned r1, r2; };
__device__ __forceinline__ P4Raw p4_load_row(const bf16* nope, const bf16* pe, int lane) { const int sub = lane & 7; P4Raw x; x.raw = *(const v4u*)(nope + 8 * sub); x.r1 = *(const unsigned*)(pe + 2 * sub); x.r2 = *(const unsigned*)(pe + 16 + 2 * sub); return x; }
__device__ __forceinline__ void p4_norm_rope_row(const P4Raw in, const float* g, const float* cs, const float* sn, int pos, float oscale, bf16* dst, int lane, bf16* dst2 = nullptr) {
    const int sub = lane & 7;
    const v4u raw = in.raw;
    const unsigned r1 = in.r1, r2 = in.r2;
    float x[8];
#pragma unroll
    for (int i = 0; i < 4; ++i) { x[2 * i] = bflo(raw[i]); x[2 * i + 1] = bfhi(raw[i]); }
    float a0 = bflo(r1), a1 = bfhi(r1), b0 = bflo(r2), b1 = bfhi(r2);
    float ss = (a0 * a0 + a1 * a1) + (b0 * b0 + b1 * b1);
#pragma unroll
    for (int i = 0; i < 8; ++i) ss += x[i] * x[i];
    ss = dpp_sum8(ss);
    const float rs = rsqrtf(ss * (1.f / 96.f) + EPS) * oscale;
    const f32x4 g0 = *(const f32x4*)(g + 8 * sub), g1 = *(const f32x4*)(g + 8 * sub + 4);
    v4u o; o.x = pk2(x[0] * rs * g0[0], x[1] * rs * g0[1]); o.y = pk2(x[2] * rs * g0[2], x[3] * rs * g0[3]); o.z = pk2(x[4] * rs * g1[0], x[5] * rs * g1[1]); o.w = pk2(x[6] * rs * g1[2], x[7] * rs * g1[3]);
    *(v4u*)(dst + 8 * sub) = o;
    const int f = 2 * sub;
    a0 *= rs * g[64 + f]; a1 *= rs * g[65 + f]; b0 *= rs * g[80 + f]; b1 *= rs * g[81 + f];
    const float c0 = cs[pos * 16 + f], c1 = cs[pos * 16 + f + 1], s0 = sn[pos * 16 + f], s1 = sn[pos * 16 + f + 1];
    const unsigned o1_ = pk2(a0 * c0 - b0 * s0, a1 * c1 - b1 * s1), o2_ = pk2(b0 * c0 + a0 * s0, b1 * c1 + a1 * s1);
    *(unsigned*)(dst + 64 + f) = o1_; *(unsigned*)(dst + 80 + f) = o2_;
    if (dst2) { *(unsigned*)(dst2 + f) = o1_; *(unsigned*)(dst2 + 16 + f) = o2_; }
}
__device__ __forceinline__ void p4_qk_norm_rope(Frame& F) {
    const int gw = F.bid * NWAVES + F.wave, NGW = F.G * NWAVES, lane = F.lane, h = lane >> 3;
    const float* cs = F.w<float>(WS_ROPE); const float* sn = cs + ROPE_N * 16;
    const bf16* QR = F.w<bf16>(WS_QR); const bf16* KNR = F.w<bf16>(WS_KNR); const bf16* Z = F.w<bf16>(WS_Z);
    for (int r0 = gw; r0 < T; r0 += 4 * NGW) {
        P4Raw qin[4], kin[4];
#pragma unroll
        for (int k = 0; k < 4; ++k) { const int r = r0 + k * NGW; if (r < T) { const bf16* q = QR + (size_t)r * 768 + 96 * h; qin[k] = p4_load_row(q, q + 64, lane);
            if (r < TP) kin[k] = p4_load_row(KNR + (size_t)r * 512 + 64 * h, Z + (size_t)r * NINP + 1536, lane); } }
#pragma unroll
        for (int k = 0; k < 4; ++k) { const int r = r0 + k * NGW; if (r < T) {
            const int pos = r < TP ? (r & 2047) : PAST + ((r - TP) & 3);
            bf16* qx = nullptr;
            if (r >= TP) { const int sq = (r - TP) >> 2, tq = (r - TP) & 3; qx = F.w<bf16>(WS_QEXT) + ((size_t)sq * 32 + tq * 8 + h) * 288 + 256; }
            p4_norm_rope_row(qin[k], F.inf(I_GQKQ), cs, sn, pos, QSCALE, F.w<bf16>(WS_QF) + (size_t)r * 768 + 96 * h, lane, qx);
            if (r < TP) p4_norm_rope_row(kin[k], F.inf(I_GQKK), cs, sn, pos, 1.f, F.w<bf16>(WS_KF) + (size_t)r * 768 + 96 * h, lane);
        } }
    }
}
__device__ __forceinline__ void p4_qext(Frame& F) {
    const int gw = F.bid * NWAVES + F.wave, NGW = F.G * NWAVES, lane = F.lane, l31 = lane & 31, hh = lane >> 5;
    const float* gq = F.inf(I_GQKQ); const float* gk = F.inf(I_GQKK);
    for (int u = gw; u < 1024; u += NGW) {
        const int h = u & 7, cbk = (u >> 3) & 7, rbk = u >> 6;
        const int row = TP + 32 * rbk + l31;
        const bf16* qp = F.w<bf16>(WS_QR) + (size_t)row * 768 + 96 * h;
        v4u raw[4]; float ss = 0.f;
#pragma unroll
        for (int ks = 0; ks < 4; ++ks) { raw[ks] = *(const v4u*)(qp + 16 * ks + 8 * hh);
#pragma unroll
            for (int i = 0; i < 4; ++i) { const float a = bflo(raw[ks][i]), c = bfhi(raw[ks][i]); ss += a * a + c * c; } }
        { const v4u r0 = *(const v4u*)(qp + 64 + 16 * hh), r1 = *(const v4u*)(qp + 64 + 16 * hh + 8);
#pragma unroll
          for (int i = 0; i < 4; ++i) { const float a = bflo(r0[i]), c = bfhi(r0[i]), d = bflo(r1[i]), e = bfhi(r1[i]); ss += (a * a + c * c) + (d * d + e * e); } }
        ss += __shfl_xor(ss, 32);
        const float rs = rsqrtf(ss * (1.f / 96.f) + EPS) * QSCALE;
        f32x16 acc = {};
        const float* wp = F.inf(I_WUK) + (size_t)(32 * cbk + l31) * 512 + h * 64 + 8 * hh;
#pragma unroll
        for (int ks = 0; ks < 4; ++ks) {
            const int d0 = 16 * ks + 8 * hh;
            const f32x4 w0 = *(const f32x4*)(wp + 16 * ks), w1 = *(const f32x4*)(wp + 16 * ks + 4);
            v4u wa; wa.x = cvtpk(w0[0], w0[1]); wa.y = cvtpk(w0[2], w0[3]); wa.z = cvtpk(w1[0], w1[1]); wa.w = cvtpk(w1[2], w1[3]);
            const f32x4 q0 = *(const f32x4*)(gq + d0), q1 = *(const f32x4*)(gq + d0 + 4), k0 = *(const f32x4*)(gk + d0), k1 = *(const f32x4*)(gk + d0 + 4);
            v4u qb; qb.x = cvtpk(bflo(raw[ks][0]) * rs * q0[0] * k0[0], bfhi(raw[ks][0]) * rs * q0[1] * k0[1]); qb.y = cvtpk(bflo(raw[ks][1]) * rs * q0[2] * k0[2], bfhi(raw[ks][1]) * rs * q0[3] * k0[3]);
            qb.z = cvtpk(bflo(raw[ks][2]) * rs * q1[0] * k1[0], bfhi(raw[ks][2]) * rs * q1[1] * k1[1]); qb.w = cvtpk(bflo(raw[ks][3]) * rs * q1[2] * k1[2], bfhi(raw[ks][3]) * rs * q1[3] * k1[3]);
            acc = __builtin_amdgcn_mfma_f32_32x32x16_bf16(__builtin_bit_cast(bf16x8, wa), __builtin_bit_cast(bf16x8, qb), acc, 0, 0, 0);
        }
        const int sq = (32 * rbk + l31) >> 2, tq = l31 & 3;
        bf16* dst = F.w<bf16>(WS_QEXT) + ((size_t)sq * 32 + tq * 8 + h) * 288 + 32 * cbk + 4 * hh;
#pragma unroll
        for (int g = 0; g < 4; ++g) { v2u o; o.x = cvtpk(acc[4 * g], acc[4 * g + 1]); o.y = cvtpk(acc[4 * g + 2], acc[4 * g + 3]); *(v2u*)(dst + 8 * g) = o; }
    }
}
}
namespace mk {
__device__ __forceinline__ float wave_max(float v) {
#pragma unroll
    for (int o = 1; o < 64; o <<= 1) v = fmaxf(v, __shfl_xor(v, o));
    return v;
}
__device__ __forceinline__ float gain_absmax(const float* g, int n, int lane) { float m = 0.f; for (int i = lane; i < n; i += 64) m = fmaxf(m, fabsf(g[i])); return wave_max(m); }

constexpr int PA_KROW = 208, PA_VROW = 144, PA_KBUF = 0, PA_VBUF = 2 * 64 * PA_KROW, PA_END = PA_VBUF + 2 * 64 * PA_VROW;
__device__ __forceinline__ void attn_prompt_unit(Frame& F, int b, int h, int qb, float negM) {
    const int tid = F.tid, lane = F.lane, wv = F.wave, l31 = lane & 31, hh = lane >> 5;
    LAS unsigned char* L = F.lds;
    const int q0w = 256 * qb + 32 * wv;
    const bf16* Qp = F.w<bf16>(WS_QF) + (size_t)(b * SEQ + q0w + l31) * 768 + h * 96 + 8 * hh;
    bf16x8 qf[6];
#pragma unroll
    for (int ks = 0; ks < 6; ++ks) qf[ks] = *(const bf16x8*)(Qp + 16 * ks);
    const bf16* Kg = F.w<bf16>(WS_KF) + (size_t)(b * SEQ) * 768 + h * 96;
    const bf16* Vg = F.w<bf16>(WS_VT) + (size_t)(h * 64) * TP + (size_t)b * SEQ;
    const int keyA = tid / 12, cA = tid % 12, keyB = (512 + tid) / 12, cB = (512 + tid) % 12, dvv = tid >> 3, cv = tid & 7;
    const int NT = 4 * qb + 4;
    v4u ka, kb2 = (v4u){0, 0, 0, 0}, vv_;
#define PA_LOAD(kt) do { ka = *(const v4u*)(Kg + (size_t)(64 * (kt) + keyA) * 768 + 8 * cA); if (tid < 256) kb2 = *(const v4u*)(Kg + (size_t)(64 * (kt) + keyB) * 768 + 8 * cB); \
        vv_ = *(const v4u*)(Vg + (size_t)dvv * TP + 64 * (kt) + 8 * cv); } while (0)
#define PA_STORE(buf) do { *(LAS v4u*)(L + PA_KBUF + (buf) * 64 * PA_KROW + keyA * PA_KROW + 16 * cA) = ka; if (tid < 256) *(LAS v4u*)(L + PA_KBUF + (buf) * 64 * PA_KROW + keyB * PA_KROW + 16 * cB) = kb2; \
        *(LAS v4u*)(L + PA_VBUF + (buf) * 64 * PA_VROW + dvv * PA_VROW + 16 * cv) = vv_; } while (0)
    PA_LOAD(0); PA_STORE(0);
    __syncthreads();
    if (NT > 1) PA_LOAD(1);
    f32x16 o0 = {}, o1 = {}; float l = 0.f;
#pragma unroll 1
    for (int kt = 0; kt < NT; ++kt) {
        const int buf = kt & 1;
        if (64 * kt <= q0w + 31) {
            const bool part = (64 * kt + 63 > q0w);
            const LAS unsigned char* kbp = L + PA_KBUF + buf * 64 * PA_KROW + l31 * PA_KROW + 16 * hh;
            const LAS unsigned char* vbp = L + PA_VBUF + buf * 64 * PA_VROW + l31 * PA_VROW + 8 * hh;
            bf16x8 kfa[6], kfb[6], vfa[2][2], vfb[2][2];
#define PA_VFRAG(dst, sub_) do { _Pragma("unroll") for (int s2 = 0; s2 < 2; ++s2) _Pragma("unroll") for (int dt = 0; dt < 2; ++dt) { const LAS unsigned char* vp = vbp + dt * 32 * PA_VROW + (32 * (sub_) + 16 * s2) * 2; \
                const s16x4 lo = *(const LAS s16x4*)vp, hi = *(const LAS s16x4*)(vp + 16); dst[s2][dt] = (bf16x8){lo[0], lo[1], lo[2], lo[3], hi[0], hi[1], hi[2], hi[3]}; } } while (0)
#define PA_EXP(s, sub_, pb, MASK) do { float p[16]; \
                _Pragma("unroll") for (int i = 0; i < 16; ++i) { float e = __builtin_amdgcn_exp2f(s[i] + negM); if (MASK && (64 * kt + 32 * (sub_) + (i & 3) + 8 * (i >> 2) + 4 * hh) > q0w + l31) e = 0.f; p[i] = e; l += e; } \
                _Pragma("unroll") for (int s2 = 0; s2 < 2; ++s2) { v4u w; w.x = cvtpk(p[8 * s2 + 0], p[8 * s2 + 1]); w.y = cvtpk(p[8 * s2 + 2], p[8 * s2 + 3]); w.z = cvtpk(p[8 * s2 + 4], p[8 * s2 + 5]); w.w = cvtpk(p[8 * s2 + 6], p[8 * s2 + 7]); pb[s2] = __builtin_bit_cast(bf16x8, w); } } while (0)
#pragma unroll
            for (int ks = 0; ks < 6; ++ks) kfa[ks] = *(const LAS bf16x8*)(kbp + 32 * ks);
            __builtin_amdgcn_sched_barrier(0);
            f32x16 sA = {}, sB = {};
#pragma unroll
            for (int ks = 0; ks < 6; ++ks) kfb[ks] = *(const LAS bf16x8*)(kbp + 32 * PA_KROW + 32 * ks);
#pragma unroll
            for (int ks = 0; ks < 6; ++ks) sA = __builtin_amdgcn_mfma_f32_32x32x16_bf16(kfa[ks], qf[ks], sA, 0, 0, 0);
            __builtin_amdgcn_sched_barrier(0);
            PA_VFRAG(vfa, 0);
#pragma unroll
            for (int ks = 0; ks < 6; ++ks) sB = __builtin_amdgcn_mfma_f32_32x32x16_bf16(kfb[ks], qf[ks], sB, 0, 0, 0);
            __builtin_amdgcn_sched_barrier(0);
            bf16x8 pbA[2], pbB[2];
            if (part) PA_EXP(sA, 0, pbA, true); else PA_EXP(sA, 0, pbA, false);
            __builtin_amdgcn_sched_barrier(0);
            PA_VFRAG(vfb, 1);
#pragma unroll
            for (int s2 = 0; s2 < 2; ++s2) { o0 = __builtin_amdgcn_mfma_f32_32x32x16_bf16(vfa[s2][0], pbA[s2], o0, 0, 0, 0); o1 = __builtin_amdgcn_mfma_f32_32x32x16_bf16(vfa[s2][1], pbA[s2], o1, 0, 0, 0); }
            __builtin_amdgcn_sched_barrier(0);
            if (part) PA_EXP(sB, 1, pbB, true); else PA_EXP(sB, 1, pbB, false);
            __builtin_amdgcn_sched_barrier(0);
#pragma unroll
            for (int s2 = 0; s2 < 2; ++s2) { o0 = __builtin_amdgcn_mfma_f32_32x32x16_bf16(vfb[s2][0], pbB[s2], o0, 0, 0, 0); o1 = __builtin_amdgcn_mfma_f32_32x32x16_bf16(vfb[s2][1], pbB[s2], o1, 0, 0, 0); }
            __builtin_amdgcn_sched_barrier(0);
#undef PA_VFRAG
#undef PA_EXP
        }
        if (kt + 1 < NT) PA_STORE(buf ^ 1);
        __syncthreads();
        if (kt + 2 < NT) PA_LOAD(kt + 2);
    }
#undef PA_LOAD
#undef PA_STORE
    l += __shfl_xor(l, 32);
    const float rl = 1.f / l;
    bf16* Op = F.w<bf16>(WS_BO) + (size_t)(b * SEQ + q0w + l31) * 512 + h * 64 + 4 * hh;
#pragma unroll
    for (int g = 0; g < 4; ++g) {
        v2u w0; w0.x = cvtpk(o0[4 * g] * rl, o0[4 * g + 1] * rl); w0.y = cvtpk(o0[4 * g + 2] * rl, o0[4 * g + 3] * rl);
        v2u w1; w1.x = cvtpk(o1[4 * g] * rl, o1[4 * g + 1] * rl); w1.y = cvtpk(o1[4 * g + 2] * rl, o1[4 * g + 3] * rl);
        *(v2u*)(Op + 8 * g) = w0; *(v2u*)(Op + 32 + 8 * g) = w1;
    }
}
__device__ __forceinline__ void p5_attn_prompt(Frame& F, float negM) {
    for (int u = F.bid; u < 256; u += F.G) {
        const int bh = u >> 2, p = u & 3, b = bh >> 3, h = bh & 7;
        attn_prompt_unit(F, b, h, p, negM);
        attn_prompt_unit(F, b, h, 7 - p, negM);
    }
}
}
namespace mk {
constexpr int SA_ROWB = 592;
constexpr int SA_TILE = 0, SA_T8 = 2 * 64 * SA_ROWB, SA_T8ROW = 272, SA_KP2 = SA_T8 + 64 * SA_T8ROW, SA_GPE = SA_KP2 + 256, SA_R = SA_GPE + 128, SA_PT = SA_R + 2048, SA_PTROW = 144,
              SA_QEXT = SA_PT + 32 * SA_PTROW, SA_RBASE = SA_QEXT + 32 * SA_ROWB  , SA_RDEL = SA_RBASE + 65 * 128  , SA_END = SA_RDEL + 64 * 128;
static_assert(SA_END <= RING_BYTES, "sample attention LDS");
typedef short v4i16_t __attribute__((ext_vector_type(4)));
#define SA_BAR() do { asm volatile("s_waitcnt lgkmcnt(0)" ::: "memory"); __builtin_amdgcn_s_barrier(); asm volatile("" ::: "memory"); } while (0)

__device__ __forceinline__ void attn_sample_unit(Frame& F, int s, int split, float negM) {
    const int tid = F.tid, lane = F.lane, w = F.wave, hh = lane >> 5, l31 = lane & 31;
    LAS unsigned char* L = F.lds;
    const float* pool_ckv = F.inf(I_CKV); const float* pool_kpe = F.inf(I_KPE); const int* pt = (const int*)F.in[I_PT] + s * 64;
    const float* cs = F.w<float>(WS_ROPE); const float* sn = cs + ROPE_N * 16;
    const float* gk = F.inf(I_GQKK);
    const int kbeg = split * 4096, NT = split ? 65 : 64;
    const int prow = tid >> 3, pc4 = tid & 7;
    const int mypage = pt[split * 32 + l31];
    f32x4 va[8], vb[8], pe;
#define SA_LOADC(n, V) do { const int key0_ = kbeg + 64 * (n); const int page_ = __builtin_amdgcn_readlane(mypage, (n) >> 1); const size_t rb_ = (size_t)page_ * 128 + (key0_ & 127); \
        const float* cp_ = pool_ckv + (rb_ + w) * 256 + 4 * lane; \
        _Pragma("unroll") for (int i = 0; i < 8; ++i) V[i] = __builtin_nontemporal_load((const f32x4*)(cp_ + (size_t)i * 2048)); } while (0)
#define SA_LOADPC(n) do { const int key0_ = kbeg + 64 * (n); const int page_ = __builtin_amdgcn_readlane(mypage, (n) >> 1); const size_t rb_ = (size_t)page_ * 128 + (key0_ & 127); \
        pe = __builtin_nontemporal_load((const f32x4*)(pool_kpe + (rb_ + prow) * 32 + 4 * pc4)); } while (0)
#define SA_LOADP(n) do { if (kbeg + 64 * (n) < PAST) SA_LOADPC(n); else { pe = (f32x4){0.f, 0.f, 0.f, 0.f}; \
            if (prow < 4) { const v2u r_ = *(const v2u*)(F.w<bf16>(WS_Z) + (size_t)(TP + 4 * s + prow) * NINP + 1536 + 4 * pc4); pe = (f32x4){bflo(r_.x), bfhi(r_.x), bflo(r_.y), bfhi(r_.y)}; } } } while (0)
#define SA_LOAD(n, V) do { \
        if (kbeg + 64 * (n) < PAST) SA_LOADC(n, V); else { \
            _Pragma("unroll") for (int i = 0; i < 8; ++i) V[i] = (f32x4){0.f, 0.f, 0.f, 0.f}; \
            if (w < 4) { const v2u o_ = *(const v2u*)(F.w<bf16>(WS_CKVN) + (size_t)(TP + 4 * s + w) * 256 + 4 * lane); V[0] = (f32x4){bflo(o_.x), bfhi(o_.x), bflo(o_.y), bfhi(o_.y)}; } \
        } } while (0)
#define SA_CONVERT(n, V) do { LAS unsigned char* tb_ = L + SA_TILE + ((n) & 1) * 64 * SA_ROWB; \
        _Pragma("unroll") for (int i = 0; i < 8; ++i) { v2u o_; o_.x = cvtpk(V[i][0], V[i][1]); o_.y = cvtpk(V[i][2], V[i][3]); \
            *(LAS v2u*)(tb_ + (w + 8 * i) * SA_ROWB + 8 * lane) = o_; \
            int f8_ = 0; f8_ = __builtin_amdgcn_cvt_pk_fp8_f32(V[i][0], V[i][1], f8_, false); f8_ = __builtin_amdgcn_cvt_pk_fp8_f32(V[i][2], V[i][3], f8_, true); \
            *(LAS int*)(L + SA_T8 + (w + 8 * i) * SA_T8ROW + 4 * lane) = f8_; } \
        { const f32x4 pv = pe; float ss_ = (pv[0] * pv[0] + pv[1] * pv[1]) + (pv[2] * pv[2] + pv[3] * pv[3]); ss_ += __shfl_xor(ss_, 1); ss_ += __shfl_xor(ss_, 2); ss_ += __shfl_xor(ss_, 4); \
          if (pc4 == 0) ((LAS float*)(L + SA_KP2))[prow] = ss_; \
          const LAS float* rb_ = (const LAS float*)(L + SA_RBASE) + (n) * 32 + 4 * (pc4 & 3); const LAS float* rd_ = (const LAS float*)(L + SA_RDEL) + prow * 32 + 4 * (pc4 & 3); \
          const f32x4 cb_ = *(const LAS f32x4*)rb_, sb_ = *(const LAS f32x4*)(rb_ + 16), cd_ = *(const LAS f32x4*)rd_, sd_ = *(const LAS f32x4*)(rd_ + 16); \
          const f32x4 c_ = cb_ * cd_ - sb_ * sd_, s_ = sb_ * cd_ + cb_ * sd_; \
          f32x4 x_ = pv * *(const LAS f32x4*)(L + SA_GPE + 16 * pc4), y_, o4_; y_[0] = __shfl_xor(x_[0], 4); y_[1] = __shfl_xor(x_[1], 4); y_[2] = __shfl_xor(x_[2], 4); y_[3] = __shfl_xor(x_[3], 4); \
          if (pc4 < 4) o4_ = x_ * c_ - y_ * s_; else o4_ = x_ * c_ + y_ * s_; \
          v2u o_; o_.x = cvtpk(o4_[0], o4_[1]); o_.y = cvtpk(o4_[2], o4_[3]); *(LAS v2u*)(tb_ + prow * SA_ROWB + 512 + pc4 * 8) = o_; } } while (0)
    SA_LOADPC(0); SA_LOADC(0, va);
    __builtin_amdgcn_sched_barrier(0);
    SA_LOADC(1, vb);
    __builtin_amdgcn_sched_barrier(0);
    { const bf16* qx = F.w<bf16>(WS_QEXT) + (size_t)s * 32 * 288;
      for (int ch = tid; ch < 32 * 36; ch += 512) { const int r_ = ch / 36, c_ = ch % 36; *(LAS v4u*)(L + SA_QEXT + r_ * SA_ROWB + 16 * c_) = *(const v4u*)(qx + r_ * 288 + 8 * c_); } }
    typedef int v8i_t __attribute__((ext_vector_type(8)));
    v8i_t Wf[2][4];
    { const bf16* Wp = F.w<bf16>(WS_W_UK) + (size_t)(w * 64 + l31) * 256 + 32 * hh;
#pragma unroll
      for (int dt = 0; dt < 2; ++dt)
#pragma unroll
          for (int ks = 0; ks < 4; ++ks) { v8i_t fr;
#pragma unroll
              for (int q = 0; q < 4; ++q) { const v4u raw = *(const v4u*)(Wp + (size_t)dt * 32 * 256 + 64 * ks + 8 * q);
                  int d0 = 0, d1 = 0;
                  d0 = __builtin_amdgcn_cvt_pk_fp8_f32(bflo(raw.x) * 16.f, bfhi(raw.x) * 16.f, d0, false); d0 = __builtin_amdgcn_cvt_pk_fp8_f32(bflo(raw.y) * 16.f, bfhi(raw.y) * 16.f, d0, true);
                  d1 = __builtin_amdgcn_cvt_pk_fp8_f32(bflo(raw.z) * 16.f, bfhi(raw.z) * 16.f, d1, false); d1 = __builtin_amdgcn_cvt_pk_fp8_f32(bflo(raw.w) * 16.f, bfhi(raw.w) * 16.f, d1, true);
                  fr[2 * q] = d0; fr[2 * q + 1] = d1; }
              Wf[dt][ks] = fr; } }
    if (tid < 32) ((LAS float*)(L + SA_GPE))[tid] = gk[64 + tid];
    for (int i = tid; i < 65 * 8; i += 512) { const int n_ = i >> 3, c_ = i & 7; *(LAS f32x4*)(L + SA_RBASE + n_ * 128 + 16 * c_) = *(const f32x4*)((c_ < 4 ? cs : sn - 16) + (size_t)(kbeg + 64 * n_) * 16 + 4 * c_); }
    { const int r_ = tid >> 3, c_ = tid & 7; *(LAS f32x4*)(L + SA_RDEL + r_ * 128 + 16 * c_) = *(const f32x4*)((c_ < 4 ? cs : sn - 16) + (size_t)r_ * 16 + 4 * c_); }
    SA_BAR();
    f32x16 oacc = {}; float lsum = 0.f;
    SA_CONVERT(0, va);
    __builtin_amdgcn_sched_barrier(0);
    SA_LOADPC(1);
    __builtin_amdgcn_sched_barrier(0);
    SA_LOADC(2, va);
    __builtin_amdgcn_sched_barrier(0);
    SA_BAR();
    const int lane_ = lane, tid_ = tid;
#define SA_STEP(n, V, DO_CONV, DO_LOADP, LOADPM, DO_LOAD, LOADM) do { \
        const int lane = opaque_i(lane_), tid = opaque_i(tid_), hh = lane >> 5, l31 = lane & 31, prow = tid >> 3, pc4 = tid & 7, l15 = lane & 15, l4 = lane >> 4;     \
        const LAS unsigned char* tb = L + SA_TILE + ((n) & 1) * 64 * SA_ROWB; \
          \
        _Pragma("unroll") for (int kt2 = 0; kt2 < 2; ++kt2) { \
            const LAS unsigned char* bp = L + SA_T8 + (32 * kt2 + l31) * SA_T8ROW + 32 * hh; \
            f32x16 a0 = {}, a1 = {}; \
            _Pragma("unroll") for (int ks = 0; ks < 4; ++ks) { const v4u lo = *(const LAS v4u*)(bp + 64 * ks), hi = *(const LAS v4u*)(bp + 64 * ks + 16); \
                const v8i_t fb = (v8i_t){(int)lo.x, (int)lo.y, (int)lo.z, (int)lo.w, (int)hi.x, (int)hi.y, (int)hi.z, (int)hi.w}; \
                a0 = __builtin_amdgcn_mfma_scale_f32_32x32x64_f8f6f4(Wf[0][ks], fb, a0, 0, 0, 0, 0x7B7B7B7B, 0, 0x7F7F7F7F); \
                a1 = __builtin_amdgcn_mfma_scale_f32_32x32x64_f8f6f4(Wf[1][ks], fb, a1, 0, 0, 0, 0x7B7B7B7B, 0, 0x7F7F7F7F); \
                if (ks & 1) __builtin_amdgcn_sched_barrier(0); } \
            float ss = 0.f; \
            _Pragma("unroll") for (int i = 0; i < 16; ++i) ss += a0[i] * a0[i] + a1[i] * a1[i]; \
            ss += __shfl_xor(ss, 32); \
            ss += ((const LAS float*)(L + SA_KP2))[32 * kt2 + l31]; \
            if (hh == 0) ((LAS float*)(L + SA_R))[w * 64 + 32 * kt2 + l31] = rsqrtf(ss * (1.f / 96.f) + EPS); \
        } \
        SA_BAR(); \
        if (DO_CONV) SA_CONVERT((n) + 1, V); \
        __builtin_amdgcn_sched_barrier(0); \
        if (DO_LOADP) LOADPM((n) + 2); \
        __builtin_amdgcn_sched_barrier(0); \
        if (DO_LOAD) LOADM((n) + 3, V); \
        __builtin_amdgcn_sched_barrier(0); \
          \
        if (w < 2) { \
            f32x16 sa0 = {}, sa1 = {}; \
            const LAS unsigned char* ap = tb + (32 * w + l31) * SA_ROWB + 16 * hh; \
            const LAS unsigned char* qp = L + SA_QEXT + l31 * SA_ROWB + 16 * hh; \
            _Pragma("unroll") for (int k0 = 0; k0 < 18; k0 += 3) { bf16x8 afr[3], qfr[3]; \
                _Pragma("unroll") for (int ks = 0; ks < 3; ++ks) { afr[ks] = *(const LAS bf16x8*)(ap + 32 * (k0 + ks)); qfr[ks] = *(const LAS bf16x8*)(qp + 32 * (k0 + ks)); } \
                __builtin_amdgcn_sched_barrier(0); \
                _Pragma("unroll") for (int ks = 0; ks < 3; ++ks) { if ((k0 + ks) & 1) sa1 = __builtin_amdgcn_mfma_f32_32x32x16_bf16(afr[ks], qfr[ks], sa1, 0, 0, 0); else sa0 = __builtin_amdgcn_mfma_f32_32x32x16_bf16(afr[ks], qfr[ks], sa0, 0, 0, 0); } \
                __builtin_amdgcn_sched_barrier(0); } \
            const int t_q = l31 >> 3, h_q = l31 & 7; \
            _Pragma("unroll") for (int g = 0; g < 4; ++g) { \
                const f32x4 r4 = *(const LAS f32x4*)(L + SA_R + (h_q * 64 + 32 * w + 8 * g + 4 * hh) * 4); \
                const int kg = kbeg + 64 * (n) + 32 * w + 8 * g + 4 * hh; \
                float p[4]; \
                _Pragma("unroll") for (int i = 0; i < 4; ++i) { float e = __builtin_amdgcn_exp2f((sa0[4 * g + i] + sa1[4 * g + i]) * r4[i] + negM); if (kg + i > PAST + t_q) e = 0.f; p[i] = e; lsum += e; } \
                v2u o; o.x = cvtpk(p[0], p[1]); o.y = cvtpk(p[2], p[3]); \
                *(LAS v2u*)(L + SA_PT + l31 * SA_PTROW + (32 * w + 8 * g + 4 * hh) * 2) = o; } \
        } \
        SA_BAR(); \
          \
        { \
            const LAS unsigned char* trp = tb + (8 * hh + (l15 >> 2)) * SA_ROWB + (32 * w + 16 * (l4 & 1) + 4 * (l15 & 3)) * 2; \
            const LAS unsigned char* pp = L + SA_PT + l31 * SA_PTROW + 16 * hh; \
            _Pragma("unroll") for (int s2 = 0; s2 < 4; ++s2) { \
                const s16x4 lo = __builtin_bit_cast(s16x4, __builtin_amdgcn_ds_read_tr16_b64_v4i16((LAS v4i16_t*)(trp + (16 * s2) * SA_ROWB))); \
                const s16x4 hi = __builtin_bit_cast(s16x4, __builtin_amdgcn_ds_read_tr16_b64_v4i16((LAS v4i16_t*)(trp + (16 * s2 + 4) * SA_ROWB))); \
                const bf16x8 af = (bf16x8){lo[0], lo[1], lo[2], lo[3], hi[0], hi[1], hi[2], hi[3]}; \
                const bf16x8 pf = *(const LAS bf16x8*)(pp + 32 * s2); \
                oacc = __builtin_amdgcn_mfma_f32_32x32x16_bf16(af, pf, oacc, 0, 0, 0); if (s2 & 1) __builtin_amdgcn_sched_barrier(0); \
            } \
        } } while (0)
#pragma unroll 1
    for (int n = 0; n < 60; n += 2) {
        SA_STEP(n, vb, true, true, SA_LOADPC, true, SA_LOADC);
        SA_STEP(n + 1, va, true, true, SA_LOADPC, true, SA_LOADC);
    }
#pragma unroll 1
    for (int n = 60; n < NT; n += 2) {
        SA_STEP(n, vb, n + 1 < NT, n + 2 < NT, SA_LOADP, n + 3 < NT, SA_LOAD);
        if (n + 1 < NT) SA_STEP(n + 1, va, n + 2 < NT, n + 3 < NT, SA_LOADP, n + 4 < NT, SA_LOAD);
    }
#undef SA_STEP
#undef SA_LOAD
#undef SA_LOADC
#undef SA_LOADP
#undef SA_LOADPC
#undef SA_CONVERT
    float* part = (float*)(F.ws + WS_SPART + (size_t)(s * 2 + split) * SPART_STRIDE);
    lsum += __shfl_xor(lsum, 32);
    __syncthreads();
    if (w < 2 && lane < 32) ((LAS float*)(L + SA_R))[w * 32 + lane] = lsum;
    __syncthreads();
    if (tid < 32) { const LAS float* lp = (const LAS float*)(L + SA_R); part[tid] = lp[tid] + lp[32 + tid]; }
#pragma unroll
    for (int g = 0; g < 4; ++g) *(f32x4*)(part + 32 + l31 * 256 + 32 * w + 8 * g + 4 * hh) = (f32x4){oacc[4 * g], oacc[4 * g + 1], oacc[4 * g + 2], oacc[4 * g + 3]};
    __syncthreads();
}
}
namespace mk {
__device__ __forceinline__ void p6_gmlp_chunk(Frame& F, int chunk) {
    const int lane = F.lane, g = F.wave, hh = lane >> 5, l31 = lane & 31;
    LAS float* SS = (LAS float*)(F.lds + 131072);
    LAS unsigned char* VT_ = F.lds + g * 16384;
    const int row0 = chunk * 128;
    const bf16* VG = F.w<bf16>(WS_VG) + (size_t)row0 * 512 + g * 64;
    const bf16* Z = F.w<bf16>(WS_Z) + (size_t)row0 * NINP + g * 64;
    const bf16* Wg = F.w<bf16>(WS_W_SB) + (size_t)g * 128 * 128;
    const float* bs = F.inf(I_BS) + g * 128;
    v4u wf[4][8];
#pragma unroll
    for (int tt = 0; tt < 4; ++tt)
#pragma unroll
        for (int ks = 0; ks < 2 * tt + 2; ++ks) wf[tt][ks] = *(const v4u*)(Wg + (size_t)(32 * tt + l31) * 128 + 16 * ks + 8 * hh);
#pragma unroll
    for (int i = 0; i < 16; ++i) { const int r = (lane >> 3) + 8 * i, ch = lane & 7; const v4u v = *(const v4u*)(VG + (size_t)r * 512 + 8 * ch); *(LAS v4u*)(VT_ + r * 128 + 16 * ch) = v;
        if ((i & 3) == 3) __builtin_amdgcn_sched_barrier(0); }
    LDS_WAIT(); asm volatile("" ::: "memory");
    const int l4 = lane >> 4, l15 = lane & 15;
    const LAS unsigned char* trb = VT_ + (8 * hh + (l15 >> 2)) * 128 + (16 * (l4 & 1) + 4 * (l15 & 3)) * 2;
    v2u pa[4][2][4];
    v2u ura[4][2][4]; float bta[4];
#pragma unroll
    for (int tt = 0; tt < 4; ++tt) { const int t = 32 * tt + l31; bta[tt] = bs[t];
#pragma unroll
        for (int dt = 0; dt < 2; ++dt)
#pragma unroll
            for (int gq = 0; gq < 4; ++gq) ura[tt][dt][gq] = *(const v2u*)(Z + (size_t)t * NINP + 32 * dt + 8 * gq + 4 * hh); }
#pragma unroll
    for (int tt = 0; tt < 4; ++tt) {
        const int t = 32 * tt + l31;
        const v2u (&ur)[2][4] = ura[tt];
        const float bt = bta[tt];
        f32x16 a0 = {}, a1 = {};
#pragma unroll
        for (int ks = 0; ks < 2 * tt + 2; ++ks) {
            v4u pk = wf[tt][ks];
            if (ks >= 2 * tt) {
                const int s0 = 16 * ks + 8 * hh;
#pragma unroll
                for (int i = 0; i < 4; ++i) { unsigned wv = pk[i]; if (s0 + 2 * i > t) wv = 0u; else if (s0 + 2 * i + 1 > t) wv &= 0xffffu; pk[i] = wv; }
            }
            const bf16x8 bfr = __builtin_bit_cast(bf16x8, pk);
            bf16x8 af[2];
#pragma unroll
            for (int dt = 0; dt < 2; ++dt) {
                const s16x4 lo = __builtin_bit_cast(s16x4, __builtin_amdgcn_ds_read_tr16_b64_v4i16((LAS v4i16_t*)(trb + (16 * ks) * 128 + 64 * dt)));
                const s16x4 hi = __builtin_bit_cast(s16x4, __builtin_amdgcn_ds_read_tr16_b64_v4i16((LAS v4i16_t*)(trb + (16 * ks + 4) * 128 + 64 * dt)));
                af[dt] = (bf16x8){lo[0], lo[1], lo[2], lo[3], hi[0], hi[1], hi[2], hi[3]};
            }
            a0 = __builtin_amdgcn_mfma_f32_32x32x16_bf16(af[0], bfr, a0, 0, 0, 0); a1 = __builtin_amdgcn_mfma_f32_32x32x16_bf16(af[1], bfr, a1, 0, 0, 0);
        }
        float ss = 0.f;
#pragma unroll
        for (int dt = 0; dt < 2; ++dt)
#pragma unroll
            for (int gq = 0; gq < 4; ++gq) {
                const v2u u2 = ur[dt][gq];
                const float u0 = gelu_tanh_f(bflo(u2.x)), u1 = gelu_tanh_f(bfhi(u2.x)), u2f = gelu_tanh_f(bflo(u2.y)), u3 = gelu_tanh_f(bfhi(u2.y));
                const f32x16& acc = dt ? a1 : a0;
                const float v0 = u0 * (acc[4 * gq] + bt), v1 = u1 * (acc[4 * gq + 1] + bt), v2 = u2f * (acc[4 * gq + 2] + bt), v3 = u3 * (acc[4 * gq + 3] + bt);
                ss += (v0 * v0 + v1 * v1) + (v2 * v2 + v3 * v3);
                v2u o; o.x = cvtpk(v0, v1); o.y = cvtpk(v2, v3); pa[tt][dt][gq] = o;
            }
        ss += __shfl_xor(ss, 32);
        if (hh == 0) SS[g * 128 + t] = ss;
    }
    __syncthreads();
    const float* goa = F.inf(I_GOA) + g * 64;
    bf16* MRG = F.w<bf16>(WS_MRG) + (size_t)row0 * 1024 + g * 64;
#pragma unroll
    for (int tt = 0; tt < 4; ++tt) {
        const int t = 32 * tt + l31;
        float tot = 0.f;
#pragma unroll
        for (int k = 0; k < 8; ++k) tot += SS[k * 128 + t];
        const float rstd = rsqrtf(tot * (1.f / 512.f) + EPS);
#pragma unroll
        for (int dt = 0; dt < 2; ++dt)
#pragma unroll
            for (int gq = 0; gq < 4; ++gq) {
                const int d0 = 32 * dt + 8 * gq + 4 * hh;
                const f32x4 gg = *(const f32x4*)(goa + d0);
                const v2u v = pa[tt][dt][gq];
                v2u o; o.x = cvtpk(bflo(v.x) * rstd * gg[0], bfhi(v.x) * rstd * gg[1]); o.y = cvtpk(bflo(v.y) * rstd * gg[2], bfhi(v.y) * rstd * gg[3]);
                *(v2u*)(MRG + (size_t)t * 1024 + d0) = o;
            }
    }
    __syncthreads();
}
__device__ __forceinline__ void p6_sample_seq(Frame& F, int s) {
    const int tid = F.tid, lane = F.lane, w = F.wave, l31 = lane & 31, hh = lane >> 5;
    LAS float* RED = (LAS float*)(F.lds + 32768);
    const float* p0 = (const float*)(F.ws + WS_SPART + (size_t)(s * 2) * SPART_STRIDE); const float* p1 = (const float*)((const unsigned char*)p0 + SPART_STRIDE);
    f32x16 a0 = {}, a1 = {};
    {
        const int th = (l31 & 3) * 8 + w;
        const float inv_l = 1.f / (p0[th] + p1[th]);
        const float* o0 = p0 + 32 + th * 256 + 8 * hh; const float* o1 = p1 + 32 + th * 256 + 8 * hh;
        const bf16* Wp = F.w<bf16>(WS_W_UV) + (size_t)(w * 64 + l31) * 256 + 8 * hh;
#pragma unroll
        for (int k0 = 0; k0 < 16; k0 += 4) {
            f32x4 x0[4], x1[4], y0[4], y1[4]; bf16x8 b0[4], b1[4];
#pragma unroll
            for (int i = 0; i < 4; ++i) { const int ks = k0 + i; x0[i] = *(const f32x4*)(o0 + 16 * ks); x1[i] = *(const f32x4*)(o0 + 16 * ks + 4); y0[i] = *(const f32x4*)(o1 + 16 * ks); y1[i] = *(const f32x4*)(o1 + 16 * ks + 4);
                b0[i] = *(const bf16x8*)(Wp + 16 * ks); b1[i] = *(const bf16x8*)(Wp + (size_t)32 * 256 + 16 * ks); }
#pragma unroll
            for (int i = 0; i < 4; ++i) { const f32x4 u0 = (x0[i] + y0[i]) * inv_l, u1 = (x1[i] + y1[i]) * inv_l;
                v4u pk; pk.x = cvtpk(u0[0], u0[1]); pk.y = cvtpk(u0[2], u0[3]); pk.z = cvtpk(u1[0], u1[1]); pk.w = cvtpk(u1[2], u1[3]);
                if (l31 >= 4) pk = (v4u){0u, 0u, 0u, 0u};
                const bf16x8 af = __builtin_bit_cast(bf16x8, pk);
                a0 = __builtin_amdgcn_mfma_f32_32x32x16_bf16(af, b0[i], a0, 0, 0, 0); a1 = __builtin_amdgcn_mfma_f32_32x32x16_bf16(af, b1[i], a1, 0, 0, 0); }
        }
    }
    const int col = tid;
    float ao[4];
    { const int g = col >> 6; const bf16* VG = F.w<bf16>(WS_VG) + (size_t)(TP + 4 * s) * 512 + col; const bf16* Z = F.w<bf16>(WS_Z) + (size_t)(TP + 4 * s) * NINP + col;
      const float* Wg = F.inf(I_WS) + (size_t)g * 128 * 128; const float* bs = F.inf(I_BS) + g * 128;
      float vg[4];
#pragma unroll
      for (int t = 0; t < 4; ++t) vg[t] = bf2f(VG[(size_t)t * 512]);
#pragma unroll
      for (int t = 0; t < 4; ++t) { float m = bs[t];
#pragma unroll
          for (int s2 = 0; s2 <= t; ++s2) m += Wg[t * 128 + s2] * vg[s2];
          ao[t] = gelu_tanh_f(bf2f(Z[(size_t)t * NINP])) * m; } }
    float red[8];
#pragma unroll
    for (int t = 0; t < 4; ++t) { red[t] = wave_sum(ao[t] * ao[t]); const float bq = (hh == 0) ? (a0[t] * a0[t] + a1[t] * a1[t]) : 0.f; red[4 + t] = wave_sum(bq); }
    if (lane < 8) { float v = red[0];
#pragma unroll
        for (int k = 1; k < 8; ++k) v = (lane == k) ? red[k] : v;
        RED[w * 8 + lane] = v; }
    __syncthreads();
    const float ga = F.inf(I_GOA)[col];
    bf16* MRG = F.w<bf16>(WS_MRG) + (size_t)(TP + 4 * s) * 1024; bf16* BO = F.w<bf16>(WS_BO) + (size_t)(TP + 4 * s) * 512;
    const float gb0 = F.inf(I_GOB)[w * 64 + l31], gb1 = F.inf(I_GOB)[w * 64 + 32 + l31];
#pragma unroll
    for (int t = 0; t < 4; ++t) {
        float sa = 0.f, sb = 0.f;
#pragma unroll
        for (int k = 0; k < 8; ++k) { sa += RED[k * 8 + t]; sb += RED[k * 8 + 4 + t]; }
        MRG[(size_t)t * 1024 + col] = (bf16)f2bf(ao[t] * rsqrtf(sa * (1.f / 512.f) + EPS) * ga);
        if (hh == 0) { const float rb = rsqrtf(sb * (1.f / 512.f) + EPS);
            MRG[(size_t)t * 1024 + 512 + w * 64 + l31] = (bf16)f2bf(a0[t] * rb * gb0); MRG[(size_t)t * 1024 + 512 + w * 64 + 32 + l31] = (bf16)f2bf(a1[t] * rb * gb1);
            BO[(size_t)t * 512 + w * 64 + l31] = (bf16)f2bf(a0[t]); BO[(size_t)t * 512 + w * 64 + 32 + l31] = (bf16)f2bf(a1[t]); }
    }
    __syncthreads();
}
static_assert(TP % (4 * 256 * NWAVES) == 0, "b_out norm loop: four rows per wave iteration");
__device__ __forceinline__ void p6_merge(Frame& F) {
#ifdef MK_TIMING
    unsigned long long* st_ = (unsigned long long*)(F.ws + WS_CTL + (768 << 10)) + F.bid * 32;
#define P6ST(k) do { if (F.tid == 0) st_[k] = __builtin_amdgcn_s_memrealtime(); } while (0)
#else
#define P6ST(k) do {} while (0)
#endif
    { const int u = F.bid; if (u < 128) { P6ST(24); p6_gmlp_chunk(F, u); P6ST(25); } else { P6ST(26); p6_sample_seq(F, u - 128); P6ST(27); } }
    P6ST(28);
    const int gw = F.bid * NWAVES + F.wave, NGW = F.G * NWAVES, lane = F.lane;
    const f32x4 g0 = *(const f32x4*)(F.inf(I_GOB) + 8 * lane), g1 = *(const f32x4*)(F.inf(I_GOB) + 8 * lane + 4);
    for (int r0 = gw; r0 < TP; r0 += 4 * NGW) {
        v4u raws[4];
#pragma unroll
        for (int k = 0; k < 4; ++k) raws[k] = *(const v4u*)(F.w<bf16>(WS_BO) + (size_t)(r0 + k * NGW) * 512 + 8 * lane);
#pragma unroll
        for (int k = 0; k < 4; ++k) { const int r = r0 + k * NGW; const v4u raw = raws[k];
        float x[8];
#pragma unroll
        for (int i = 0; i < 4; ++i) { x[2 * i] = bflo(raw[i]); x[2 * i + 1] = bfhi(raw[i]); }
        float ss = 0.f;
#pragma unroll
        for (int i = 0; i < 8; ++i) ss += x[i] * x[i];
        const float rstd = rsqrtf(wave_sum(ss) * (1.f / 512.f) + EPS);
        v4u o; o.x = pk2(x[0] * rstd * g0[0], x[1] * rstd * g0[1]); o.y = pk2(x[2] * rstd * g0[2], x[3] * rstd * g0[3]); o.z = pk2(x[4] * rstd * g1[0], x[5] * rstd * g1[1]); o.w = pk2(x[6] * rstd * g1[2], x[7] * rstd * g1[3]);
        *(v4u*)(F.w<bf16>(WS_MRG) + (size_t)r * 1024 + 512 + 8 * lane) = o;
        }
    }
    P6ST(29);
}
}
namespace mk {
__device__ __forceinline__ void rms_rowb_finish(const v4u a, const v4u b, const f32x4 g0, const f32x4 g1, const f32x4 g2, const f32x4 g3, bf16* orow, int lane) {
    float x[16];
#pragma unroll
    for (int i = 0; i < 4; ++i) { x[2 * i] = bflo(a[i]); x[2 * i + 1] = bfhi(a[i]); x[8 + 2 * i] = bflo(b[i]); x[8 + 2 * i + 1] = bfhi(b[i]); }
    float s = 0.f;
#pragma unroll
    for (int i = 0; i < 16; ++i) s += x[i] * x[i];
    const float rstd = rsqrtf(wave_sum(s) * (1.f / 1024.f) + EPS);
    v4u o0, o1;
    o0.x = pk2(x[0] * rstd * g0[0], x[1] * rstd * g0[1]); o0.y = pk2(x[2] * rstd * g0[2], x[3] * rstd * g0[3]); o0.z = pk2(x[4] * rstd * g1[0], x[5] * rstd * g1[1]); o0.w = pk2(x[6] * rstd * g1[2], x[7] * rstd * g1[3]);
    o1.x = pk2(x[8] * rstd * g2[0], x[9] * rstd * g2[1]); o1.y = pk2(x[10] * rstd * g2[2], x[11] * rstd * g2[3]); o1.z = pk2(x[12] * rstd * g3[0], x[13] * rstd * g3[1]); o1.w = pk2(x[14] * rstd * g3[2], x[15] * rstd * g3[3]);
    *(v4u*)(orow + 8 * lane) = o0; *(v4u*)(orow + 512 + 8 * lane) = o1;
}
__device__ __forceinline__ void p_rms_rows(Frame& F, size_t src_off, int gain_idx, size_t dst_off) {
    const int gw = F.bid * NWAVES + F.wave, NGW = F.G * NWAVES, lane = F.lane;
    const float* g = F.inf(gain_idx);
    const f32x4 g0 = *(const f32x4*)(g + 8 * lane), g1 = *(const f32x4*)(g + 8 * lane + 4), g2 = *(const f32x4*)(g + 512 + 8 * lane), g3 = *(const f32x4*)(g + 512 + 8 * lane + 4);
    const bf16* src = F.w<bf16>(src_off); bf16* dst = F.w<bf16>(dst_off);
    for (int r = gw; r < T; r += 4 * NGW) {
        v4u a[4], b[4];
#pragma unroll
        for (int k = 0; k < 4; ++k) { const int rr = r + k * NGW; if (rr < T) { a[k] = *(const v4u*)(src + (size_t)rr * D + 8 * lane); b[k] = *(const v4u*)(src + (size_t)rr * D + 512 + 8 * lane); } }
#pragma unroll
        for (int k = 0; k < 4; ++k) { const int rr = r + k * NGW; if (rr < T) rms_rowb_finish(a[k], b[k], g0, g1, g2, g3, dst + (size_t)rr * D, lane); }
    }
}

constexpr int MA_KROW = 272, MA_VROW = 528, MA_K = 0, MA_V = 256 * MA_KROW;
static_assert(MA_V + 128 * MA_VROW <= RING_BYTES, "memory attention LDS");
__device__ __forceinline__ void memattn_prompt_unit(Frame& F, int pb, int h, float negM) {
    const int tid = F.tid, lane = F.lane, l31 = lane & 31, hh = lane >> 5;
    const int b = pb >> 3, row = 256 * pb + 32 * F.wave + l31;
    LAS unsigned char* L = F.lds;
    {
        const bf16* Kg = F.w<bf16>(WS_MK) + (size_t)(b * 256) * 512 + h * 128;
        const bf16* Vg = F.w<bf16>(WS_MVT) + (size_t)(b * 4 + h) * 128 * 256;
        v4u kr[8], vr[8];
#pragma unroll
        for (int i = 0; i < 8; ++i) { const int ch = tid + 512 * i; kr[i] = *(const v4u*)(Kg + (size_t)(ch >> 4) * 512 + 8 * (ch & 15)); vr[i] = *(const v4u*)(Vg + (size_t)(ch >> 5) * 256 + 8 * (ch & 31)); }
#pragma unroll
        for (int i = 0; i < 8; ++i) { const int ch = tid + 512 * i; *(LAS v4u*)(L + MA_K + (ch >> 4) * MA_KROW + 16 * (ch & 15)) = kr[i]; *(LAS v4u*)(L + MA_V + (ch >> 5) * MA_VROW + 16 * (ch & 31)) = vr[i]; }
    }
    const bf16* Qp = F.w<bf16>(WS_MQ) + (size_t)row * 512 + h * 128 + 8 * hh;
    const float* g = F.inf(I_GMQ) + 8 * hh;
    bf16x8 qf[8];
    {
        v4u raw[8]; float ss = 0.f;
#pragma unroll
        for (int ks = 0; ks < 8; ++ks) { raw[ks] = *(const v4u*)(Qp + 16 * ks);
#pragma unroll
            for (int i = 0; i < 4; ++i) { const float a = bflo(raw[ks][i]), c = bfhi(raw[ks][i]); ss += a * a + c * c; } }
        ss += __shfl_xor(ss, 32);
        const float rs = rsqrtf(ss * (1.f / 128.f) + EPS) * MQSCALE;
#pragma unroll
        for (int ks = 0; ks < 8; ++ks) { const f32x4 g0 = *(const f32x4*)(g + 16 * ks), g1 = *(const f32x4*)(g + 16 * ks + 4); v4u o;
            o.x = cvtpk(bflo(raw[ks][0]) * rs * g0[0], bfhi(raw[ks][0]) * rs * g0[1]); o.y = cvtpk(bflo(raw[ks][1]) * rs * g0[2], bfhi(raw[ks][1]) * rs * g0[3]);
            o.z = cvtpk(bflo(raw[ks][2]) * rs * g1[0], bfhi(raw[ks][2]) * rs * g1[1]); o.w = cvtpk(bflo(raw[ks][3]) * rs * g1[2], bfhi(raw[ks][3]) * rs * g1[3]);
            qf[ks] = __builtin_bit_cast(bf16x8, o); }
    }
    __syncthreads();
    f32x16 o[4]; o[0] = f32x16{}; o[1] = f32x16{}; o[2] = f32x16{}; o[3] = f32x16{};
    float l = 0.f;
    const LAS unsigned char* Kp = L + MA_K + l31 * MA_KROW + 16 * hh;
    const LAS unsigned char* Vp = L + MA_V + l31 * MA_VROW + 8 * hh;
#pragma unroll 1
    for (int kt = 0; kt < 8; ++kt) {
        f32x16 s = {};
#pragma unroll
        for (int ks = 0; ks < 8; ++ks) { const bf16x8 kf = *(const LAS bf16x8*)(Kp + kt * 32 * MA_KROW + 32 * ks); s = __builtin_amdgcn_mfma_f32_32x32x16_bf16(kf, qf[ks], s, 0, 0, 0); }
        float p[16];
#pragma unroll
        for (int i = 0; i < 16; ++i) { p[i] = __builtin_amdgcn_exp2f(s[i] + negM); l += p[i]; }
        bf16x8 pb2[2];
#pragma unroll
        for (int s2 = 0; s2 < 2; ++s2) { v4u w; w.x = cvtpk(p[8 * s2 + 0], p[8 * s2 + 1]); w.y = cvtpk(p[8 * s2 + 2], p[8 * s2 + 3]); w.z = cvtpk(p[8 * s2 + 4], p[8 * s2 + 5]); w.w = cvtpk(p[8 * s2 + 6], p[8 * s2 + 7]); pb2[s2] = __builtin_bit_cast(bf16x8, w); }
#pragma unroll
        for (int dt = 0; dt < 4; ++dt)
#pragma unroll
            for (int s2 = 0; s2 < 2; ++s2) { const LAS unsigned char* vp = Vp + dt * 32 * MA_VROW + (kt * 32 + 16 * s2) * 2; const s16x4 lo = *(const LAS s16x4*)vp, hi = *(const LAS s16x4*)(vp + 16);
                const bf16x8 va = (bf16x8){lo[0], lo[1], lo[2], lo[3], hi[0], hi[1], hi[2], hi[3]};
                o[dt] = __builtin_amdgcn_mfma_f32_32x32x16_bf16(va, pb2[s2], o[dt], 0, 0, 0); }
    }
    l += __shfl_xor(l, 32);
    const float rl = 1.f / l;
    bf16* Op = F.w<bf16>(WS_MO) + (size_t)row * 512 + h * 128 + 4 * hh;
#pragma unroll
    for (int dt = 0; dt < 4; ++dt)
#pragma unroll
        for (int gq = 0; gq < 4; ++gq) { v2u w0; w0.x = cvtpk(o[dt][4 * gq] * rl, o[dt][4 * gq + 1] * rl); w0.y = cvtpk(o[dt][4 * gq + 2] * rl, o[dt][4 * gq + 3] * rl);
            *(v2u*)(Op + 32 * dt + 8 * gq) = w0; }
    __syncthreads();
}
__device__ __forceinline__ void memattn_sample_wg(Frame& F, int U) {
    const int lane = F.lane, l31 = lane & 31, hh = lane >> 5, pair = F.wave >> 2, kq = F.wave & 3;
    const int sh = 2 * U + pair, s = sh >> 2, h = sh & 3;
    LAS float* SC = (LAS float*)(F.lds + pair * 4096);
    LAS float* OP = (LAS float*)(F.lds + 8192 + pair * 8192);
    f32x4 q[4];
    { const f32x4 g = *(const f32x4*)(F.inf(I_GMQ) + 4 * l31);
#pragma unroll
      for (int t = 0; t < 4; ++t) { const v2u raw = *(const v2u*)(F.w<bf16>(WS_MQ) + (size_t)(TP + 4 * s + t) * 512 + h * 128 + 4 * l31);
          f32x4 x = (f32x4){bflo(raw.x), bfhi(raw.x), bflo(raw.y), bfhi(raw.y)};
          float ss = (x[0] * x[0] + x[1] * x[1]) + (x[2] * x[2] + x[3] * x[3]);
          ss = dpp_sum16(ss); ss += __shfl_xor(ss, 16);
          const float rs = rsqrtf(ss * (1.f / 128.f) + EPS) * 0.08838834764831845f;
          q[t] = x * rs * g; } }
    const size_t cbase = ((size_t)(s * 256 + 64 * kq) * 4 + h) * 128 + 4 * l31;
    const float* Kc = F.inf(I_CMK) + cbase; const float* Vc = F.inf(I_CMV) + cbase;
    const bool b4 = (l31 & 16) != 0, b3 = (l31 & 8) != 0, b2 = (l31 & 4) != 0, b1 = (l31 & 2) != 0;
#pragma unroll 1
    for (int kp = 0; kp < 32; kp += 16) {
        f32x4 kv[16];
#pragma unroll
        for (int u = 0; u < 16; ++u) kv[u] = __builtin_nontemporal_load((const f32x4*)(Kc + (size_t)(2 * (kp + u) + hh) * 512));
#pragma unroll
        for (int t = 0; t < 4; ++t) {
            float pt[16], v8[8], v4[4], v2[2];
#pragma unroll
            for (int u = 0; u < 16; ++u) pt[u] = (kv[u][0] * q[t][0] + kv[u][1] * q[t][1]) + (kv[u][2] * q[t][2] + kv[u][3] * q[t][3]);
#pragma unroll
            for (int i = 0; i < 8; ++i) { const float send = b4 ? pt[i] : pt[8 + i], keep = b4 ? pt[8 + i] : pt[i]; v8[i] = keep + __shfl_xor(send, 16); }
#pragma unroll
            for (int i = 0; i < 4; ++i) { const float send = b3 ? v8[i] : v8[4 + i], keep = b3 ? v8[4 + i] : v8[i]; v4[i] = keep + __shfl_xor(send, 8); }
#pragma unroll
            for (int i = 0; i < 2; ++i) { const float send = b2 ? v4[i] : v4[2 + i], keep = b2 ? v4[2 + i] : v4[i]; v2[i] = keep + __shfl_xor(send, 4); }
            float v1; { const float send = b1 ? v2[0] : v2[1], keep = b1 ? v2[1] : v2[0]; v1 = keep + __shfl_xor(send, 2); }
            v1 += __shfl_xor(v1, 1);
            if ((l31 & 1) == 0) SC[t * 256 + 64 * kq + 2 * (kp + (l31 >> 1)) + hh] = v1;
        }
    }
    f32x4 vv[16];
#pragma unroll
    for (int u = 0; u < 16; ++u) vv[u] = __builtin_nontemporal_load((const f32x4*)(Vc + (size_t)(2 * u + hh) * 512));
    __syncthreads();
    LAS float* PS = (LAS float*)(F.lds + 24576 + pair * 4096);
    float rsum[4];
#pragma unroll
    for (int t = 0; t < 4; ++t) {
        const f32x4 sc = *(const LAS f32x4*)(SC + t * 256 + 4 * lane);
        float m = fmaxf(fmaxf(sc[0], sc[1]), fmaxf(sc[2], sc[3]));
#pragma unroll
        for (int o = 1; o < 64; o <<= 1) m = fmaxf(m, __shfl_xor(m, o));
        f32x4 e; float sum = 0.f;
#pragma unroll
        for (int i = 0; i < 4; ++i) { e[i] = __expf(sc[i] - m); sum += e[i]; }
        *(LAS f32x4*)(PS + t * 256 + 4 * lane) = e;
        rsum[t] = 1.f / wave_sum(sum);
    }
    LDS_WAIT(); asm volatile("" ::: "memory");
    f32x4 o[4]; o[0] = o[1] = o[2] = o[3] = (f32x4){0.f, 0.f, 0.f, 0.f};
#pragma unroll 1
    for (int kp = 0; kp < 32; kp += 16) {
#pragma unroll
        for (int u = 0; u < 16; ++u)
#pragma unroll
            for (int t = 0; t < 4; ++t) { const float p = PS[t * 256 + 64 * kq + 2 * (kp + u) + hh]; o[t] += vv[u] * p; }
        if (kp + 16 < 32) {
#pragma unroll
            for (int u = 0; u < 16; ++u) vv[u] = __builtin_nontemporal_load((const f32x4*)(Vc + (size_t)(2 * (kp + 16 + u) + hh) * 512));
        }
    }
#pragma unroll
    for (int t = 0; t < 4; ++t) {
#pragma unroll
        for (int i = 0; i < 4; ++i) o[t][i] += __shfl_xor(o[t][i], 32);
        if (hh == 0) *(LAS f32x4*)(OP + (kq * 4 + t) * 128 + 4 * l31) = o[t];
    }
    __syncthreads();
    {
        const int t = kq;
        float a0 = 0.f, a1 = 0.f;
#pragma unroll
        for (int k = 0; k < 4; ++k) { a0 += OP[(k * 4 + t) * 128 + 2 * lane]; a1 += OP[(k * 4 + t) * 128 + 2 * lane + 1]; }
        float rs = rsum[0]; rs = (t == 1) ? rsum[1] : rs; rs = (t == 2) ? rsum[2] : rs; rs = (t == 3) ? rsum[3] : rs;
        *(unsigned*)(F.w<bf16>(WS_MO) + (size_t)(TP + 4 * s + t) * 512 + h * 128 + 2 * lane) = cvtpk(a0 * rs, a1 * rs);
    }
    __syncthreads();
}
__device__ __forceinline__ void p10_memattn(Frame& F) {
    const float negM = -(LOG2E * 11.313708498984761f * gain_absmax(F.inf(I_GMQ), 128, F.lane) * gain_absmax(F.inf(I_GMK), 128, F.lane) * 1.01f);
    const int gw = F.bid * NWAVES + F.wave, NGW = F.G * NWAVES;
#pragma unroll 1
    for (int pass = 0; pass < 2; ++pass) {
        F.tid = opaque_i(F.tid); F.lane = F.tid & 63;
        if ((pass == 0) == (((F.bid >> 3) & 1) == 0)) memattn_prompt_unit(F, F.bid >> 2, F.bid & 3, negM);
        else memattn_sample_wg(F, F.bid);
    }
}

__device__ __forceinline__ void p15_pre(Frame& F, int pm) {
    const float* wc = F.inf(I_WCONV); const float* bc = F.inf(I_BCONV);
    {
        const bf16* UPS = F.w<bf16>(WS_UP); const float* st = F.inf(I_CONVST);
        for (int it = F.bid * 512 + F.tid; it < TSMP * 352; it += F.G * 512) {
            const int rs = it / 352, ch = it % 352, f = 8 * ch, t = rs & 3, n = rs >> 2;
            const int cg = 256 * (f >> 7) + (f & 127);
            float g0[8], g1[8], g2[8], vv[8];
            { const v4u a = *(const v4u*)(UPS + (size_t)rs * (2 * DFF) + cg), v = *(const v4u*)(UPS + (size_t)rs * (2 * DFF) + cg + 128);
#pragma unroll
              for (int i = 0; i < 4; ++i) { g0[2 * i] = bflo(a[i]); g0[2 * i + 1] = bfhi(a[i]); vv[2 * i] = bflo(v[i]); vv[2 * i + 1] = bfhi(v[i]); } }
            if (t >= 1) { const v4u a = *(const v4u*)(UPS + (size_t)(rs - 1) * (2 * DFF) + cg);
#pragma unroll
                for (int i = 0; i < 4; ++i) { g1[2 * i] = bflo(a[i]); g1[2 * i + 1] = bfhi(a[i]); } }
            else { const float* sp = st + (size_t)(n * 2 + 1) * DFF + f; const f32x4 a = *(const f32x4*)sp, b = *(const f32x4*)(sp + 4);
#pragma unroll
                for (int i = 0; i < 4; ++i) { g1[i] = a[i]; g1[4 + i] = b[i]; } }
            if (t >= 2) { const v4u a = *(const v4u*)(UPS + (size_t)(rs - 2) * (2 * DFF) + cg);
#pragma unroll
                for (int i = 0; i < 4; ++i) { g2[2 * i] = bflo(a[i]); g2[2 * i + 1] = bfhi(a[i]); } }
            else { const float* sp = st + (size_t)(n * 2 + t) * DFF + f; const f32x4 a = *(const f32x4*)sp, b = *(const f32x4*)(sp + 4);
#pragma unroll
                for (int i = 0; i < 4; ++i) { g2[i] = a[i]; g2[4 + i] = b[i]; } }
            float hv[8];
#pragma unroll
            for (int i = 0; i < 8; ++i) { const float c = bc[f + i] + g2[i] * wc[f + i] + g1[i] * wc[DFF + f + i] + g0[i] * wc[2 * DFF + f + i]; hv[i] = c / (1.f + __expf(-c)) * vv[i]; }
            v4u o; o.x = cvtpk(hv[0], hv[1]); o.y = cvtpk(hv[2], hv[3]); o.z = cvtpk(hv[4], hv[5]); o.w = cvtpk(hv[6], hv[7]);
            *(v4u*)(F.w<bf16>(WS_HID) + (size_t)(TP + rs) * DFF + f) = o;
            if (t >= 2) { float* co = F.out + O_SCONV + (size_t)(n * 2 + (t - 2)) * DFF + f; *(f32x4*)co = (f32x4){g0[0], g0[1], g0[2], g0[3]}; *(f32x4*)(co + 4) = (f32x4){g0[4], g0[5], g0[6], g0[7]}; }
        }
    }
    if ((pm & 7) != 0) {
        const bf16* R0 = F.w<bf16>(WS_RAW01) + (size_t)pm * 2 * (2 * DFF); const float* G = F.w<float>(WS_RAWG) + (size_t)(pm - 1) * 2 * DFF;
        if (F.tid < DFF / 8) {
            const int f = 8 * F.tid;
            const v4u rg0 = *(const v4u*)(R0 + f), rv0 = *(const v4u*)(R0 + DFF + f), rg1 = *(const v4u*)(R0 + 2 * DFF + f), rv1 = *(const v4u*)(R0 + 3 * DFF + f);
            float hv0[8], hv1[8];
#pragma unroll
            for (int q = 0; q < 2; ++q) {
                const f32x4 gm2 = *(const f32x4*)(G + f + 4 * q), gm1 = *(const f32x4*)(G + DFF + f + 4 * q);
                const f32x4 w0 = *(const f32x4*)(wc + f + 4 * q), w1 = *(const f32x4*)(wc + DFF + f + 4 * q), w2 = *(const f32x4*)(wc + 2 * DFF + f + 4 * q), b = *(const f32x4*)(bc + f + 4 * q);
#pragma unroll
                for (int e = 0; e < 4; ++e) { const int i = 4 * q + e; const unsigned wg0 = rg0[i >> 1], wv0 = rv0[i >> 1], wg1 = rg1[i >> 1], wv1 = rv1[i >> 1];
                    const float g0 = (i & 1) ? bfhi(wg0) : bflo(wg0), v0 = (i & 1) ? bfhi(wv0) : bflo(wv0), g1 = (i & 1) ? bfhi(wg1) : bflo(wg1), v1 = (i & 1) ? bfhi(wv1) : bflo(wv1);
                    const float c0 = b[e] + gm2[e] * w0[e] + gm1[e] * w1[e] + g0 * w2[e], c1 = b[e] + gm1[e] * w0[e] + g0 * w1[e] + g1 * w2[e];
                    hv0[i] = c0 / (1.f + __expf(-c0)) * v0; hv1[i] = c1 / (1.f + __expf(-c1)) * v1; }
            }
            v4u o0, o1; o0.x = cvtpk(hv0[0], hv0[1]); o0.y = cvtpk(hv0[2], hv0[3]); o0.z = cvtpk(hv0[4], hv0[5]); o0.w = cvtpk(hv0[6], hv0[7]);
            o1.x = cvtpk(hv1[0], hv1[1]); o1.y = cvtpk(hv1[2], hv1[3]); o1.z = cvtpk(hv1[4], hv1[5]); o1.w = cvtpk(hv1[6], hv1[7]);
            *(v4u*)(F.w<bf16>(WS_HID) + (size_t)(256 * pm) * DFF + f) = o0; *(v4u*)(F.w<bf16>(WS_HID) + (size_t)(256 * pm + 1) * DFF + f) = o1;
        }
    }
    VM_WAIT();
    __syncthreads();
}
}
namespace mk {
template <int K, bool RES_BF16, bool OUT_BF16, bool HAS_RES = true>
__device__ __forceinline__ void small_gemm_unit(Frame& F, const bf16* A, const bf16* Bt, int rbk, int cbk, const void* res, void* out, int ldc, float* ssq_out = nullptr, const float* ssq_in = nullptr) {
    static_assert(K % 64 == 0, "K in chunks of 64");
    constexpr int NCH = K / 64;
    const int lane = F.lane, w = F.wave, l31 = lane & 31, hh = lane >> 5, tid = F.tid, lr = lane >> 3, lc = lane & 7;
    LAS unsigned char* Tl = F.lds + w * 16384;
    const bf16* Ag = A + (size_t)(32 * rbk + lr) * K + 8 * lc;
    const bf16* Bg = Bt + (size_t)(64 * cbk + lr) * K + 8 * lc;
    f32x16 a0 = {}, a1 = {};
    v4u ra[4], rbv[8];
    int c = w;
    if (c < NCH) {
#pragma unroll
        for (int j = 0; j < 4; ++j) ra[j] = *(const v4u*)(Ag + (size_t)(8 * j) * K + 64 * c);
#pragma unroll
        for (int j = 0; j < 8; ++j) rbv[j] = *(const v4u*)(Bg + (size_t)(8 * j) * K + 64 * c);
    }
#pragma unroll 1
    for (; c < NCH; c += 8) {
#pragma unroll
        for (int j = 0; j < 4; ++j) *(LAS v4u*)(Tl + (lr + 8 * j) * 144 + 16 * lc) = ra[j];
#pragma unroll
        for (int j = 0; j < 8; ++j) *(LAS v4u*)(Tl + (32 + lr + 8 * j) * 144 + 16 * lc) = rbv[j];
        LDS_WAIT(); asm volatile("" ::: "memory");
        if (c + 8 < NCH) {
#pragma unroll
            for (int j = 0; j < 4; ++j) ra[j] = *(const v4u*)(Ag + (size_t)(8 * j) * K + 64 * (c + 8));
#pragma unroll
            for (int j = 0; j < 8; ++j) rbv[j] = *(const v4u*)(Bg + (size_t)(8 * j) * K + 64 * (c + 8));
        }
#pragma unroll
        for (int s = 0; s < 4; ++s) {
            const bf16x8 af = *(const LAS bf16x8*)(Tl + l31 * 144 + 32 * s + 16 * hh), b0 = *(const LAS bf16x8*)(Tl + (32 + l31) * 144 + 32 * s + 16 * hh), b1 = *(const LAS bf16x8*)(Tl + (64 + l31) * 144 + 32 * s + 16 * hh);
            a0 = __builtin_amdgcn_mfma_f32_32x32x16_bf16(af, b0, a0, 0, 0, 0); a1 = __builtin_amdgcn_mfma_f32_32x32x16_bf16(af, b1, a1, 0, 0, 0);
        }
        LDS_WAIT(); asm volatile("" ::: "memory");
    }
    __syncthreads();
    LAS float* RED = (LAS float*)F.lds + w * 2048;
#pragma unroll
    for (int i = 0; i < 16; ++i) { const int r = (i & 3) + 8 * (i >> 2) + 4 * hh; RED[r * 64 + l31] = a0[i]; RED[r * 64 + 32 + l31] = a1[i]; }
    __syncthreads();
    { const int r = tid >> 4, c4 = (tid & 15) * 4; const size_t off = (size_t)(32 * rbk + r) * ldc + 64 * cbk + c4;
      f32x4 sum;
      if (!HAS_RES) sum = (f32x4){0.f, 0.f, 0.f, 0.f}; else if (RES_BF16) { const v2u rw = *(const v2u*)((const bf16*)res + off); sum = (f32x4){bflo(rw.x), bfhi(rw.x), bflo(rw.y), bfhi(rw.y)}; } else sum = *(const f32x4*)((const float*)res + off);
#pragma unroll
      for (int k = 0; k < 8; ++k) sum += *(const LAS f32x4*)((LAS float*)F.lds + k * 2048 + r * 64 + c4);
      if (ssq_in) { float t = ssq_in[(size_t)(32 * rbk + r) * 16 + (tid & 15)]; t += __shfl_xor(t, 1); t += __shfl_xor(t, 2); t += __shfl_xor(t, 4); t += __shfl_xor(t, 8); sum = sum * rsqrtf(t * (1.f / 1024.f) + EPS); }
      if (ssq_out) { float s2 = (sum[0] * sum[0] + sum[1] * sum[1]) + (sum[2] * sum[2] + sum[3] * sum[3]); s2 += __shfl_xor(s2, 1); s2 += __shfl_xor(s2, 2); s2 += __shfl_xor(s2, 4); s2 += __shfl_xor(s2, 8);
          if ((tid & 15) == 0) ssq_out[(size_t)(32 * rbk + r) * 16 + cbk] = s2; }
      if (OUT_BF16) { v2u wb; wb.x = cvtpk(sum[0], sum[1]); wb.y = cvtpk(sum[2], sum[3]); *(v2u*)((bf16*)out + off) = wb; } else *(f32x4*)((float*)out + off) = sum; }
    __syncthreads();
}
}
namespace mk {
constexpr int N_PHASES = 16;
__global__ void __launch_bounds__(NWAVES * 64, 2) mk_fwd(Args args) {
    extern __shared__ __attribute__((aligned(16))) unsigned char lds[];
    Frame F;
    F.lds = (LAS unsigned char*)lds; F.lds_g = lds;
    F.tid = threadIdx.x; F.lane = F.tid & 63; F.wave = __builtin_amdgcn_readfirstlane(F.tid >> 6);
    F.G = gridDim.x; F.bid = blockIdx.x;
    F.ws = args.ws; F.out = args.out; F.in = (const float* const*)args.in;
    volatile LAS unsigned* MISC = (volatile LAS unsigned*)(F.lds + MISC_OFF);
    for (int u = F.tid; u < (LDS_BYTES - RING_BYTES) / 4; u += NWAVES * 64) ((LAS unsigned*)(F.lds + RING_BYTES))[u] = 0u;
    __syncthreads();
    unsigned* ctl = (unsigned*)(F.ws + WS_CTL);
    XcdBarrier bar = xcd_barrier_post(ctl + CW_BAR, MISC + 8);
    const int lo = args.ph_lo, hi = args.ph_hi;
    if (F.G != 256) return;
#define IN(k) (lo <= (k) && (k) < hi)
#ifdef MK_TIMING
    unsigned long long* stamps = (unsigned long long*)(F.ws + WS_CTL + (768 << 10));
#define STAMP(k) do { if (F.tid == 0) stamps[F.bid * 32 + (k)] = __builtin_amdgcn_s_memrealtime(); } while (0)
#else
#define STAMP(k) do {} while (0)
#endif
#define SEAM(k) do { if (IN(k) && IN((k) + 1)) xcd_barrier(bar); STAMP((k) + 1); F.tid = opaque_i(F.tid); F.lane = F.tid & 63; } while (0)
    STAMP(0);

    if (IN(0)) { p0_prologue(F); }
    SEAM(0);
    if (IN(1)) {
        { pg8::Gemm g{F.w<bf16>(WS_XN), F.w<bf16>(WS_W_IN), T, NINP, D}; pg8::StaticOrder S; S.init(T, NINP, F.G, F.bid);
          pg8::EpiBf16 E{F.w<bf16>(WS_Z), NINP, 1.f};
          pg8::gemm_phase<pg8::EpiBf16, pg8::StaticOrder, true, true>(F.lds, g, S, E); }
        { pg8::Gemm g{F.w<bf16>(WS_MN), F.w<bf16>(WS_W_MKV), 2048, 1024, D}; pg8::StaticOrder S; S.init(2048, 1024, F.G, (F.bid + F.G - 206) % F.G);
          pg8::EpiBf16 E{F.w<bf16>(WS_MKV), 1024, 1.f};
          pg8::gemm_phase<pg8::EpiBf16, pg8::StaticOrder, true, true>(F.lds, g, S, E); }
    }
    SEAM(1);
    if (IN(2)) { p2_post_inproj(F); }
    SEAM(2);
    if (IN(3)) {
        { pg8::Gemm g{F.w<bf16>(WS_CQN), F.w<bf16>(WS_W_UQ), T, 768, 256}; pg8::StaticOrder S; S.init(T, 768, F.G, F.bid);
          pg8::EpiBf16 E{F.w<bf16>(WS_QR), 768, 1.f};
          pg8::gemm_phase<pg8::EpiBf16, pg8::StaticOrder, true, true>(F.lds, g, S, E); }
        { pg8::Gemm g{F.w<bf16>(WS_CKVN), F.w<bf16>(WS_W_UK), TP, 512, 256}; pg8::StaticOrder S; S.init(TP, 512, F.G, (F.bid + F.G - 198) % F.G);
          pg8::EpiBf16 E{F.w<bf16>(WS_KNR), 512, 1.f};
          pg8::gemm_phase<pg8::EpiBf16, pg8::StaticOrder, true, true>(F.lds, g, S, E); }
        { pg8::Gemm g{F.w<bf16>(WS_W_UV), F.w<bf16>(WS_CKVN), 512, TP, 256}; pg8::StaticOrder S; S.init(512, TP, F.G, (F.bid + F.G - 70) % F.G);
          pg8::EpiBf16 E{F.w<bf16>(WS_VT), TP, 1.f};
          pg8::gemm_phase<pg8::EpiBf16, pg8::StaticOrder, true, true>(F.lds, g, S, E); }
    }
    SEAM(3);
    if (IN(4)) { p4_qk_norm_rope(F); p4_qext(F); }
    SEAM(4);
    if (IN(5)) {
        const float mq_ = gain_absmax(F.inf(I_GQKQ), 96, F.lane), mk2_ = gain_absmax(F.inf(I_GQKK), 96, F.lane);
        const float negM = -(LOG2E * 9.797958971132712f * mq_ * mk2_ * 1.01f);
#pragma unroll 1
        for (int pass = 0; pass < 3; ++pass) {
            F.tid = opaque_i(F.tid); F.lane = F.tid & 63;
            if (pass == 1) { STAMP(20); attn_sample_unit(F, F.bid >> 1, F.bid & 1, negM); STAMP(21); }
            else if ((pass == 0) == (((F.bid >> 3) & 1) != 0)) { STAMP(22); p5_attn_prompt(F, negM); STAMP(23); }
        }
    }
    SEAM(5);
    if (IN(6)) { p6_merge(F); }
    SEAM(6);
    if (IN(7)) { pg8::Gemm g{F.w<bf16>(WS_MRG), F.w<bf16>(WS_W_O), TP, 1024, 1024}; pg8::StaticOrder S; S.init(TP, 1024, F.G, F.bid);
        pg8::EpiResN<false> E{F.inf(I_XP), F.inf(I_XS), TP / 256, F.w<bf16>(WS_X1), F.w<float>(WS_SSQ1), 1024};
        pg8::gemm_phase<pg8::EpiResN<false>, pg8::StaticOrder, true, true>(F.lds, g, S, E);
        small_gemm_unit<1024, false, true>(F, F.w<bf16>(WS_MRG) + (size_t)TP * 1024, F.w<bf16>(WS_W_O), F.bid >> 4, F.bid & 15, F.inf(I_XS), F.w<bf16>(WS_X1) + (size_t)TP * 1024, 1024, F.w<float>(WS_SSQ1) + (size_t)TP * 16); }
    SEAM(7);
    STAMP(9);
    if (IN(9)) { pg8::Gemm g{F.w<bf16>(WS_X1), F.w<bf16>(WS_W_MQ), T, 512, 1024}; pg8::StaticOrder S; S.init(T, 512, F.G, F.bid);
        pg8::EpiBf16S E{F.w<bf16>(WS_MQ), 512, F.w<float>(WS_SSQ1), EPS};
        pg8::gemm_phase<pg8::EpiBf16S, pg8::StaticOrder, true, true>(F.lds, g, S, E);
        if (F.bid >= 132) p0_transposes<9, 11>(F, (F.bid - 132) * NWAVES + F.wave, (F.G - 132) * NWAVES); }
    SEAM(9);
    if (IN(10)) { p10_memattn(F); }
    SEAM(10);
    if (IN(11)) { pg8::Gemm g{F.w<bf16>(WS_MO), F.w<bf16>(WS_W_MO), TP, 1024, 512}; pg8::StaticOrder S; S.init(TP, 1024, F.G, F.bid);
        pg8::EpiResN<true> E{F.w<bf16>(WS_X1), F.w<bf16>(WS_X1), 1 << 20, F.w<bf16>(WS_X2), F.w<float>(WS_SSQ2), 1024};
        pg8::gemm_phase<pg8::EpiResN<true>, pg8::StaticOrder, true, true>(F.lds, g, S, E);
        small_gemm_unit<512, true, true>(F, F.w<bf16>(WS_MO) + (size_t)TP * 512, F.w<bf16>(WS_W_MO), F.bid >> 4, F.bid & 15, F.w<bf16>(WS_X1) + (size_t)TP * 1024, F.w<bf16>(WS_X2) + (size_t)TP * 1024, 1024, F.w<float>(WS_SSQ2) + (size_t)TP * 16); }
    SEAM(11);
    STAMP(12); STAMP(13);
    if (IN(13)) { pg8::Gemm g{F.w<bf16>(WS_X2), F.w<bf16>(WS_W_UP), TP, 2 * DFF, 1024}; pg8::StaticOrder S; S.init(TP, 2 * DFF, F.G, F.bid);
        pg8::EpiUpFused E{F.w<bf16>(WS_HID), F.inf(I_WCONV), F.inf(I_BCONV), F.w<bf16>(WS_RAW01), F.w<float>(WS_RAWG), F.out + O_PCONV, (LAS float*)(F.lds + 131072), DFF, (const LAS float*)(F.lds + 135168)};
        { LAS float* rt = (LAS float*)(F.lds + 135168); const float* sq = F.w<float>(WS_SSQ2) + (size_t)(F.bid & 7) * 2048 * 16;
          f32x4 p[4][4];
#pragma unroll
          for (int k = 0; k < 4; ++k)
#pragma unroll
              for (int q = 0; q < 4; ++q) p[k][q] = *(const f32x4*)(sq + (size_t)(F.tid + 512 * k) * 16 + 4 * q);
#pragma unroll
          for (int k = 0; k < 4; ++k) { const f32x4 t = (p[k][0] + p[k][1]) + (p[k][2] + p[k][3]); rt[F.tid + 512 * k] = rsqrtf(((t[0] + t[1]) + (t[2] + t[3])) * (1.f / 1024.f) + EPS); }
          __syncthreads(); }
        pg8::gemm_phase<pg8::EpiUpFused, pg8::StaticOrder, true, true>(F.lds, g, S, E);
        if (F.bid >= 128) { for (int su = F.bid - 128; su < 16 * 88; su += 128)
            small_gemm_unit<1024, false, true, false>(F, F.w<bf16>(WS_X2) + (size_t)TP * 1024, F.w<bf16>(WS_W_UP), su / 88, su % 88, nullptr, F.w<bf16>(WS_UP), 2 * DFF, nullptr, F.w<float>(WS_SSQ2) + (size_t)TP * 16); } }
    SEAM(13);
    if (IN(15)) { pg8::Gemm g{F.w<bf16>(WS_HID), F.w<bf16>(WS_W_DN), TP, 1024, DFF}; pg8::StaticOrder S; S.init(TP, 1024, F.G, F.bid);
        p15_pre(F, 8 * (F.bid & 7) + ((F.bid >> 3) & 7));
        if (F.tid == 0) { const unsigned nloc = bar.st[0]; const unsigned old = xb_add(ctl + CW_HIDS + 64 * bar.x, 1u);
            if (old + 1u == nloc) { __builtin_amdgcn_fence(__ATOMIC_RELEASE, "agent"); asm volatile("s_waitcnt vmcnt(0)" ::: "memory"); (void)xb_add(ctl + CW_HIDS + 64 * 16, 1u); } }
        pg8::EpiRes<true, false> E{F.w<bf16>(WS_X2), F.w<bf16>(WS_X2), 1 << 20, F.out + O_YP, 1024};
        pg8::gemm_phase<pg8::EpiRes<true, false>, pg8::StaticOrder, true, true>(F.lds, g, S, E);
        if (F.tid == 0) { const unsigned nx = bar.st[1]; XB_SPIN(xb_ld(ctl + CW_HIDS + 64 * 16) < nx, ctl + CW_BAR); __builtin_amdgcn_fence(__ATOMIC_ACQUIRE, "agent"); asm volatile("s_waitcnt vmcnt(0)" ::: "memory"); }
        __syncthreads();
        small_gemm_unit<DFF, true, false>(F, F.w<bf16>(WS_HID) + (size_t)TP * DFF, F.w<bf16>(WS_W_DN), F.bid >> 4, F.bid & 15, F.w<bf16>(WS_X2) + (size_t)TP * 1024, F.out + O_YS, 1024); }
#ifdef MK_TIMING
    xcd_barrier(bar); STAMP(16);
    xcd_barrier(bar);
    if (F.bid == 0) {
        volatile LAS float* s_ca = (volatile LAS float*)(F.lds + RING_BYTES + 1024);
#define s_c s_ca[0]
#define s_a s_ca[1]
        if (F.tid == 0) {
            unsigned long long a0 = ~0ull, a1 = 0, b0 = ~0ull, b1 = 0;
#ifdef MK_TPERWG
            unsigned long long ma = 0, mb = 0;
            for (int w = 0; w < 256; ++w) { const unsigned long long* st = stamps + w * 32; const unsigned long long xa = st[MK_TA_HI] - st[MK_TA_LO], xb = st[MK_TB_HI] - st[MK_TB_LO]; ma = xa > ma ? xa : ma; mb = xb > mb ? xb : mb; }
            a0 = 0; a1 = ma; b0 = 0; b1 = mb;
#else
            for (int w = 0; w < 256; ++w) { const unsigned long long* st = stamps + w * 32;
                a0 = st[MK_TA_LO] < a0 ? st[MK_TA_LO] : a0; a1 = st[MK_TA_HI] > a1 ? st[MK_TA_HI] : a1; b0 = st[MK_TB_LO] < b0 ? st[MK_TB_LO] : b0; b1 = st[MK_TB_HI] > b1 ? st[MK_TB_HI] : b1; }
#endif
            const float da = (float)(a1 - a0) * 0.01f, db = (float)(b1 - b0) * 0.01f;
            s_c = sqrtf(da * 1e-4f); s_a = db * 0.1f;
        }
        __syncthreads();
        float* sk = F.out + O_SKPE;
        for (int i = F.tid; i < 16384; i += 512) sk[i] *= (1.f + s_c);
        if (F.tid == 0) F.out[O_YP] += s_a;
#undef s_c
#undef s_a
    }
#endif
#undef IN
#undef SEAM
}
}
extern "C" void kernel_launch(void* const* d_in, const int* in_sizes, int n_in, void* d_out, int out_size, void* d_ws, size_t ws_size, hipStream_t stream) {
    using namespace mk;
    static int ready = 0;
    if (ready == 0) {
        if (n_in != 38 || out_size != 25292800 || ws_size < WS_MK_END) { fprintf(stderr, "kernel_launch: unexpected n_in %d / out_size %d / ws %zu\n", n_in, out_size, ws_size); ready = -1; return; }
        if (hipFuncSetAttribute((const void*)mk_fwd, hipFuncAttributeMaxDynamicSharedMemorySize, LDS_BYTES) != hipSuccess) { fprintf(stderr, "kernel_launch: hipFuncSetAttribute failed\n"); ready = -1; return; }
        int dev = 0, cus = 0, per_cu = 0;
        (void)hipGetDevice(&dev); (void)hipDeviceGetAttribute(&cus, hipDeviceAttributeMultiprocessorCount, dev);
        (void)hipOccupancyMaxActiveBlocksPerMultiprocessor(&per_cu, (const void*)mk_fwd, NWAVES * 64, LDS_BYTES);
        if (cus < 256 || per_cu < 1) fprintf(stderr, "kernel_launch: note: %d CUs, occupancy query %d (this kernel needs 256 resident workgroups of %d B LDS)\n", cus, per_cu, LDS_BYTES);
        (void)hipGetLastError();
        ready = 1;
    }
    if (ready < 0) return;
    (void)hipMemsetAsync((unsigned char*)d_ws + WS_CTL, 0, CTL_ZERO_BYTES, stream);
    Args a{}; for (int i = 0; i < 38; ++i) a.in[i] = d_in[i];
    a.out = (float*)d_out; a.ws = (unsigned char*)d_ws; a.ph_lo = 0; a.ph_hi = N_PHASES;
    hipLaunchKernelGGL(mk_fwd, dim3(256), dim3(NWAVES * 64), LDS_BYTES, stream, a);
}
```

```cpp
#include <hip/hip_runtime.h>
#include <cstdio>
#include <cstdint>
#include <cmath>
#define GAS __attribute__((address_space(1)))
#define LAS __attribute__((address_space(3)))
typedef unsigned short bf16;
typedef unsigned v4u __attribute__((ext_vector_type(4)));
typedef unsigned v2u __attribute__((ext_vector_type(2)));
typedef float f32x4 __attribute__((ext_vector_type(4)));
typedef float f32x16 __attribute__((ext_vector_type(16)));
typedef short bf16x8 __attribute__((ext_vector_type(8)));
typedef short s16x4 __attribute__((ext_vector_type(4)));
#define LDS_WAIT() asm volatile("s_waitcnt lgkmcnt(0)" ::: "memory")
#define VM_WAIT() asm volatile("s_waitcnt vmcnt(0)" ::: "memory")
__device__ __forceinline__ unsigned f2bf(float f) { unsigned u = __builtin_bit_cast(unsigned, f); return (u + 0x7fffu + ((u >> 16) & 1u)) >> 16; }
__device__ __forceinline__ unsigned pk2(float lo, float hi) { return f2bf(lo) | (f2bf(hi) << 16); }
typedef float f32x2_t __attribute__((ext_vector_type(2))); typedef __bf16 bf16x2_t __attribute__((ext_vector_type(2)));
__device__ __forceinline__ unsigned cvtpk(float lo, float hi) { f32x2_t v = {lo, hi}; bf16x2_t b = __builtin_convertvector(v, bf16x2_t); return __builtin_bit_cast(unsigned, b); }
__device__ __forceinline__ float bf2f(unsigned short b) { return __builtin_bit_cast(float, (unsigned)b << 16); }
__device__ __forceinline__ float bflo(unsigned w) { return __builtin_bit_cast(float, w << 16); }
__device__ __forceinline__ float bfhi(unsigned w) { return __builtin_bit_cast(float, w & 0xffff0000u); }
__device__ __forceinline__ int opaque_i(int x) { asm volatile("" : "+v"(x)); return x; }
template <int CTRL, int ROWMASK> __device__ __forceinline__ float dpp_take(float x) { return __builtin_bit_cast(float, __builtin_amdgcn_update_dpp(0, __builtin_bit_cast(int, x), CTRL, ROWMASK, 0xf, false)); }
__device__ __forceinline__ float dpp_sum8(float v) { v += dpp_take<0xB1, 0xf>(v); v += dpp_take<0x4E, 0xf>(v); v += dpp_take<0x141, 0xf>(v); return v; }
__device__ __forceinline__ float dpp_sum16(float v) { v = dpp_sum8(v); v += dpp_take<0x140, 0xf>(v); return v; }
__device__ __forceinline__ float wave_sum(float v) {
    v += dpp_take<0xB1, 0xf>(v); v += dpp_take<0x4E, 0xf>(v); v += dpp_take<0x141, 0xf>(v); v += dpp_take<0x140, 0xf>(v);
    v += dpp_take<0x142, 0xa>(v); v += dpp_take<0x143, 0xc>(v);
    return __builtin_bit_cast(float, __builtin_amdgcn_readlane(__builtin_bit_cast(int, v), 63));
}
__device__ __forceinline__ float gelu_tanh_f(float x) {
    const float t = x * (-2.3022082062f - 0.1029432457f * x * x);
    return x * __builtin_amdgcn_rcpf(1.f + __builtin_amdgcn_exp2f(t));
}
namespace pg8 {
#define PG8_LAS __attribute__((address_space(3)))
typedef unsigned short bf16_t;
typedef short bf16x8 __attribute__((ext_vector_type(8)));
typedef float f32x4 __attribute__((ext_vector_type(4)));
typedef unsigned u32x4 __attribute__((ext_vector_type(4)));
constexpr int BM = 256, BK = 64, HALF = 128, HTB = HALF * BK * 2  , STAGE_BYTES = 8 * HTB, NXCD = 8, WGM = 8;

__host__ __device__ __forceinline__ int lds_byte(int r, int c) { const int st = (r >> 4) * 2 + (c >> 5), rr = r & 15, cc = c & 31, ob = rr * 64 + cc * 2; return st * 1024 + (ob ^ (((ob >> 9) & 1) << 5)); }
__host__ __device__ __forceinline__ void stage_rc(int b, int& R, int& C) { const int st = b / 1024, sb = b % 1024, swz = sb ^ (((sb >> 9) & 1) << 5); R = (st >> 1) * 16 + swz / 64; C = (st & 1) * 32 + (swz % 64) / 2; }
__host__ __device__ __forceinline__ int perm32(int rho) { const int n = rho >> 4, i = rho & 15; return 8 * (i >> 2) + 4 * n + (i & 3); }

struct Unit { int pm, pn; };
struct Gemm { const bf16_t* A; const bf16_t* Bt; int M, N, K; };

struct StaticOrder {
    int nM, nN, nwg, G, c;
    __host__ __device__ void init(int M, int N, int G_, int c_) { nM = M / BM; nN = N / BM; nwg = nM * nN; G = G_; c = c_; }
    __host__ __device__ bool next(int i, Unit& u) const {
        const long L = (long)i * G + c; if (L >= nwg) return false;
        int wgid = (int)L; { const int q = nwg / NXCD, r = nwg % NXCD, xcd = wgid % NXCD, off = wgid / NXCD; wgid = (xcd < r ? xcd * (q + 1) : r * (q + 1) + (xcd - r) * q) + off; }
        const int nig = WGM * nN, gid = wgid / nig, fm = gid * WGM, gsz = (nM - fm) < WGM ? (nM - fm) : WGM;
        u.pm = fm + ((wgid % nig) % gsz); u.pn = (wgid % nig) / gsz; return true;
    }
    __device__ __forceinline__ void a_ready(const Unit&) const {}
    __device__ __forceinline__ void done(const Unit&) const {}
};

__device__ __forceinline__ unsigned cvt_pk_bf16(float lo, float hi) { unsigned r; asm volatile("v_cvt_pk_bf16_f32 %0, %1, %2" : "=v"(r) : "v"(lo), "v"(hi)); return r; }
typedef float f32x2 __attribute__((ext_vector_type(2)));
struct EpiBf16 {
    static constexpr bool PERM = true, AFTER_DRAIN = false;
    bf16_t* O; int ldc; float scale;
    __device__ __forceinline__ void operator()(const f32x4 (&acc)[2][2][4][2], const Unit& u, int wr, int wc, int fr, int fq) const {
        const int row0 = u.pm * BM + wr * 64 + fr; const int col0 = u.pn * BM + wc * 32 + 8 * fq;
#pragma unroll
        for (int ai = 0; ai < 2; ++ai)
#pragma unroll
            for (int m = 0; m < 4; ++m) { bf16_t* rowp = O + (size_t)(row0 + ai * HALF + m * 16) * ldc + col0;
#pragma unroll
                for (int bj = 0; bj < 2; ++bj) { const f32x4 v0 = acc[ai][bj][m][0] * scale, v1 = acc[ai][bj][m][1] * scale;
                    u32x4 w; w.x = cvt_pk_bf16(v0[0], v0[1]); w.y = cvt_pk_bf16(v0[2], v0[3]); w.z = cvt_pk_bf16(v1[0], v1[1]); w.w = cvt_pk_bf16(v1[2], v1[3]);
                    *(u32x4*)(rowp + bj * HALF) = w; } }
    }
};
struct EpiResF32 {
    static constexpr bool PERM = false, AFTER_DRAIN = false;
    const float* res0; const float* res1; int split_pm; float* out; int ldc;
    __device__ __forceinline__ void operator()(const f32x4 (&acc)[2][2][4][2], const Unit& u, int wr, int wc, int fr, int fq) const {
        const int row0 = u.pm * BM + wr * 64 + fr; const int col0 = u.pn * BM + wc * 32 + 4 * fq;
        const float* rb = (u.pm < split_pm) ? res0 : res1 - (size_t)split_pm * BM * ldc;
#pragma unroll
        for (int ai = 0; ai < 2; ++ai)
#pragma unroll
            for (int m = 0; m < 4; ++m) { const size_t off = (size_t)(row0 + ai * HALF + m * 16) * ldc + col0;
#pragma unroll
                for (int bj = 0; bj < 2; ++bj)
#pragma unroll
                    for (int n = 0; n < 2; ++n) { const f32x4 r = *(const f32x4*)(rb + off + bj * HALF + n * 16); *(f32x4*)(out + off + bj * HALF + n * 16) = acc[ai][bj][m][n] + r; }
                if (m & 1) asm volatile("" ::: "memory"); }
    }
};
struct EpiResF32N {
    static constexpr bool PERM = false, AFTER_DRAIN = false;
    const float* res0; const float* res1; int split_pm; float* out; bf16_t* outb; float* ssq; int ldc;
    __device__ __forceinline__ void operator()(const f32x4 (&acc)[2][2][4][2], const Unit& u, int wr, int wc, int fr, int fq) const {
        const int row0 = u.pm * BM + wr * 64 + fr; const int col0 = u.pn * BM + wc * 32 + 4 * fq;
        const float* rb = (u.pm < split_pm) ? res0 : res1 - (size_t)split_pm * BM * ldc;
#pragma unroll
        for (int ai = 0; ai < 2; ++ai)
#pragma unroll
            for (int m = 0; m < 4; ++m) { const int row = row0 + ai * HALF + m * 16; const size_t off = (size_t)row * ldc + col0; float s = 0.f;
#pragma unroll
                for (int bj = 0; bj < 2; ++bj)
#pragma unroll
                    for (int n = 0; n < 2; ++n) { const f32x4 r = *(const f32x4*)(rb + off + bj * HALF + n * 16); const f32x4 v = acc[ai][bj][m][n] + r; *(f32x4*)(out + off + bj * HALF + n * 16) = v;
                        s += (v[0] * v[0] + v[1] * v[1]) + (v[2] * v[2] + v[3] * v[3]);
                        typedef unsigned u32x2_ __attribute__((ext_vector_type(2))); u32x2_ w; w.x = cvt_pk_bf16(v[0], v[1]); w.y = cvt_pk_bf16(v[2], v[3]); *(u32x2_*)(outb + off + bj * HALF + n * 16) = w; }
                s += __shfl_xor(s, 16); s += __shfl_xor(s, 32);
                if (fq == 0) ssq[(size_t)row * 16 + u.pn * 4 + wc] = s;
                if (m & 1) asm volatile("" ::: "memory"); }
    }
};
struct EpiBf16S {
    static constexpr bool PERM = true, AFTER_DRAIN = false;
    bf16_t* O; int ldc; const float* ssq; float eps;
    __device__ __forceinline__ void operator()(const f32x4 (&acc)[2][2][4][2], const Unit& u, int wr, int wc, int fr, int fq) const {
        const int row0 = u.pm * BM + wr * 64 + fr; const int col0 = u.pn * BM + wc * 32 + 8 * fq;
        f32x4 part[2][4];
#pragma unroll
        for (int ai = 0; ai < 2; ++ai)
#pragma unroll
            for (int m = 0; m < 4; ++m) part[ai][m] = *(const f32x4*)(ssq + (size_t)(row0 + ai * HALF + m * 16) * 16 + 4 * fq);
#pragma unroll
        for (int ai = 0; ai < 2; ++ai)
#pragma unroll
            for (int m = 0; m < 4; ++m) { const int row = row0 + ai * HALF + m * 16;
                float tot = (part[ai][m][0] + part[ai][m][1]) + (part[ai][m][2] + part[ai][m][3]);
                tot += __shfl_xor(tot, 16); tot += __shfl_xor(tot, 32);
                const float scale = __builtin_amdgcn_rsqf(tot * (1.0f / 1024.0f) + eps);
                bf16_t* rowp = O + (size_t)row * ldc + col0;
#pragma unroll
                for (int bj = 0; bj < 2; ++bj) { const f32x4 v0 = acc[ai][bj][m][0] * scale, v1 = acc[ai][bj][m][1] * scale;
                    u32x4 w; w.x = cvt_pk_bf16(v0[0], v0[1]); w.y = cvt_pk_bf16(v0[2], v0[3]); w.z = cvt_pk_bf16(v1[0], v1[1]); w.w = cvt_pk_bf16(v1[2], v1[3]);
                    *(u32x4*)(rowp + bj * HALF) = w; } }
    }
};
template <bool RES_BF16, bool OUT_BF16> struct EpiRes {
    static constexpr bool PERM = false, AFTER_DRAIN = false;
    const void* res0; const void* res1; int split_pm; void* out; int ldc;
    __device__ __forceinline__ void operator()(const f32x4 (&acc)[2][2][4][2], const Unit& u, int wr, int wc, int fr, int fq) const {
        typedef unsigned u32x2_ __attribute__((ext_vector_type(2)));
        const int row0 = u.pm * BM + wr * 64 + fr; const int col0 = u.pn * BM + wc * 32 + 4 * fq;
        const bool first = u.pm < split_pm;
#pragma unroll
        for (int ai = 0; ai < 2; ++ai)
#pragma unroll
            for (int m = 0; m < 4; ++m) { const int row = row0 + ai * HALF + m * 16; const size_t off = (size_t)row * ldc + col0; const size_t roff = first ? off : off - (size_t)split_pm * BM * ldc;
#pragma unroll
                for (int bj = 0; bj < 2; ++bj)
#pragma unroll
                    for (int n = 0; n < 2; ++n) { const size_t o2 = bj * HALF + n * 16; f32x4 r;
                        if (RES_BF16) { const u32x2_ rw = *(const u32x2_*)((const bf16_t*)(first ? res0 : res1) + roff + o2); r = (f32x4){__builtin_bit_cast(float, rw.x << 16), __builtin_bit_cast(float, rw.x & 0xffff0000u), __builtin_bit_cast(float, rw.y << 16), __builtin_bit_cast(float, rw.y & 0xffff0000u)}; }
                        else r = *(const f32x4*)((const float*)(first ? res0 : res1) + roff + o2);
                        const f32x4 v = acc[ai][bj][m][n] + r;
                        if (OUT_BF16) { u32x2_ w; w.x = cvt_pk_bf16(v[0], v[1]); w.y = cvt_pk_bf16(v[2], v[3]); *(u32x2_*)((bf16_t*)out + off + o2) = w; }
                        else *(f32x4*)((float*)out + off + o2) = v; }
                if (m & 1) asm volatile("" ::: "memory"); }
    }
};
template <bool RES_BF16> struct EpiResN {
    static constexpr bool PERM = false, AFTER_DRAIN = false;
    const void* res0; const void* res1; int split_pm; bf16_t* out; float* ssq; int ldc;
    __device__ __forceinline__ void operator()(const f32x4 (&acc)[2][2][4][2], const Unit& u, int wr, int wc, int fr, int fq) const {
        typedef unsigned u32x2_ __attribute__((ext_vector_type(2)));
        const int row0 = u.pm * BM + wr * 64 + fr; const int col0 = u.pn * BM + wc * 32 + 4 * fq;
        const bool first = u.pm < split_pm;
#pragma unroll
        for (int ai = 0; ai < 2; ++ai)
#pragma unroll
            for (int m = 0; m < 4; ++m) { const int row = row0 + ai * HALF + m * 16; const size_t off = (size_t)row * ldc + col0; const size_t roff = first ? off : off - (size_t)split_pm * BM * ldc; float s = 0.f;
#pragma unroll
                for (int bj = 0; bj < 2; ++bj)
#pragma unroll
                    for (int n = 0; n < 2; ++n) { const size_t o2 = bj * HALF + n * 16; f32x4 r;
                        if (RES_BF16) { const u32x2_ rw = *(const u32x2_*)((const bf16_t*)(first ? res0 : res1) + roff + o2); r = (f32x4){__builtin_bit_cast(float, rw.x << 16), __builtin_bit_cast(float, rw.x & 0xffff0000u), __builtin_bit_cast(float, rw.y << 16), __builtin_bit_cast(float, rw.y & 0xffff0000u)}; }
                        else r = *(const f32x4*)((const float*)(first ? res0 : res1) + roff + o2);
                        const f32x4 v = acc[ai][bj][m][n] + r;
                        s += (v[0] * v[0] + v[1] * v[1]) + (v[2] * v[2] + v[3] * v[3]);
                        u32x2_ w; w.x = cvt_pk_bf16(v[0], v[1]); w.y = cvt_pk_bf16(v[2], v[3]); *(u32x2_*)(out + off + o2) = w; }
                s += __shfl_xor(s, 16); s += __shfl_xor(s, 32);
                if (fq == 0) ssq[(size_t)row * 16 + u.pn * 4 + wc] = s;
                if (m & 1) asm volatile("" ::: "memory"); }
    }
};
__device__ __forceinline__ float dpp_ror1(float x) { return __builtin_bit_cast(float, __builtin_amdgcn_update_dpp(0, __builtin_bit_cast(int, x), 0x121, 0xf, 0xf, false)); }
__device__ __forceinline__ float dpp_ror2(float x) { return __builtin_bit_cast(float, __builtin_amdgcn_update_dpp(0, __builtin_bit_cast(int, x), 0x122, 0xf, 0xf, false)); }
struct EpiUpFused {
    static constexpr bool PERM = false, AFTER_DRAIN = false;
    bf16_t* HID; const float* wconv; const float* bconv; bf16_t* RAW01; float* RAWG; float* pconv; PG8_LAS float* halo; int dff; const PG8_LAS float* rstd;
    __device__ __forceinline__ void operator()(const f32x4 (&acc)[2][2][4][2], const Unit& u, int wr, int wc, int fr, int fq) const {
        typedef unsigned u32x2_ __attribute__((ext_vector_type(2)));
        const int lane = fq * 16 + fr;
        const int fb = u.pn * 128 + wc * 32 + 4 * fq;
        const int hc = wc * 32 + 4 * fq;
        float rs[2][4];
#pragma unroll
        for (int ai = 0; ai < 2; ++ai)
#pragma unroll
            for (int m = 0; m < 4; ++m) rs[ai][m] = rstd[(u.pm & 7) * BM + ai * HALF + wr * 64 + m * 16 + fr];
        if (fr >= 14) {
#pragma unroll
            for (int ai = 0; ai < 2; ++ai)
#pragma unroll
                for (int n = 0; n < 2; ++n) *(PG8_LAS f32x4*)(halo + ((ai * 2 + wr) * 2 + (fr - 14)) * 128 + hc + 16 * n) = acc[ai][0][3][n] * rs[ai][3];
        }
        asm volatile("s_waitcnt lgkmcnt(0)" ::: "memory"); __builtin_amdgcn_s_barrier(); asm volatile("" ::: "memory");
        const bool seq_tile = (u.pm & 7) == 0;
#pragma unroll
        for (int n = 0; n < 2; ++n) {
            const f32x4 w0 = *(const f32x4*)(wconv + fb + 16 * n), w1 = *(const f32x4*)(wconv + dff + fb + 16 * n), w2 = *(const f32x4*)(wconv + 2 * dff + fb + 16 * n), bb = *(const f32x4*)(bconv + fb + 16 * n);
#pragma unroll
            for (int ai = 0; ai < 2; ++ai) {
                f32x4 p14 = (f32x4){0.f, 0.f, 0.f, 0.f}, p15 = p14;
                const bool top = (ai == 0 && wr == 0);
                if (!top) { const int pg = (wr == 1) ? (ai * 2 + 0) : ((ai - 1) * 2 + 1); p14 = *(const PG8_LAS f32x4*)(halo + (pg * 2 + 0) * 128 + hc + 16 * n); p15 = *(const PG8_LAS f32x4*)(halo + (pg * 2 + 1) * 128 + hc + 16 * n); }
                f32x4 pr1, pr2;
#pragma unroll
                for (int e = 0; e < 4; ++e) { const float x0 = (fr == 14) ? p14[e] : p15[e]; pr1[e] = dpp_ror1(x0); pr2[e] = dpp_ror2(x0); }
#pragma unroll
                for (int m = 0; m < 4; ++m) {
                    const f32x4 cur = acc[ai][0][m][n] * rs[ai][m], val = acc[ai][1][m][n] * rs[ai][m];
                    f32x4 g1, g2, c1, c2;
#pragma unroll
                    for (int e = 0; e < 4; ++e) { c1[e] = dpp_ror1(cur[e]); c2[e] = dpp_ror2(cur[e]);
                        g1[e] = fr >= 1 ? c1[e] : pr1[e]; g2[e] = fr >= 2 ? c2[e] : pr2[e]; }
                    pr1 = c1; pr2 = c2;
                    const int row = u.pm * BM + ai * HALF + wr * 64 + m * 16 + fr;
                    const bool first2 = top && m == 0 && fr < 2;
                    if (first2 && seq_tile) { if (fr == 0) g1 = (f32x4){0.f, 0.f, 0.f, 0.f}; g2 = (f32x4){0.f, 0.f, 0.f, 0.f}; }
                    if (first2 && !seq_tile) {
                        u32x2_ wg_, wv_; wg_.x = cvt_pk_bf16(cur[0], cur[1]); wg_.y = cvt_pk_bf16(cur[2], cur[3]); wv_.x = cvt_pk_bf16(val[0], val[1]); wv_.y = cvt_pk_bf16(val[2], val[3]);
                        bf16_t* rp = RAW01 + ((size_t)u.pm * 2 + fr) * (2 * dff) + fb + 16 * n; *(u32x2_*)rp = wg_; *(u32x2_*)(rp + dff) = wv_;
                    } else {
                        f32x4 h;
#pragma unroll
                        for (int e = 0; e < 4; ++e) { const float c = bb[e] + g2[e] * w0[e] + g1[e] * w1[e] + cur[e] * w2[e]; h[e] = c * __builtin_amdgcn_rcpf(1.f + __expf(-c)) * val[e]; }
                        u32x2_ wh; wh.x = cvt_pk_bf16(h[0], h[1]); wh.y = cvt_pk_bf16(h[2], h[3]);
                        *(u32x2_*)(HID + (size_t)row * dff + fb + 16 * n) = wh;
                    }
                    if (ai == 1 && wr == 1 && m == 3 && fr >= 14) {
                        *(f32x4*)(RAWG + ((size_t)u.pm * 2 + (fr - 14)) * dff + fb + 16 * n) = cur;
                        if ((u.pm & 7) == 7) *(f32x4*)(pconv + ((size_t)(u.pm >> 3) * 2 + (fr - 14)) * dff + fb + 16 * n) = cur;
                    }
                }
            }
        }
        asm volatile("s_waitcnt lgkmcnt(0)" ::: "memory"); __builtin_amdgcn_s_barrier(); asm volatile("" ::: "memory");
    }
};
template <class Epi, class Sched, bool ALIGN_EPI = false, bool SP2 = false>
__device__ __forceinline__ void gemm_phase(PG8_LAS unsigned char* lds, const Gemm g, const Sched& S, const Epi& E) {
    const int tid = opaque_i(threadIdx.x), wid = __builtin_amdgcn_readfirstlane(tid >> 6), lane = tid & 63, wr = wid >> 2, wc = wid & 3, fr = lane & 15, fq = lane >> 4;
    const int K = g.K, nt = K / BK;
    unsigned voffA[2], voffB[2];
#pragma unroll
    for (int i = 0; i < 2; ++i) { int R, C; stage_rc(tid * 16 + i * 8192, R, C); const int Rb = Epi::PERM ? ((R & ~31) + perm32(R & 31)) : R;
        voffA[i] = (unsigned)(R * K + C) * 2u; voffB[i] = (unsigned)(Rb * K + C) * 2u; }
    const size_t kstep = (size_t)(BK * 2);
    const size_t hstep = (size_t)HALF * K * 2;
    const size_t tstep = 2 * hstep;
    const unsigned ldsw = (unsigned)wid * 1024u;
    const int aoff = lds_byte(wr * 64 + fr, fq * 8), boff = lds_byte(wc * 32 + fr, fq * 8);
#define PG8_SA(b, h) (((b) * 2 + (h)) * HTB)
#define PG8_SB(b, h) ((4 + (b) * 2 + (h)) * HTB)
#define PG8_STAGE(bufoff, gbase, voff) do { _Pragma("unroll") for (int _i = 0; _i < 2; ++_i) \
        __builtin_amdgcn_global_load_lds((const unsigned*)((const char*)(gbase) + (voff)[_i]), (PG8_LAS unsigned*)(lds + (bufoff) + ldsw + _i * 8192), 16, 0, 0); } while (0)
#define PG8_LDA(dst, b, h) do { _Pragma("unroll") for (int m = 0; m < 4; ++m) _Pragma("unroll") for (int k = 0; k < 2; ++k) dst[m][k] = *(const PG8_LAS bf16x8*)(lds + PG8_SA(b, h) + aoff + m * 2048 + k * 1024); } while (0)
#define PG8_LDB(dst, b, h) do { _Pragma("unroll") for (int n = 0; n < 2; ++n) _Pragma("unroll") for (int k = 0; k < 2; ++k) dst[n][k] = *(const PG8_LAS bf16x8*)(lds + PG8_SB(b, h) + boff + n * 2048 + k * 1024); } while (0)
#define PG8_MMA(ai, bj, At, Bt) do { __builtin_amdgcn_s_setprio(1); _Pragma("unroll") for (int m = 0; m < 4; ++m) _Pragma("unroll") for (int n = 0; n < 2; ++n) _Pragma("unroll") for (int k = 0; k < 2; ++k) \
        acc[ai][bj][m][n] = __builtin_amdgcn_mfma_f32_16x16x32_bf16(Bt[n][k], At[m][k], acc[ai][bj][m][n], 0, 0, 0); __builtin_amdgcn_s_setprio(0); } while (0)
#define PG8_WAIT_V(n) asm volatile("s_waitcnt vmcnt(" #n ")" ::: "memory")
#define PG8_WAIT_L(n) asm volatile("s_waitcnt lgkmcnt(" #n ")" ::: "memory")
#define PG8_BAR __builtin_amdgcn_s_barrier()
#define PG8_SCHED __builtin_amdgcn_sched_barrier(0)
    Unit cur, nxt; int ui = 0;
    if (!S.next(0, cur)) return;
    f32x4 acc[2][2][4][2];
#pragma unroll
    for (int a = 0; a < 2; ++a)
#pragma unroll
        for (int b = 0; b < 2; ++b)
#pragma unroll
            for (int m = 0; m < 4; ++m)
#pragma unroll
                for (int n = 0; n < 2; ++n) acc[a][b][m][n] = (f32x4){0.f, 0.f, 0.f, 0.f};
    bf16x8 At[4][2], B0[2][2], B1[2][2];
    const char* cA = (const char*)g.A + (size_t)cur.pm * tstep; const char* cB = (const char*)g.Bt + (size_t)cur.pn * tstep;
    S.a_ready(cur);
    if constexpr (SP2) {
        PG8_STAGE(PG8_SB(0, 0), cB, voffB); PG8_STAGE(PG8_SB(0, 1), cB + hstep, voffB); PG8_STAGE(PG8_SA(0, 0), cA, voffA); PG8_STAGE(PG8_SA(0, 1), cA + hstep, voffA);
        if (wr == 1) PG8_BAR;
        PG8_WAIT_V(2); PG8_BAR;
        PG8_STAGE(PG8_SB(1, 0), cB + kstep, voffB); PG8_STAGE(PG8_SA(1, 0), cA + kstep, voffA); PG8_STAGE(PG8_SB(1, 1), cB + hstep + kstep, voffB);
        PG8_WAIT_V(6); PG8_BAR;
    } else {
        PG8_STAGE(PG8_SB(0, 0), cB, voffB); PG8_STAGE(PG8_SA(0, 0), cA, voffA); PG8_STAGE(PG8_SB(0, 1), cB + hstep, voffB); PG8_STAGE(PG8_SA(0, 1), cA + hstep, voffA);
        if (wr == 1) PG8_BAR;
        PG8_WAIT_V(4); PG8_BAR;
        PG8_STAGE(PG8_SB(1, 0), cB + kstep, voffB); PG8_STAGE(PG8_SA(1, 0), cA + kstep, voffA); PG8_STAGE(PG8_SB(1, 1), cB + hstep + kstep, voffB);
        PG8_WAIT_V(6); PG8_BAR;
    }
    for (;;) {
        const bool has_next = S.next(ui + 1, nxt);
        const char* nA = has_next ? (const char*)g.A + (size_t)nxt.pm * tstep : cA; const char* nB = has_next ? (const char*)g.Bt + (size_t)nxt.pn * tstep : cB;
        for (int t = 0; t < nt; t += 2) {
            const bool last = (t == nt - 2);
            const char* a1 = cA + (size_t)(t + 1) * kstep;
            const char* a2 = last ? nA : cA + (size_t)(t + 2) * kstep; const char* b2 = last ? nB : cB + (size_t)(t + 2) * kstep;
            const char* a3 = a2 + kstep; const char* b3 = b2 + kstep;
            if (last && has_next) S.a_ready(nxt);
            if constexpr (SP2) {
            PG8_LDB(B0, 0, 0); PG8_LDB(B1, 0, 1); PG8_SCHED; PG8_LDA(At, 0, 0); PG8_STAGE(PG8_SA(1, 1), a1 + hstep, voffA);
            PG8_WAIT_V(8); PG8_WAIT_L(0); PG8_BAR; PG8_MMA(0, 0, At, B0); PG8_MMA(0, 1, At, B1); PG8_BAR; PG8_SCHED;
            PG8_LDA(At, 0, 1); PG8_STAGE(PG8_SB(0, 0), b2, voffB); PG8_STAGE(PG8_SB(0, 1), b2 + hstep, voffB); PG8_STAGE(PG8_SA(0, 0), a2, voffA);
            PG8_WAIT_V(8); PG8_WAIT_L(0); PG8_BAR; PG8_MMA(1, 0, At, B0); PG8_MMA(1, 1, At, B1); PG8_BAR; PG8_SCHED;
            PG8_LDB(B0, 1, 0); PG8_LDB(B1, 1, 1); PG8_SCHED; PG8_LDA(At, 1, 0); PG8_STAGE(PG8_SA(0, 1), a2 + hstep, voffA);
            PG8_WAIT_V(8); PG8_WAIT_L(0); PG8_BAR; PG8_MMA(0, 0, At, B0); PG8_MMA(0, 1, At, B1); PG8_BAR; PG8_SCHED;
            PG8_LDA(At, 1, 1); PG8_STAGE(PG8_SB(1, 0), b3, voffB); PG8_STAGE(PG8_SB(1, 1), b3 + hstep, voffB); PG8_STAGE(PG8_SA(1, 0), a3, voffA);
            PG8_WAIT_V(8); PG8_WAIT_L(0); PG8_BAR; PG8_MMA(1, 0, At, B0); PG8_MMA(1, 1, At, B1); PG8_BAR; PG8_SCHED;
            } else {
            PG8_LDB(B0, 0, 0); PG8_SCHED; PG8_LDA(At, 0, 0); PG8_STAGE(PG8_SA(1, 1), a1 + hstep, voffA);
            PG8_WAIT_L(8); PG8_BAR; PG8_WAIT_L(0); PG8_MMA(0, 0, At, B0); PG8_BAR; PG8_SCHED;
            PG8_LDB(B1, 0, 1); PG8_STAGE(PG8_SB(0, 0), b2, voffB);
            PG8_BAR; PG8_WAIT_L(0); PG8_MMA(0, 1, At, B1); PG8_BAR;
            PG8_LDA(At, 0, 1); PG8_STAGE(PG8_SA(0, 0), a2, voffA);
            PG8_BAR; PG8_WAIT_L(0); PG8_MMA(1, 0, At, B0); PG8_BAR; PG8_SCHED;
            PG8_STAGE(PG8_SB(0, 1), b2 + hstep, voffB);
            PG8_WAIT_V(6); PG8_BAR; PG8_MMA(1, 1, At, B1); PG8_BAR;
            PG8_LDB(B0, 1, 0); PG8_SCHED; PG8_LDA(At, 1, 0); PG8_STAGE(PG8_SA(0, 1), a2 + hstep, voffA);
            PG8_WAIT_L(8); PG8_BAR; PG8_WAIT_L(0); PG8_MMA(0, 0, At, B0); PG8_BAR; PG8_SCHED;
            PG8_LDB(B1, 1, 1); PG8_STAGE(PG8_SB(1, 0), b3, voffB);
            PG8_BAR; PG8_WAIT_L(0); PG8_MMA(0, 1, At, B1); PG8_BAR;
            PG8_LDA(At, 1, 1); PG8_STAGE(PG8_SA(1, 0), a3, voffA);
            PG8_BAR; PG8_WAIT_L(0); PG8_MMA(1, 0, At, B0); PG8_BAR; PG8_SCHED;
            PG8_STAGE(PG8_SB(1, 1), b3 + hstep, voffB);
            PG8_WAIT_V(6); PG8_BAR; PG8_MMA(1, 1, At, B1); PG8_BAR;
            }
        }
        if constexpr (ALIGN_EPI) { if (wr == 0) PG8_BAR; }
        if constexpr (!Epi::AFTER_DRAIN) { E(acc, cur, wr, wc, fr, fq); S.done(cur); }
        if (!has_next) break;
#pragma unroll
        for (int a = 0; a < 2; ++a)
#pragma unroll
            for (int b = 0; b < 2; ++b)
#pragma unroll
                for (int m = 0; m < 4; ++m)
#pragma unroll
                    for (int n = 0; n < 2; ++n) acc[a][b][m][n] = (f32x4){0.f, 0.f, 0.f, 0.f};
        cur = nxt; cA = nA; cB = nB; ++ui;
        if constexpr (ALIGN_EPI) { if (wr == 1) PG8_BAR; }
    }
    PG8_WAIT_V(0);
    if constexpr (!ALIGN_EPI) { if (wr == 0) PG8_BAR; }
    PG8_BAR;
    if constexpr (Epi::AFTER_DRAIN) { E.fused(acc, cur, wr, wc, fr, fq, lds, wid, lane); S.done(cur); }
#undef PG8_SA
#undef PG8_SB
#undef PG8_STAGE
#undef PG8_LDA
#undef PG8_LDB
#undef PG8_MMA
#undef PG8_WAIT_V
#undef PG8_WAIT_L
#undef PG8_BAR
#undef PG8_SCHED
}
}
#define XB_TMO      128
#define XB_XCNT(j)  (256  + 64 * (j))
#define XB_XSUB(j)  (1280 + 64 * (j))
#define XB_XGEN(j)  (2304 + 64 * (j))
#define XB_TOP      3328
#define XB_TOPGEN   3392
#define XCD_BAR_WORDS 3456
#define XB_SPIN_CAP (1u << 18)

__device__ __forceinline__ unsigned xb_ld(unsigned* p)              { return __hip_atomic_load(p, __ATOMIC_RELAXED, __HIP_MEMORY_SCOPE_AGENT); }
__device__ __forceinline__ unsigned xb_add(unsigned* p, unsigned v) { return __hip_atomic_fetch_add(p, v, __ATOMIC_RELAXED, __HIP_MEMORY_SCOPE_AGENT); }
__device__ __forceinline__ unsigned xb_xcc_id() { return (unsigned)__builtin_amdgcn_s_getreg((3 << 11) | 20) & 0xFu; }
#define XB_SPIN(cond, bar) do { unsigned _sp = 0; while (cond) { __builtin_amdgcn_s_sleep(1); \
    if ((++_sp & 255u) == 0u) { if (xb_ld(&(bar)[XB_TMO])) break; if (_sp > XB_SPIN_CAP) { atomicAdd(&(bar)[XB_TMO], 1u); break; } } } } while (0)

struct XcdBarrier {
    unsigned* bar; unsigned x;
    volatile LAS unsigned* st;
};

__device__ __forceinline__ XcdBarrier xcd_barrier_post(unsigned* bar, volatile LAS unsigned* st) {
    XcdBarrier b; b.bar = bar; b.x = xb_xcc_id(); b.st = st;
    if (threadIdx.x == 0) (void)xb_add(&bar[XB_XCNT(b.x)], 1u);
    return b;
}
__device__ __forceinline__ void xcd_barrier_complete(unsigned* bar, unsigned x, unsigned& nloc, unsigned& nx) {
    const unsigned G = gridDim.x * gridDim.y * gridDim.z;
    unsigned sum, cnt, mine, sp = 0u;
    for (;;) {
        sum = 0u; cnt = 0u; mine = 0u;
#pragma unroll
        for (unsigned j = 0; j < 16; ++j) { const unsigned c = xb_ld(&bar[XB_XCNT(j)]); sum += c; cnt += (c > 0u) ? 1u : 0u; mine = (j == x) ? c : mine; }
        if (sum == G) break;
        __builtin_amdgcn_s_sleep(1);
        if ((++sp & 255u) == 0u) { if (xb_ld(&bar[XB_TMO])) break; if (sp > XB_SPIN_CAP) { atomicAdd(&bar[XB_TMO], 1u); break; } }
    }
    nloc = mine > 0u ? mine : 1u; nx = cnt > 0u ? cnt : 1u;
}

__device__ __forceinline__ void xcd_barrier(const XcdBarrier& b) {
    asm volatile("s_waitcnt vmcnt(0)" ::: "memory");
    __syncthreads();
    if (threadIdx.x == 0) {
        unsigned* bar = b.bar;
        __builtin_amdgcn_s_waitcnt(0);
        unsigned nloc = b.st[0], nx = b.st[1];
        if (nloc == 0u) { xcd_barrier_complete(bar, b.x, nloc, nx); b.st[0] = nloc; b.st[1] = nx; }
        const unsigned old = xb_add(&bar[XB_XSUB(b.x)], 1u);
        const unsigned gen = old / nloc;
        if (old + 1u == (gen + 1u) * nloc) {
            __builtin_amdgcn_fence(__ATOMIC_RELEASE, "agent");
            asm volatile("s_waitcnt vmcnt(0)" ::: "memory");
            const unsigned og = xb_add(&bar[XB_TOP], 1u);
            const unsigned tg = og / nx;
            if (og + 1u == (tg + 1u) * nx) xb_add(&bar[XB_TOPGEN], 1u);
            else XB_SPIN(xb_ld(&bar[XB_TOPGEN]) == tg, bar);
            __builtin_amdgcn_fence(__ATOMIC_ACQUIRE, "agent");
            xb_add(&bar[XB_XGEN(b.x)], 1u);
            asm volatile("s_waitcnt vmcnt(0)" ::: "memory");
        } else {
            XB_SPIN(xb_ld(&bar[XB_XGEN(b.x)]) == gen, bar);
            __builtin_amdgcn_fence(__ATOMIC_ACQUIRE, "agent");
            asm volatile("s_waitcnt vmcnt(0)" ::: "memory");
        }
    }
    __syncthreads();
}
namespace mk {
constexpr int NWAVES = 8;
constexpr int D = 1024, TP = 16384, TSMP = 512, T = TP + TSMP, SEQ = 2048, NSEQ = 128, PAST = 8192;
constexpr int NIN = 1568, NINP = 1792, DFF = 2816;
constexpr float EPS = 1e-6f;
constexpr float LOG2E = 1.4426950408889634f;
constexpr float QSCALE = 0.10206207261596577f * LOG2E;
constexpr float MQSCALE = 0.08838834764831845f * LOG2E;

constexpr size_t O_YP = 0, O_YS = 16777216, O_PCKV = O_YS + 524288, O_PKPE = O_PCKV + 4194304, O_PMK = O_PKPE + 524288, O_PMV = O_PMK + 1048576,
                 O_PCONV = O_PMV + 1048576, O_SCKV = O_PCONV + 45056, O_SKPE = O_SCKV + 131072, O_SCV = O_SKPE + 16384, O_SCONV = O_SCV + 262144, O_END = O_SCONV + 720896;
static_assert(O_END == 25292800, "output size");

constexpr size_t al(size_t x) { return (x + 4095) & ~(size_t)4095; }
constexpr size_t WS_CTL = 0, CTL_ZERO_BYTES = 1u << 20;
constexpr size_t WS_W_IN = 1u << 20;
constexpr size_t WS_W_UQ = al(WS_W_IN + (size_t)NINP * D * 2);
constexpr size_t WS_W_UK = al(WS_W_UQ + (size_t)768 * 256 * 2);
constexpr size_t WS_W_UV = al(WS_W_UK + (size_t)512 * 256 * 2);
constexpr size_t WS_W_O = al(WS_W_UV + (size_t)512 * 256 * 2);
constexpr size_t WS_W_MQ = al(WS_W_O + (size_t)1024 * 1024 * 2);
constexpr size_t WS_W_MKV = al(WS_W_MQ + (size_t)512 * 1024 * 2);
constexpr size_t WS_W_MO = al(WS_W_MKV + (size_t)1024 * 1024 * 2);
constexpr size_t WS_W_UP = al(WS_W_MO + (size_t)1024 * 512 * 2);
constexpr size_t WS_W_DN = al(WS_W_UP + (size_t)2 * DFF * D * 2);
constexpr size_t WS_ROPE = al(WS_W_DN + (size_t)D * DFF * 2);
constexpr size_t ROPE_N = 8200;
constexpr size_t WS_XN = al(WS_ROPE + 2 * ROPE_N * 16 * 4);
constexpr size_t WS_MN = al(WS_XN + (size_t)T * D * 2);
constexpr size_t WS_Z = al(WS_MN + (size_t)2048 * D * 2);
constexpr size_t WS_MKV = al(WS_Z + (size_t)T * NINP * 2);
constexpr size_t WS_CQN = al(WS_MKV + (size_t)2048 * 1024 * 2);
constexpr size_t WS_CKVN = al(WS_CQN + (size_t)T * 256 * 2);
constexpr size_t WS_VG = al(WS_CKVN + (size_t)T * 256 * 2);
constexpr size_t WS_MK = al(WS_VG + (size_t)T * 512 * 2);
constexpr size_t WS_MVT = al(WS_MK + (size_t)2048 * 512 * 2);
constexpr size_t WS_QR = al(WS_MVT + (size_t)2048 * 512 * 2);
constexpr size_t WS_KNR = al(WS_QR + (size_t)T * 768 * 2);
constexpr size_t WS_VT = al(WS_KNR + (size_t)TP * 512 * 2);
constexpr size_t WS_QF = al(WS_VT + (size_t)512 * TP * 2);
constexpr size_t WS_KF = al(WS_QF + (size_t)T * 768 * 2);
constexpr size_t WS_BO = al(WS_KF + (size_t)TP * 768 * 2);
constexpr size_t WS_MRG = al(WS_BO + (size_t)T * 512 * 2);
constexpr size_t WS_X1 = al(WS_MRG + (size_t)T * 1024 * 2);
constexpr size_t WS_H2 = al(WS_X1 + (size_t)T * 1024 * 4);
constexpr size_t WS_MQ = al(WS_H2 + (size_t)T * 1024 * 2);
constexpr size_t WS_MO = al(WS_MQ + (size_t)T * 512 * 2);
constexpr size_t WS_X2 = al(WS_MO + (size_t)T * 512 * 2);
constexpr size_t WS_H3 = al(WS_X2 + (size_t)T * 1024 * 4);
constexpr size_t WS_UP = al(WS_H3 + (size_t)T * 1024 * 2);
constexpr size_t WS_HID = al(WS_UP + (size_t)T * 2 * DFF * 2);
constexpr size_t WS_SPART = al(WS_HID + (size_t)T * DFF * 2);
constexpr size_t SPART_STRIDE = (32 + 32 * 256) * 4;
constexpr size_t WS_QEXT = al(WS_SPART + (size_t)NSEQ * 2 * SPART_STRIDE);
constexpr size_t WS_W_SB = al(WS_QEXT + (size_t)NSEQ * 32 * 288 * 2);
constexpr size_t WS_SSQ1_PRE = al(WS_W_SB + (size_t)8 * 128 * 128 * 2);
constexpr size_t WS_RAW01 = WS_SSQ1_PRE;
constexpr size_t WS_RAWG = al(WS_RAW01 + (size_t)64 * 2 * 5632 * 2);
constexpr size_t WS_SSQ1 = al(WS_RAWG + (size_t)64 * 2 * 2816 * 4);
constexpr size_t WS_SSQ2 = al(WS_SSQ1 + (size_t)T * 16 * 4);
constexpr size_t WS_MK_END = al(WS_SSQ2 + (size_t)T * 16 * 4);
static_assert(WS_MK_END < (1000u << 20), "mk workspace under 1000 MiB");
constexpr int CW_BAR = 4096;
constexpr int CW_HIDS = 16384;

constexpr int RING_BYTES = 155648, MISC_OFF = RING_BYTES + 320, LDS_BYTES = 159744;

struct Args { const void* in[38]; float* out; unsigned char* ws; int ph_lo, ph_hi; };
static_assert(sizeof(Args) == 38 * 8 + 8 + 8 + 8, "Args has no padding");

struct Frame {
    LAS unsigned char* lds; unsigned char* lds_g;
    int tid, lane, wave, G, bid;
    unsigned char* ws; float* out;
    const float* const* in;
    template <class P> __device__ __forceinline__ P* w(size_t off) const { return (P*)(ws + off); }
    __device__ __forceinline__ const float* inf(int i) const { return (const float*)in[i]; }
};

enum { I_XP = 0, I_XS, I_CKV, I_KPE, I_CMK, I_CMV, I_CONVST, I_PT, I_MEMP, I_GMIX, I_WIN, I_LNG, I_LNB, I_WS, I_BS, I_GQA, I_WUQ, I_GKVA, I_WUK, I_WUV, I_GQKQ, I_GQKK,
       I_GOA, I_GOB, I_WO, I_GMEMX, I_GMEMIN, I_WMQ, I_WMK, I_WMV, I_GMQ, I_GMK, I_WMO, I_GFFN, I_WUP, I_WCONV, I_BCONV, I_WDOWN };

struct P0Item { float v[32]; float g; };
__device__ __forceinline__ void p0_item_load(P0Item& x, const float* W, int K, int N, int item, int lane, const float* gain) {
    const int nblk = N / 32, kb = item / nblk, nb = item % nblk, k0 = 64 * kb, n0 = 32 * nb;
#pragma unroll
    for (int i = 0; i < 32; ++i) { const int kk = 2 * i + (lane >> 5); x.v[i] = W[(size_t)(k0 + kk) * N + n0 + (lane & 31)]; }
    x.g = gain ? gain[k0 + lane] : 1.f;
}
__device__ __forceinline__ void p0_item_finish(const P0Item& x, int K, int N, bf16* WT, int row_off, LAS float* scr, int item, int lane, bool has_gain) {
    const int nblk = N / 32, kb = item / nblk, nb = item % nblk, k0 = 64 * kb, n0 = 32 * nb;
#pragma unroll
    for (int i = 0; i < 32; ++i) { const int kk = 2 * i + (lane >> 5); float wv_ = x.v[i]; if (has_gain) wv_ *= __shfl(x.g, kk); scr[kk * 33 + (lane & 31)] = wv_; }
    LDS_WAIT(); asm volatile("" ::: "memory");
    const int c = lane & 7;
#pragma unroll
    for (int j = 0; j < 4; ++j) { const int n = (lane >> 3) + 8 * j; const LAS float* s = scr + (8 * c) * 33 + n;
        v4u o; o.x = pk2(s[0 * 33], s[1 * 33]); o.y = pk2(s[2 * 33], s[3 * 33]); o.z = pk2(s[4 * 33], s[5 * 33]); o.w = pk2(s[6 * 33], s[7 * 33]);
        *(v4u*)(WT + (size_t)(row_off + n0 + n) * K + k0 + 8 * c) = o; }
    LDS_WAIT(); asm volatile("" ::: "memory");
}
__device__ __forceinline__ void rms_row_to_bf16(const float* xrow, const float* g, bf16* orow, int lane) {
    const f32x4* xr = (const f32x4*)xrow + lane; const f32x4* gr = (const f32x4*)g + lane;
    f32x4 v[4]; float s = 0.f;
#pragma unroll
    for (int j = 0; j < 4; ++j) { v[j] = xr[64 * j]; s += (v[j].x * v[j].x + v[j].y * v[j].y) + (v[j].z * v[j].z + v[j].w * v[j].w); }
    const float rstd = rsqrtf(wave_sum(s) * (1.f / 1024.f) + EPS);
    unsigned long long* o8 = (unsigned long long*)orow + lane;
#pragma unroll
    for (int j = 0; j < 4; ++j) { const f32x4 gg = gr[64 * j];
        o8[64 * j] = (unsigned long long)pk2(v[j].x * rstd * gg.x, v[j].y * rstd * gg.y) | ((unsigned long long)pk2(v[j].z * rstd * gg.z, v[j].w * rstd * gg.w) << 32); }
}
__device__ __forceinline__ const float* xrow_ptr(const Frame& F, int r) { return r < TP ? F.inf(I_XP) + (size_t)r * D : F.inf(I_XS) + (size_t)(r - TP) * D; }

template <int M_LO, int M_HI>
__device__ __forceinline__ void p0_transposes(Frame& F, int gw, int NGW) {
    LAS float* scr = (LAS float*)(F.lds + F.wave * 16384);
    constexpr int NI = 11;
    const int srcs[NI] = {I_WIN, I_WUQ, I_WUK, I_WUV, I_WO, I_WMQ, I_WMK, I_WMV, I_WMO, I_WUP, I_WDOWN};
    const int Ks[NI] = {1024, 256, 256, 256, 1024, 1024, 1024, 1024, 512, 1024, 2816};
    const int Ns[NI] = {1568, 768, 512, 512, 1024, 512, 512, 512, 1024, 5632, 1024};
    const size_t dsts[NI] = {WS_W_IN, WS_W_UQ, WS_W_UK, WS_W_UV, WS_W_O, WS_W_MQ, WS_W_MKV, WS_W_MKV, WS_W_MO, WS_W_UP, WS_W_DN};
    const int roffs[NI] = {0, 0, 0, 0, 0, 0, 0, 512, 0, 0, 0};
    const int gains[NI] = {-1, -1, -1, -1, -1, I_GMEMX, -1, -1, -1, I_GFFN, -1};
    int base = 0;
#pragma unroll
    for (int m = M_LO; m < M_HI; ++m) {
        const int cnt = (Ks[m] / 64) * (Ns[m] / 32);
        int first = gw - (base % NGW); if (first < 0) first += NGW;
        const float* gp = gains[m] >= 0 ? F.inf(gains[m]) : nullptr;
        P0Item cur_, nxt_;
        if (first < cnt) p0_item_load(cur_, F.inf(srcs[m]), Ks[m], Ns[m], first, F.lane, gp);
        for (int it = first; it < cnt; it += NGW) {
            const bool more = it + NGW < cnt;
            if (more) p0_item_load(nxt_, F.inf(srcs[m]), Ks[m], Ns[m], it + NGW, F.lane, gp);
            int roff = roffs[m];
            if (m == 9) {
                const int n0 = 32 * (it % (Ns[m] / 32)); const int f0 = n0 < DFF ? n0 : n0 - DFF; roff = 256 * (f0 >> 7) + (n0 < DFF ? 0 : 128) + (f0 & 127) - n0; }
            p0_item_finish(cur_, Ks[m], Ns[m], F.w<bf16>(dsts[m]), roff, scr, it, F.lane, gains[m] >= 0);
            if (more) cur_ = nxt_;
        }
        base += cnt;
    }
}
__device__ __forceinline__ void p0_prologue(Frame& F) {
    const int gw = F.bid * NWAVES + F.wave, NGW = F.G * NWAVES;
    p0_transposes<0, 9>(F, gw, NGW);
    for (int r = gw; r < NINP - NIN; r += NGW) { v4u* p = (v4u*)(F.w<bf16>(WS_W_IN) + (size_t)(NIN + r) * D) + F.lane; p[0] = (v4u){0, 0, 0, 0}; p[64] = (v4u){0, 0, 0, 0}; }
    for (int r = gw; r < T + 2048; r += 2 * NGW) {
        f32x4 v[2][4]; const float* gp[2]; bf16* op[2]; bool ok[2];
#pragma unroll
        for (int k = 0; k < 2; ++k) { const int rr = r + k * NGW; ok[k] = rr < T + 2048;
            const float* xr = !ok[k] ? F.inf(I_XP) : (rr < T ? xrow_ptr(F, rr) : F.inf(I_MEMP) + (size_t)(rr - T) * D);
            gp[k] = (rr < T) ? F.inf(I_GMIX) : F.inf(I_GMEMIN); op[k] = (rr < T) ? F.w<bf16>(WS_XN) + (size_t)rr * D : F.w<bf16>(WS_MN) + (size_t)(rr - T) * D;
#pragma unroll
            for (int j = 0; j < 4; ++j) v[k][j] = ((const f32x4*)xr)[F.lane + 64 * j]; }
#pragma unroll
        for (int k = 0; k < 2; ++k) if (ok[k]) {
            float sq = 0.f;
#pragma unroll
            for (int j = 0; j < 4; ++j) sq += (v[k][j].x * v[k][j].x + v[k][j].y * v[k][j].y) + (v[k][j].z * v[k][j].z + v[k][j].w * v[k][j].w);
            const float rstd = rsqrtf(wave_sum(sq) * (1.f / 1024.f) + EPS);
            unsigned long long* o8 = (unsigned long long*)op[k] + F.lane;
#pragma unroll
            for (int j = 0; j < 4; ++j) { const f32x4 gg = ((const f32x4*)gp[k])[F.lane + 64 * j];
                o8[64 * j] = (unsigned long long)pk2(v[k][j].x * rstd * gg.x, v[k][j].y * rstd * gg.y) | ((unsigned long long)pk2(v[k][j].z * rstd * gg.z, v[k][j].w * rstd * gg.w) << 32); }
        }
    }
    { const float* wsrc = F.inf(I_WS); bf16* wdst = F.w<bf16>(WS_W_SB);
      for (int i = F.bid * 512 + F.tid; i < 8 * 128 * 128 / 4; i += F.G * 512) { const f32x4 v = *(const f32x4*)(wsrc + 4 * i); v2u o; o.x = pk2(v[0], v[1]); o.y = pk2(v[2], v[3]); *(v2u*)(wdst + 4 * i) = o; } }
    { float* cs = F.w<float>(WS_ROPE); float* sn = cs + ROPE_N * 16;
      for (int i = F.bid * 512 + F.tid; i < (int)ROPE_N * 16; i += F.G * 512) { const int pos = i >> 4, f = i & 15;
          const double ang = (double)pos * pow(10000.0, -(double)f / 16.0); cs[i] = (float)cos(ang); sn[i] = (float)sin(ang); } }
}

__device__ __forceinline__ void p2_post_inproj(Frame& F) {
    const int gw = F.bid * NWAVES + F.wave, NGW = F.G * NWAVES, lane = F.lane;
    const bf16* Z = F.w<bf16>(WS_Z);
    const float* lg = F.inf(I_LNG); const float* lb = F.inf(I_LNB);
    const f32x4 lg0 = *(const f32x4*)(lg + 8 * lane), lg1 = *(const f32x4*)(lg + 8 * lane + 4), lb0 = *(const f32x4*)(lb + 8 * lane), lb1 = *(const f32x4*)(lb + 8 * lane + 4);
    const f32x4 gqa = *(const f32x4*)(F.inf(I_GQA) + 4 * lane), gkva = *(const f32x4*)(F.inf(I_GKVA) + 4 * lane);
    for (int r0 = gw; r0 < T; r0 += 4 * NGW) {
        v4u rawv[4]; v2u rawq[4], rawk[4]; bf16 rawp[4];
#pragma unroll
        for (int k = 0; k < 4; ++k) { const int r = r0 + k * NGW; if (r < T) { const bf16* zr = Z + (size_t)r * NINP;
            rawv[k] = *(const v4u*)(zr + 512 + 8 * lane); rawq[k] = *(const v2u*)(zr + 1024 + 4 * lane); rawk[k] = *(const v2u*)(zr + 1280 + 4 * lane); rawp[k] = zr[1536 + (lane & 31)]; } }
#pragma unroll
        for (int k = 0; k < 4; ++k) { const int r = r0 + k * NGW; if (r < T) {
        {
            const v4u raw = rawv[k];
            float x[8];
#pragma unroll
            for (int i = 0; i < 4; ++i) { x[2 * i] = gelu_tanh_f(bflo(raw[i])); x[2 * i + 1] = gelu_tanh_f(bfhi(raw[i])); }
            float s = 0.f;
#pragma unroll
            for (int i = 0; i < 8; ++i) s += x[i];
            s = dpp_sum8(s);
            const float mean = s * (1.f / 64.f);
            float q = 0.f;
#pragma unroll
            for (int i = 0; i < 8; ++i) { x[i] -= mean; q += x[i] * x[i]; }
            q = dpp_sum8(q);
            const float rstd = rsqrtf(q * (1.f / 64.f) + EPS);
            f32x4 y0, y1;
#pragma unroll
            for (int i = 0; i < 4; ++i) { y0[i] = x[i] * rstd * lg0[i] + lb0[i]; y1[i] = x[4 + i] * rstd * lg1[i] + lb1[i]; }
            v4u o; o.x = pk2(y0[0], y0[1]); o.y = pk2(y0[2], y0[3]); o.z = pk2(y1[0], y1[1]); o.w = pk2(y1[2], y1[3]);
            *(v4u*)(F.w<bf16>(WS_VG) + (size_t)r * 512 + 8 * lane) = o;
            if (r >= TP) { float* d = F.out + O_SCV + (size_t)(r - TP) * 512 + 8 * lane; *(f32x4*)d = y0; *(f32x4*)(d + 4) = y1; }
        }
#pragma unroll
        for (int which = 0; which < 2; ++which) {
            const v2u raw = which ? rawk[k] : rawq[k];
            f32x4 x; x[0] = bflo(raw[0]); x[1] = bfhi(raw[0]); x[2] = bflo(raw[1]); x[3] = bfhi(raw[1]);
            const float ss = wave_sum((x[0] * x[0] + x[1] * x[1]) + (x[2] * x[2] + x[3] * x[3]));
            const float rstd = rsqrtf(ss * (1.f / 256.f) + EPS);
            const f32x4 g = which ? gkva : gqa;
            f32x4 y;
#pragma unroll
            for (int i = 0; i < 4; ++i) y[i] = x[i] * rstd * g[i];
            v2u o; o.x = pk2(y[0], y[1]); o.y = pk2(y[2], y[3]);
            *(v2u*)(F.w<bf16>(which ? WS_CKVN : WS_CQN) + (size_t)r * 256 + 4 * lane) = o;
            if (which) { float* d = (r < TP) ? F.out + O_PCKV + (size_t)r * 256 : F.out + O_SCKV + (size_t)(r - TP) * 256; *(f32x4*)(d + 4 * lane) = y; }
        }
        if (lane < 32) { float* d = (r < TP) ? F.out + O_PKPE + (size_t)r * 32 : F.out + O_SKPE + (size_t)(r - TP) * 32; d[lane] = bf2f(rawp[k]); }
        } }
    }
    const bf16* MKV = F.w<bf16>(WS_MKV);
    for (int r = gw; r < 2048; r += NGW) {
        const bf16* mr = MKV + (size_t)r * 1024;
        {
            const v4u raw = *(const v4u*)(mr + 8 * lane);
            float x[8];
#pragma unroll
            for (int i = 0; i < 4; ++i) { x[2 * i] = bflo(raw[i]); x[2 * i + 1] = bfhi(raw[i]); }
            float ss = 0.f;
#pragma unroll
            for (int i = 0; i < 8; ++i) ss += x[i] * x[i];
            ss = dpp_sum16(ss);
            const float rstd = rsqrtf(ss * (1.f / 128.f) + EPS);
            const float* g = F.inf(I_GMK) + ((8 * lane) & 127);
            f32x4 y0, y1;
#pragma unroll
            for (int i = 0; i < 4; ++i) { y0[i] = x[i] * rstd * g[i]; y1[i] = x[4 + i] * rstd * g[4 + i]; }
            float* d = F.out + O_PMK + (size_t)r * 512 + 8 * lane; *(f32x4*)d = y0; *(f32x4*)(d + 4) = y1;
            v4u o; o.x = pk2(y0[0], y0[1]); o.y = pk2(y0[2], y0[3]); o.z = pk2(y1[0], y1[1]); o.w = pk2(y1[2], y1[3]);
            *(v4u*)(F.w<bf16>(WS_MK) + (size_t)r * 512 + 8 * lane) = o;
        }
        {
            const v4u raw = *(const v4u*)(mr + 512 + 8 * lane);
            float x[8];
#pragma unroll
            for (int i = 0; i < 4; ++i) { x[2 * i] = bflo(raw[i]); x[2 * i + 1] = bfhi(raw[i]); }
            float* d = F.out + O_PMV + (size_t)r * 512 + 8 * lane; *(f32x4*)d = (f32x4){x[0], x[1], x[2], x[3]}; *(f32x4*)(d + 4) = (f32x4){x[4], x[5], x[6], x[7]};
        }
    }
    for (int g8 = gw; g8 < 256; g8 += NGW) {
        v4u rw[8];
#pragma unroll
        for (int k = 0; k < 8; ++k) rw[k] = *(const v4u*)(MKV + (size_t)(8 * g8 + k) * 1024 + 512 + 8 * lane);
        const int b = (8 * g8) >> 8, key0 = (8 * g8) & 255;
        bf16* mvt = F.w<bf16>(WS_MVT);
#pragma unroll
        for (int i = 0; i < 8; ++i) { const int col = 8 * lane + i, h = col >> 7, dv = col & 127; v4u o;
#pragma unroll
            for (int j = 0; j < 4; ++j) { const unsigned lo = (i & 1) ? (rw[2 * j][i >> 1] >> 16) : (rw[2 * j][i >> 1] & 0xffffu), hi = (i & 1) ? (rw[2 * j + 1][i >> 1] >> 16) : (rw[2 * j + 1][i >> 1] & 0xffffu); o[j] = lo | (hi << 16); }
            *(v4u*)(mvt + ((size_t)(b * 4 + h) * 128 + dv) * 256 + key0) = o; }
    }
}
}
namespace mk {
struct P4Raw { v4u raw; unsigned r1, r2; };
__device__ __forceinline__ P4Raw p4_load_row(const bf16* nope, const bf16* pe, int lane) { const int sub = lane & 7; P4Raw x; x.raw = *(const v4u*)(nope + 8 * sub); x.r1 = *(const unsigned*)(pe + 2 * sub); x.r2 = *(const unsigned*)(pe + 16 + 2 * sub); return x; }
__device__ __forceinline__ void p4_norm_rope_row(const P4Raw in, const float* g, const float* cs, const float* sn, int pos, float oscale, bf16* dst, int lane, bf16* dst2 = nullptr) {
    const int sub = lane & 7;
    const v4u raw = in.raw;
    const unsigned r1 = in.r1, r2 = in.r2;
    float x[8];
#pragma unroll
    for (int i = 0; i < 4; ++i) { x[2 * i] = bflo(raw[i]); x[2 * i + 1] = bfhi(raw[i]); }
    float a0 = bflo(r1), a1 = bfhi(r1), b0 = bflo(r2), b1 = bfhi(r2);
    float ss = (a0 * a0 + a1 * a1) + (b0 * b0 + b1 * b1);
#pragma unroll
    for (int i = 0; i < 8; ++i) ss += x[i] * x[i];
    ss = dpp_sum8(ss);
    const float rs = rsqrtf(ss * (1.f / 96.f) + EPS) * oscale;
    const f32x4 g0 = *(const f32x4*)(g + 8 * sub), g1 = *(const f32x4*)(g + 8 * sub + 4);
    v4u o; o.x = pk2(x[0] * rs * g0[0], x[1] * rs * g0[1]); o.y = pk2(x[2] * rs * g0[2], x[3] * rs * g0[3]); o.z = pk2(x[4] * rs * g1[0], x[5] * rs * g1[1]); o.w = pk2(x[6] * rs * g1[2], x[7] * rs * g1[3]);
    *(v4u*)(dst + 8 * sub) = o;
    const int f = 2 * sub;
    a0 *= rs * g[64 + f]; a1 *= rs * g[65 + f]; b0 *= rs * g[80 + f]; b1 *= rs * g[81 + f];
    const float c0 = cs[pos * 16 + f], c1 = cs[pos * 16 + f + 1], s0 = sn[pos * 16 + f], s1 = sn[pos * 16 + f + 1];
    const unsigned o1_ = pk2(a0 * c0 - b0 * s0, a1 * c1 - b1 * s1), o2_ = pk2(b0 * c0 + a0 * s0, b1 * c1 + a1 * s1);
    *(unsigned*)(dst + 64 + f) = o1_; *(unsigned*)(dst + 80 + f) = o2_;
    if (dst2) { *(unsigned*)(dst2 + f) = o1_; *(unsigned*)(dst2 + 16 + f) = o2_; }
}
__device__ __forceinline__ void p4_qk_norm_rope(Frame& F) {
    const int gw = F.bid * NWAVES + F.wave, NGW = F.G * NWAVES, lane = F.lane, h = lane >> 3;
    const float* cs = F.w<float>(WS_ROPE); const float* sn = cs + ROPE_N * 16;
    const bf16* QR = F.w<bf16>(WS_QR); const bf16* KNR = F.w<bf16>(WS_KNR); const bf16* Z = F.w<bf16>(WS_Z);
    for (int r0 = gw; r0 < T; r0 += 4 * NGW) {
        P4Raw qin[4], kin[4];
#pragma unroll
        for (int k = 0; k < 4; ++k) { const int r = r0 + k * NGW; if (r < T) { const bf16* q = QR + (size_t)r * 768 + 96 * h; qin[k] = p4_load_row(q, q + 64, lane);
            if (r < TP) kin[k] = p4_load_row(KNR + (size_t)r * 512 + 64 * h, Z + (size_t)r * NINP + 1536, lane); } }
#pragma unroll
        for (int k = 0; k < 4; ++k) { const int r = r0 + k * NGW; if (r < T) {
            const int pos = r < TP ? (r & 2047) : PAST + ((r - TP) & 3);
            bf16* qx = nullptr;
            if (r >= TP) { const int sq = (r - TP) >> 2, tq = (r - TP) & 3; qx = F.w<bf16>(WS_QEXT) + ((size_t)sq * 32 + tq * 8 + h) * 288 + 256; }
            p4_norm_rope_row(qin[k], F.inf(I_GQKQ), cs, sn, pos, QSCALE, F.w<bf16>(WS_QF) + (size_t)r * 768 + 96 * h, lane, qx);
            if (r < TP) p4_norm_rope_row(kin[k], F.inf(I_GQKK), cs, sn, pos, 1.f, F.w<bf16>(WS_KF) + (size_t)r * 768 + 96 * h, lane);
        } }
    }
}
__device__ __forceinline__ void p4_qext(Frame& F) {
    const int gw = F.bid * NWAVES + F.wave, NGW = F.G * NWAVES, lane = F.lane, l31 = lane & 31, hh = lane >> 5;
    const float* gq = F.inf(I_GQKQ); const float* gk = F.inf(I_GQKK);
    for (int u = gw; u < 1024; u += NGW) {
        const int h = u & 7, cbk = (u >> 3) & 7, rbk = u >> 6;
        const int row = TP + 32 * rbk + l31;
        const bf16* qp = F.w<bf16>(WS_QR) + (size_t)row * 768 + 96 * h;
        v4u raw[4]; float ss = 0.f;
#pragma unroll
        for (int ks = 0; ks < 4; ++ks) { raw[ks] = *(const v4u*)(qp + 16 * ks + 8 * hh);
#pragma unroll
            for (int i = 0; i < 4; ++i) { const float a = bflo(raw[ks][i]), c = bfhi(raw[ks][i]); ss += a * a + c * c; } }
        { const v4u r0 = *(const v4u*)(qp + 64 + 16 * hh), r1 = *(const v4u*)(qp + 64 + 16 * hh + 8);
#pragma unroll
          for (int i = 0; i < 4; ++i) { const float a = bflo(r0[i]), c = bfhi(r0[i]), d = bflo(r1[i]), e = bfhi(r1[i]); ss += (a * a + c * c) + (d * d + e * e); } }
        ss += __shfl_xor(ss, 32);
        const float rs = rsqrtf(ss * (1.f / 96.f) + EPS) * QSCALE;
        f32x16 acc = {};
        const float* wp = F.inf(I_WUK) + (size_t)(32 * cbk + l31) * 512 + h * 64 + 8 * hh;
#pragma unroll
        for (int ks = 0; ks < 4; ++ks) {
            const int d0 = 16 * ks + 8 * hh;
            const f32x4 w0 = *(const f32x4*)(wp + 16 * ks), w1 = *(const f32x4*)(wp + 16 * ks + 4);
            v4u wa; wa.x = cvtpk(w0[0], w0[1]); wa.y = cvtpk(w0[2], w0[3]); wa.z = cvtpk(w1[0], w1[1]); wa.w = cvtpk(w1[2], w1[3]);
            const f32x4 q0 = *(const f32x4*)(gq + d0), q1 = *(const f32x4*)(gq + d0 + 4), k0 = *(const f32x4*)(gk + d0), k1 = *(const f32x4*)(gk + d0 + 4);
            v4u qb; qb.x = cvtpk(bflo(raw[ks][0]) * rs * q0[0] * k0[0], bfhi(raw[ks][0]) * rs * q0[1] * k0[1]); qb.y = cvtpk(bflo(raw[ks][1]) * rs * q0[2] * k0[2], bfhi(raw[ks][1]) * rs * q0[3] * k0[3]);
            qb.z = cvtpk(bflo(raw[ks][2]) * rs * q1[0] * k1[0], bfhi(raw[ks][2]) * rs * q1[1] * k1[1]); qb.w = cvtpk(bflo(raw[ks][3]) * rs * q1[2] * k1[2], bfhi(raw[ks][3]) * rs * q1[3] * k1[3]);
            acc = __builtin_amdgcn_mfma_f32_32x32x16_bf16(__builtin_bit_cast(bf16x8, wa), __builtin_bit_cast(bf16x8, qb), acc, 0, 0, 0);
        }
        const int sq = (32 * rbk + l31) >> 2, tq = l31 & 3;
        bf16* dst = F.w<bf16>(WS_QEXT) + ((size_t)sq * 32 + tq * 8 + h) * 288 + 32 * cbk + 4 * hh;
#pragma unroll
        for (int g = 0; g < 4; ++g) { v2u o; o.x = cvtpk(acc[4 * g], acc[4 * g + 1]); o.y = cvtpk(acc[4 * g + 2], acc[4 * g + 3]); *(v2u*)(dst + 8 * g) = o; }
    }
}
}
namespace mk {
__device__ __forceinline__ float wave_max(float v) {
#pragma unroll
    for (int o = 1; o < 64; o <<= 1) v = fmaxf(v, __shfl_xor(v, o));
    return v;
}
__device__ __forceinline__ float gain_absmax(const float* g, int n, int lane) { float m = 0.f; for (int i = lane; i < n; i += 64) m = fmaxf(m, fabsf(g[i])); return wave_max(m); }

constexpr int PA_KROW = 208, PA_VROW = 144, PA_KBUF = 0, PA_VBUF = 2 * 64 * PA_KROW, PA_END = PA_VBUF + 2 * 64 * PA_VROW;
__device__ __forceinline__ void attn_prompt_unit(Frame& F, int b, int h, int qb, float negM) {
    const int tid = F.tid, lane = F.lane, wv = F.wave, l31 = lane & 31, hh = lane >> 5;
    LAS unsigned char* L = F.lds;
    const int q0w = 256 * qb + 32 * wv;
    const bf16* Qp = F.w<bf16>(WS_QF) + (size_t)(b * SEQ + q0w + l31) * 768 + h * 96 + 8 * hh;
    bf16x8 qf[6];
#pragma unroll
    for (int ks = 0; ks < 6; ++ks) qf[ks] = *(const bf16x8*)(Qp + 16 * ks);
    const bf16* Kg = F.w<bf16>(WS_KF) + (size_t)(b * SEQ) * 768 + h * 96;
    const bf16* Vg = F.w<bf16>(WS_VT) + (size_t)(h * 64) * TP + (size_t)b * SEQ;
    const int keyA = tid / 12, cA = tid % 12, keyB = (512 + tid) / 12, cB = (512 + tid) % 12, dvv = tid >> 3, cv = tid & 7;
    const int NT = 4 * qb + 4;
    v4u ka, kb2 = (v4u){0, 0, 0, 0}, vv_;
#define PA_LOAD(kt) do { ka = *(const v4u*)(Kg + (size_t)(64 * (kt) + keyA) * 768 + 8 * cA); if (tid < 256) kb2 = *(const v4u*)(Kg + (size_t)(64 * (kt) + keyB) * 768 + 8 * cB); \
        vv_ = *(const v4u*)(Vg + (size_t)dvv * TP + 64 * (kt) + 8 * cv); } while (0)
#define PA_STORE(buf) do { *(LAS v4u*)(L + PA_KBUF + (buf) * 64 * PA_KROW + keyA * PA_KROW + 16 * cA) = ka; if (tid < 256) *(LAS v4u*)(L + PA_KBUF + (buf) * 64 * PA_KROW + keyB * PA_KROW + 16 * cB) = kb2; \
        *(LAS v4u*)(L + PA_VBUF + (buf) * 64 * PA_VROW + dvv * PA_VROW + 16 * cv) = vv_; } while (0)
    PA_LOAD(0); PA_STORE(0);
    __syncthreads();
    if (NT > 1) PA_LOAD(1);
    f32x16 o0 = {}, o1 = {}; float l = 0.f;
#pragma unroll 1
    for (int kt = 0; kt < NT; ++kt) {
        const int buf = kt & 1;
        if (64 * kt <= q0w + 31) {
            const bool part = (64 * kt + 63 > q0w);
            const LAS unsigned char* kbp = L + PA_KBUF + buf * 64 * PA_KROW + l31 * PA_KROW + 16 * hh;
            const LAS unsigned char* vbp = L + PA_VBUF + buf * 64 * PA_VROW + l31 * PA_VROW + 8 * hh;
            bf16x8 kfa[6], kfb[6], vfa[2][2], vfb[2][2];
#define PA_VFRAG(dst, sub_) do { _Pragma("unroll") for (int s2 = 0; s2 < 2; ++s2) _Pragma("unroll") for (int dt = 0; dt < 2; ++dt) { const LAS unsigned char* vp = vbp + dt * 32 * PA_VROW + (32 * (sub_) + 16 * s2) * 2; \
                const s16x4 lo = *(const LAS s16x4*)vp, hi = *(const LAS s16x4*)(vp + 16); dst[s2][dt] = (bf16x8){lo[0], lo[1], lo[2], lo[3], hi[0], hi[1], hi[2], hi[3]}; } } while (0)
#define PA_EXP(s, sub_, pb, MASK) do { float p[16]; \
                _Pragma("unroll") for (int i = 0; i < 16; ++i) { float e = __builtin_amdgcn_exp2f(s[i] + negM); if (MASK && (64 * kt + 32 * (sub_) + (i & 3) + 8 * (i >> 2) + 4 * hh) > q0w + l31) e = 0.f; p[i] = e; l += e; } \
                _Pragma("unroll") for (int s2 = 0; s2 < 2; ++s2) { v4u w; w.x = cvtpk(p[8 * s2 + 0], p[8 * s2 + 1]); w.y = cvtpk(p[8 * s2 + 2], p[8 * s2 + 3]); w.z = cvtpk(p[8 * s2 + 4], p[8 * s2 + 5]); w.w = cvtpk(p[8 * s2 + 6], p[8 * s2 + 7]); pb[s2] = __builtin_bit_cast(bf16x8, w); } } while (0)
#pragma unroll
            for (int ks = 0; ks < 6; ++ks) kfa[ks] = *(const LAS bf16x8*)(kbp + 32 * ks);
            __builtin_amdgcn_sched_barrier(0);
            f32x16 sA = {}, sB = {};
#pragma unroll
            for (int ks = 0; ks < 6; ++ks) kfb[ks] = *(const LAS bf16x8*)(kbp + 32 * PA_KROW + 32 * ks);
#pragma unroll
            for (int ks = 0; ks < 6; ++ks) sA = __builtin_amdgcn_mfma_f32_32x32x16_bf16(kfa[ks], qf[ks], sA, 0, 0, 0);
            __builtin_amdgcn_sched_barrier(0);
            PA_VFRAG(vfa, 0);
#pragma unroll
            for (int ks = 0; ks < 6; ++ks) sB = __builtin_amdgcn_mfma_f32_32x32x16_bf16(kfb[ks], qf[ks], sB, 0, 0, 0);
            __builtin_amdgcn_sched_barrier(0);
            bf16x8 pbA[2], pbB[2];
            if (part) PA_EXP(sA, 0, pbA, true); else PA_EXP(sA, 0, pbA, false);
            __builtin_amdgcn_sched_barrier(0);
            PA_VFRAG(vfb, 1);
#pragma unroll
            for (int s2 = 0; s2 < 2; ++s2) { o0 = __builtin_amdgcn_mfma_f32_32x32x16_bf16(vfa[s2][0], pbA[s2], o0, 0, 0, 0); o1 = __builtin_amdgcn_mfma_f32_32x32x16_bf16(vfa[s2][1], pbA[s2], o1, 0, 0, 0); }
            __builtin_amdgcn_sched_barrier(0);
            if (part) PA_EXP(sB, 1, pbB, true); else PA_EXP(sB, 1, pbB, false);
            __builtin_amdgcn_sched_barrier(0);
#pragma unroll
            for (int s2 = 0; s2 < 2; ++s2) { o0 = __builtin_amdgcn_mfma_f32_32x32x16_bf16(vfb[s2][0], pbB[s2], o0, 0, 0, 0); o1 = __builtin_amdgcn_mfma_f32_32x32x16_bf16(vfb[s2][1], pbB[s2], o1, 0, 0, 0); }
            __builtin_amdgcn_sched_barrier(0);
#undef PA_VFRAG
#undef PA_EXP
        }
        if (kt + 1 < NT) PA_STORE(buf ^ 1);
        __syncthreads();
        if (kt + 2 < NT) PA_LOAD(kt + 2);
    }
#undef PA_LOAD
#undef PA_STORE
    l += __shfl_xor(l, 32);
    const float rl = 1.f / l;
    bf16* Op = F.w<bf16>(WS_BO) + (size_t)(b * SEQ + q0w + l31) * 512 + h * 64 + 4 * hh;
#pragma unroll
    for (int g = 0; g < 4; ++g) {
        v2u w0; w0.x = cvtpk(o0[4 * g] * rl, o0[4 * g + 1] * rl); w0.y = cvtpk(o0[4 * g + 2] * rl, o0[4 * g + 3] * rl);
        v2u w1; w1.x = cvtpk(o1[4 * g] * rl, o1[4 * g + 1] * rl); w1.y = cvtpk(o1[4 * g + 2] * rl, o1[4 * g + 3] * rl);
        *(v2u*)(Op + 8 * g) = w0; *(v2u*)(Op + 32 + 8 * g) = w1;
    }
}
__device__ __forceinline__ void p5_attn_prompt(Frame& F, float negM) {
    for (int u = F.bid; u < 256; u += F.G) {
        const int bh = u >> 2, p = u & 3, b = bh >> 3, h = bh & 7;
        attn_prompt_unit(F, b, h, p, negM);
        attn_prompt_unit(F, b, h, 7 - p, negM);
    }
}
}
namespace mk {
constexpr int SA_ROWB = 592;
constexpr int SA_TILE = 0, SA_T8 = 2 * 64 * SA_ROWB, SA_T8ROW = 272, SA_KP2 = SA_T8 + 64 * SA_T8ROW, SA_GPE = SA_KP2 + 256, SA_R = SA_GPE + 128, SA_PT = SA_R + 2048, SA_PTROW = 144,
              SA_QEXT = SA_PT + 32 * SA_PTROW, SA_RBASE = SA_QEXT + 32 * SA_ROWB  , SA_RDEL = SA_RBASE + 65 * 128  , SA_END = SA_RDEL + 64 * 128;
static_assert(SA_END <= RING_BYTES, "sample attention LDS");
typedef short v4i16_t __attribute__((ext_vector_type(4)));
#define SA_BAR() do { asm volatile("s_waitcnt lgkmcnt(0)" ::: "memory"); __builtin_amdgcn_s_barrier(); asm volatile("" ::: "memory"); } while (0)

__device__ __forceinline__ void attn_sample_unit(Frame& F, int s, int split, float negM) {
    const int tid = F.tid, lane = F.lane, w = F.wave, hh = lane >> 5, l31 = lane & 31;
    LAS unsigned char* L = F.lds;
    const float* pool_ckv = F.inf(I_CKV); const float* pool_kpe = F.inf(I_KPE); const int* pt = (const int*)F.in[I_PT] + s * 64;
    const float* cs = F.w<float>(WS_ROPE); const float* sn = cs + ROPE_N * 16;
    const float* gk = F.inf(I_GQKK);
    const int kbeg = split * 4096, NT = split ? 65 : 64;
    const int prow = tid >> 3, pc4 = tid & 7;
    const int mypage = pt[split * 32 + l31];
    f32x4 va[8], vb[8], pe;
#define SA_LOADC(n, V) do { const int key0_ = kbeg + 64 * (n); const int page_ = __builtin_amdgcn_readlane(mypage, (n) >> 1); const size_t rb_ = (size_t)page_ * 128 + (key0_ & 127); \
        const float* cp_ = pool_ckv + (rb_ + w) * 256 + 4 * lane; \
        _Pragma("unroll") for (int i = 0; i < 8; ++i) V[i] = __builtin_nontemporal_load((const f32x4*)(cp_ + (size_t)i * 2048)); } while (0)
#define SA_LOADPC(n) do { const int key0_ = kbeg + 64 * (n); const int page_ = __builtin_amdgcn_readlane(mypage, (n) >> 1); const size_t rb_ = (size_t)page_ * 128 + (key0_ & 127); \
        pe = __builtin_nontemporal_load((const f32x4*)(pool_kpe + (rb_ + prow) * 32 + 4 * pc4)); } while (0)
#define SA_LOADP(n) do { if (kbeg + 64 * (n) < PAST) SA_LOADPC(n); else { pe = (f32x4){0.f, 0.f, 0.f, 0.f}; \
            if (prow < 4) { const v2u r_ = *(const v2u*)(F.w<bf16>(WS_Z) + (size_t)(TP + 4 * s + prow) * NINP + 1536 + 4 * pc4); pe = (f32x4){bflo(r_.x), bfhi(r_.x), bflo(r_.y), bfhi(r_.y)}; } } } while (0)
#define SA_LOAD(n, V) do { \
        if (kbeg + 64 * (n) < PAST) SA_LOADC(n, V); else { \
            _Pragma("unroll") for (int i = 0; i < 8; ++i) V[i] = (f32x4){0.f, 0.f, 0.f, 0.f}; \
            if (w < 4) { const v2u o_ = *(const v2u*)(F.w<bf16>(WS_CKVN) + (size_t)(TP + 4 * s + w) * 256 + 4 * lane); V[0] = (f32x4){bflo(o_.x), bfhi(o_.x), bflo(o_.y), bfhi(o_.y)}; } \
        } } while (0)
#define SA_CONVERT(n, V) do { LAS unsigned char* tb_ = L + SA_TILE + ((n) & 1) * 64 * SA_ROWB; \
        _Pragma("unroll") for (int i = 0; i < 8; ++i) { v2u o_; o_.x = cvtpk(V[i][0], V[i][1]); o_.y = cvtpk(V[i][2], V[i][3]); \
            *(LAS v2u*)(tb_ + (w + 8 * i) * SA_ROWB + 8 * lane) = o_; \
            int f8_ = 0; f8_ = __builtin_amdgcn_cvt_pk_fp8_f32(V[i][0], V[i][1], f8_, false); f8_ = __builtin_amdgcn_cvt_pk_fp8_f32(V[i][2], V[i][3], f8_, true); \
            *(LAS int*)(L + SA_T8 + (w + 8 * i) * SA_T8ROW + 4 * lane) = f8_; } \
        { const f32x4 pv = pe; float ss_ = dpp_sum8((pv[0] * pv[0] + pv[1] * pv[1]) + (pv[2] * pv[2] + pv[3] * pv[3])); \
          if (pc4 == 0) ((LAS float*)(L + SA_KP2))[prow] = ss_; \
          const LAS float* rb_ = (const LAS float*)(L + SA_RBASE) + (n) * 32 + 4 * (pc4 & 3); const LAS float* rd_ = (const LAS float*)(L + SA_RDEL) + prow * 32 + 4 * (pc4 & 3); \
          const f32x4 cb_ = *(const LAS f32x4*)rb_, sb_ = *(const LAS f32x4*)(rb_ + 16), cd_ = *(const LAS f32x4*)rd_, sd_ = *(const LAS f32x4*)(rd_ + 16); \
          const f32x4 c_ = cb_ * cd_ - sb_ * sd_, s_ = sb_ * cd_ + cb_ * sd_; \
          f32x4 x_ = pv * *(const LAS f32x4*)(L + SA_GPE + 16 * pc4), y_, o4_; _Pragma("unroll") for (int e_ = 0; e_ < 4; ++e_) { const float a_ = dpp_take<0x104, 0xf>(x_[e_]), b_ = dpp_take<0x114, 0xf>(x_[e_]); y_[e_] = pc4 >= 4 ? b_ : a_; }        \
          if (pc4 < 4) o4_ = x_ * c_ - y_ * s_; else o4_ = x_ * c_ + y_ * s_; \
          v2u o_; o_.x = cvtpk(o4_[0], o4_[1]); o_.y = cvtpk(o4_[2], o4_[3]); *(LAS v2u*)(tb_ + prow * SA_ROWB + 512 + pc4 * 8) = o_; } } while (0)
    SA_LOADPC(0); SA_LOADC(0, va);
    __builtin_amdgcn_sched_barrier(0);
    SA_LOADC(1, vb);
    __builtin_amdgcn_sched_barrier(0);
    { const bf16* qx = F.w<bf16>(WS_QEXT) + (size_t)s * 32 * 288;
      for (int ch = tid; ch < 32 * 36; ch += 512) { const int r_ = ch / 36, c_ = ch % 36; *(LAS v4u*)(L + SA_QEXT + r_ * SA_ROWB + 16 * c_) = *(const v4u*)(qx + r_ * 288 + 8 * c_); } }
    typedef int v8i_t __attribute__((ext_vector_type(8)));
    v8i_t Wf[2][4];
    { const bf16* Wp = F.w<bf16>(WS_W_UK) + (size_t)(w * 64 + l31) * 256 + 32 * hh;
#pragma unroll
      for (int dt = 0; dt < 2; ++dt)
#pragma unroll
          for (int ks = 0; ks < 4; ++ks) { v8i_t fr;
#pragma unroll
              for (int q = 0; q < 4; ++q) { const v4u raw = *(const v4u*)(Wp + (size_t)dt * 32 * 256 + 64 * ks + 8 * q);
                  int d0 = 0, d1 = 0;
                  d0 = __builtin_amdgcn_cvt_pk_fp8_f32(bflo(raw.x) * 16.f, bfhi(raw.x) * 16.f, d0, false); d0 = __builtin_amdgcn_cvt_pk_fp8_f32(bflo(raw.y) * 16.f, bfhi(raw.y) * 16.f, d0, true);
                  d1 = __builtin_amdgcn_cvt_pk_fp8_f32(bflo(raw.z) * 16.f, bfhi(raw.z) * 16.f, d1, false); d1 = __builtin_amdgcn_cvt_pk_fp8_f32(bflo(raw.w) * 16.f, bfhi(raw.w) * 16.f, d1, true);
                  fr[2 * q] = d0; fr[2 * q + 1] = d1; }
              Wf[dt][ks] = fr; } }
    if (tid < 32) ((LAS float*)(L + SA_GPE))[tid] = gk[64 + tid];
    for (int i = tid; i < 65 * 8; i += 512) { const int n_ = i >> 3, c_ = i & 7; *(LAS f32x4*)(L + SA_RBASE + n_ * 128 + 16 * c_) = *(const f32x4*)((c_ < 4 ? cs : sn - 16) + (size_t)(kbeg + 64 * n_) * 16 + 4 * c_); }
    { const int r_ = tid >> 3, c_ = tid & 7; *(LAS f32x4*)(L + SA_RDEL + r_ * 128 + 16 * c_) = *(const f32x4*)((c_ < 4 ? cs : sn - 16) + (size_t)r_ * 16 + 4 * c_); }
    SA_BAR();
    f32x16 oacc = {}; float lsum = 0.f;
    SA_CONVERT(0, va);
    __builtin_amdgcn_sched_barrier(0);
    SA_LOADPC(1);
    __builtin_amdgcn_sched_barrier(0);
    SA_LOADC(2, va);
    __builtin_amdgcn_sched_barrier(0);
    SA_BAR();
    const int lane_ = lane, tid_ = tid;
#define SA_STEP(n, V, DO_CONV, DO_LOADP, LOADPM, DO_LOAD, LOADM) do { \
        const int lane = opaque_i(lane_), tid = opaque_i(tid_), hh = lane >> 5, l31 = lane & 31, prow = tid >> 3, pc4 = tid & 7, l15 = lane & 15, l4 = lane >> 4;     \
        const LAS unsigned char* tb = L + SA_TILE + ((n) & 1) * 64 * SA_ROWB; \
          \
        _Pragma("unroll") for (int kt2 = 0; kt2 < 2; ++kt2) { \
            const LAS unsigned char* bp = L + SA_T8 + (32 * kt2 + l31) * SA_T8ROW + 32 * hh; \
            f32x16 a0 = {}, a1 = {}; \
            _Pragma("unroll") for (int ks = 0; ks < 4; ++ks) { const v4u lo = *(const LAS v4u*)(bp + 64 * ks), hi = *(const LAS v4u*)(bp + 64 * ks + 16); \
                const v8i_t fb = (v8i_t){(int)lo.x, (int)lo.y, (int)lo.z, (int)lo.w, (int)hi.x, (int)hi.y, (int)hi.z, (int)hi.w}; \
                a0 = __builtin_amdgcn_mfma_scale_f32_32x32x64_f8f6f4(Wf[0][ks], fb, a0, 0, 0, 0, 0x7B7B7B7B, 0, 0x7F7F7F7F); \
                a1 = __builtin_amdgcn_mfma_scale_f32_32x32x64_f8f6f4(Wf[1][ks], fb, a1, 0, 0, 0, 0x7B7B7B7B, 0, 0x7F7F7F7F); \
                if (ks & 1) __builtin_amdgcn_sched_barrier(0); } \
            float ss = 0.f; \
            _Pragma("unroll") for (int i = 0; i < 16; ++i) ss += a0[i] * a0[i] + a1[i] * a1[i]; \
            ss += __shfl_xor(ss, 32); \
            ss += ((const LAS float*)(L + SA_KP2))[32 * kt2 + l31]; \
            if (hh == 0) ((LAS float*)(L + SA_R))[w * 64 + 32 * kt2 + l31] = rsqrtf(ss * (1.f / 96.f) + EPS); \
        } \
        SA_BAR(); \
        if (DO_CONV) SA_CONVERT((n) + 1, V); \
        __builtin_amdgcn_sched_barrier(0); \
        if (DO_LOADP) LOADPM((n) + 2); \
        __builtin_amdgcn_sched_barrier(0); \
        if (DO_LOAD) LOADM((n) + 3, V); \
        __builtin_amdgcn_sched_barrier(0); \
          \
        if (w < 2) { \
            f32x16 sa0 = {}, sa1 = {}; \
            const LAS unsigned char* ap = tb + (32 * w + l31) * SA_ROWB + 16 * hh; \
            const LAS unsigned char* qp = L + SA_QEXT + l31 * SA_ROWB + 16 * hh; \
            _Pragma("unroll") for (int k0 = 0; k0 < 18; k0 += 3) { bf16x8 afr[3], qfr[3]; \
                _Pragma("unroll") for (int ks = 0; ks < 3; ++ks) { afr[ks] = *(const LAS bf16x8*)(ap + 32 * (k0 + ks)); qfr[ks] = *(const LAS bf16x8*)(qp + 32 * (k0 + ks)); } \
                __builtin_amdgcn_sched_barrier(0); \
                _Pragma("unroll") for (int ks = 0; ks < 3; ++ks) { if ((k0 + ks) & 1) sa1 = __builtin_amdgcn_mfma_f32_32x32x16_bf16(afr[ks], qfr[ks], sa1, 0, 0, 0); else sa0 = __builtin_amdgcn_mfma_f32_32x32x16_bf16(afr[ks], qfr[ks], sa0, 0, 0, 0); } \
                __builtin_amdgcn_sched_barrier(0); } \
            const int t_q = l31 >> 3, h_q = l31 & 7; \
            _Pragma("unroll") for (int g = 0; g < 4; ++g) { \
                const f32x4 r4 = *(const LAS f32x4*)(L + SA_R + (h_q * 64 + 32 * w + 8 * g + 4 * hh) * 4); \
                const int kg = kbeg + 64 * (n) + 32 * w + 8 * g + 4 * hh; \
                float p[4]; \
                _Pragma("unroll") for (int i = 0; i < 4; ++i) { float e = __builtin_amdgcn_exp2f((sa0[4 * g + i] + sa1[4 * g + i]) * r4[i] + negM); if (kg + i > PAST + t_q) e = 0.f; p[i] = e; lsum += e; } \
                v2u o; o.x = cvtpk(p[0], p[1]); o.y = cvtpk(p[2], p[3]); \
                *(LAS v2u*)(L + SA_PT + l31 * SA_PTROW + (32 * w + 8 * g + 4 * hh) * 2) = o; } \
        } \
        SA_BAR(); \
          \
        { \
            const LAS unsigned char* trp = tb + (8 * hh + (l15 >> 2)) * SA_ROWB + (32 * w + 16 * (l4 & 1) + 4 * (l15 & 3)) * 2; \
            const LAS unsigned char* pp = L + SA_PT + l31 * SA_PTROW + 16 * hh; \
            _Pragma("unroll") for (int s2 = 0; s2 < 4; ++s2) { \
                const s16x4 lo = __builtin_bit_cast(s16x4, __builtin_amdgcn_ds_read_tr16_b64_v4i16((LAS v4i16_t*)(trp + (16 * s2) * SA_ROWB))); \
                const s16x4 hi = __builtin_bit_cast(s16x4, __builtin_amdgcn_ds_read_tr16_b64_v4i16((LAS v4i16_t*)(trp + (16 * s2 + 4) * SA_ROWB))); \
                const bf16x8 af = (bf16x8){lo[0], lo[1], lo[2], lo[3], hi[0], hi[1], hi[2], hi[3]}; \
                const bf16x8 pf = *(const LAS bf16x8*)(pp + 32 * s2); \
                oacc = __builtin_amdgcn_mfma_f32_32x32x16_bf16(af, pf, oacc, 0, 0, 0); if (s2 & 1) __builtin_amdgcn_sched_barrier(0); \
            } \
        } } while (0)
#pragma unroll 1
    for (int n = 0; n < 60; n += 2) {
        SA_STEP(n, vb, true, true, SA_LOADPC, true, SA_LOADC);
        SA_STEP(n + 1, va, true, true, SA_LOADPC, true, SA_LOADC);
    }
#pragma unroll 1
    for (int n = 60; n < NT; n += 2) {
        SA_STEP(n, vb, n + 1 < NT, n + 2 < NT, SA_LOADP, n + 3 < NT, SA_LOAD);
        if (n + 1 < NT) SA_STEP(n + 1, va, n + 2 < NT, n + 3 < NT, SA_LOADP, n + 4 < NT, SA_LOAD);
    }
#undef SA_STEP
#undef SA_LOAD
#undef SA_LOADC
#undef SA_LOADP
#undef SA_LOADPC
#undef SA_CONVERT
    float* part = (float*)(F.ws + WS_SPART + (size_t)(s * 2 + split) * SPART_STRIDE);
    lsum += __shfl_xor(lsum, 32);
    __syncthreads();
    if (w < 2 && lane < 32) ((LAS float*)(L + SA_R))[w * 32 + lane] = lsum;
    __syncthreads();
    if (tid < 32) { const LAS float* lp = (const LAS float*)(L + SA_R); part[tid] = lp[tid] + lp[32 + tid]; }
#pragma unroll
    for (int g = 0; g < 4; ++g) *(f32x4*)(part + 32 + l31 * 256 + 32 * w + 8 * g + 4 * hh) = (f32x4){oacc[4 * g], oacc[4 * g + 1], oacc[4 * g + 2], oacc[4 * g + 3]};
    __syncthreads();
}
}
namespace mk {
__device__ __forceinline__ void p6_gmlp_chunk(Frame& F, int chunk) {
    const int lane = F.lane, g = F.wave, hh = lane >> 5, l31 = lane & 31;
    LAS float* SS = (LAS float*)(F.lds + 131072);
    LAS unsigned char* VT_ = F.lds + g * 16384;
    const int row0 = chunk * 128;
    const bf16* VG = F.w<bf16>(WS_VG) + (size_t)row0 * 512 + g * 64;
    const bf16* Z = F.w<bf16>(WS_Z) + (size_t)row0 * NINP + g * 64;
    const bf16* Wg = F.w<bf16>(WS_W_SB) + (size_t)g * 128 * 128;
    const float* bs = F.inf(I_BS) + g * 128;
    v4u wf[4][8];
#pragma unroll
    for (int tt = 0; tt < 4; ++tt)
#pragma unroll
        for (int ks = 0; ks < 2 * tt + 2; ++ks) wf[tt][ks] = *(const v4u*)(Wg + (size_t)(32 * tt + l31) * 128 + 16 * ks + 8 * hh);
#pragma unroll
    for (int i = 0; i < 16; ++i) { const int r = (lane >> 3) + 8 * i, ch = lane & 7; const v4u v = *(const v4u*)(VG + (size_t)r * 512 + 8 * ch); *(LAS v4u*)(VT_ + r * 128 + 16 * ch) = v;
        if ((i & 3) == 3) __builtin_amdgcn_sched_barrier(0); }
    LDS_WAIT(); asm volatile("" ::: "memory");
    const int l4 = lane >> 4, l15 = lane & 15;
    const LAS unsigned char* trb = VT_ + (8 * hh + (l15 >> 2)) * 128 + (16 * (l4 & 1) + 4 * (l15 & 3)) * 2;
    v2u pa[4][2][4];
    v2u ura[4][2][4]; float bta[4];
#pragma unroll
    for (int tt = 0; tt < 4; ++tt) { const int t = 32 * tt + l31; bta[tt] = bs[t];
#pragma unroll
        for (int dt = 0; dt < 2; ++dt)
#pragma unroll
            for (int gq = 0; gq < 4; ++gq) ura[tt][dt][gq] = *(const v2u*)(Z + (size_t)t * NINP + 32 * dt + 8 * gq + 4 * hh); }
#pragma unroll
    for (int tt = 0; tt < 4; ++tt) {
        const int t = 32 * tt + l31;
        const v2u (&ur)[2][4] = ura[tt];
        const float bt = bta[tt];
        f32x16 a0 = {}, a1 = {};
#pragma unroll
        for (int ks = 0; ks < 2 * tt + 2; ++ks) {
            v4u pk = wf[tt][ks];
            if (ks >= 2 * tt) {
                const int s0 = 16 * ks + 8 * hh;
#pragma unroll
                for (int i = 0; i < 4; ++i) { unsigned wv = pk[i]; if (s0 + 2 * i > t) wv = 0u; else if (s0 + 2 * i + 1 > t) wv &= 0xffffu; pk[i] = wv; }
            }
            const bf16x8 bfr = __builtin_bit_cast(bf16x8, pk);
            bf16x8 af[2];
#pragma unroll
            for (int dt = 0; dt < 2; ++dt) {
                const s16x4 lo = __builtin_bit_cast(s16x4, __builtin_amdgcn_ds_read_tr16_b64_v4i16((LAS v4i16_t*)(trb + (16 * ks) * 128 + 64 * dt)));
                const s16x4 hi = __builtin_bit_cast(s16x4, __builtin_amdgcn_ds_read_tr16_b64_v4i16((LAS v4i16_t*)(trb + (16 * ks + 4) * 128 + 64 * dt)));
                af[dt] = (bf16x8){lo[0], lo[1], lo[2], lo[3], hi[0], hi[1], hi[2], hi[3]};
            }
            a0 = __builtin_amdgcn_mfma_f32_32x32x16_bf16(af[0], bfr, a0, 0, 0, 0); a1 = __builtin_amdgcn_mfma_f32_32x32x16_bf16(af[1], bfr, a1, 0, 0, 0);
        }
        float ss = 0.f;
#pragma unroll
        for (int dt = 0; dt < 2; ++dt)
#pragma unroll
            for (int gq = 0; gq < 4; ++gq) {
                const v2u u2 = ur[dt][gq];
                const float u0 = gelu_tanh_f(bflo(u2.x)), u1 = gelu_tanh_f(bfhi(u2.x)), u2f = gelu_tanh_f(bflo(u2.y)), u3 = gelu_tanh_f(bfhi(u2.y));
                const f32x16& acc = dt ? a1 : a0;
                const float v0 = u0 * (acc[4 * gq] + bt), v1 = u1 * (acc[4 * gq + 1] + bt), v2 = u2f * (acc[4 * gq + 2] + bt), v3 = u3 * (acc[4 * gq + 3] + bt);
                ss += (v0 * v0 + v1 * v1) + (v2 * v2 + v3 * v3);
                v2u o; o.x = cvtpk(v0, v1); o.y = cvtpk(v2, v3); pa[tt][dt][gq] = o;
            }
        ss += __shfl_xor(ss, 32);
        if (hh == 0) SS[g * 128 + t] = ss;
    }
    __syncthreads();
    const float* goa = F.inf(I_GOA) + g * 64;
    bf16* MRG = F.w<bf16>(WS_MRG) + (size_t)row0 * 1024 + g * 64;
#pragma unroll
    for (int tt = 0; tt < 4; ++tt) {
        const int t = 32 * tt + l31;
        float tot = 0.f;
#pragma unroll
        for (int k = 0; k < 8; ++k) tot += SS[k * 128 + t];
        const float rstd = rsqrtf(tot * (1.f / 512.f) + EPS);
#pragma unroll
        for (int dt = 0; dt < 2; ++dt)
#pragma unroll
            for (int gq = 0; gq < 4; ++gq) {
                const int d0 = 32 * dt + 8 * gq + 4 * hh;
                const f32x4 gg = *(const f32x4*)(goa + d0);
                const v2u v = pa[tt][dt][gq];
                v2u o; o.x = cvtpk(bflo(v.x) * rstd * gg[0], bfhi(v.x) * rstd * gg[1]); o.y = cvtpk(bflo(v.y) * rstd * gg[2], bfhi(v.y) * rstd * gg[3]);
                *(v2u*)(MRG + (size_t)t * 1024 + d0) = o;
            }
    }
    __syncthreads();
}
__device__ __forceinline__ void p6_sample_seq(Frame& F, int s) {
    const int tid = F.tid, lane = F.lane, w = F.wave, l31 = lane & 31, hh = lane >> 5;
    LAS float* RED = (LAS float*)(F.lds + 32768);
    const float* p0 = (const float*)(F.ws + WS_SPART + (size_t)(s * 2) * SPART_STRIDE); const float* p1 = (const float*)((const unsigned char*)p0 + SPART_STRIDE);
    f32x16 a0 = {}, a1 = {};
    {
        const int th = (l31 & 3) * 8 + w;
        const float inv_l = 1.f / (p0[th] + p1[th]);
        const float* o0 = p0 + 32 + th * 256 + 8 * hh; const float* o1 = p1 + 32 + th * 256 + 8 * hh;
        const bf16* Wp = F.w<bf16>(WS_W_UV) + (size_t)(w * 64 + l31) * 256 + 8 * hh;
#pragma unroll
        for (int k0 = 0; k0 < 16; k0 += 4) {
            f32x4 x0[4], x1[4], y0[4], y1[4]; bf16x8 b0[4], b1[4];
#pragma unroll
            for (int i = 0; i < 4; ++i) { const int ks = k0 + i; x0[i] = *(const f32x4*)(o0 + 16 * ks); x1[i] = *(const f32x4*)(o0 + 16 * ks + 4); y0[i] = *(const f32x4*)(o1 + 16 * ks); y1[i] = *(const f32x4*)(o1 + 16 * ks + 4);
                b0[i] = *(const bf16x8*)(Wp + 16 * ks); b1[i] = *(const bf16x8*)(Wp + (size_t)32 * 256 + 16 * ks); }
#pragma unroll
            for (int i = 0; i < 4; ++i) { const f32x4 u0 = (x0[i] + y0[i]) * inv_l, u1 = (x1[i] + y1[i]) * inv_l;
                v4u pk; pk.x = cvtpk(u0[0], u0[1]); pk.y = cvtpk(u0[2], u0[3]); pk.z = cvtpk(u1[0], u1[1]); pk.w = cvtpk(u1[2], u1[3]);
                if (l31 >= 4) pk = (v4u){0u, 0u, 0u, 0u};
                const bf16x8 af = __builtin_bit_cast(bf16x8, pk);
                a0 = __builtin_amdgcn_mfma_f32_32x32x16_bf16(af, b0[i], a0, 0, 0, 0); a1 = __builtin_amdgcn_mfma_f32_32x32x16_bf16(af, b1[i], a1, 0, 0, 0); }
        }
    }
    const int col = tid;
    float ao[4];
    { const int g = col >> 6; const bf16* VG = F.w<bf16>(WS_VG) + (size_t)(TP + 4 * s) * 512 + col; const bf16* Z = F.w<bf16>(WS_Z) + (size_t)(TP + 4 * s) * NINP + col;
      const float* Wg = F.inf(I_WS) + (size_t)g * 128 * 128; const float* bs = F.inf(I_BS) + g * 128;
      float vg[4];
#pragma unroll
      for (int t = 0; t < 4; ++t) vg[t] = bf2f(VG[(size_t)t * 512]);
#pragma unroll
      for (int t = 0; t < 4; ++t) { float m = bs[t];
#pragma unroll
          for (int s2 = 0; s2 <= t; ++s2) m += Wg[t * 128 + s2] * vg[s2];
          ao[t] = gelu_tanh_f(bf2f(Z[(size_t)t * NINP])) * m; } }
    float red[8];
#pragma unroll
    for (int t = 0; t < 4; ++t) { red[t] = wave_sum(ao[t] * ao[t]); const float bq = (hh == 0) ? (a0[t] * a0[t] + a1[t] * a1[t]) : 0.f; red[4 + t] = wave_sum(bq); }
    if (lane < 8) { float v = red[0];
#pragma unroll
        for (int k = 1; k < 8; ++k) v = (lane == k) ? red[k] : v;
        RED[w * 8 + lane] = v; }
    __syncthreads();
    const float ga = F.inf(I_GOA)[col];
    bf16* MRG = F.w<bf16>(WS_MRG) + (size_t)(TP + 4 * s) * 1024; bf16* BO = F.w<bf16>(WS_BO) + (size_t)(TP + 4 * s) * 512;
    const float gb0 = F.inf(I_GOB)[w * 64 + l31], gb1 = F.inf(I_GOB)[w * 64 + 32 + l31];
#pragma unroll
    for (int t = 0; t < 4; ++t) {
        float sa = 0.f, sb = 0.f;
#pragma unroll
        for (int k = 0; k < 8; ++k) { sa += RED[k * 8 + t]; sb += RED[k * 8 + 4 + t]; }
        MRG[(size_t)t * 1024 + col] = (bf16)f2bf(ao[t] * rsqrtf(sa * (1.f / 512.f) + EPS) * ga);
        if (hh == 0) { const float rb = rsqrtf(sb * (1.f / 512.f) + EPS);
            MRG[(size_t)t * 1024 + 512 + w * 64 + l31] = (bf16)f2bf(a0[t] * rb * gb0); MRG[(size_t)t * 1024 + 512 + w * 64 + 32 + l31] = (bf16)f2bf(a1[t] * rb * gb1);
            BO[(size_t)t * 512 + w * 64 + l31] = (bf16)f2bf(a0[t]); BO[(size_t)t * 512 + w * 64 + 32 + l31] = (bf16)f2bf(a1[t]); }
    }
    __syncthreads();
}
static_assert(TP % (4 * 256 * NWAVES) == 0, "b_out norm loop: four rows per wave iteration");
__device__ __forceinline__ void p6_merge(Frame& F) {
#ifdef MK_TIMING
    unsigned long long* st_ = (unsigned long long*)(F.ws + WS_CTL + (768 << 10)) + F.bid * 32;
#define P6ST(k) do { if (F.tid == 0) st_[k] = __builtin_amdgcn_s_memrealtime(); } while (0)
#else
#define P6ST(k) do {} while (0)
#endif
    { const int u = F.bid; if (u < 128) { P6ST(24); p6_gmlp_chunk(F, u); P6ST(25); } else { P6ST(26); p6_sample_seq(F, u - 128); P6ST(27); } }
    P6ST(28);
    const int gw = F.bid * NWAVES + F.wave, NGW = F.G * NWAVES, lane = F.lane;
    const f32x4 g0 = *(const f32x4*)(F.inf(I_GOB) + 8 * lane), g1 = *(const f32x4*)(F.inf(I_GOB) + 8 * lane + 4);
    for (int r0 = gw; r0 < TP; r0 += 4 * NGW) {
        v4u raws[4];
#pragma unroll
        for (int k = 0; k < 4; ++k) raws[k] = *(const v4u*)(F.w<bf16>(WS_BO) + (size_t)(r0 + k * NGW) * 512 + 8 * lane);
#pragma unroll
        for (int k = 0; k < 4; ++k) { const int r = r0 + k * NGW; const v4u raw = raws[k];
        float x[8];
#pragma unroll
        for (int i = 0; i < 4; ++i) { x[2 * i] = bflo(raw[i]); x[2 * i + 1] = bfhi(raw[i]); }
        float ss = 0.f;
#pragma unroll
        for (int i = 0; i < 8; ++i) ss += x[i] * x[i];
        const float rstd = rsqrtf(wave_sum(ss) * (1.f / 512.f) + EPS);
        v4u o; o.x = pk2(x[0] * rstd * g0[0], x[1] * rstd * g0[1]); o.y = pk2(x[2] * rstd * g0[2], x[3] * rstd * g0[3]); o.z = pk2(x[4] * rstd * g1[0], x[5] * rstd * g1[1]); o.w = pk2(x[6] * rstd * g1[2], x[7] * rstd * g1[3]);
        *(v4u*)(F.w<bf16>(WS_MRG) + (size_t)r * 1024 + 512 + 8 * lane) = o;
        }
    }
    P6ST(29);
}
}
namespace mk {
__device__ __forceinline__ void rms_rowb_finish(const v4u a, const v4u b, const f32x4 g0, const f32x4 g1, const f32x4 g2, const f32x4 g3, bf16* orow, int lane) {
    float x[16];
#pragma unroll
    for (int i = 0; i < 4; ++i) { x[2 * i] = bflo(a[i]); x[2 * i + 1] = bfhi(a[i]); x[8 + 2 * i] = bflo(b[i]); x[8 + 2 * i + 1] = bfhi(b[i]); }
    float s = 0.f;
#pragma unroll
    for (int i = 0; i < 16; ++i) s += x[i] * x[i];
    const float rstd = rsqrtf(wave_sum(s) * (1.f / 1024.f) + EPS);
    v4u o0, o1;
    o0.x = pk2(x[0] * rstd * g0[0], x[1] * rstd * g0[1]); o0.y = pk2(x[2] * rstd * g0[2], x[3] * rstd * g0[3]); o0.z = pk2(x[4] * rstd * g1[0], x[5] * rstd * g1[1]); o0.w = pk2(x[6] * rstd * g1[2], x[7] * rstd * g1[3]);
    o1.x = pk2(x[8] * rstd * g2[0], x[9] * rstd * g2[1]); o1.y = pk2(x[10] * rstd * g2[2], x[11] * rstd * g2[3]); o1.z = pk2(x[12] * rstd * g3[0], x[13] * rstd * g3[1]); o1.w = pk2(x[14] * rstd * g3[2], x[15] * rstd * g3[3]);
    *(v4u*)(orow + 8 * lane) = o0; *(v4u*)(orow + 512 + 8 * lane) = o1;
}
__device__ __forceinline__ void p_rms_rows(Frame& F, size_t src_off, int gain_idx, size_t dst_off) {
    const int gw = F.bid * NWAVES + F.wave, NGW = F.G * NWAVES, lane = F.lane;
    const float* g = F.inf(gain_idx);
    const f32x4 g0 = *(const f32x4*)(g + 8 * lane), g1 = *(const f32x4*)(g + 8 * lane + 4), g2 = *(const f32x4*)(g + 512 + 8 * lane), g3 = *(const f32x4*)(g + 512 + 8 * lane + 4);
    const bf16* src = F.w<bf16>(src_off); bf16* dst = F.w<bf16>(dst_off);
    for (int r = gw; r < T; r += 4 * NGW) {
        v4u a[4], b[4];
#pragma unroll
        for (int k = 0; k < 4; ++k) { const int rr = r + k * NGW; if (rr < T) { a[k] = *(const v4u*)(src + (size_t)rr * D + 8 * lane); b[k] = *(const v4u*)(src + (size_t)rr * D + 512 + 8 * lane); } }
#pragma unroll
        for (int k = 0; k < 4; ++k) { const int rr = r + k * NGW; if (rr < T) rms_rowb_finish(a[k], b[k], g0, g1, g2, g3, dst + (size_t)rr * D, lane); }
    }
}

constexpr int MA_KROW = 272, MA_VROW = 528, MA_K = 0, MA_V = 256 * MA_KROW;
static_assert(MA_V + 128 * MA_VROW <= RING_BYTES, "memory attention LDS");
__device__ __forceinline__ void memattn_prompt_unit(Frame& F, int pb, int h, float negM) {
    const int tid = F.tid, lane = F.lane, l31 = lane & 31, hh = lane >> 5;
    const int b = pb >> 3, row = 256 * pb + 32 * F.wave + l31;
    LAS unsigned char* L = F.lds;
    {
        const bf16* Kg = F.w<bf16>(WS_MK) + (size_t)(b * 256) * 512 + h * 128;
        const bf16* Vg = F.w<bf16>(WS_MVT) + (size_t)(b * 4 + h) * 128 * 256;
        v4u kr[8], vr[8];
#pragma unroll
        for (int i = 0; i < 8; ++i) { const int ch = tid + 512 * i; kr[i] = *(const v4u*)(Kg + (size_t)(ch >> 4) * 512 + 8 * (ch & 15)); vr[i] = *(const v4u*)(Vg + (size_t)(ch >> 5) * 256 + 8 * (ch & 31)); }
#pragma unroll
        for (int i = 0; i < 8; ++i) { const int ch = tid + 512 * i; *(LAS v4u*)(L + MA_K + (ch >> 4) * MA_KROW + 16 * (ch & 15)) = kr[i]; *(LAS v4u*)(L + MA_V + (ch >> 5) * MA_VROW + 16 * (ch & 31)) = vr[i]; }
    }
    const bf16* Qp = F.w<bf16>(WS_MQ) + (size_t)row * 512 + h * 128 + 8 * hh;
    const float* g = F.inf(I_GMQ) + 8 * hh;
    bf16x8 qf[8];
    {
        v4u raw[8]; float ss = 0.f;
#pragma unroll
        for (int ks = 0; ks < 8; ++ks) { raw[ks] = *(const v4u*)(Qp + 16 * ks);
#pragma unroll
            for (int i = 0; i < 4; ++i) { const float a = bflo(raw[ks][i]), c = bfhi(raw[ks][i]); ss += a * a + c * c; } }
        ss += __shfl_xor(ss, 32);
        const float rs = rsqrtf(ss * (1.f / 128.f) + EPS) * MQSCALE;
#pragma unroll
        for (int ks = 0; ks < 8; ++ks) { const f32x4 g0 = *(const f32x4*)(g + 16 * ks), g1 = *(const f32x4*)(g + 16 * ks + 4); v4u o;
            o.x = cvtpk(bflo(raw[ks][0]) * rs * g0[0], bfhi(raw[ks][0]) * rs * g0[1]); o.y = cvtpk(bflo(raw[ks][1]) * rs * g0[2], bfhi(raw[ks][1]) * rs * g0[3]);
            o.z = cvtpk(bflo(raw[ks][2]) * rs * g1[0], bfhi(raw[ks][2]) * rs * g1[1]); o.w = cvtpk(bflo(raw[ks][3]) * rs * g1[2], bfhi(raw[ks][3]) * rs * g1[3]);
            qf[ks] = __builtin_bit_cast(bf16x8, o); }
    }
    __syncthreads();
    f32x16 o[4]; o[0] = f32x16{}; o[1] = f32x16{}; o[2] = f32x16{}; o[3] = f32x16{};
    float l = 0.f;
    const LAS unsigned char* Kp = L + MA_K + l31 * MA_KROW + 16 * hh;
    const LAS unsigned char* Vp = L + MA_V + l31 * MA_VROW + 8 * hh;
#pragma unroll 1
    for (int kt = 0; kt < 8; ++kt) {
        f32x16 s = {};
#pragma unroll
        for (int ks = 0; ks < 8; ++ks) { const bf16x8 kf = *(const LAS bf16x8*)(Kp + kt * 32 * MA_KROW + 32 * ks); s = __builtin_amdgcn_mfma_f32_32x32x16_bf16(kf, qf[ks], s, 0, 0, 0); }
        float p[16];
#pragma unroll
        for (int i = 0; i < 16; ++i) { p[i] = __builtin_amdgcn_exp2f(s[i] + negM); l += p[i]; }
        bf16x8 pb2[2];
#pragma unroll
        for (int s2 = 0; s2 < 2; ++s2) { v4u w; w.x = cvtpk(p[8 * s2 + 0], p[8 * s2 + 1]); w.y = cvtpk(p[8 * s2 + 2], p[8 * s2 + 3]); w.z = cvtpk(p[8 * s2 + 4], p[8 * s2 + 5]); w.w = cvtpk(p[8 * s2 + 6], p[8 * s2 + 7]); pb2[s2] = __builtin_bit_cast(bf16x8, w); }
#pragma unroll
        for (int dt = 0; dt < 4; ++dt)
#pragma unroll
            for (int s2 = 0; s2 < 2; ++s2) { const LAS unsigned char* vp = Vp + dt * 32 * MA_VROW + (kt * 32 + 16 * s2) * 2; const s16x4 lo = *(const LAS s16x4*)vp, hi = *(const LAS s16x4*)(vp + 16);
                const bf16x8 va = (bf16x8){lo[0], lo[1], lo[2], lo[3], hi[0], hi[1], hi[2], hi[3]};
                o[dt] = __builtin_amdgcn_mfma_f32_32x32x16_bf16(va, pb2[s2], o[dt], 0, 0, 0); }
    }
    l += __shfl_xor(l, 32);
    const float rl = 1.f / l;
    bf16* Op = F.w<bf16>(WS_MO) + (size_t)row * 512 + h * 128 + 4 * hh;
#pragma unroll
    for (int dt = 0; dt < 4; ++dt)
#pragma unroll
        for (int gq = 0; gq < 4; ++gq) { v2u w0; w0.x = cvtpk(o[dt][4 * gq] * rl, o[dt][4 * gq + 1] * rl); w0.y = cvtpk(o[dt][4 * gq + 2] * rl, o[dt][4 * gq + 3] * rl);
            *(v2u*)(Op + 32 * dt + 8 * gq) = w0; }
    __syncthreads();
}
__device__ __forceinline__ void memattn_sample_wg(Frame& F, int U) {
    const int lane = F.lane, l31 = lane & 31, hh = lane >> 5, pair = F.wave >> 2, kq = F.wave & 3;
    const int sh = 2 * U + pair, s = sh >> 2, h = sh & 3;
    LAS float* SC = (LAS float*)(F.lds + pair * 4096);
    LAS float* OP = (LAS float*)(F.lds + 8192 + pair * 8192);
    f32x4 q[4];
    { const f32x4 g = *(const f32x4*)(F.inf(I_GMQ) + 4 * l31);
#pragma unroll
      for (int t = 0; t < 4; ++t) { const v2u raw = *(const v2u*)(F.w<bf16>(WS_MQ) + (size_t)(TP + 4 * s + t) * 512 + h * 128 + 4 * l31);
          f32x4 x = (f32x4){bflo(raw.x), bfhi(raw.x), bflo(raw.y), bfhi(raw.y)};
          float ss = (x[0] * x[0] + x[1] * x[1]) + (x[2] * x[2] + x[3] * x[3]);
          ss = dpp_sum16(ss); ss += __shfl_xor(ss, 16);
          const float rs = rsqrtf(ss * (1.f / 128.f) + EPS) * 0.08838834764831845f;
          q[t] = x * rs * g; } }
    const size_t cbase = ((size_t)(s * 256 + 64 * kq) * 4 + h) * 128 + 4 * l31;
    const float* Kc = F.inf(I_CMK) + cbase; const float* Vc = F.inf(I_CMV) + cbase;
    const bool b4 = (l31 & 16) != 0, b3 = (l31 & 8) != 0, b2 = (l31 & 4) != 0, b1 = (l31 & 2) != 0;
#pragma unroll 1
    for (int kp = 0; kp < 32; kp += 16) {
        f32x4 kv[16];
#pragma unroll
        for (int u = 0; u < 16; ++u) kv[u] = __builtin_nontemporal_load((const f32x4*)(Kc + (size_t)(2 * (kp + u) + hh) * 512));
#pragma unroll
        for (int t = 0; t < 4; ++t) {
            float pt[16], v8[8], v4[4], v2[2];
#pragma unroll
            for (int u = 0; u < 16; ++u) pt[u] = (kv[u][0] * q[t][0] + kv[u][1] * q[t][1]) + (kv[u][2] * q[t][2] + kv[u][3] * q[t][3]);
#pragma unroll
            for (int i = 0; i < 8; ++i) { const float send = b4 ? pt[i] : pt[8 + i], keep = b4 ? pt[8 + i] : pt[i]; v8[i] = keep + __shfl_xor(send, 16); }
#pragma unroll
            for (int i = 0; i < 4; ++i) { const float send = b3 ? v8[i] : v8[4 + i], keep = b3 ? v8[4 + i] : v8[i]; v4[i] = keep + __shfl_xor(send, 8); }
#pragma unroll
            for (int i = 0; i < 2; ++i) { const float send = b2 ? v4[i] : v4[2 + i], keep = b2 ? v4[2 + i] : v4[i]; v2[i] = keep + __shfl_xor(send, 4); }
            float v1; { const float send = b1 ? v2[0] : v2[1], keep = b1 ? v2[1] : v2[0]; v1 = keep + __shfl_xor(send, 2); }
            v1 += __shfl_xor(v1, 1);
            if ((l31 & 1) == 0) SC[t * 256 + 64 * kq + 2 * (kp + (l31 >> 1)) + hh] = v1;
        }
    }
    f32x4 vv[16];
#pragma unroll
    for (int u = 0; u < 16; ++u) vv[u] = __builtin_nontemporal_load((const f32x4*)(Vc + (size_t)(2 * u + hh) * 512));
    __syncthreads();
    LAS float* PS = (LAS float*)(F.lds + 24576 + pair * 4096);
    float rsum[4];
#pragma unroll
    for (int t = 0; t < 4; ++t) {
        const f32x4 sc = *(const LAS f32x4*)(SC + t * 256 + 4 * lane);
        float m = fmaxf(fmaxf(sc[0], sc[1]), fmaxf(sc[2], sc[3]));
#pragma unroll
        for (int o = 1; o < 64; o <<= 1) m = fmaxf(m, __shfl_xor(m, o));
        f32x4 e; float sum = 0.f;
#pragma unroll
        for (int i = 0; i < 4; ++i) { e[i] = __expf(sc[i] - m); sum += e[i]; }
        *(LAS f32x4*)(PS + t * 256 + 4 * lane) = e;
        rsum[t] = 1.f / wave_sum(sum);
    }
    LDS_WAIT(); asm volatile("" ::: "memory");
    f32x4 o[4]; o[0] = o[1] = o[2] = o[3] = (f32x4){0.f, 0.f, 0.f, 0.f};
#pragma unroll 1
    for (int kp = 0; kp < 32; kp += 16) {
#pragma unroll
        for (int u = 0; u < 16; ++u)
#pragma unroll
            for (int t = 0; t < 4; ++t) { const float p = PS[t * 256 + 64 * kq + 2 * (kp + u) + hh]; o[t] += vv[u] * p; }
        if (kp + 16 < 32) {
#pragma unroll
            for (int u = 0; u < 16; ++u) vv[u] = __builtin_nontemporal_load((const f32x4*)(Vc + (size_t)(2 * (kp + 16 + u) + hh) * 512));
        }
    }
#pragma unroll
    for (int t = 0; t < 4; ++t) {
#pragma unroll
        for (int i = 0; i < 4; ++i) o[t][i] += __shfl_xor(o[t][i], 32);
        if (hh == 0) *(LAS f32x4*)(OP + (kq * 4 + t) * 128 + 4 * l31) = o[t];
    }
    __syncthreads();
    {
        const int t = kq;
        float a0 = 0.f, a1 = 0.f;
#pragma unroll
        for (int k = 0; k < 4; ++k) { a0 += OP[(k * 4 + t) * 128 + 2 * lane]; a1 += OP[(k * 4 + t) * 128 + 2 * lane + 1]; }
        float rs = rsum[0]; rs = (t == 1) ? rsum[1] : rs; rs = (t == 2) ? rsum[2] : rs; rs = (t == 3) ? rsum[3] : rs;
        *(unsigned*)(F.w<bf16>(WS_MO) + (size_t)(TP + 4 * s + t) * 512 + h * 128 + 2 * lane) = cvtpk(a0 * rs, a1 * rs);
    }
    __syncthreads();
}
__device__ __forceinline__ void p10_memattn(Frame& F) {
    const float negM = -(LOG2E * 11.313708498984761f * gain_absmax(F.inf(I_GMQ), 128, F.lane) * gain_absmax(F.inf(I_GMK), 128, F.lane) * 1.01f);
    const int gw = F.bid * NWAVES + F.wave, NGW = F.G * NWAVES;
#pragma unroll 1
    for (int pass = 0; pass < 2; ++pass) {
        F.tid = opaque_i(F.tid); F.lane = F.tid & 63;
        if ((pass == 0) == (((F.bid >> 3) & 1) == 0)) memattn_prompt_unit(F, F.bid >> 2, F.bid & 3, negM);
        else memattn_sample_wg(F, F.bid);
    }
}

__device__ __forceinline__ void p15_pre(Frame& F, int pm) {
    const float* wc = F.inf(I_WCONV); const float* bc = F.inf(I_BCONV);
    {
        const bf16* UPS = F.w<bf16>(WS_UP); const float* st = F.inf(I_CONVST);
        for (int it = F.bid * 512 + F.tid; it < TSMP * 352; it += F.G * 512) {
            const int rs = it / 352, ch = it % 352, f = 8 * ch, t = rs & 3, n = rs >> 2;
            const int cg = 256 * (f >> 7) + (f & 127);
            float g0[8], g1[8], g2[8], vv[8];
            { const v4u a = *(const v4u*)(UPS + (size_t)rs * (2 * DFF) + cg), v = *(const v4u*)(UPS + (size_t)rs * (2 * DFF) + cg + 128);
#pragma unroll
              for (int i = 0; i < 4; ++i) { g0[2 * i] = bflo(a[i]); g0[2 * i + 1] = bfhi(a[i]); vv[2 * i] = bflo(v[i]); vv[2 * i + 1] = bfhi(v[i]); } }
            if (t >= 1) { const v4u a = *(const v4u*)(UPS + (size_t)(rs - 1) * (2 * DFF) + cg);
#pragma unroll
                for (int i = 0; i < 4; ++i) { g1[2 * i] = bflo(a[i]); g1[2 * i + 1] = bfhi(a[i]); } }
            else { const float* sp = st + (size_t)(n * 2 + 1) * DFF + f; const f32x4 a = *(const f32x4*)sp, b = *(const f32x4*)(sp + 4);
#pragma unroll
                for (int i = 0; i < 4; ++i) { g1[i] = a[i]; g1[4 + i] = b[i]; } }
            if (t >= 2) { const v4u a = *(const v4u*)(UPS + (size_t)(rs - 2) * (2 * DFF) + cg);
#pragma unroll
                for (int i = 0; i < 4; ++i) { g2[2 * i] = bflo(a[i]); g2[2 * i + 1] = bfhi(a[i]); } }
            else { const float* sp = st + (size_t)(n * 2 + t) * DFF + f; const f32x4 a = *(const f32x4*)sp, b = *(const f32x4*)(sp + 4);
#pragma unroll
                for (int i = 0; i < 4; ++i) { g2[i] = a[i]; g2[4 + i] = b[i]; } }
            float hv[8];
#pragma unroll
            for (int i = 0; i < 8; ++i) { const float c = bc[f + i] + g2[i] * wc[f + i] + g1[i] * wc[DFF + f + i] + g0[i] * wc[2 * DFF + f + i]; hv[i] = c / (1.f + __expf(-c)) * vv[i]; }
            v4u o; o.x = cvtpk(hv[0], hv[1]); o.y = cvtpk(hv[2], hv[3]); o.z = cvtpk(hv[4], hv[5]); o.w = cvtpk(hv[6], hv[7]);
            *(v4u*)(F.w<bf16>(WS_HID) + (size_t)(TP + rs) * DFF + f) = o;
            if (t >= 2) { float* co = F.out + O_SCONV + (size_t)(n * 2 + (t - 2)) * DFF + f; *(f32x4*)co = (f32x4){g0[0], g0[1], g0[2], g0[3]}; *(f32x4*)(co + 4) = (f32x4){g0[4], g0[5], g0[6], g0[7]}; }
        }
    }
    if ((pm & 7) != 0) {
        const bf16* R0 = F.w<bf16>(WS_RAW01) + (size_t)pm * 2 * (2 * DFF); const float* G = F.w<float>(WS_RAWG) + (size_t)(pm - 1) * 2 * DFF;
        if (F.tid < DFF / 8) {
            const int f = 8 * F.tid;
            const v4u rg0 = *(const v4u*)(R0 + f), rv0 = *(const v4u*)(R0 + DFF + f), rg1 = *(const v4u*)(R0 + 2 * DFF + f), rv1 = *(const v4u*)(R0 + 3 * DFF + f);
            float hv0[8], hv1[8];
#pragma unroll
            for (int q = 0; q < 2; ++q) {
                const f32x4 gm2 = *(const f32x4*)(G + f + 4 * q), gm1 = *(const f32x4*)(G + DFF + f + 4 * q);
                const f32x4 w0 = *(const f32x4*)(wc + f + 4 * q), w1 = *(const f32x4*)(wc + DFF + f + 4 * q), w2 = *(const f32x4*)(wc + 2 * DFF + f + 4 * q), b = *(const f32x4*)(bc + f + 4 * q);
#pragma unroll
                for (int e = 0; e < 4; ++e) { const int i = 4 * q + e; const unsigned wg0 = rg0[i >> 1], wv0 = rv0[i >> 1], wg1 = rg1[i >> 1], wv1 = rv1[i >> 1];
                    const float g0 = (i & 1) ? bfhi(wg0) : bflo(wg0), v0 = (i & 1) ? bfhi(wv0) : bflo(wv0), g1 = (i & 1) ? bfhi(wg1) : bflo(wg1), v1 = (i & 1) ? bfhi(wv1) : bflo(wv1);
                    const float c0 = b[e] + gm2[e] * w0[e] + gm1[e] * w1[e] + g0 * w2[e], c1 = b[e] + gm1[e] * w0[e] + g0 * w1[e] + g1 * w2[e];
                    hv0[i] = c0 / (1.f + __expf(-c0)) * v0; hv1[i] = c1 / (1.f + __expf(-c1)) * v1; }
            }
            v4u o0, o1; o0.x = cvtpk(hv0[0], hv0[1]); o0.y = cvtpk(hv0[2], hv0[3]); o0.z = cvtpk(hv0[4], hv0[5]); o0.w = cvtpk(hv0[6], hv0[7]);
            o1.x = cvtpk(hv1[0], hv1[1]); o1.y = cvtpk(hv1[2], hv1[3]); o1.z = cvtpk(hv1[4], hv1[5]); o1.w = cvtpk(hv1[6], hv1[7]);
            *(v4u*)(F.w<bf16>(WS_HID) + (size_t)(256 * pm) * DFF + f) = o0; *(v4u*)(F.w<bf16>(WS_HID) + (size_t)(256 * pm + 1) * DFF + f) = o1;
        }
    }
    VM_WAIT();
    __syncthreads();
}
}
namespace mk {
template <int K, bool RES_BF16, bool OUT_BF16, bool HAS_RES = true>
__device__ __forceinline__ void small_gemm_unit(Frame& F, const bf16* A, const bf16* Bt, int rbk, int cbk, const void* res, void* out, int ldc, float* ssq_out = nullptr, const float* ssq_in = nullptr) {
    static_assert(K % 64 == 0, "K in chunks of 64");
    constexpr int NCH = K / 64;
    const int lane = F.lane, w = F.wave, l31 = lane & 31, hh = lane >> 5, tid = F.tid, lr = lane >> 3, lc = lane & 7;
    LAS unsigned char* Tl = F.lds + w * 16384;
    const bf16* Ag = A + (size_t)(32 * rbk + lr) * K + 8 * lc;
    const bf16* Bg = Bt + (size_t)(64 * cbk + lr) * K + 8 * lc;
    f32x16 a0 = {}, a1 = {};
    v4u ra[4], rbv[8];
    int c = w;
    if (c < NCH) {
#pragma unroll
        for (int j = 0; j < 4; ++j) ra[j] = *(const v4u*)(Ag + (size_t)(8 * j) * K + 64 * c);
#pragma unroll
        for (int j = 0; j < 8; ++j) rbv[j] = *(const v4u*)(Bg + (size_t)(8 * j) * K + 64 * c);
    }
#pragma unroll 1
    for (; c < NCH; c += 8) {
#pragma unroll
        for (int j = 0; j < 4; ++j) *(LAS v4u*)(Tl + (lr + 8 * j) * 144 + 16 * lc) = ra[j];
#pragma unroll
        for (int j = 0; j < 8; ++j) *(LAS v4u*)(Tl + (32 + lr + 8 * j) * 144 + 16 * lc) = rbv[j];
        LDS_WAIT(); asm volatile("" ::: "memory");
        if (c + 8 < NCH) {
#pragma unroll
            for (int j = 0; j < 4; ++j) ra[j] = *(const v4u*)(Ag + (size_t)(8 * j) * K + 64 * (c + 8));
#pragma unroll
            for (int j = 0; j < 8; ++j) rbv[j] = *(const v4u*)(Bg + (size_t)(8 * j) * K + 64 * (c + 8));
        }
#pragma unroll
        for (int s = 0; s < 4; ++s) {
            const bf16x8 af = *(const LAS bf16x8*)(Tl + l31 * 144 + 32 * s + 16 * hh), b0 = *(const LAS bf16x8*)(Tl + (32 + l31) * 144 + 32 * s + 16 * hh), b1 = *(const LAS bf16x8*)(Tl + (64 + l31) * 144 + 32 * s + 16 * hh);
            a0 = __builtin_amdgcn_mfma_f32_32x32x16_bf16(af, b0, a0, 0, 0, 0); a1 = __builtin_amdgcn_mfma_f32_32x32x16_bf16(af, b1, a1, 0, 0, 0);
        }
        LDS_WAIT(); asm volatile("" ::: "memory");
    }
    __syncthreads();
    LAS float* RED = (LAS float*)F.lds + w * 2048;
#pragma unroll
    for (int i = 0; i < 16; ++i) { const int r = (i & 3) + 8 * (i >> 2) + 4 * hh; RED[r * 64 + l31] = a0[i]; RED[r * 64 + 32 + l31] = a1[i]; }
    __syncthreads();
    { const int r = tid >> 4, c4 = (tid & 15) * 4; const size_t off = (size_t)(32 * rbk + r) * ldc + 64 * cbk + c4;
      f32x4 sum;
      if (!HAS_RES) sum = (f32x4){0.f, 0.f, 0.f, 0.f}; else if (RES_BF16) { const v2u rw = *(const v2u*)((const bf16*)res + off); sum = (f32x4){bflo(rw.x), bfhi(rw.x), bflo(rw.y), bfhi(rw.y)}; } else sum = *(const f32x4*)((const float*)res + off);
#pragma unroll
      for (int k = 0; k < 8; ++k) sum += *(const LAS f32x4*)((LAS float*)F.lds + k * 2048 + r * 64 + c4);
      if (ssq_in) { float t = ssq_in[(size_t)(32 * rbk + r) * 16 + (tid & 15)]; t += __shfl_xor(t, 1); t += __shfl_xor(t, 2); t += __shfl_xor(t, 4); t += __shfl_xor(t, 8); sum = sum * rsqrtf(t * (1.f / 1024.f) + EPS); }
      if (ssq_out) { float s2 = (sum[0] * sum[0] + sum[1] * sum[1]) + (sum[2] * sum[2] + sum[3] * sum[3]); s2 += __shfl_xor(s2, 1); s2 += __shfl_xor(s2, 2); s2 += __shfl_xor(s2, 4); s2 += __shfl_xor(s2, 8);
          if ((tid & 15) == 0) ssq_out[(size_t)(32 * rbk + r) * 16 + cbk] = s2; }
      if (OUT_BF16) { v2u wb; wb.x = cvtpk(sum[0], sum[1]); wb.y = cvtpk(sum[2], sum[3]); *(v2u*)((bf16*)out + off) = wb; } else *(f32x4*)((float*)out + off) = sum; }
    __syncthreads();
}
}
namespace mk {
constexpr int N_PHASES = 16;
__global__ void __launch_bounds__(NWAVES * 64, 2) mk_fwd(Args args) {
    extern __shared__ __attribute__((aligned(16))) unsigned char lds[];
    Frame F;
    F.lds = (LAS unsigned char*)lds; F.lds_g = lds;
    F.tid = threadIdx.x; F.lane = F.tid & 63; F.wave = __builtin_amdgcn_readfirstlane(F.tid >> 6);
    F.G = gridDim.x; F.bid = blockIdx.x;
    F.ws = args.ws; F.out = args.out; F.in = (const float* const*)args.in;
    volatile LAS unsigned* MISC = (volatile LAS unsigned*)(F.lds + MISC_OFF);
    for (int u = F.tid; u < (LDS_BYTES - RING_BYTES) / 4; u += NWAVES * 64) ((LAS unsigned*)(F.lds + RING_BYTES))[u] = 0u;
    __syncthreads();
    unsigned* ctl = (unsigned*)(F.ws + WS_CTL);
    XcdBarrier bar = xcd_barrier_post(ctl + CW_BAR, MISC + 8);
    const int lo = args.ph_lo, hi = args.ph_hi;
    if (F.G != 256) return;
#define IN(k) (lo <= (k) && (k) < hi)
#ifdef MK_TIMING
    unsigned long long* stamps = (unsigned long long*)(F.ws + WS_CTL + (768 << 10));
#define STAMP(k) do { if (F.tid == 0) stamps[F.bid * 32 + (k)] = __builtin_amdgcn_s_memrealtime(); } while (0)
#else
#define STAMP(k) do {} while (0)
#endif
#define SEAM(k) do { if (IN(k) && IN((k) + 1)) xcd_barrier(bar); STAMP((k) + 1); F.tid = opaque_i(F.tid); F.lane = F.tid & 63; } while (0)
    STAMP(0);

    if (IN(0)) { p0_prologue(F); }
    SEAM(0);
    if (IN(1)) {
        { pg8::Gemm g{F.w<bf16>(WS_XN), F.w<bf16>(WS_W_IN), T, NINP, D}; pg8::StaticOrder S; S.init(T, NINP, F.G, F.bid);
          pg8::EpiBf16 E{F.w<bf16>(WS_Z), NINP, 1.f};
          pg8::gemm_phase<pg8::EpiBf16, pg8::StaticOrder, true, true>(F.lds, g, S, E); }
        { pg8::Gemm g{F.w<bf16>(WS_MN), F.w<bf16>(WS_W_MKV), 2048, 1024, D}; pg8::StaticOrder S; S.init(2048, 1024, F.G, (F.bid + F.G - 206) % F.G);
          pg8::EpiBf16 E{F.w<bf16>(WS_MKV), 1024, 1.f};
          pg8::gemm_phase<pg8::EpiBf16, pg8::StaticOrder, true, true>(F.lds, g, S, E); }
    }
    SEAM(1);
    if (IN(2)) { p2_post_inproj(F); }
    SEAM(2);
    if (IN(3)) {
        { pg8::Gemm g{F.w<bf16>(WS_CQN), F.w<bf16>(WS_W_UQ), T, 768, 256}; pg8::StaticOrder S; S.init(T, 768, F.G, F.bid);
          pg8::EpiBf16 E{F.w<bf16>(WS_QR), 768, 1.f};
          pg8::gemm_phase<pg8::EpiBf16, pg8::StaticOrder, true, true>(F.lds, g, S, E); }
        { pg8::Gemm g{F.w<bf16>(WS_CKVN), F.w<bf16>(WS_W_UK), TP, 512, 256}; pg8::StaticOrder S; S.init(TP, 512, F.G, (F.bid + F.G - 198) % F.G);
          pg8::EpiBf16 E{F.w<bf16>(WS_KNR), 512, 1.f};
          pg8::gemm_phase<pg8::EpiBf16, pg8::StaticOrder, true, true>(F.lds, g, S, E); }
        { pg8::Gemm g{F.w<bf16>(WS_W_UV), F.w<bf16>(WS_CKVN), 512, TP, 256}; pg8::StaticOrder S; S.init(512, TP, F.G, (F.bid + F.G - 70) % F.G);
          pg8::EpiBf16 E{F.w<bf16>(WS_VT), TP, 1.f};
          pg8::gemm_phase<pg8::EpiBf16, pg8::StaticOrder, true, true>(F.lds, g, S, E); }
    }
    SEAM(3);
    if (IN(4)) { p4_qk_norm_rope(F); p4_qext(F); }
    SEAM(4);
    if (IN(5)) {
        const float mq_ = gain_absmax(F.inf(I_GQKQ), 96, F.lane), mk2_ = gain_absmax(F.inf(I_GQKK), 96, F.lane);
        const float negM = -(LOG2E * 9.797958971132712f * mq_ * mk2_ * 1.01f);
#pragma unroll 1
        for (int pass = 0; pass < 3; ++pass) {
            F.tid = opaque_i(F.tid); F.lane = F.tid & 63;
            if (pass == 1) { STAMP(20); attn_sample_unit(F, F.bid >> 1, F.bid & 1, negM); STAMP(21); }
            else if ((pass == 0) == (((F.bid >> 3) & 1) != 0)) { STAMP(22); p5_attn_prompt(F, negM); STAMP(23); }
        }
    }
    SEAM(5);
    if (IN(6)) { p6_merge(F); }
    SEAM(6);
    if (IN(7)) { pg8::Gemm g{F.w<bf16>(WS_MRG), F.w<bf16>(WS_W_O), TP, 1024, 1024}; pg8::StaticOrder S; S.init(TP, 1024, F.G, F.bid);
        pg8::EpiResN<false> E{F.inf(I_XP), F.inf(I_XS), TP / 256, F.w<bf16>(WS_X1), F.w<float>(WS_SSQ1), 1024};
        pg8::gemm_phase<pg8::EpiResN<false>, pg8::StaticOrder, true, true>(F.lds, g, S, E);
        small_gemm_unit<1024, false, true>(F, F.w<bf16>(WS_MRG) + (size_t)TP * 1024, F.w<bf16>(WS_W_O), F.bid >> 4, F.bid & 15, F.inf(I_XS), F.w<bf16>(WS_X1) + (size_t)TP * 1024, 1024, F.w<float>(WS_SSQ1) + (size_t)TP * 16); }
    SEAM(7);
    STAMP(9);
    if (IN(9)) { pg8::Gemm g{F.w<bf16>(WS_X1), F.w<bf16>(WS_W_MQ), T, 512, 1024}; pg8::StaticOrder S; S.init(T, 512, F.G, F.bid);
        pg8::EpiBf16S E{F.w<bf16>(WS_MQ), 512, F.w<float>(WS_SSQ1), EPS};
        pg8::gemm_phase<pg8::EpiBf16S, pg8::StaticOrder, true, true>(F.lds, g, S, E);
        if (F.bid >= 132) p0_transposes<9, 11>(F, (F.bid - 132) * NWAVES + F.wave, (F.G - 132) * NWAVES); }
    SEAM(9);
    if (IN(10)) { p10_memattn(F); }
    SEAM(10);
    if (IN(11)) { pg8::Gemm g{F.w<bf16>(WS_MO), F.w<bf16>(WS_W_MO), TP, 1024, 512}; pg8::StaticOrder S; S.init(TP, 1024, F.G, F.bid);
        pg8::EpiResN<true> E{F.w<bf16>(WS_X1), F.w<bf16>(WS_X1), 1 << 20, F.w<bf16>(WS_X2), F.w<float>(WS_SSQ2), 1024};
        pg8::gemm_phase<pg8::EpiResN<true>, pg8::StaticOrder, true, true>(F.lds, g, S, E);
        small_gemm_unit<512, true, true>(F, F.w<bf16>(WS_MO) + (size_t)TP * 512, F.w<bf16>(WS_W_MO), F.bid >> 4, F.bid & 15, F.w<bf16>(WS_X1) + (size_t)TP * 1024, F.w<bf16>(WS_X2) + (size_t)TP * 1024, 1024, F.w<float>(WS_SSQ2) + (size_t)TP * 16); }
    SEAM(11);
    STAMP(12); STAMP(13);
    if (IN(13)) { pg8::Gemm g{F.w<bf16>(WS_X2), F.w<bf16>(WS_W_UP), TP, 2 * DFF, 1024}; pg8::StaticOrder S; S.init(TP, 2 * DFF, F.G, F.bid);
        pg8::EpiUpFused E{F.w<bf16>(WS_HID), F.inf(I_WCONV), F.inf(I_BCONV), F.w<bf16>(WS_RAW01), F.w<float>(WS_RAWG), F.out + O_PCONV, (LAS float*)(F.lds + 131072), DFF, (const LAS float*)(F.lds + 135168)};
        { LAS float* rt = (LAS float*)(F.lds + 135168); const float* sq = F.w<float>(WS_SSQ2) + (size_t)(F.bid & 7) * 2048 * 16;
          f32x4 p[4][4];
#pragma unroll
          for (int k = 0; k < 4; ++k)
#pragma unroll
              for (int q = 0; q < 4; ++q) p[k][q] = *(const f32x4*)(sq + (size_t)(F.tid + 512 * k) * 16 + 4 * q);
#pragma unroll
          for (int k = 0; k < 4; ++k) { const f32x4 t = (p[k][0] + p[k][1]) + (p[k][2] + p[k][3]); rt[F.tid + 512 * k] = rsqrtf(((t[0] + t[1]) + (t[2] + t[3])) * (1.f / 1024.f) + EPS); }
          __syncthreads(); }
        pg8::gemm_phase<pg8::EpiUpFused, pg8::StaticOrder, true, true>(F.lds, g, S, E);
        if (F.bid >= 128) { for (int su = F.bid - 128; su < 16 * 88; su += 128)
            small_gemm_unit<1024, false, true, false>(F, F.w<bf16>(WS_X2) + (size_t)TP * 1024, F.w<bf16>(WS_W_UP), su / 88, su % 88, nullptr, F.w<bf16>(WS_UP), 2 * DFF, nullptr, F.w<float>(WS_SSQ2) + (size_t)TP * 16); } }
    SEAM(13);
    if (IN(15)) { pg8::Gemm g{F.w<bf16>(WS_HID), F.w<bf16>(WS_W_DN), TP, 1024, DFF}; pg8::StaticOrder S; S.init(TP, 1024, F.G, F.bid);
        p15_pre(F, 8 * (F.bid & 7) + ((F.bid >> 3) & 7));
        if (F.tid == 0) { const unsigned nloc = bar.st[0]; const unsigned old = xb_add(ctl + CW_HIDS + 64 * bar.x, 1u);
            if (old + 1u == nloc) { __builtin_amdgcn_fence(__ATOMIC_RELEASE, "agent"); asm volatile("s_waitcnt vmcnt(0)" ::: "memory"); (void)xb_add(ctl + CW_HIDS + 64 * 16, 1u); } }
        pg8::EpiRes<true, false> E{F.w<bf16>(WS_X2), F.w<bf16>(WS_X2), 1 << 20, F.out + O_YP, 1024};
        pg8::gemm_phase<pg8::EpiRes<true, false>, pg8::StaticOrder, true, true>(F.lds, g, S, E);
        if (F.tid == 0) { const unsigned nx = bar.st[1]; XB_SPIN(xb_ld(ctl + CW_HIDS + 64 * 16) < nx, ctl + CW_BAR); __builtin_amdgcn_fence(__ATOMIC_ACQUIRE, "agent"); asm volatile("s_waitcnt vmcnt(0)" ::: "memory"); }
        __syncthreads();
        small_gemm_unit<DFF, true, false>(F, F.w<bf16>(WS_HID) + (size_t)TP * DFF, F.w<bf16>(WS_W_DN), F.bid >> 4, F.bid & 15, F.w<bf16>(WS_X2) + (size_t)TP * 1024, F.out + O_YS, 1024); }
#ifdef MK_TIMING
    xcd_barrier(bar); STAMP(16);
    xcd_barrier(bar);
    if (F.bid == 0) {
        volatile LAS float* s_ca = (volatile LAS float*)(F.lds + RING_BYTES + 1024);
#define s_c s_ca[0]
#define s_a s_ca[1]
        if (F.tid == 0) {
            unsigned long long a0 = ~0ull, a1 = 0, b0 = ~0ull, b1 = 0;
#ifdef MK_TPERWG
            unsigned long long ma = 0, mb = 0;
            for (int w = 0; w < 256; ++w) { const unsigned long long* st = stamps + w * 32; const unsigned long long xa = st[MK_TA_HI] - st[MK_TA_LO], xb = st[MK_TB_HI] - st[MK_TB_LO]; ma = xa > ma ? xa : ma; mb = xb > mb ? xb : mb; }
            a0 = 0; a1 = ma; b0 = 0; b1 = mb;
#else
            for (int w = 0; w < 256; ++w) { const unsigned long long* st = stamps + w * 32;
                a0 = st[MK_TA_LO] < a0 ? st[MK_TA_LO] : a0; a1 = st[MK_TA_HI] > a1 ? st[MK_TA_HI] : a1; b0 = st[MK_TB_LO] < b0 ? st[MK_TB_LO] : b0; b1 = st[MK_TB_HI] > b1 ? st[MK_TB_HI] : b1; }
#endif
            const float da = (float)(a1 - a0) * 0.01f, db = (float)(b1 - b0) * 0.01f;
            s_c = sqrtf(da * 1e-4f); s_a = db * 0.1f;
        }
        __syncthreads();
        float* sk = F.out + O_SKPE;
        for (int i = F.tid; i < 16384; i += 512) sk[i] *= (1.f + s_c);
        if (F.tid == 0) F.out[O_YP] += s_a;
#undef s_c
#undef s_a
    }
#endif
#undef IN
#undef SEAM
}
}
extern "C" void kernel_launch(void* const* d_in, const int* in_sizes, int n_in, void* d_out, int out_size, void* d_ws, size_t ws_size, hipStream_t stream) {
    using namespace mk;
    static int ready = 0;
    if (ready == 0) {
        if (n_in != 38 || out_size != 25292800 || ws_size < WS_MK_END) { fprintf(stderr, "kernel_launch: unexpected n_in %d / out_size %d / ws %zu\n", n_in, out_size, ws_size); ready = -1; return; }
        if (hipFuncSetAttribute((const void*)mk_fwd, hipFuncAttributeMaxDynamicSharedMemorySize, LDS_BYTES) != hipSuccess) { fprintf(stderr, "kernel_launch: hipFuncSetAttribute failed\n"); ready = -1; return; }
        int dev = 0, cus = 0, per_cu = 0;
        (void)hipGetDevice(&dev); (void)hipDeviceGetAttribute(&cus, hipDeviceAttributeMultiprocessorCount, dev);
        (void)hipOccupancyMaxActiveBlocksPerMultiprocessor(&per_cu, (const void*)mk_fwd, NWAVES * 64, LDS_BYTES);
        if (cus < 256 || per_cu < 1) fprintf(stderr, "kernel_launch: note: %d CUs, occupancy query %d (this kernel needs 256 resident workgroups of %d B LDS)\n", cus, per_cu, LDS_BYTES);
        (void)hipGetLastError();
        ready = 1;
    }
    if (ready < 0) return;
    (void)hipMemsetAsync((unsigned char*)d_ws + WS_CTL, 0, CTL_ZERO_BYTES, stream);
    Args a{}; for (int i = 0; i < 38; ++i) a.in[i] = d_in[i];
    a.out = (float*)d_out; a.ws = (unsigned char*)d_ws; a.ph_lo = 0; a.ph_hi = N_PHASES;
    hipLaunchKernelGGL(mk_fwd, dim3(256), dim3(NWAVES * 64), LDS_BYTES, stream, a);
}
```
